# Optimizing an MI355X kernel written in HIP

```python
import jax, jax.numpy as jnp
from jax import lax
import numpy as np

D_MODEL = 4096
BATCH = 2
SEQ = 8192
DEPTH = 1

D_MIX = D_MODEL
HEAD_DIM = 128
ATTN_WIDTH = D_MIX // 2
N_ATTN_HEADS = ATTN_WIDTH // HEAD_DIM
CONV_WIDTH = D_MIX - ATTN_WIDTH
CONV_GROUP = 128
N_CONV_GROUPS = CONV_WIDTH // CONV_GROUP
CONV_K = 3
Q_BLOCK = 128
D_FF = ((8 * D_MODEL // 3 + 255) // 256) * 256
N_MOD = 6
EPS = 1e-6
IN_SPLITS = (ATTN_WIDTH, ATTN_WIDTH, ATTN_WIDTH, N_ATTN_HEADS, CONV_WIDTH, CONV_WIDTH, CONV_WIDTH)
N_IN = sum(IN_SPLITS)

kernel_name = "hymba_conv_fox_sandwich_adaln_block"


def rms_norm(x, g):
    xf = x.astype(jnp.float32)
    y = xf * lax.rsqrt(jnp.mean(xf * xf, axis=-1, keepdims=True) + EPS)
    return (y * g.astype(jnp.float32)).astype(x.dtype)


def modulate(h, shift, scale):
    return h * (1 + scale[:, None, :]) + shift[:, None, :]


def causal_short_conv(u, w):
    s = u.shape[1]
    u_pad = jnp.pad(u, ((0, 0), (CONV_K - 1, 0), (0, 0)))
    return sum(w[k][None, None, :] * u_pad[:, k:k + s, :] for k in range(CONV_K))


def forgetting_attention(q, k, v, f_logit):
    b, s, h, dh = q.shape
    scale = dh ** -0.5
    log_f = jax.nn.log_sigmoid(f_logit.astype(jnp.float32))
    F = jnp.cumsum(log_f, axis=1).transpose(0, 2, 1)
    qh = q.transpose(0, 2, 1, 3)
    kh = k.transpose(0, 2, 1, 3)
    vh = v.transpose(0, 2, 1, 3)
    nb = s // Q_BLOCK
    qb = qh.reshape(b, h, nb, Q_BLOCK, dh).transpose(2, 0, 1, 3, 4)
    Fb = F.reshape(b, h, nb, Q_BLOCK).transpose(2, 0, 1, 3)
    kpos = jnp.arange(s)

    def block(args):
        q_blk, F_blk, i = args
        logits = jnp.einsum('bhqd,bhkd->bhqk', q_blk, kh).astype(jnp.float32) * scale
        logits = logits + F_blk[..., None] - F[:, :, None, :]
        qpos = i * Q_BLOCK + jnp.arange(Q_BLOCK)
        mask = kpos[None, :] <= qpos[:, None]
        logits = jnp.where(mask[None, None], logits, -jnp.inf)
        p = jax.nn.softmax(logits, axis=-1)
        return jnp.einsum('bhqk,bhkd->bhqd', p.astype(vh.dtype), vh)

    out = lax.map(block, (qb, Fb, jnp.arange(nb)))
    return out.transpose(1, 0, 3, 2, 4).reshape(b, s, h * dh)


def hybrid_mixer(h, w_in, b_f, conv_w, attn_out_norm, conv_out_norm, w_out):
    b, s, _ = h.shape
    proj = jnp.einsum('bsd,dn->bsn', h, w_in)
    idx = list(np.cumsum(IN_SPLITS)[:-1])
    q, k, v, f_logit, gate_b, gate_c, u = jnp.split(proj, idx, axis=-1)
    q = q.reshape(b, s, N_ATTN_HEADS, HEAD_DIM)
    k = k.reshape(b, s, N_ATTN_HEADS, HEAD_DIM)
    v = v.reshape(b, s, N_ATTN_HEADS, HEAD_DIM)
    y_attn = forgetting_attention(q, k, v, f_logit + b_f)
    y_conv = gate_b * causal_short_conv(gate_c * u, conv_w)
    y = jnp.concatenate([rms_norm(y_attn, attn_out_norm), rms_norm(y_conv, conv_out_norm)], axis=-1)
    return jnp.einsum('bsm,md->bsd', y, w_out)


def swiglu(h, w_gate, w_up, w_down):
    g = jnp.einsum('bsd,df->bsf', h, w_gate)
    u = jnp.einsum('bsd,df->bsf', h, w_up)
    return jnp.einsum('bsf,fd->bsd', jax.nn.silu(g) * u, w_down)


def setup_inputs(seed: int = 0) -> dict:
    key = jax.random.key(seed)
    ks = jax.random.split(key, 20)
    d = D_MODEL
    L = DEPTH
    nrm = lambda k, shape, s: jax.random.normal(k, shape, jnp.float32) * s
    gain = lambda k, n: 1.0 + nrm(k, (L, n), 0.05)
    return {
        "x": nrm(ks[0], (BATCH, SEQ, d), 1.0),
        "c": nrm(ks[1], (BATCH, d), 1.0),
        "w_ada": nrm(ks[2], (L, d, N_MOD * d), 0.5 * d ** -0.5),
        "b_ada": nrm(ks[3], (L, N_MOD * d), 0.01),
        "pre_norm_mix": gain(ks[4], d),
        "w_in": nrm(ks[5], (L, d, N_IN), d ** -0.5),
        "b_f": jax.random.uniform(ks[6], (L, N_ATTN_HEADS), jnp.float32, 1.0, 4.0),
        "conv_w": nrm(ks[7], (L, CONV_K, CONV_WIDTH), CONV_K ** -0.5),
        "attn_out_norm": gain(ks[8], ATTN_WIDTH),
        "conv_out_norm": gain(ks[9], CONV_WIDTH),
        "w_out": nrm(ks[10], (L, D_MIX, d), D_MIX ** -0.5),
        "post_norm_mix": gain(ks[11], d),
        "pre_norm_ffn": gain(ks[12], d),
        "w_gate": nrm(ks[13], (L, d, D_FF), d ** -0.5),
        "w_up": nrm(ks[14], (L, d, D_FF), d ** -0.5),
        "w_down": nrm(ks[15], (L, D_FF, d), D_FF ** -0.5),
        "post_norm_ffn": gain(ks[16], d),
    }


def reference(x, c, w_ada, b_ada, pre_norm_mix, w_in, b_f, conv_w, attn_out_norm,
              conv_out_norm, w_out, post_norm_mix, pre_norm_ffn, w_gate, w_up, w_down,
              post_norm_ffn):
    c_act = jax.nn.silu(c)
    for l in range(DEPTH):
        mod = jnp.einsum('bd,dm->bm', c_act, w_ada[l]) + b_ada[l]
        sh1, sc1, g1, sh2, sc2, g2 = jnp.split(mod, N_MOD, axis=-1)
        h = modulate(rms_norm(x, pre_norm_mix[l]), sh1, sc1)
        h = hybrid_mixer(h, w_in[l], b_f[l], conv_w[l], attn_out_norm[l], conv_out_norm[l], w_out[l])
        x = x + g1[:, None, :] * rms_norm(h, post_norm_mix[l])
        h = modulate(rms_norm(x, pre_norm_ffn[l]), sh2, sc2)
        h = swiglu(h, w_gate[l], w_up[l], w_down[l])
        x = x + g2[:, None, :] * rms_norm(h, post_norm_ffn[l])
    return x
```

```cpp
#include <hip/hip_runtime.h>
#include <cstdio>
#include <cstdint>
#include <cmath>
#ifndef DUP_MASK
#define DUP_MASK 0
#endif
__device__ __forceinline__ int opaque_tid(int wave_s) { int l; asm volatile("v_mbcnt_lo_u32_b32 %0, -1, 0\n\tv_mbcnt_hi_u32_b32 %0, -1, %0" : "=v"(l)); return (wave_s << 6) | l; }
namespace pg8 {
#define PG8_LAS __attribute__((address_space(3)))
typedef unsigned short bf16_t;
typedef short bf16x8 __attribute__((ext_vector_type(8)));
typedef float f32x4 __attribute__((ext_vector_type(4)));
typedef unsigned u32x4 __attribute__((ext_vector_type(4)));
constexpr int BM = 256, BK = 64, HALF = 128, HTB = HALF * BK * 2  , STAGE_BYTES = 8 * HTB, NXCD = 8, WGM = 8;

__host__ __device__ __forceinline__ int lds_byte(int r, int c) { const int st = (r >> 4) * 2 + (c >> 5), rr = r & 15, cc = c & 31, ob = rr * 64 + cc * 2; return st * 1024 + (ob ^ (((ob >> 9) & 1) << 5)); }
__host__ __device__ __forceinline__ void stage_rc(int b, int& R, int& C) { const int st = b / 1024, sb = b % 1024, swz = sb ^ (((sb >> 9) & 1) << 5); R = (st >> 1) * 16 + swz / 64; C = (st & 1) * 32 + (swz % 64) / 2; }
__host__ __device__ __forceinline__ int perm32(int rho) { const int n = rho >> 4, i = rho & 15; return 8 * (i >> 2) + 4 * n + (i & 3); }

struct Unit { int pm, pn; };
struct Gemm { const bf16_t* A; const bf16_t* Bt; int M, N, K; };

struct StaticOrder {
    int nM, nN, nwg, G, c;
    __host__ __device__ void init(int M, int N, int G_, int c_) { nM = M / BM; nN = N / BM; nwg = nM * nN; G = G_; c = c_; }
    __host__ __device__ bool next(int i, Unit& u) const {
        const long L = (long)i * G + c; if (L >= nwg) return false;
        int wgid = (int)L; { const int q = nwg / NXCD, r = nwg % NXCD, xcd = wgid % NXCD, off = wgid / NXCD; wgid = (xcd < r ? xcd * (q + 1) : r * (q + 1) + (xcd - r) * q) + off; }
        const int nig = WGM * nN, gid = wgid / nig, fm = gid * WGM, gsz = (nM - fm) < WGM ? (nM - fm) : WGM;
        u.pm = fm + ((wgid % nig) % gsz); u.pn = (wgid % nig) / gsz; return true;
    }
    __device__ __forceinline__ void a_ready(const Unit&) const {}
    __device__ __forceinline__ void done(const Unit&) const {}
};
__device__ __forceinline__ unsigned cvt_pk_bf16(float lo, float hi) { unsigned r; asm volatile("v_cvt_pk_bf16_f32 %0, %1, %2" : "=v"(r) : "v"(lo), "v"(hi)); return r; }
typedef float f32x2 __attribute__((ext_vector_type(2)));
struct EpiPlain {
    static constexpr bool PERM = true, AFTER_DRAIN = false;
    bf16_t* O; int ldc;
    __device__ __forceinline__ void operator()(const f32x4 (&acc)[2][2][4][2], const Unit& u, int wr, int wc, int fr, int fq) const {
        const int row0 = u.pm * BM + wr * 64 + fr, col0 = u.pn * BM + wc * 32 + 8 * fq;
#pragma unroll
        for (int ai = 0; ai < 2; ++ai)
#pragma unroll
            for (int m = 0; m < 4; ++m) { bf16_t* rowp = O + (size_t)(row0 + ai * HALF + m * 16) * ldc + col0;
#pragma unroll
                for (int bj = 0; bj < 2; ++bj) { const f32x4 v0 = acc[ai][bj][m][0], v1 = acc[ai][bj][m][1];
                    u32x4 w; w.x = cvt_pk_bf16(v0[0], v0[1]); w.y = cvt_pk_bf16(v0[2], v0[3]); w.z = cvt_pk_bf16(v1[0], v1[1]); w.w = cvt_pk_bf16(v1[2], v1[3]);
                    *(u32x4*)(rowp + bj * HALF) = w; } }
    }
};
struct EpiInProj {
    static constexpr bool PERM = true, AFTER_DRAIN = false;
    bf16_t *Q, *K, *V, *GB, *CU; float qscale; unsigned* qkmax;
    __device__ __forceinline__ void operator()(const f32x4 (&acc)[2][2][4][2], const Unit& u, int wr, int wc, int fr, int fq) const {
        const int row0 = u.pm * BM + wr * 64 + fr;
        if (u.pn < 32) {
            const int t = u.pn >> 3; bf16_t* base = (t == 0) ? Q : (t == 1) ? K : (t == 2) ? V : GB; const float s = (t == 0) ? qscale : 1.f;
            const int col0 = (u.pn & 7) * BM + wc * 32 + 8 * fq;
#pragma unroll
            for (int ai = 0; ai < 2; ++ai)
#pragma unroll
                for (int m = 0; m < 4; ++m) { bf16_t* rowp = base + (size_t)(row0 + ai * HALF + m * 16) * 2048 + col0;
#pragma unroll
                    for (int bj = 0; bj < 2; ++bj) { const f32x4 v0 = acc[ai][bj][m][0] * s, v1 = acc[ai][bj][m][1] * s;
                        u32x4 w; w.x = cvt_pk_bf16(v0[0], v0[1]); w.y = cvt_pk_bf16(v0[2], v0[3]); w.z = cvt_pk_bf16(v1[0], v1[1]); w.w = cvt_pk_bf16(v1[2], v1[3]);
                        *(u32x4*)(rowp + bj * HALF) = w; } }
            if (t <= 1) {
                float mx[2] = {0.f, 0.f};
#pragma unroll
                for (int ai = 0; ai < 2; ++ai)
#pragma unroll
                    for (int m = 0; m < 4; ++m)
#pragma unroll
                        for (int bj = 0; bj < 2; ++bj) { const f32x4 v0 = acc[ai][bj][m][0] * s, v1 = acc[ai][bj][m][1] * s;
                            float ss = (v0[0] * v0[0] + v0[1] * v0[1]) + (v0[2] * v0[2] + v0[3] * v0[3]) + (v1[0] * v1[0] + v1[1] * v1[1]) + (v1[2] * v1[2] + v1[3] * v1[3]);
                            ss += __shfl_xor(ss, 16); ss += __shfl_xor(ss, 32); mx[bj] = fmaxf(mx[bj], ss); }
#pragma unroll
                for (int bj = 0; bj < 2; ++bj) { float mm = mx[bj];
#pragma unroll
                    for (int o = 1; o < 16; o <<= 1) mm = fmaxf(mm, __shfl_xor(mm, o));
                    if (fr == 0 && fq == 0) __hip_atomic_fetch_max(qkmax + (((u.pm >> 5) * 16 + (u.pn & 7) * 2 + bj) * 2 + t) * 4 + wc, __float_as_uint(mm), __ATOMIC_RELAXED, __HIP_MEMORY_SCOPE_AGENT); }
            }
        } else {
            const int col0 = (u.pn - 32) * HALF + wc * 32 + 8 * fq;
#pragma unroll
            for (int ai = 0; ai < 2; ++ai)
#pragma unroll
                for (int m = 0; m < 4; ++m) { bf16_t* rowp = CU + (size_t)(row0 + ai * HALF + m * 16) * 2048 + col0;
                    const f32x4 v0 = acc[ai][0][m][0] * acc[ai][1][m][0], v1 = acc[ai][0][m][1] * acc[ai][1][m][1];
                    u32x4 w; w.x = cvt_pk_bf16(v0[0], v0[1]); w.y = cvt_pk_bf16(v0[2], v0[3]); w.z = cvt_pk_bf16(v1[0], v1[1]); w.w = cvt_pk_bf16(v1[2], v1[3]);
                    *(u32x4*)rowp = w; }
        }
    }
};
struct EpiSwiGLU {
    static constexpr bool PERM = true, AFTER_DRAIN = false;
    bf16_t* O; int ldc;
    __device__ __forceinline__ void operator()(const f32x4 (&acc)[2][2][4][2], const Unit& u, int wr, int wc, int fr, int fq) const {
        const int row0 = u.pm * BM + wr * 64 + fr, col0 = u.pn * HALF + wc * 32 + 8 * fq;
#pragma unroll
        for (int ai = 0; ai < 2; ++ai)
#pragma unroll
            for (int m = 0; m < 4; ++m) { bf16_t* rowp = O + (size_t)(row0 + ai * HALF + m * 16) * ldc + col0;
                f32x4 r[2];
#pragma unroll
                for (int n = 0; n < 2; ++n) { const f32x4 g = acc[ai][0][m][n], up = acc[ai][1][m][n];
#pragma unroll
                    for (int j = 0; j < 4; ++j) { const float e = __builtin_amdgcn_exp2f(g[j] * -1.4426950408889634f); r[n][j] = g[j] * up[j] * __builtin_amdgcn_rcpf(1.0f + e); } }
                u32x4 w; w.x = cvt_pk_bf16(r[0][0], r[0][1]); w.y = cvt_pk_bf16(r[0][2], r[0][3]); w.z = cvt_pk_bf16(r[1][0], r[1][1]); w.w = cvt_pk_bf16(r[1][2], r[1][3]);
                *(u32x4*)rowp = w; }
    }
};

template <class Epi, class Sched, bool ALIGN_EPI = false, bool SP2 = false>
__device__ __forceinline__ void gemm_phase(PG8_LAS unsigned char* lds, const Gemm g, const Sched& S, const Epi& E, const int tid) {
    const int wid = __builtin_amdgcn_readfirstlane(tid >> 6), lane = tid & 63, wr = wid >> 2, wc = wid & 3, fr = lane & 15, fq = lane >> 4;
    const int K = g.K, nt = K / BK;
    unsigned voffA[2], voffB[2];
#pragma unroll
    for (int i = 0; i < 2; ++i) { int R, C; stage_rc(tid * 16 + i * 8192, R, C); const int Rb = Epi::PERM ? ((R & ~31) + perm32(R & 31)) : R;
        voffA[i] = (unsigned)(R * K + C) * 2u; voffB[i] = (unsigned)(Rb * K + C) * 2u; }
    const size_t kstep = (size_t)(BK * 2);
    const size_t hstep = (size_t)HALF * K * 2;
    const size_t tstep = 2 * hstep;
    const unsigned ldsw = (unsigned)wid * 1024u;
    const int aoff = lds_byte(wr * 64 + fr, fq * 8), boff = lds_byte(wc * 32 + fr, fq * 8);
#define PG8_SA(b, h) (((b) * 2 + (h)) * HTB)
#define PG8_SB(b, h) ((4 + (b) * 2 + (h)) * HTB)
#define PG8_STAGE(bufoff, gbase, voff) do { _Pragma("unroll") for (int _i = 0; _i < 2; ++_i) \
        __builtin_amdgcn_global_load_lds((const unsigned*)((const char*)(gbase) + (voff)[_i]), (PG8_LAS unsigned*)(lds + (bufoff) + ldsw + _i * 8192), 16, 0, 0); } while (0)
#define PG8_LDA(dst, b, h) do { _Pragma("unroll") for (int m = 0; m < 4; ++m) _Pragma("unroll") for (int k = 0; k < 2; ++k) dst[m][k] = *(const PG8_LAS bf16x8*)(lds + PG8_SA(b, h) + aoff + m * 2048 + k * 1024); } while (0)
#define PG8_LDB(dst, b, h) do { _Pragma("unroll") for (int n = 0; n < 2; ++n) _Pragma("unroll") for (int k = 0; k < 2; ++k) dst[n][k] = *(const PG8_LAS bf16x8*)(lds + PG8_SB(b, h) + boff + n * 2048 + k * 1024); } while (0)
#define PG8_MMA(ai, bj, At, Bt) do { __builtin_amdgcn_s_setprio(1); _Pragma("unroll") for (int m = 0; m < 4; ++m) _Pragma("unroll") for (int n = 0; n < 2; ++n) _Pragma("unroll") for (int k = 0; k < 2; ++k) \
        acc[ai][bj][m][n] = __builtin_amdgcn_mfma_f32_16x16x32_bf16(Bt[n][k], At[m][k], acc[ai][bj][m][n], 0, 0, 0); __builtin_amdgcn_s_setprio(0); } while (0)
#define PG8_WAIT_V(n) asm volatile("s_waitcnt vmcnt(" #n ")" ::: "memory")
#define PG8_WAIT_L(n) asm volatile("s_waitcnt lgkmcnt(" #n ")" ::: "memory")
#define PG8_BAR __builtin_amdgcn_s_barrier()
#define PG8_SCHED __builtin_amdgcn_sched_barrier(0)
    Unit cur, nxt; int ui = 0;
    if (!S.next(0, cur)) return;
    f32x4 acc[2][2][4][2];
#pragma unroll
    for (int a = 0; a < 2; ++a)
#pragma unroll
        for (int b = 0; b < 2; ++b)
#pragma unroll
            for (int m = 0; m < 4; ++m)
#pragma unroll
                for (int n = 0; n < 2; ++n) acc[a][b][m][n] = (f32x4){0.f, 0.f, 0.f, 0.f};
    bf16x8 At[4][2], B0[2][2], B1[2][2];
    const char* cA = (const char*)g.A + (size_t)cur.pm * tstep; const char* cB = (const char*)g.Bt + (size_t)cur.pn * tstep;
    S.a_ready(cur);
    if constexpr (SP2) {
        PG8_STAGE(PG8_SB(0, 0), cB, voffB); PG8_STAGE(PG8_SB(0, 1), cB + hstep, voffB); PG8_STAGE(PG8_SA(0, 0), cA, voffA); PG8_STAGE(PG8_SA(0, 1), cA + hstep, voffA);
        if (wr == 1) PG8_BAR;
        PG8_WAIT_V(2); PG8_BAR;
        PG8_STAGE(PG8_SB(1, 0), cB + kstep, voffB); PG8_STAGE(PG8_SA(1, 0), cA + kstep, voffA); PG8_STAGE(PG8_SB(1, 1), cB + hstep + kstep, voffB);
        PG8_WAIT_V(6); PG8_BAR;
    } else {
        PG8_STAGE(PG8_SB(0, 0), cB, voffB); PG8_STAGE(PG8_SA(0, 0), cA, voffA); PG8_STAGE(PG8_SB(0, 1), cB + hstep, voffB); PG8_STAGE(PG8_SA(0, 1), cA + hstep, voffA);
        if (wr == 1) PG8_BAR;
        PG8_WAIT_V(4); PG8_BAR;
        PG8_STAGE(PG8_SB(1, 0), cB + kstep, voffB); PG8_STAGE(PG8_SA(1, 0), cA + kstep, voffA); PG8_STAGE(PG8_SB(1, 1), cB + hstep + kstep, voffB);
        PG8_WAIT_V(6); PG8_BAR;
    }
    for (;;) {
        const bool has_next = S.next(ui + 1, nxt);
        const char* nA = has_next ? (const char*)g.A + (size_t)nxt.pm * tstep : cA; const char* nB = has_next ? (const char*)g.Bt + (size_t)nxt.pn * tstep : cB;
        for (int t = 0; t < nt; t += 2) {
            const bool last = (t == nt - 2);
            const char* a1 = cA + (size_t)(t + 1) * kstep;
            const char* a2 = last ? nA : cA + (size_t)(t + 2) * kstep; const char* b2 = last ? nB : cB + (size_t)(t + 2) * kstep;
            const char* a3 = a2 + kstep; const char* b3 = b2 + kstep;
            if (last && has_next) S.a_ready(nxt);
            if constexpr (SP2) {
            PG8_LDB(B0, 0, 0); PG8_LDB(B1, 0, 1); PG8_SCHED; PG8_LDA(At, 0, 0); PG8_STAGE(PG8_SA(1, 1), a1 + hstep, voffA);
            PG8_WAIT_V(8); PG8_WAIT_L(0); PG8_BAR; PG8_MMA(0, 0, At, B0); PG8_MMA(0, 1, At, B1); PG8_BAR; PG8_SCHED;
            PG8_LDA(At, 0, 1); PG8_STAGE(PG8_SB(0, 0), b2, voffB); PG8_STAGE(PG8_SB(0, 1), b2 + hstep, voffB); PG8_STAGE(PG8_SA(0, 0), a2, voffA);
            PG8_WAIT_V(8); PG8_WAIT_L(0); PG8_BAR; PG8_MMA(1, 0, At, B0); PG8_MMA(1, 1, At, B1); PG8_BAR; PG8_SCHED;
            PG8_LDB(B0, 1, 0); PG8_LDB(B1, 1, 1); PG8_SCHED; PG8_LDA(At, 1, 0); PG8_STAGE(PG8_SA(0, 1), a2 + hstep, voffA);
            PG8_WAIT_V(8); PG8_WAIT_L(0); PG8_BAR; PG8_MMA(0, 0, At, B0); PG8_MMA(0, 1, At, B1); PG8_BAR; PG8_SCHED;
            PG8_LDA(At, 1, 1); PG8_STAGE(PG8_SB(1, 0), b3, voffB); PG8_STAGE(PG8_SB(1, 1), b3 + hstep, voffB); PG8_STAGE(PG8_SA(1, 0), a3, voffA);
            PG8_WAIT_V(8); PG8_WAIT_L(0); PG8_BAR; PG8_MMA(1, 0, At, B0); PG8_MMA(1, 1, At, B1); PG8_BAR; PG8_SCHED;
            } else {
            PG8_LDB(B0, 0, 0); PG8_SCHED; PG8_LDA(At, 0, 0); PG8_STAGE(PG8_SA(1, 1), a1 + hstep, voffA);
            PG8_WAIT_L(8); PG8_BAR; PG8_WAIT_L(0); PG8_MMA(0, 0, At, B0); PG8_BAR; PG8_SCHED;
            PG8_LDB(B1, 0, 1); PG8_STAGE(PG8_SB(0, 0), b2, voffB);
            PG8_BAR; PG8_WAIT_L(0); PG8_MMA(0, 1, At, B1); PG8_BAR;
            PG8_LDA(At, 0, 1); PG8_STAGE(PG8_SA(0, 0), a2, voffA);
            PG8_BAR; PG8_WAIT_L(0); PG8_MMA(1, 0, At, B0); PG8_BAR; PG8_SCHED;
            PG8_STAGE(PG8_SB(0, 1), b2 + hstep, voffB);
            PG8_WAIT_V(6); PG8_BAR; PG8_MMA(1, 1, At, B1); PG8_BAR;
            PG8_LDB(B0, 1, 0); PG8_SCHED; PG8_LDA(At, 1, 0); PG8_STAGE(PG8_SA(0, 1), a2 + hstep, voffA);
            PG8_WAIT_L(8); PG8_BAR; PG8_WAIT_L(0); PG8_MMA(0, 0, At, B0); PG8_BAR; PG8_SCHED;
            PG8_LDB(B1, 1, 1); PG8_STAGE(PG8_SB(1, 0), b3, voffB);
            PG8_BAR; PG8_WAIT_L(0); PG8_MMA(0, 1, At, B1); PG8_BAR;
            PG8_LDA(At, 1, 1); PG8_STAGE(PG8_SA(1, 0), a3, voffA);
            PG8_BAR; PG8_WAIT_L(0); PG8_MMA(1, 0, At, B0); PG8_BAR; PG8_SCHED;
            PG8_STAGE(PG8_SB(1, 1), b3 + hstep, voffB);
            PG8_WAIT_V(6); PG8_BAR; PG8_MMA(1, 1, At, B1); PG8_BAR;
            }
        }
        if constexpr (ALIGN_EPI) { if (wr == 0) PG8_BAR; }
        if constexpr (!Epi::AFTER_DRAIN) { E(acc, cur, wr, wc, fr, fq); S.done(cur); }
        if (!has_next) break;
#pragma unroll
        for (int a = 0; a < 2; ++a)
#pragma unroll
            for (int b = 0; b < 2; ++b)
#pragma unroll
                for (int m = 0; m < 4; ++m)
#pragma unroll
                    for (int n = 0; n < 2; ++n) acc[a][b][m][n] = (f32x4){0.f, 0.f, 0.f, 0.f};
        cur = nxt; cA = nA; cB = nB; ++ui;
        if constexpr (ALIGN_EPI) { if (wr == 1) PG8_BAR; }
    }
    PG8_WAIT_V(0);
    if constexpr (!ALIGN_EPI) { if (wr == 0) PG8_BAR; }
    PG8_BAR;
    if constexpr (Epi::AFTER_DRAIN) { E.fused(acc, cur, wr, wc, fr, fq, lds, wid, lane); S.done(cur); }
#undef PG8_SA
#undef PG8_SB
#undef PG8_STAGE
#undef PG8_LDA
#undef PG8_LDB
#undef PG8_MMA
#undef PG8_WAIT_V
#undef PG8_WAIT_L
#undef PG8_BAR
#undef PG8_SCHED
}
}
namespace fa {
typedef unsigned short bf16;
typedef short bf16x8 __attribute__((ext_vector_type(8)));
typedef short s16x4 __attribute__((ext_vector_type(4)));
typedef float f32x16 __attribute__((ext_vector_type(16)));
typedef float f32x4 __attribute__((ext_vector_type(4)));
typedef unsigned u32x4 __attribute__((ext_vector_type(4)));
constexpr int D = 128, PITCH = 2048, SEQ = 8192, NHEAD = 16;
constexpr int NW = 8, QBLK = 32, KVBLK = 64, QB = NW * QBLK, NQB = SEQ / QB;
constexpr int SHM_V = KVBLK * D * 2, SHM_K = KVBLK * D * 2;
constexpr int F_OFF = 2 * SHM_V + 2 * SHM_K + NW * 64 * 4 + 2048;
constexpr int ATT_LDS_BYTES = F_OFF + SEQ * 4 + 256;
constexpr float THR2 = 11.5415603f;
#define FA_KSWZ(row, colB) ((row) * 256 + ((colB) ^ (((row) & 7) << 4)))
#define FA_SBAR() __builtin_amdgcn_sched_barrier(0)
__device__ __forceinline__ int v_st(int k, int c) { const int kk = (k & ~0xC) | ((k & 4) << 1) | ((k & 8) >> 1); return ((kk >> 3) * 4 + (c >> 5)) * 512 + ((kk & 7) * 32 + (c & 31)) * 2; }
__device__ __forceinline__ int v_rd_base(int lane) { return ((lane & 3) << 3) | (((lane >> 2) & 3) << 6) | (((lane >> 4) & 1) << 5) | (((lane >> 5) & 1) << 8); }
constexpr int v_rd_off(int d0, int ks, int half) { return d0 * 512 + ks * 4096 + half * 2048; }
__device__ __forceinline__ int crow(int r, int hi) { return (r & 3) + 8 * (r >> 2) + 4 * hi; }
__device__ __forceinline__ unsigned cvtpk(float lo, float hi) { unsigned r; asm volatile("v_cvt_pk_bf16_f32 %0, %1, %2" : "=v"(r) : "v"(lo), "v"(hi)); return r; }
__device__ __forceinline__ bf16x8 load8(const bf16* p) { return *reinterpret_cast<const bf16x8*>(p); }
__device__ __forceinline__ void mask_tile(f32x16& p0, f32x16& p1, int dq) {
#pragma unroll
    for (int r = 0; r < 16; ++r) { const int c = (r & 3) + 8 * (r >> 2);
        const float t0 = __uint_as_float(0x7f800000u | ((unsigned)(dq - c) & 0x80000000u)), t1 = __uint_as_float(0x7f800000u | ((unsigned)(dq - c - 32) & 0x80000000u));
        p0[r] = fminf(p0[r], t0); p1[r] = fminf(p1[r], t1); }
}
__device__ __forceinline__ void partialSM(f32x16& p0, f32x16& p1, float& m_reg, float& mn, float& alpha) {
    float pmax = p0[0];
#pragma unroll
    for (int r = 1; r < 16; ++r) pmax = fmaxf(pmax, p0[r]);
#pragma unroll
    for (int r = 0; r < 16; ++r) pmax = fmaxf(pmax, p1[r]);
    { auto rr = __builtin_amdgcn_permlane32_swap(__float_as_uint(pmax), __float_as_uint(pmax), false, false);
      pmax = fmaxf(__uint_as_float(rr[0]), __uint_as_float(rr[1])); }
    if (__builtin_expect(__all((pmax - m_reg) <= THR2), 1)) { mn = m_reg; alpha = 1.f; }
    else { mn = fmaxf(m_reg, pmax); alpha = __builtin_amdgcn_exp2f(m_reg - mn); m_reg = mn; }
#pragma unroll
    for (int r = 0; r < 16; ++r) p0[r] = p0[r] - mn;
#pragma unroll
    for (int r = 0; r < 16; ++r) p1[r] = p1[r] - mn;
#pragma unroll
    for (int r = 0; r < 16; ++r) p0[r] = __builtin_amdgcn_exp2f(p0[r]);
}
__device__ __forceinline__ void finishSM(f32x16& p0, f32x16& p1, float alpha, float& l_reg, bf16x8& pa0, bf16x8& pa1, bf16x8& pa2, bf16x8& pa3) {
#pragma unroll
    for (int r = 0; r < 16; ++r) p1[r] = __builtin_amdgcn_exp2f(p1[r]);
    float ps = 0;
#pragma unroll
    for (int r = 0; r < 16; ++r) ps += p0[r];
#pragma unroll
    for (int r = 0; r < 16; ++r) ps += p1[r];
    { auto rr = __builtin_amdgcn_permlane32_swap(__float_as_uint(ps), __float_as_uint(ps), false, false);
      ps = __uint_as_float(rr[0]) + __uint_as_float(rr[1]); }
    l_reg = l_reg * alpha + ps;
#define FA_PK4(P, B_, OUT) do { unsigned a0 = cvtpk(P[B_+0], P[B_+1]), a1 = cvtpk(P[B_+2], P[B_+3]);                          \
        unsigned b0 = cvtpk(P[B_+4], P[B_+5]), b1 = cvtpk(P[B_+6], P[B_+7]);                                             \
        auto r0 = __builtin_amdgcn_permlane32_swap(a0, b0, false, false); auto r1 = __builtin_amdgcn_permlane32_swap(a1, b1, false, false); \
        u32x4 w = {r0[0], r1[0], r0[1], r1[1]}; OUT = *reinterpret_cast<bf16x8*>(&w); } while (0)
    FA_PK4(p0, 0, pa0); FA_PK4(p0, 8, pa1); FA_PK4(p1, 0, pa2); FA_PK4(p1, 8, pa3);
#undef FA_PK4
}
template <int KB>
__device__ __forceinline__ void qkt(f32x16& p0, f32x16& p1, const char* K_lds, int r32, int hi, const bf16x8* qr, const __attribute__((address_space(3))) float* fl) {
#pragma unroll
    for (int g = 0; g < 4; ++g) { const f32x4 a = *(const __attribute__((address_space(3))) f32x4*)(fl + 8 * g), b = *(const __attribute__((address_space(3))) f32x4*)(fl + 32 + 8 * g);
#pragma unroll
        for (int i = 0; i < 4; ++i) { p0[4 * g + i] = a[i]; p1[4 * g + i] = b[i]; } }
    const char* kb[4];
#pragma unroll
    for (int dd = 0; dd < 4; ++dd) kb[dd] = K_lds + KB * SHM_K + FA_KSWZ(r32, (dd * 16 + hi * 8) * 2);
#pragma unroll
    for (int d0 = 0; d0 < 8; ++d0) { const char* a = kb[d0 & 3] + (d0 >> 2) * 128;
        bf16x8 b0 = *reinterpret_cast<const bf16x8*>(a);
        bf16x8 b1 = *reinterpret_cast<const bf16x8*>(a + 32 * 256);
        p0 = __builtin_amdgcn_mfma_f32_32x32x16_bf16(b0, qr[d0], p0, 0, 0, 0);
        p1 = __builtin_amdgcn_mfma_f32_32x32x16_bf16(b1, qr[d0], p1, 0, 0, 0); }
}
template <int VB>
__device__ __forceinline__ void pv_tile(f32x16* o, int vb0, bf16x8 pa0, bf16x8 pa1, bf16x8 pa2, bf16x8 pa3) {
#define FA_TRRD(dst, off) asm volatile("ds_read_b64_tr_b16 %0, %1 offset:%2" : "=&v"(dst) : "v"(vb0), "i"(off) : "memory")
#define FA_PV_D0(d0) do { s16x4 l0, l1, l2, l3, h0, h1, h2, h3; constexpr int b_ = VB * SHM_V + v_rd_off(d0, 0, 0); \
        FA_TRRD(l0, b_); FA_TRRD(h0, b_ + 2048); FA_TRRD(l1, b_ + 4096); FA_TRRD(h1, b_ + 6144); FA_TRRD(l2, b_ + 8192); FA_TRRD(h2, b_ + 10240); FA_TRRD(l3, b_ + 12288); FA_TRRD(h3, b_ + 14336); \
        asm volatile("s_waitcnt lgkmcnt(0)" ::: "memory"); FA_SBAR();   \
        o[d0] = __builtin_amdgcn_mfma_f32_32x32x16_bf16(pa0, (bf16x8){l0[0], l0[1], l0[2], l0[3], h0[0], h0[1], h0[2], h0[3]}, o[d0], 0, 0, 0);   \
        o[d0] = __builtin_amdgcn_mfma_f32_32x32x16_bf16(pa1, (bf16x8){l1[0], l1[1], l1[2], l1[3], h1[0], h1[1], h1[2], h1[3]}, o[d0], 0, 0, 0);   \
        o[d0] = __builtin_amdgcn_mfma_f32_32x32x16_bf16(pa2, (bf16x8){l2[0], l2[1], l2[2], l2[3], h2[0], h2[1], h2[2], h2[3]}, o[d0], 0, 0, 0);   \
        o[d0] = __builtin_amdgcn_mfma_f32_32x32x16_bf16(pa3, (bf16x8){l3[0], l3[1], l3[2], l3[3], h3[0], h3[1], h3[2], h3[3]}, o[d0], 0, 0, 0); } while (0)
    FA_PV_D0(0); FA_PV_D0(1); FA_PV_D0(2); FA_PV_D0(3);
#undef FA_PV_D0
#undef FA_TRRD
}
constexpr size_t BUF = (size_t)16384 * 2048;
struct BlockRef { const bf16* Q; const bf16* K; int P0; int jlo; };
#ifndef FA_SELFCHECK
#define FA_SELFCHECK 0
#endif
#if FA_SELFCHECK
#endif
struct Seam { bf16x8 qr[8]; bf16x8 st_v0, st_v1, st_k0, st_k1; };
#define FA_TILE(p, k0, half) ((const char*)(p) + ((size_t)((k0) + 32 * (half)) * PITCH * 2))
#define FA_VMW() asm volatile("s_waitcnt vmcnt(0)" ::: "memory")
#define FA_VMWN(n) asm volatile("s_waitcnt vmcnt(%0)" :: "i"(n) : "memory")
#define FA_SLOAD(Kp, Vp, k0) do { S.st_v0 = load8((const bf16*)(FA_TILE(Vp, k0, 0) + svoff)); S.st_v1 = load8((const bf16*)(FA_TILE(Vp, k0, 1) + svoff));              \
                         S.st_k0 = load8((const bf16*)(FA_TILE(Kp, k0, 0) + svoff)); S.st_k1 = load8((const bf16*)(FA_TILE(Kp, k0, 1) + svoff)); } while (0)
#define FA_SWRITE_K(bf) do { *(bf16x8*)(K_lds + (bf) * SHM_K + kws) = S.st_k0; *(bf16x8*)(K_lds + (bf) * SHM_K + kws + 32 * 256) = S.st_k1; } while (0)
#define FA_SWRITE_V(bf) do { *(bf16x8*)(V_lds + (bf) * SHM_V + vst0) = S.st_v0; *(bf16x8*)(V_lds + (bf) * SHM_V + vst1) = S.st_v1; } while (0)
#define FA_SWRITE(bf) do { FA_SWRITE_V(bf); FA_SWRITE_K(bf); } while (0)
__device__ __forceinline__ void attn_prime(const BlockRef& cur, char* lds, Seam& S, const int tid) {
    const int wid = __builtin_amdgcn_readfirstlane(tid >> 6), lane = tid & 63, r32 = lane & 31, hi = lane >> 5;
    const int sr = tid >> 4, sc = (tid & 15) * 8, kws = FA_KSWZ(sr, sc * 2); const unsigned svoff = (unsigned)(sr * PITCH + sc) * 2u; char* K_lds = lds + 2 * SHM_V;
#pragma unroll
    for (int d0 = 0; d0 < 8; ++d0) S.qr[d0] = load8(cur.Q + (size_t)(wid * QBLK + r32) * PITCH + d0 * 16 + hi * 8);
    FA_SLOAD(cur.K, cur.K + BUF, cur.jlo * KVBLK); FA_VMW(); FA_SWRITE_K(0);
    __syncthreads();
}
__device__ __forceinline__ void attn_block(const BlockRef& cur, const BlockRef& nxt, char* lds, Seam& S, const int tid, const int obuf = 5) {
    const int wid = __builtin_amdgcn_readfirstlane(tid >> 6), lane = tid & 63, r32 = lane & 31, hi = lane >> 5;
    const int j_lo = cur.jlo, NT = cur.P0 / KVBLK + QB / KVBLK - j_lo;
    const int qlo = cur.P0 + wid * QBLK, qm = qlo + r32 - 4 * hi;
    char* V_lds = lds; char* K_lds = lds + 2 * SHM_V;
    float* ws = (float*)(lds + 2 * SHM_V + 2 * SHM_K) + wid * 64; float* li_l = ws, * al_l = ws + 32;
    const __attribute__((address_space(3))) float* Fl = (const __attribute__((address_space(3))) float*)((__attribute__((address_space(3))) char*)lds + F_OFF) + 4 * hi;
    float m_reg = -1e30f, l_reg = 0; f32x16 o[4] = {};
    const int sr = tid >> 4, sc = (tid & 15) * 8, vst0 = v_st(sr, sc), vst1 = vst0 + 8192  , kws = FA_KSWZ(sr, sc * 2); const unsigned svoff = (unsigned)(sr * PITCH + sc) * 2u;
    const int vb0 = (int)(uintptr_t)V_lds + v_rd_base(lane);
    const bf16* Kh = cur.K; const bf16* Vh = cur.K + BUF;
#define FA_RESC(a) do { if (__any((a) < 1.f)) { if (hi == 0) al_l[r32] = (a); asm volatile("s_waitcnt lgkmcnt(0)" ::: "memory");              \
                     for (int d_ = 0; d_ < 4; ++d_) for (int r = 0; r < 16; ++r) o[d_][r] *= al_l[crow(r, hi)]; } } while (0)
#define FA_KBASE(t) ((j_lo + (t)) * KVBLK)
#define FA_BIASMASK(P0_, P1_, t) do { const int kb_ = FA_KBASE(t); if (kb_ + KVBLK - 1 > qlo) mask_tile(P0_, P1_, qm - kb_); } while (0)
    constexpr int NQL = 8;
#define FA_SEAM_K0() do { FA_VMWN(NQL); FA_SWRITE_K(0); FA_SBAR(); } while (0)
    f32x16 pA0, pA1, pB0, pB1; float mnA, mnB, alA, alB; bf16x8 pa0, pa1, pa2, pa3;
    FA_SWRITE_V(0); FA_SBAR();
    if (NT > 1) { FA_SLOAD(Kh, Vh, FA_KBASE(1)); }
    FA_SBAR(); qkt<0>(pA0, pA1, K_lds, r32, hi, S.qr, Fl + FA_KBASE(0));
    FA_BIASMASK(pA0, pA1, 0); partialSM(pA0, pA1, m_reg, mnA, alA);
    if (NT > 1) { FA_VMW(); FA_SWRITE(1); }
    __syncthreads();
#define FA_HALF_STEP(PX0, PX1, mnX, alX, PY0, PY1, alY, t, KB, VB, SB) do {                                                      \
        FA_SBAR(); qkt<KB>(PX0, PX1, K_lds, r32, hi, S.qr, Fl + FA_KBASE(t));                                             \
        finishSM(PY0, PY1, alY, l_reg, pa0, pa1, pa2, pa3); FA_SBAR();                                                           \
        if ((t) + 1 < NT) { FA_SLOAD(Kh, Vh, FA_KBASE((t) + 1)); FA_SBAR(); }                                               \
        pv_tile<VB>(o, vb0, pa0, pa1, pa2, pa3); FA_BIASMASK(PX0, PX1, (t)); partialSM(PX0, PX1, m_reg, mnX, alX);                                        \
        __syncthreads();                                                                                                      \
        if ((t) + 1 < NT) { FA_VMW(); FA_SWRITE(SB); }                                                                          \
        FA_RESC(alX); __syncthreads(); } while (0)
    for (int t = 1; t + 1 < NT; t += 2) {
        FA_HALF_STEP(pB0, pB1, mnB, alB, pA0, pA1, alA, t, 1, 0, 0);
        FA_HALF_STEP(pA0, pA1, mnA, alA, pB0, pB1, alB, t + 1, 0, 1, 1);
    }
    const bool even = (NT & 1) == 0;
    if (even) { FA_SBAR(); qkt<1>(pB0, pB1, K_lds, r32, hi, S.qr, Fl + FA_KBASE(NT - 1)); FA_SBAR(); }
    FA_SLOAD(nxt.K, nxt.K + BUF, nxt.jlo * KVBLK); FA_SBAR();
#pragma unroll
    for (int d0 = 0; d0 < 8; ++d0) S.qr[d0] = load8(nxt.Q + (size_t)(wid * QBLK + r32) * PITCH + d0 * 16 + hi * 8);
    FA_SBAR();
    finishSM(pA0, pA1, alA, l_reg, pa0, pa1, pa2, pa3); FA_SBAR();
    pv_tile<0>(o, vb0, pa0, pa1, pa2, pa3);
    if (even) { FA_BIASMASK(pB0, pB1, NT - 1); partialSM(pB0, pB1, m_reg, mnB, alB); __syncthreads(); FA_RESC(alB);
        finishSM(pB0, pB1, alB, l_reg, pa0, pa1, pa2, pa3); FA_SBAR(); pv_tile<1>(o, vb0, pa0, pa1, pa2, pa3); }
    FA_SBAR(); FA_SEAM_K0();
    if (hi == 0) li_l[r32] = l_reg; asm volatile("s_waitcnt lgkmcnt(0)" ::: "memory");
    float rli[16];
#pragma unroll
    for (int r = 0; r < 16; ++r) rli[r] = __builtin_amdgcn_rcpf(li_l[crow(r, hi)]);
    bf16* Ow = const_cast<bf16*>(cur.Q) + (size_t)obuf * BUF + (size_t)(wid * QBLK) * PITCH;
#pragma unroll
    for (int r = 0; r < 16; ++r) { const int orow = crow(r, hi);
#pragma unroll
        for (int d0 = 0; d0 < 4; ++d0) { const float v = o[d0][r] * rli[r];
            const float vn = __shfl_xor(v, 1);
            if ((r32 & 1) == 0) *(unsigned*)(Ow + (size_t)orow * PITCH + d0 * 32 + r32) = cvtpk(v, vn); } }
    __syncthreads();
#undef FA_RESC
#undef FA_KBASE
#undef FA_BIASMASK
#undef FA_SEAM_K0
#undef FA_HALF_STEP
}
#undef FA_TILE
#undef FA_VMW
#undef FA_VMWN
#undef FA_SLOAD
#undef FA_SWRITE_K
#undef FA_SWRITE_V
#undef FA_SWRITE
__device__ __forceinline__ BlockRef block_ref(int bh, int qb, int jlo, const bf16* Q) {
    const int b = bh >> 4, h = bh & 15; BlockRef r;
    r.Q = Q + ((size_t)b * SEQ + (size_t)qb * QB) * PITCH + (size_t)h * D; r.K = Q + BUF + (size_t)b * SEQ * PITCH + (size_t)h * D; r.P0 = qb * QB; r.jlo = jlo; return r;
}
__device__ __forceinline__ void load_bias(char* lds, const float* FB, int bh, int k_lo, int k_hi, const int tid) {
    const f32x4* src = (const f32x4*)(FB + (size_t)bh * SEQ); __attribute__((address_space(3))) f32x4* dst = (__attribute__((address_space(3))) f32x4*)((__attribute__((address_space(3))) char*)lds + F_OFF);
    int t0 = tid; asm volatile("" : "+v"(t0));
    for (int i = k_lo / 4 + t0; i < k_hi / 4; i += NW * 64) dst[i] = src[i];
    __syncthreads();
}
#ifndef FA_PRUNE
#define FA_PRUNE 1
#endif
constexpr float PRUNE_T2 = 44.0f;
constexpr int NTICKETS = (1 + (((DUP_MASK) >> 3) & 1)) * 2 * NHEAD * NQB;
constexpr int XQ_OFF = F_OFF + SEQ * 4;
struct Ticket { int idx, bh, qb, jlo; };
__device__ __forceinline__ Ticket next_block(char* lds, const bf16* Q, const float* FB, const unsigned* qkmax, unsigned* qhead, const int tid, const bool prune = true) {
    __attribute__((address_space(3))) int* xi = (__attribute__((address_space(3))) int*)((__attribute__((address_space(3))) char*)lds + XQ_OFF);
    __attribute__((address_space(3))) float* xf = (__attribute__((address_space(3))) float*)(xi + 16);
    int t0 = tid; asm volatile("" : "+v"(t0));
    const int wid = __builtin_amdgcn_readfirstlane(t0 >> 6), lane = t0 & 63;
    if (t0 == 0) xi[0] = (int)__hip_atomic_fetch_add(qhead, 1u, __ATOMIC_RELAXED, __HIP_MEMORY_SCOPE_AGENT);
    __syncthreads();
    Ticket T; T.idx = xi[0]; { const int id = T.idx % (2 * NHEAD * NQB); T.qb = NQB - 1 - (id >> 5); T.bh = id & 31; } T.jlo = 0;
    if (T.idx >= NTICKETS) { __syncthreads(); return T; }
    const int b = T.bh >> 4, h = T.bh & 15, P0 = T.qb * QB;
#if FA_PRUNE
    const int row = t0 >> 1, half = t0 & 1;
    const bf16* qp = Q + ((size_t)b * SEQ + P0 + row) * PITCH + (size_t)h * D + 64 * half; const bf16* kp = qp + BUF;
    float d = 0.f;
#pragma unroll
    for (int c = 0; c < 8; ++c) { const u32x4 qa = *(const u32x4*)(qp + 8 * c), ka = *(const u32x4*)(kp + 8 * c);
#pragma unroll
        for (int e = 0; e < 4; ++e) { d += __uint_as_float(qa[e] << 16) * __uint_as_float(ka[e] << 16); d += __uint_as_float(qa[e] & 0xffff0000u) * __uint_as_float(ka[e] & 0xffff0000u); } }
    d += __shfl_xor(d, 1);
    d += FB[(size_t)T.bh * SEQ + P0 + row];
#pragma unroll
    for (int o = 2; o < 64; o <<= 1) d = fminf(d, __shfl_xor(d, o));
    if (lane == 0) xf[wid] = d;
    float smax = 0.f;
#pragma unroll
    for (int w = 0; w < 4; ++w) smax += sqrtf(__uint_as_float(qkmax[(T.bh * 2 + 0) * 4 + w]) * __uint_as_float(qkmax[(T.bh * 2 + 1) * 4 + w]));
    smax = smax * 1.02f + 0.5f;
    __syncthreads();
    float mmin = xf[0];
#pragma unroll
    for (int w = 1; w < 8; ++w) mmin = fminf(mmin, xf[w]);
    const float thresh = prune ? mmin - PRUNE_T2 - smax : -__builtin_inff();
    const int nb0 = P0 / KVBLK;
    const bool skip = (t0 < nb0) && (FB[(size_t)T.bh * SEQ + t0 * KVBLK + KVBLK - 1] < thresh);
    const unsigned long long bal = __ballot(skip);
    if (lane == 0) xi[8 + wid] = __popcll(bal);
    __syncthreads();
    T.jlo = xi[8] + xi[9];
    __syncthreads();
#else
    __syncthreads();
#endif
    return T;
}
__device__ __forceinline__ void attn_phase(char* lds, const bf16* Q, const float* FB, const unsigned* qkmax, unsigned* qhead, const int tid, const bool prune = true, const int obuf = 5) {
    Ticket tc = next_block(lds, Q, FB, qkmax, qhead, tid, prune);
    if (tc.idx >= NTICKETS) return;
    BlockRef cur = block_ref(tc.bh, tc.qb, tc.jlo, Q);
    Seam S;
    load_bias(lds, FB, tc.bh, tc.jlo * KVBLK, (tc.qb + 1) * QB, tid);
    attn_prime(cur, lds, S, tid);
    for (;;) {
        const Ticket tn = next_block(lds, Q, FB, qkmax, qhead, tid, prune);
        const bool last = tn.idx >= NTICKETS;
        const BlockRef nxt = last ? cur : block_ref(tn.bh, tn.qb, tn.jlo, Q);
        attn_block(cur, nxt, lds, S, tid, obuf);
        if (last) break;
        load_bias(lds, FB, tn.bh, tn.jlo * KVBLK, (tn.qb + 1) * QB, tid);
        cur = nxt;
    }
}
}

constexpr int NWAVES = 8;
constexpr int BATCH = 2, SEQ = 8192, DM = 4096, NH = 16, HD = 128, AW = 2048, CW = 2048, DFF = 11008, NIN = 12304;
constexpr int M = BATCH * SEQ;
constexpr int NPROJ = 12288;
constexpr int NGU = 2 * DFF;
constexpr float EPS = 1e-6f;
constexpr float QSCALE = 0.08838834764831845f * 1.4426950408889634f;
#ifndef MK_N_LAUNCHES
#define MK_N_LAUNCHES 1
#endif
constexpr int N_PHASES = 10;

#ifndef PG8_ALIGN
#define PG8_ALIGN true
#endif
#ifndef PG8_SP2
#define PG8_SP2 true
#endif
constexpr size_t MiB = 1u << 20;
constexpr size_t WS_CTL = 0, CTL_ZERO_BYTES = 1 * MiB;
constexpr size_t WS_MOD = 512 * 1024;
constexpr size_t WS_WF = 1 * MiB;
constexpr size_t WS_FT = 2 * MiB;
constexpr size_t WS_FB = 3 * MiB;
constexpr size_t WS_WIN = 4 * MiB;
constexpr size_t WS_WOUT = WS_WIN + (size_t)NPROJ * DM * 2;
constexpr size_t WS_WGU = WS_WOUT + (size_t)DM * DM * 2;
constexpr size_t WS_WD = WS_WGU + (size_t)NGU * DM * 2;
constexpr size_t WS_H = WS_WD + (size_t)DM * DFF * 2;
constexpr size_t WS_Q = WS_H + (size_t)M * DM * 2;
constexpr size_t WS_K = WS_Q + (size_t)M * 2048 * 2, WS_V = WS_K + (size_t)M * 2048 * 2, WS_GB = WS_V + (size_t)M * 2048 * 2, WS_CU = WS_GB + (size_t)M * 2048 * 2, WS_YA = WS_CU + (size_t)M * 2048 * 2;
constexpr size_t WS_ACT = WS_Q;
constexpr size_t WS_HM = WS_YA + (size_t)M * 2048 * 2;
constexpr size_t WS_END = WS_HM + (size_t)M * DM * 2;
static_assert(WS_ACT + (size_t)M * DFF * 2 <= WS_HM, "ACT overlay fits inside Q..YA");
static_assert(WS_WIN % 256 == 0 && WS_WOUT % 256 == 0 && WS_WGU % 256 == 0 && WS_WD % 256 == 0 && WS_H % 256 == 0 && WS_Q % 256 == 0 && WS_HM % 256 == 0, "alignment");
constexpr int CW_BAR = 4096;
constexpr int CW_QHEAD = 512, CW_QKMAX = 1024;
constexpr int RING_BYTES = 131072, LDSCTL_OFF = RING_BYTES, MISC_OFF = LDSCTL_OFF + 320, LDS_BYTES = 147456;
static_assert(fa::ATT_LDS_BYTES <= RING_BYTES, "attention LDS");
static_assert(WS_K - WS_Q == fa::BUF * 2 && WS_V - WS_K == fa::BUF * 2 && WS_YA - WS_Q == 5 * fa::BUF * 2, "attention tensor spacing");

#define GAS __attribute__((address_space(1)))
#define LAS __attribute__((address_space(3)))
typedef unsigned short bf16;
typedef unsigned v4u __attribute__((ext_vector_type(4)));
typedef unsigned v2u __attribute__((ext_vector_type(2)));
typedef float f32x4 __attribute__((ext_vector_type(4)));
typedef short bf16x8 __attribute__((ext_vector_type(8)));
typedef GAS unsigned gu32;
#define RLX_AGENT __ATOMIC_RELAXED, __HIP_MEMORY_SCOPE_AGENT
#define LDS_WAIT() asm volatile("s_waitcnt lgkmcnt(0)" ::: "memory")
#define VM_WAIT() asm volatile("s_waitcnt vmcnt(0)" ::: "memory")
__device__ __forceinline__ unsigned f2bf(float f) { unsigned u = __builtin_bit_cast(unsigned, f); return (u + 0x7fffu + ((u >> 16) & 1u)) >> 16; }
__device__ __forceinline__ unsigned pk2(float lo, float hi) { return f2bf(lo) | (f2bf(hi) << 16); }
__device__ __forceinline__ float bflo(unsigned w) { return __builtin_bit_cast(float, w << 16); }
__device__ __forceinline__ float bfhi(unsigned w) { return __builtin_bit_cast(float, w & 0xffff0000u); }
__device__ __forceinline__ float wave_sum(float v) {
#pragma unroll
    for (int o = 1; o < 64; o <<= 1) v += __shfl_xor(v, o);
    return v;
}
#define XB_TMO      128
#define XB_XCNT(j)  (256  + 64 * (j))
#define XB_XSUB(j)  (1280 + 64 * (j))
#define XB_XGEN(j)  (2304 + 64 * (j))
#define XB_TOP      3328
#define XB_TOPGEN   3392
#define XCD_BAR_WORDS 3456
#define XB_SPIN_CAP (1u << 18)

__device__ __forceinline__ unsigned xb_ld(unsigned* p)              { return __hip_atomic_load(p, __ATOMIC_RELAXED, __HIP_MEMORY_SCOPE_AGENT); }
__device__ __forceinline__ unsigned xb_add(unsigned* p, unsigned v) { return __hip_atomic_fetch_add(p, v, __ATOMIC_RELAXED, __HIP_MEMORY_SCOPE_AGENT); }
__device__ __forceinline__ unsigned xb_xcc_id() { return (unsigned)__builtin_amdgcn_s_getreg((3 << 11) | 20) & 0xFu; }
#define XB_SPIN(cond, bar) do { unsigned _sp = 0; while (cond) { __builtin_amdgcn_s_sleep(1); \
    if ((++_sp & 255u) == 0u) { if (xb_ld(&(bar)[XB_TMO])) break; if (_sp > XB_SPIN_CAP) { atomicAdd(&(bar)[XB_TMO], 1u); break; } } } } while (0)

struct XcdBarrier {
    unsigned* bar; unsigned x;
    volatile LAS unsigned* st;
};

__device__ __forceinline__ XcdBarrier xcd_barrier_post(unsigned* bar, volatile LAS unsigned* st, const int tid) {
    XcdBarrier b; b.bar = bar; b.x = xb_xcc_id(); b.st = st;
    if (tid == 0) (void)xb_add(&bar[XB_XCNT(b.x)], 1u);
    return b;
}
__device__ __forceinline__ void xcd_barrier_complete(unsigned* bar, unsigned x, unsigned& nloc, unsigned& nx) {
    const unsigned G = gridDim.x * gridDim.y * gridDim.z;
    unsigned sum, cnt, mine, sp = 0u;
    for (;;) {
        sum = 0u; cnt = 0u; mine = 0u;
#pragma unroll
        for (unsigned j = 0; j < 16; ++j) { const unsigned c = xb_ld(&bar[XB_XCNT(j)]); sum += c; cnt += (c > 0u) ? 1u : 0u; mine = (j == x) ? c : mine; }
        if (sum == G) break;
        __builtin_amdgcn_s_sleep(1);
        if ((++sp & 255u) == 0u) { if (xb_ld(&bar[XB_TMO])) break; if (sp > XB_SPIN_CAP) { atomicAdd(&bar[XB_TMO], 1u); break; } }
    }
    nloc = mine > 0u ? mine : 1u; nx = cnt > 0u ? cnt : 1u;
}

__device__ __forceinline__ void xcd_barrier(const XcdBarrier& b, const int tid) {
    asm volatile("s_waitcnt vmcnt(0)" ::: "memory");
    __syncthreads();
    if (tid == 0) {
        unsigned* bar = b.bar;
        __builtin_amdgcn_s_waitcnt(0);
        unsigned nloc = b.st[0], nx = b.st[1];
        if (nloc == 0u) { xcd_barrier_complete(bar, b.x, nloc, nx); b.st[0] = nloc; b.st[1] = nx; }
        const unsigned old = xb_add(&bar[XB_XSUB(b.x)], 1u);
        const unsigned gen = old / nloc;
        if (old + 1u == (gen + 1u) * nloc) {
            __builtin_amdgcn_fence(__ATOMIC_RELEASE, "agent");
            asm volatile("s_waitcnt vmcnt(0)" ::: "memory");
            const unsigned og = xb_add(&bar[XB_TOP], 1u);
            const unsigned tg = og / nx;
            if (og + 1u == (tg + 1u) * nx) xb_add(&bar[XB_TOPGEN], 1u);
            else XB_SPIN(xb_ld(&bar[XB_TOPGEN]) == tg, bar);
            __builtin_amdgcn_fence(__ATOMIC_ACQUIRE, "agent");
            xb_add(&bar[XB_XGEN(b.x)], 1u);
            asm volatile("s_waitcnt vmcnt(0)" ::: "memory");
        } else {
            XB_SPIN(xb_ld(&bar[XB_XGEN(b.x)]) == gen, bar);
            __builtin_amdgcn_fence(__ATOMIC_ACQUIRE, "agent");
            asm volatile("s_waitcnt vmcnt(0)" ::: "memory");
        }
    }
    __syncthreads();
}
struct DestWin { bf16* W; __device__ __forceinline__ bf16* operator()(int n) const {
    if (n < 6144) return W + (size_t)n * DM;
    if (n < 6160) return nullptr;
    if (n < 8208) return W + (size_t)(6144 + (n - 6160)) * DM;
    if (n < 10256) { const int j = n - 8208; return W + (size_t)(8192 + (j >> 7) * 256 + (j & 127)) * DM; }
    const int j = n - 10256; return W + (size_t)(8192 + (j >> 7) * 256 + 128 + (j & 127)) * DM; } };
struct DestPlain { bf16* W; int K; __device__ __forceinline__ bf16* operator()(int n) const { return W + (size_t)n * K; } };
struct DestGU { bf16* W; int half; __device__ __forceinline__ bf16* operator()(int n) const { return W + (size_t)((n >> 7) * 256 + half * 128 + (n & 127)) * DM; } };
template <class Dest>
__device__ __forceinline__ void p0_transpose_item(const float* W, int K, int N, int item, int lane, const Dest dest) {
    const int nblk = (N + 63) / 64, kb = item / nblk, nb = item - kb * nblk, k0 = 64 * kb, n0 = 64 * nb;
    const int c4 = lane & 15, rs = lane >> 4, n = n0 + 4 * c4; const bool nok = n < N;
    const float* wp = W + (size_t)(k0 + 8 * rs) * N + n;
    f32x4 v[2][8];
#pragma unroll
    for (int jj = 0; jj < 2; ++jj)
#pragma unroll
        for (int kk = 0; kk < 8; ++kk) v[jj][kk] = nok ? __builtin_nontemporal_load((const GAS f32x4*)(wp + (size_t)(32 * jj + kk) * N)) : (f32x4){0.f, 0.f, 0.f, 0.f};
#pragma unroll
    for (int q = 0; q < 4; ++q) { bf16* drow = nok ? dest(n + q) : nullptr;
        if (drow) {
#pragma unroll
            for (int jj = 0; jj < 2; ++jj) { v4u o; o.x = pg8::cvt_pk_bf16(v[jj][0][q], v[jj][1][q]); o.y = pg8::cvt_pk_bf16(v[jj][2][q], v[jj][3][q]); o.z = pg8::cvt_pk_bf16(v[jj][4][q], v[jj][5][q]); o.w = pg8::cvt_pk_bf16(v[jj][6][q], v[jj][7][q]);
                __builtin_nontemporal_store(o, (GAS v4u*)(drow + k0 + 8 * (rs + 4 * jj))); } } }
}
constexpr int P0_REPS = 1 + ((DUP_MASK) & 1);
struct P0Args { const float *c, *w_ada, *b_ada, *w_in, *w_out, *w_gate, *w_up, *w_down; float* mod; bf16 *WF, *WIN, *WOUT, *WGU, *WD; };
constexpr int P0_I_IN = (DM / 64) * ((NIN + 63) / 64), P0_I_OUT = (DM / 64) * (DM / 64), P0_I_G = (DM / 64) * (DFF / 64), P0_NITEMS = P0_I_IN + P0_I_OUT + 2 * P0_I_G;
struct P0Item { const float* W; bf16* Dst; int N, kind, k0, n0; };
__device__ __forceinline__ P0Item p0_decode(const P0Args& A, int it) {
    P0Item I; int r = it;
    if (r < P0_I_IN) { I.W = A.w_in; I.Dst = A.WIN; I.N = NIN; I.kind = 0; }
    else if ((r -= P0_I_IN) < P0_I_OUT) { I.W = A.w_out; I.Dst = A.WOUT; I.N = DM; I.kind = 1; }
    else if ((r -= P0_I_OUT) < P0_I_G) { I.W = A.w_gate; I.Dst = A.WGU; I.N = DFF; I.kind = 2; }
    else { r -= P0_I_G; I.W = A.w_up; I.Dst = A.WGU; I.N = DFF; I.kind = 3; }
    const int nblk = (I.N + 63) / 64, kb = r / nblk, nb = r - kb * nblk; I.k0 = 64 * kb; I.n0 = 64 * nb; return I;
}
__device__ __forceinline__ bf16* p0_dest(const P0Item& I, int n) {
    if (I.kind == 0) return DestWin{I.Dst}(n);
    if (I.kind == 1) return I.Dst + (size_t)n * DM;
    return DestGU{I.Dst, I.kind - 2}(n);
}
__device__ __forceinline__ void p0_load(const P0Item& I, int lane, f32x4 (&v)[2][8]) {
    const int c4 = lane & 15, rs = lane >> 4, n = I.n0 + 4 * c4; const bool nok = n < I.N;
    const float* wp = I.W + (size_t)(I.k0 + 8 * rs) * I.N + n;
#pragma unroll
    for (int jj = 0; jj < 2; ++jj)
#pragma unroll
        for (int kk = 0; kk < 8; ++kk) v[jj][kk] = nok ? __builtin_nontemporal_load((const GAS f32x4*)(wp + (size_t)(32 * jj + kk) * I.N)) : (f32x4){0.f, 0.f, 0.f, 0.f};
}
__device__ __forceinline__ void p0_store(const P0Item& I, int lane, const f32x4 (&v)[2][8]) {
    const int c4 = lane & 15, rs = lane >> 4, n = I.n0 + 4 * c4; const bool nok = n < I.N;
#pragma unroll
    for (int q = 0; q < 4; ++q) { bf16* drow = nok ? p0_dest(I, n + q) : nullptr;
        if (drow) {
#pragma unroll
            for (int jj = 0; jj < 2; ++jj) { v4u o; o.x = pg8::cvt_pk_bf16(v[jj][0][q], v[jj][1][q]); o.y = pg8::cvt_pk_bf16(v[jj][2][q], v[jj][3][q]); o.z = pg8::cvt_pk_bf16(v[jj][4][q], v[jj][5][q]); o.w = pg8::cvt_pk_bf16(v[jj][6][q], v[jj][7][q]);
                __builtin_nontemporal_store(o, (GAS v4u*)(drow + I.k0 + 8 * (rs + 4 * jj))); } } }
}
__device__ __forceinline__ void p0_prologue(LAS unsigned char* lds, const P0Args& A, int G, int bid, int tid, int wave, int lane) {
    LAS float* cact = (LAS float*)(lds + 73728);
    for (int i = tid; i < 2 * DM; i += NWAVES * 64) { const float v = A.c[i]; cact[i] = v / (1.f + expf(-v)); }
    __syncthreads();
    for (int rep0 = 0; rep0 < P0_REPS; ++rep0)
    for (int it = bid; it < 12 * 64; it += G) {
        const int cg = it % 12, kc = it / 12, n = cg * 2048 + tid * 4;
        const float* wp = A.w_ada + (size_t)(kc * 64) * (6 * DM) + n;
        f32x4 a0 = {0.f, 0.f, 0.f, 0.f}, a1 = {0.f, 0.f, 0.f, 0.f};
#pragma unroll 32
        for (int kk = 0; kk < 64; ++kk) { const f32x4 w = __builtin_nontemporal_load((const GAS f32x4*)(wp + (size_t)kk * (6 * DM))); const float c0 = cact[kc * 64 + kk], c1 = cact[DM + kc * 64 + kk]; a0 += w * c0; a1 += w * c1; }
        if (kc == 0) { const f32x4 b = *(const f32x4*)(A.b_ada + n); a0 += b; a1 += b; }
        float* m0 = A.mod + n; float* m1 = A.mod + 6 * DM + n;
        if (rep0 == 0 || a0[0] == 1.2345678e30f)
#pragma unroll
        for (int j = 0; j < 4; ++j) { __hip_atomic_fetch_add(m0 + j, a0[j], __ATOMIC_RELAXED, __HIP_MEMORY_SCOPE_AGENT); __hip_atomic_fetch_add(m1 + j, a1[j], __ATOMIC_RELAXED, __HIP_MEMORY_SCOPE_AGENT); }
    }
    { const int g = bid * NWAVES * 64 + tid; if (g < 16 * DM) { const int k = g >> 4, n = g & 15; A.WF[(size_t)n * DM + k] = (bf16)f2bf(A.w_in[(size_t)k * NIN + 6144 + n]); } }
    const int gw = bid * NWAVES + wave, NGW = G * NWAVES;
    constexpr int NVIRT = P0_REPS * P0_NITEMS;
    f32x4 va[2][8], vb[2][8];
    int it = gw;
    if (it < NVIRT) { const P0Item I = p0_decode(A, it % P0_NITEMS); p0_load(I, lane, va); }
    while (it < NVIRT) {
        const int i1 = it + NGW, i2 = it + 2 * NGW;
        if (i1 < NVIRT) { const P0Item I = p0_decode(A, i1 % P0_NITEMS); p0_load(I, lane, vb); }
        { const P0Item I = p0_decode(A, it % P0_NITEMS); p0_store(I, lane, va); }
        if (i1 >= NVIRT) break;
        if (i2 < NVIRT) { const P0Item I = p0_decode(A, i2 % P0_NITEMS); p0_load(I, lane, va); }
        { const P0Item I = p0_decode(A, i1 % P0_NITEMS); p0_store(I, lane, vb); }
        it = i2;
    }
}
__device__ __forceinline__ void convert_w_down(const float* w_down, bf16* WD, int b, int nb, int wave, int lane) {
    constexpr int I_D = (DFF / 64) * (DM / 64);
    for (int it = b * NWAVES + wave; it < I_D; it += nb * NWAVES) p0_transpose_item(w_down, DFF, DM, it, lane, DestPlain{WD, DFF});
}
__device__ __forceinline__ void p1_norm1(LAS unsigned char* lds, const float* x, const float* pre_norm_mix, const float* mod, const bf16* WF, bf16* H1, float* FT, int G, int bid, int tid, int wave, int lane) {
    LAS float* G1 = (LAS float*)lds; LAS float* SH1 = G1 + DM; LAS float* ssqp = SH1 + DM; LAS f32x4* fpart = (LAS f32x4*)(ssqp + 256);
    int cur_b = -1, par = 0; const int r = lane & 15, kq = lane >> 4;
    for (int tile = bid; tile < M / 16; tile += G) {
        const int b = tile / (SEQ / 16);
        if (b != cur_b) { __syncthreads();
            for (int i = tid; i < DM; i += NWAVES * 64) { G1[i] = pre_norm_mix[i] * (1.f + mod[b * 6 * DM + DM + i]); SH1[i] = mod[b * 6 * DM + i]; }
            __syncthreads(); cur_b = b; }
        const int row = tile * 16 + r, kbase = wave * 512 + kq * 8;
        const float* xp = x + (size_t)row * DM + kbase;
        f32x4 xv[16][2];
#pragma unroll
        for (int i = 0; i < 16; ++i) { xv[i][0] = __builtin_nontemporal_load((const GAS f32x4*)(xp + 32 * i)); xv[i][1] = __builtin_nontemporal_load((const GAS f32x4*)(xp + 32 * i + 4)); }
        float ss = 0.f;
#pragma unroll
        for (int i = 0; i < 16; ++i)
#pragma unroll
            for (int h = 0; h < 2; ++h) { const f32x4 v = xv[i][h]; ss += (v[0] * v[0] + v[1] * v[1]) + (v[2] * v[2] + v[3] * v[3]); }
        ss += __shfl_xor(ss, 16); ss += __shfl_xor(ss, 32);
        if (kq == 0) ssqp[(par * 8 + wave) * 16 + r] = ss;
        __syncthreads();
        float tot = 0.f;
#pragma unroll
        for (int w = 0; w < 8; ++w) tot += ssqp[(par * 8 + w) * 16 + r];
        const float rstd = 1.0f / sqrtf(tot * (1.0f / DM) + EPS);
        f32x4 acc = {0.f, 0.f, 0.f, 0.f};
        bf16* hp = H1 + (size_t)row * DM + kbase; const bf16* wfp = WF + (size_t)r * DM + kbase;
#pragma unroll
        for (int i = 0; i < 16; ++i) {
            const f32x4 g0 = *(const LAS f32x4*)(G1 + kbase + 32 * i), g1 = *(const LAS f32x4*)(G1 + kbase + 32 * i + 4);
            const f32x4 s0 = *(const LAS f32x4*)(SH1 + kbase + 32 * i), s1 = *(const LAS f32x4*)(SH1 + kbase + 32 * i + 4);
            const f32x4 v0 = xv[i][0] * rstd * g0 + s0, v1 = xv[i][1] * rstd * g1 + s1;
            v4u w; w.x = pg8::cvt_pk_bf16(v0[0], v0[1]); w.y = pg8::cvt_pk_bf16(v0[2], v0[3]); w.z = pg8::cvt_pk_bf16(v1[0], v1[1]); w.w = pg8::cvt_pk_bf16(v1[2], v1[3]);
            *(GAS v4u*)(hp + 32 * i) = w;
            const bf16x8 af = __builtin_bit_cast(bf16x8, w); const bf16x8 bfr = *(const GAS bf16x8*)(wfp + 32 * i);
            acc = __builtin_amdgcn_mfma_f32_16x16x32_bf16(af, bfr, acc, 0, 0, 0);
        }
        fpart[(par * 8 + wave) * 64 + lane] = acc;
        __syncthreads();
        if (wave == 0) { f32x4 s = fpart[(par * 8) * 64 + lane];
#pragma unroll
            for (int w = 1; w < 8; ++w) s += fpart[(par * 8 + w) * 64 + lane];
            const int t0 = (tile * 16) % SEQ + 4 * kq;
            *(GAS f32x4*)(FT + (size_t)(b * NH + r) * SEQ + t0) = s; }
        par ^= 1;
    }
}
__device__ __forceinline__ void p2_scan(LAS unsigned char* lds, const float* FT, const float* b_f, float* FB, int bh, int tid, int wave, int lane) {
    const float bias = b_f[bh & 15];
    const GAS f32x4* src = (const GAS f32x4*)(FT + (size_t)bh * SEQ + tid * 16);
    double pre[16]; double run = 0.0;
#pragma unroll
    for (int q = 0; q < 4; ++q) { const f32x4 v = src[q];
#pragma unroll
        for (int j = 0; j < 4; ++j) { const float z = v[j] + bias; const float ls = (z >= 0.f) ? -log1pf(expf(-z)) : z - log1pf(expf(z)); run += (double)ls; pre[4 * q + j] = run; } }
    double incl = run;
#pragma unroll
    for (int o = 1; o < 64; o <<= 1) { const double t = __shfl_up(incl, o); if (lane >= o) incl += t; }
    LAS double* wt = (LAS double*)lds;
    if (lane == 63) wt[wave] = incl;
    __syncthreads();
    double off = incl - run;
    for (int w = 0; w < wave; ++w) off += wt[w];
    GAS f32x4* dst = (GAS f32x4*)(FB + (size_t)bh * SEQ + tid * 16);
#pragma unroll
    for (int q = 0; q < 4; ++q) { f32x4 o;
#pragma unroll
        for (int j = 0; j < 4; ++j) o[j] = (float)(-(off + pre[4 * q + j]) * 1.4426950408889634);
        dst[q] = o; }
    __syncthreads();
}
__device__ __forceinline__ void unpack8(const v4u w, float (&f)[8]) { f[0] = bflo(w.x); f[1] = bfhi(w.x); f[2] = bflo(w.y); f[3] = bfhi(w.y); f[4] = bflo(w.z); f[5] = bfhi(w.z); f[6] = bflo(w.w); f[7] = bfhi(w.w); }
__device__ __forceinline__ void p4_ynorm_conv(LAS unsigned char* lds, const bf16* YA, const bf16* GB, const bf16* CU, const float* conv_w, const float* attn_g, const float* conv_g, bf16* Y, int G, int bid, int tid, int wave, int lane) {
    LAS float* CWl = (LAS float*)lds; LAS float* AGl = CWl + 3 * CW; LAS float* CGl = AGl + AW;
    for (int i = tid; i < 3 * CW; i += NWAVES * 64) CWl[i] = conv_w[i];
    for (int i = tid; i < AW; i += NWAVES * 64) { AGl[i] = attn_g[i]; CGl[i] = conv_g[i]; }
    __syncthreads();
    const int gw = bid * NWAVES + wave, NGW = G * NWAVES;
    for (int chunk = gw; chunk < M / 8; chunk += NGW) {
        const int m0 = chunk * 8, t0 = m0 % SEQ;
        v4u c1[4], c2[4];
#pragma unroll
        for (int j = 0; j < 4; ++j) { c1[j] = (v4u){0u, 0u, 0u, 0u}; c2[j] = (v4u){0u, 0u, 0u, 0u}; }
        if (t0 != 0) {
#pragma unroll
            for (int j = 0; j < 4; ++j) { c1[j] = *(const GAS v4u*)(CU + (size_t)(m0 - 1) * CW + j * 512 + lane * 8); c2[j] = *(const GAS v4u*)(CU + (size_t)(m0 - 2) * CW + j * 512 + lane * 8); } }
#pragma unroll 1
        for (int rr = 0; rr < 8; ++rr) { const int m = m0 + rr; __builtin_amdgcn_sched_barrier(0);
            v4u a[4], c0[4], gb[4];
#pragma unroll
            for (int j = 0; j < 4; ++j) { a[j] = __builtin_nontemporal_load((const GAS v4u*)(YA + (size_t)m * AW + j * 512 + lane * 8)); c0[j] = __builtin_nontemporal_load((const GAS v4u*)(CU + (size_t)m * CW + j * 512 + lane * 8)); gb[j] = __builtin_nontemporal_load((const GAS v4u*)(GB + (size_t)m * CW + j * 512 + lane * 8)); }
            float ssa = 0.f;
#pragma unroll
            for (int j = 0; j < 4; ++j) { float f[8]; unpack8(a[j], f);
#pragma unroll
                for (int i = 0; i < 8; ++i) ssa += f[i] * f[i]; }
            __builtin_amdgcn_sched_barrier(0);
            const float rsa = 1.0f / sqrtf(wave_sum(ssa) * (1.0f / AW) + EPS);
#pragma unroll
            for (int j = 0; j < 4; ++j) { float f[8]; unpack8(a[j], f); const int cb = j * 512 + lane * 8;
                const f32x4 g0 = *(const LAS f32x4*)(AGl + cb), g1 = *(const LAS f32x4*)(AGl + cb + 4);
                v4u w; w.x = pg8::cvt_pk_bf16(f[0] * rsa * g0[0], f[1] * rsa * g0[1]); w.y = pg8::cvt_pk_bf16(f[2] * rsa * g0[2], f[3] * rsa * g0[3]);
                w.z = pg8::cvt_pk_bf16(f[4] * rsa * g1[0], f[5] * rsa * g1[1]); w.w = pg8::cvt_pk_bf16(f[6] * rsa * g1[2], f[7] * rsa * g1[3]);
                *(GAS v4u*)(Y + (size_t)m * DM + cb) = w; __builtin_amdgcn_sched_barrier(0); }
            float yc[4][8]; float ssc = 0.f;
#pragma unroll
            for (int j = 0; j < 4; ++j) { float f0[8], f1[8], f2[8], fg[8]; unpack8(c0[j], f0); unpack8(c1[j], f1); unpack8(c2[j], f2); unpack8(gb[j], fg); const int cb = j * 512 + lane * 8;
#pragma unroll
                for (int h = 0; h < 2; ++h) { const f32x4 w0 = *(const LAS f32x4*)(CWl + cb + 4 * h), w1 = *(const LAS f32x4*)(CWl + CW + cb + 4 * h), w2 = *(const LAS f32x4*)(CWl + 2 * CW + cb + 4 * h);
#pragma unroll
                    for (int i = 0; i < 4; ++i) { const float v = fg[4 * h + i] * (w0[i] * f2[4 * h + i] + w1[i] * f1[4 * h + i] + w2[i] * f0[4 * h + i]); yc[j][4 * h + i] = v; ssc += v * v; } }
                __builtin_amdgcn_sched_barrier(0); }
            const float rsc = 1.0f / sqrtf(wave_sum(ssc) * (1.0f / CW) + EPS);
#pragma unroll
            for (int j = 0; j < 4; ++j) { const int cb = j * 512 + lane * 8;
                const f32x4 g0 = *(const LAS f32x4*)(CGl + cb), g1 = *(const LAS f32x4*)(CGl + cb + 4);
                v4u w; w.x = pg8::cvt_pk_bf16(yc[j][0] * rsc * g0[0], yc[j][1] * rsc * g0[1]); w.y = pg8::cvt_pk_bf16(yc[j][2] * rsc * g0[2], yc[j][3] * rsc * g0[3]);
                w.z = pg8::cvt_pk_bf16(yc[j][4] * rsc * g1[0], yc[j][5] * rsc * g1[1]); w.w = pg8::cvt_pk_bf16(yc[j][6] * rsc * g1[2], yc[j][7] * rsc * g1[3]);
                *(GAS v4u*)(Y + (size_t)m * DM + AW + cb) = w; __builtin_amdgcn_sched_barrier(0); }
#pragma unroll
            for (int j = 0; j < 4; ++j) { c2[j] = c1[j]; c1[j] = c0[j]; }
        }
    }
}
__device__ __forceinline__ void p6_resid1(LAS unsigned char* lds, const float* x, const bf16* HM, const float* mod, const float* post_norm_mix, const float* pre_norm_ffn, float* out, bf16* H2, int G, int bid, int tid, int wave, int lane) {
    LAS float* V1 = (LAS float*)lds; LAS float* G2 = V1 + DM; LAS float* S2 = G2 + DM;
    int cur_b = -1;
    for (int blk = bid; blk < M / 64; blk += G) {
        const int b = blk / (SEQ / 64);
        if (b != cur_b) { __syncthreads();
            for (int i = tid; i < DM; i += NWAVES * 64) { const float* mb = mod + b * 6 * DM; V1[i] = mb[2 * DM + i] * post_norm_mix[i]; G2[i] = pre_norm_ffn[i] * (1.f + mb[4 * DM + i]); S2[i] = mb[3 * DM + i]; }
            __syncthreads(); cur_b = b; }
#pragma unroll 1
        for (int rr = 0; rr < 8; ++rr) { const int m = blk * 64 + wave * 8 + rr; __builtin_amdgcn_sched_barrier(0);
            f32x4 xv[16]; v2u hv[16];
#pragma unroll
            for (int j = 0; j < 16; ++j) { xv[j] = __builtin_nontemporal_load((const GAS f32x4*)(x + (size_t)m * DM + j * 256 + lane * 4)); hv[j] = __builtin_nontemporal_load((const GAS v2u*)(HM + (size_t)m * DM + j * 256 + lane * 4)); }
            float ss = 0.f;
#pragma unroll
            for (int j = 0; j < 16; ++j) { const float h0 = bflo(hv[j].x), h1 = bfhi(hv[j].x), h2 = bflo(hv[j].y), h3 = bfhi(hv[j].y); ss += (h0 * h0 + h1 * h1) + (h2 * h2 + h3 * h3); }
            const float r1 = 1.0f / sqrtf(wave_sum(ss) * (1.0f / DM) + EPS);
            float ss2 = 0.f;
#pragma unroll
            for (int j = 0; j < 16; ++j) { const f32x4 v1 = *(const LAS f32x4*)(V1 + j * 256 + lane * 4);
                f32x4 h = {bflo(hv[j].x), bfhi(hv[j].x), bflo(hv[j].y), bfhi(hv[j].y)};
                const f32x4 x1 = xv[j] + v1 * h * r1; xv[j] = x1;
                __builtin_nontemporal_store(x1, (GAS f32x4*)(out + (size_t)m * DM + j * 256 + lane * 4));
                ss2 += (x1[0] * x1[0] + x1[1] * x1[1]) + (x1[2] * x1[2] + x1[3] * x1[3]); }
            const float r2 = 1.0f / sqrtf(wave_sum(ss2) * (1.0f / DM) + EPS);
#pragma unroll
            for (int j = 0; j < 16; ++j) { const f32x4 g2 = *(const LAS f32x4*)(G2 + j * 256 + lane * 4), s2 = *(const LAS f32x4*)(S2 + j * 256 + lane * 4);
                const f32x4 h = xv[j] * r2 * g2 + s2; v2u w; w.x = pg8::cvt_pk_bf16(h[0], h[1]); w.y = pg8::cvt_pk_bf16(h[2], h[3]);
                *(GAS v2u*)(H2 + (size_t)m * DM + j * 256 + lane * 4) = w; }
        }
    }
}
__device__ __forceinline__ void p9_final(LAS unsigned char* lds, const bf16* HM, const float* mod, const float* post_norm_ffn, float* out, int G, int bid, int tid, int wave, int lane) {
    LAS float* V2 = (LAS float*)lds;
    int cur_b = -1;
    for (int blk = bid; blk < M / 64; blk += G) {
        const int b = blk / (SEQ / 64);
        if (b != cur_b) { __syncthreads();
            for (int i = tid; i < DM; i += NWAVES * 64) V2[i] = mod[b * 6 * DM + 5 * DM + i] * post_norm_ffn[i];
            __syncthreads(); cur_b = b; }
#pragma unroll 1
        for (int rr = 0; rr < 8; ++rr) { const int m = blk * 64 + wave * 8 + rr; __builtin_amdgcn_sched_barrier(0);
            f32x4 xv[16]; v2u hv[16];
#pragma unroll
            for (int j = 0; j < 16; ++j) { xv[j] = __builtin_nontemporal_load((const GAS f32x4*)(out + (size_t)m * DM + j * 256 + lane * 4)); hv[j] = __builtin_nontemporal_load((const GAS v2u*)(HM + (size_t)m * DM + j * 256 + lane * 4)); }
            float ss = 0.f;
#pragma unroll
            for (int j = 0; j < 16; ++j) { const float h0 = bflo(hv[j].x), h1 = bfhi(hv[j].x), h2 = bflo(hv[j].y), h3 = bfhi(hv[j].y); ss += (h0 * h0 + h1 * h1) + (h2 * h2 + h3 * h3); }
            const float r1 = 1.0f / sqrtf(wave_sum(ss) * (1.0f / DM) + EPS);
#pragma unroll
            for (int j = 0; j < 16; ++j) { const f32x4 v2 = *(const LAS f32x4*)(V2 + j * 256 + lane * 4);
                f32x4 h = {bflo(hv[j].x), bfhi(hv[j].x), bflo(hv[j].y), bfhi(hv[j].y)};
                __builtin_nontemporal_store(xv[j] + v2 * h * r1, (GAS f32x4*)(out + (size_t)m * DM + j * 256 + lane * 4)); }
        }
    }
}
struct Args { const float* in[17]; float* out; unsigned char* ws; int ph_lo, ph_hi, grid, pad; };
#define KARGP() const __attribute__((address_space(4))) char* kp = (const __attribute__((address_space(4))) char*)__builtin_amdgcn_kernarg_segment_ptr(); asm volatile("" : "+s"(kp))
#define INP(i) (*(const float* const __attribute__((address_space(4)))*)(kp + 8 * (i)))
#define OUTP() (*(float* const __attribute__((address_space(4)))*)(kp + 136))
#define WSP(T, off) ((T*)(*(unsigned char* const __attribute__((address_space(4)))*)(kp + 144) + (off)))
#define KINT(off) (*(const int __attribute__((address_space(4)))*)(kp + (off)))
#define TIDS() const int tid = opaque_tid(wave_s), lane = tid & 63, wave = wave_s
#ifndef PH_MASK
#define PH_MASK 0x3ff
#endif
#define REPS(k) for (int rep_ = 0; rep_ < 1 + (((DUP_MASK) >> (k)) & 1); ++rep_)
#define IN(k) ((((PHM) >> (k)) & 1) != 0)
#define SEAM(k) do { KARGP(); if (IN(k) && IN((k) + 1)) { const int tid = opaque_tid(wave_s); XcdBarrier bar; bar.bar = WSP(unsigned, WS_CTL) + CW_BAR; bar.x = xb_xcc_id(); bar.st = (volatile LAS unsigned*)(lds + MISC_OFF) + 8; xcd_barrier(bar, tid); } } while (0)
template <int PHM> __global__ void __launch_bounds__(NWAVES * 64, 2) hymba_fwd(Args args) {
    constexpr bool HAS_SEAM = (PHM & (PHM >> 1)) != 0;
    extern __shared__ __attribute__((aligned(16))) unsigned char lds_raw[];
    LAS unsigned char* lds = (LAS unsigned char*)lds_raw;
    const int wave_s = __builtin_amdgcn_readfirstlane((int)(threadIdx.x >> 6));
    const int bid = blockIdx.x;
    { KARGP(); TIDS(); (void)lane; (void)wave;
      for (int u = tid; u < (LDS_BYTES - LDSCTL_OFF) / 4; u += NWAVES * 64) ((LAS unsigned*)(lds + LDSCTL_OFF))[u] = 0u;
      __syncthreads();
      if (HAS_SEAM) (void)xcd_barrier_post(WSP(unsigned, WS_CTL) + CW_BAR, (volatile LAS unsigned*)(lds + MISC_OFF) + 8, tid); }

    { KARGP(); if (IN(0)) { TIDS(); const int G = KINT(160); P0Args A{INP(1), INP(2), INP(3), INP(5), INP(10), INP(13), INP(14), INP(15), WSP(float, WS_MOD), WSP(bf16, WS_WF), WSP(bf16, WS_WIN), WSP(bf16, WS_WOUT), WSP(bf16, WS_WGU), WSP(bf16, WS_WD)};
        p0_prologue(lds, A, G, bid, tid, wave, lane); } }
    SEAM(0);
    { KARGP(); if (IN(1)) REPS(1) { TIDS(); const int G = KINT(160); p1_norm1(lds, INP(0), INP(4), WSP(float, WS_MOD), WSP(bf16, WS_WF), WSP(bf16, WS_H), WSP(float, WS_FT), G, bid, tid, wave, lane); } }
    SEAM(1);
    { KARGP(); if (IN(2)) REPS(2) { const int G = KINT(160);
        if (bid < BATCH * NH) { TIDS(); p2_scan(lds, WSP(float, WS_FT), INP(6), WSP(float, WS_FB), bid, tid, wave, lane); }
        pg8::Gemm g{WSP(bf16, WS_H), WSP(bf16, WS_WIN), M, NPROJ, DM}; pg8::StaticOrder S; S.init(M, NPROJ, G, bid);
        pg8::EpiInProj E{WSP(bf16, WS_Q), WSP(bf16, WS_K), WSP(bf16, WS_V), WSP(bf16, WS_GB), WSP(bf16, WS_CU), QSCALE, WSP(unsigned, WS_CTL) + CW_QKMAX};
        pg8::gemm_phase<pg8::EpiInProj, pg8::StaticOrder, PG8_ALIGN, PG8_SP2>(lds, g, S, E, opaque_tid(wave_s)); } }
    SEAM(2);
    { KARGP(); if (IN(3)) { fa::attn_phase((char*)lds_raw, WSP(bf16, WS_Q), WSP(float, WS_FB), WSP(unsigned, WS_CTL) + CW_QKMAX, WSP(unsigned, WS_CTL) + CW_QHEAD, opaque_tid(wave_s)); } }
    SEAM(3);
#if FA_SELFCHECK
    { KARGP(); fa::attn_phase((char*)lds_raw, WSP(bf16, WS_Q), WSP(float, WS_FB), WSP(unsigned, WS_CTL) + CW_QKMAX, WSP(unsigned, WS_CTL) + CW_QHEAD + 64, opaque_tid(wave_s), false, 6); }
    SEAM(3);
    { KARGP(); TIDS(); (void)lane; (void)wave; const unsigned short* a = (const unsigned short*)WSP(bf16, WS_YA); const unsigned short* b = (const unsigned short*)WSP(bf16, WS_HM); unsigned bad = 0;
      for (size_t i = (size_t)bid * 512 + tid; i < (size_t)M * 2048; i += (size_t)KINT(160) * 512) { const float x = __uint_as_float((unsigned)a[i] << 16), y = __uint_as_float((unsigned)b[i] << 16);
          const float tol = fmaxf(fabsf(y), 1e-30f) * (1.0f / 100.0f);
          if (!(fabsf(x - y) <= tol)) bad++; }
      if (bad) __hip_atomic_fetch_add(WSP(unsigned, WS_CTL) + CW_QHEAD + 128, bad, __ATOMIC_RELAXED, __HIP_MEMORY_SCOPE_AGENT); }
    SEAM(3);
#endif
    { KARGP(); if (IN(4)) REPS(4) { TIDS(); const int G = KINT(160); p4_ynorm_conv(lds, WSP(bf16, WS_YA), WSP(bf16, WS_GB), WSP(bf16, WS_CU), INP(7), INP(8), INP(9), WSP(bf16, WS_H), G, bid, tid, wave, lane); } }
    SEAM(4);
    { KARGP(); if (IN(5)) REPS(5) { const int G = KINT(160);
        pg8::Gemm g{WSP(bf16, WS_H), WSP(bf16, WS_WOUT), M, DM, DM}; pg8::StaticOrder S; S.init(M, DM, G, bid);
        pg8::EpiPlain E{WSP(bf16, WS_HM), DM};
        pg8::gemm_phase<pg8::EpiPlain, pg8::StaticOrder, PG8_ALIGN, PG8_SP2>(lds, g, S, E, opaque_tid(wave_s)); } }
    SEAM(5);
    { KARGP(); if (IN(6)) REPS(6) { TIDS(); const int G = KINT(160); p6_resid1(lds, INP(0), WSP(bf16, WS_HM), WSP(float, WS_MOD), INP(11), INP(12), OUTP(), WSP(bf16, WS_H), G, bid, tid, wave, lane); } }
    SEAM(6);
    { KARGP(); if (IN(7)) REPS(7) { const int G = KINT(160);
        pg8::Gemm g{WSP(bf16, WS_H), WSP(bf16, WS_WGU), M, NGU, DM}; pg8::StaticOrder S; S.init(M, NGU, G, bid);
        pg8::EpiSwiGLU E{WSP(bf16, WS_ACT), DFF};
        pg8::gemm_phase<pg8::EpiSwiGLU, pg8::StaticOrder, PG8_ALIGN, PG8_SP2>(lds, g, S, E, opaque_tid(wave_s));
        constexpr int NU7 = (M / 256) * (NGU / 256); const int rem = NU7 % G, first_idle = (rem == 0) ? 0 : rem, nidle = G - first_idle;
        if (bid >= first_idle) { TIDS(); (void)tid; convert_w_down(INP(15), WSP(bf16, WS_WD), bid - first_idle, nidle, wave, lane); } } }
    SEAM(7);
    { KARGP(); if (IN(8)) REPS(8) { const int G = KINT(160);
        pg8::Gemm g{WSP(bf16, WS_ACT), WSP(bf16, WS_WD), M, DM, DFF}; pg8::StaticOrder S; S.init(M, DM, G, bid);
        pg8::EpiPlain E{WSP(bf16, WS_HM), DM};
        pg8::gemm_phase<pg8::EpiPlain, pg8::StaticOrder, PG8_ALIGN, PG8_SP2>(lds, g, S, E, opaque_tid(wave_s)); } }
    SEAM(8);
    { KARGP(); if (IN(9)) { TIDS(); const int G = KINT(160); p9_final(lds, WSP(bf16, WS_HM), WSP(float, WS_MOD), INP(16), OUTP(), G, bid, tid, wave, lane); } }
#if FA_SELFCHECK
    SEAM(8);
    { KARGP(); const int tid = opaque_tid(wave_s); if (bid == 0 && tid == 0 && __hip_atomic_load(WSP(unsigned, WS_CTL) + CW_QHEAD + 128, __ATOMIC_RELAXED, __HIP_MEMORY_SCOPE_AGENT) != 0u) OUTP()[0] = __builtin_nanf(""); }
#endif
}
#undef IN
#undef SEAM
#undef INP
#undef WSP
#undef OUTP
#undef KARGP
#undef KINT
#undef TIDS

typedef void (*kern_t)(Args);
template <int PHM> static bool set_attr() { return hipFuncSetAttribute((const void*)hymba_fwd<PHM>, hipFuncAttributeMaxDynamicSharedMemorySize, LDS_BYTES) == hipSuccess; }
extern "C" void kernel_launch(void* const* d_in, const int* in_sizes, int n_in, void* d_out, int out_size, void* d_ws, size_t ws_size, hipStream_t stream) {
    static int grid = 0;
#if MK_N_LAUNCHES == 1
    static const kern_t kerns[1] = {hymba_fwd<(PH_MASK)>};
#else
    static const kern_t kerns[N_PHASES] = {hymba_fwd<1>, hymba_fwd<2>, hymba_fwd<4>, hymba_fwd<8>, hymba_fwd<16>, hymba_fwd<32>, hymba_fwd<64>, hymba_fwd<128>, hymba_fwd<256>, hymba_fwd<512>};
#endif
    if (grid == 0) {
        if (n_in != 17 || in_sizes[0] != M * DM || out_size != M * DM || ws_size < WS_END) {
            fprintf(stderr, "kernel_launch: built for 17 inputs, x/out of %d floats, >= %zu bytes of workspace; got n_in %d, in0 %d, out %d, ws %zu; nothing launched\n", M * DM, (size_t)WS_END, n_in, n_in > 0 ? in_sizes[0] : -1, out_size, ws_size);
            grid = -1; return; }
        int dev = 0, cus = 0, per_cu = 0;
        if (hipGetDevice(&dev) != hipSuccess || hipDeviceGetAttribute(&cus, hipDeviceAttributeMultiprocessorCount, dev) != hipSuccess) { fprintf(stderr, "kernel_launch: device query failed\n"); grid = -1; return; }
#if MK_N_LAUNCHES == 1
        bool ok = set_attr<(PH_MASK)>();
#else
        bool ok = set_attr<1>() && set_attr<2>() && set_attr<4>() && set_attr<8>() && set_attr<16>() && set_attr<32>() && set_attr<64>() && set_attr<128>() && set_attr<256>() && set_attr<512>();
#endif
        if (!ok) { fprintf(stderr, "kernel_launch: hipFuncSetAttribute failed\n"); grid = -1; return; }
        if (hipOccupancyMaxActiveBlocksPerMultiprocessor(&per_cu, (const void*)kerns[0], NWAVES * 64, LDS_BYTES) != hipSuccess || per_cu < 1)
            fprintf(stderr, "kernel_launch: note: occupancy query reports %d workgroups per CU\n", per_cu);
        (void)hipGetLastError();
        grid = cus;
    }
    if (grid < 0) return;
    if (hipMemsetAsync((char*)d_ws + WS_CTL, 0, CTL_ZERO_BYTES, stream) != hipSuccess) { fprintf(stderr, "kernel_launch: memset failed\n"); return; }
    Args a{};
    for (int i = 0; i < 17; ++i) a.in[i] = (const float*)d_in[i];
    a.out = (float*)d_out; a.ws = (unsigned char*)d_ws; a.grid = grid; a.pad = 0; a.ph_lo = 0; a.ph_hi = N_PHASES;
    for (int li = 0; li < MK_N_LAUNCHES; ++li) {
        hipLaunchKernelGGL(kerns[li], dim3(grid), dim3(NWAVES * 64), LDS_BYTES, stream, a);
        const hipError_t le = hipPeekAtLastError();
        if (le != hipSuccess) { fprintf(stderr, "kernel_launch: launch %d failed: %s\n", li, hipGetErrorName(le)); break; }
    }
}
```

```cpp
#include <hip/hip_runtime.h>
#include <cstdio>
#include <cstdint>
#include <cmath>
#ifndef DUP_MASK
#define DUP_MASK 0
#endif
__device__ __forceinline__ int opaque_tid(int wave_s) { int l; asm volatile("v_mbcnt_lo_u32_b32 %0, -1, 0\n\tv_mbcnt_hi_u32_b32 %0, -1, %0" : "=v"(l)); return (wave_s << 6) | l; }
namespace pg8 {
#define PG8_LAS __attribute__((address_space(3)))
typedef unsigned short bf16_t;
typedef short bf16x8 __attribute__((ext_vector_type(8)));
typedef float f32x4 __attribute__((ext_vector_type(4)));
typedef unsigned u32x4 __attribute__((ext_vector_type(4)));
constexpr int BM = 256, BK = 64, HALF = 128, HTB = HALF * BK * 2  , STAGE_BYTES = 8 * HTB, NXCD = 8, WGM = 8;

__host__ __device__ __forceinline__ int lds_byte(int r, int c) { const int st = (r >> 4) * 2 + (c >> 5), rr = r & 15, cc = c & 31, ob = rr * 64 + cc * 2; return st * 1024 + (ob ^ (((ob >> 9) & 1) << 5)); }
__host__ __device__ __forceinline__ void stage_rc(int b, int& R, int& C) { const int st = b / 1024, sb = b % 1024, swz = sb ^ (((sb >> 9) & 1) << 5); R = (st >> 1) * 16 + swz / 64; C = (st & 1) * 32 + (swz % 64) / 2; }
__host__ __device__ __forceinline__ int perm32(int rho) { const int n = rho >> 4, i = rho & 15; return 8 * (i >> 2) + 4 * n + (i & 3); }

struct Unit { int pm, pn; };
struct Gemm { const bf16_t* A; const bf16_t* Bt; int M, N, K; };

struct StaticOrder {
    int nM, nN, nwg, G, c;
    __host__ __device__ void init(int M, int N, int G_, int c_) { nM = M / BM; nN = N / BM; nwg = nM * nN; G = G_; c = c_; }
    __host__ __device__ bool next(int i, Unit& u) const {
        const long L = (long)i * G + c; if (L >= nwg) return false;
        int wgid = (int)L; { const int q = nwg / NXCD, r = nwg % NXCD, xcd = wgid % NXCD, off = wgid / NXCD; wgid = (xcd < r ? xcd * (q + 1) : r * (q + 1) + (xcd - r) * q) + off; }
        const int nig = WGM * nN, gid = wgid / nig, fm = gid * WGM, gsz = (nM - fm) < WGM ? (nM - fm) : WGM;
        u.pm = fm + ((wgid % nig) % gsz); u.pn = (wgid % nig) / gsz; return true;
    }
    __device__ __forceinline__ void a_ready(const Unit&) const {}
    __device__ __forceinline__ void done(const Unit&) const {}
};
__device__ __forceinline__ unsigned cvt_pk_bf16(float lo, float hi) { unsigned r; asm volatile("v_cvt_pk_bf16_f32 %0, %1, %2" : "=v"(r) : "v"(lo), "v"(hi)); return r; }
typedef float f32x2 __attribute__((ext_vector_type(2)));
#define PG8_RSRC(base, nbytes) __builtin_amdgcn_make_buffer_rsrc((void*)(base), 0, (int)(nbytes), 0x00020000)
#define PG8_ST16(w, rs, boff) __builtin_amdgcn_raw_buffer_store_b128((w), (rs), (int)(boff), 0, 16)
struct EpiPlain {
    static constexpr bool PERM = true, AFTER_DRAIN = false;
    bf16_t* O; int ldc;
    __device__ __forceinline__ void operator()(const f32x4 (&acc)[2][2][4][2], const Unit& u, int wr, int wc, int fr, int fq) const {
        const int row0 = u.pm * BM + wr * 64 + fr, col0 = u.pn * BM + wc * 32 + 8 * fq;
        const auto rs = PG8_RSRC(O, (size_t)16384 * ldc * 2);
#pragma unroll
        for (int ai = 0; ai < 2; ++ai)
#pragma unroll
            for (int m = 0; m < 4; ++m) { const unsigned ro = ((unsigned)(row0 + ai * HALF + m * 16) * (unsigned)ldc + (unsigned)col0) * 2u;
#pragma unroll
                for (int bj = 0; bj < 2; ++bj) { const f32x4 v0 = acc[ai][bj][m][0], v1 = acc[ai][bj][m][1];
                    u32x4 w; w.x = cvt_pk_bf16(v0[0], v0[1]); w.y = cvt_pk_bf16(v0[2], v0[3]); w.z = cvt_pk_bf16(v1[0], v1[1]); w.w = cvt_pk_bf16(v1[2], v1[3]);
                    PG8_ST16(w, rs, ro + bj * HALF * 2); } }
    }
};
struct EpiInProj {
    static constexpr bool PERM = true, AFTER_DRAIN = false;
    bf16_t *Q, *K, *V, *GB, *CU; float qscale; unsigned* qkmax;
    __device__ __forceinline__ void operator()(const f32x4 (&acc)[2][2][4][2], const Unit& u, int wr, int wc, int fr, int fq) const {
        const int row0 = u.pm * BM + wr * 64 + fr;
        if (u.pn < 32) {
            const int t = u.pn >> 3; bf16_t* base = (t == 0) ? Q : (t == 1) ? K : (t == 2) ? V : GB; const float s = (t == 0) ? qscale : 1.f;
            const int col0 = (u.pn & 7) * BM + wc * 32 + 8 * fq;
            const auto rs = PG8_RSRC(base, (size_t)16384 * 2048 * 2);
#pragma unroll
            for (int ai = 0; ai < 2; ++ai)
#pragma unroll
                for (int m = 0; m < 4; ++m) { const unsigned ro = ((unsigned)(row0 + ai * HALF + m * 16) * 2048u + (unsigned)col0) * 2u;
#pragma unroll
                    for (int bj = 0; bj < 2; ++bj) { const f32x4 v0 = acc[ai][bj][m][0] * s, v1 = acc[ai][bj][m][1] * s;
                        u32x4 w; w.x = cvt_pk_bf16(v0[0], v0[1]); w.y = cvt_pk_bf16(v0[2], v0[3]); w.z = cvt_pk_bf16(v1[0], v1[1]); w.w = cvt_pk_bf16(v1[2], v1[3]);
                        PG8_ST16(w, rs, ro + bj * HALF * 2); } }
            if (t <= 1) {
                float mx[2] = {0.f, 0.f};
#pragma unroll
                for (int ai = 0; ai < 2; ++ai)
#pragma unroll
                    for (int m = 0; m < 4; ++m)
#pragma unroll
                        for (int bj = 0; bj < 2; ++bj) { const f32x4 v0 = acc[ai][bj][m][0] * s, v1 = acc[ai][bj][m][1] * s;
                            float ss = (v0[0] * v0[0] + v0[1] * v0[1]) + (v0[2] * v0[2] + v0[3] * v0[3]) + (v1[0] * v1[0] + v1[1] * v1[1]) + (v1[2] * v1[2] + v1[3] * v1[3]);
                            ss += __shfl_xor(ss, 16); ss += __shfl_xor(ss, 32); mx[bj] = fmaxf(mx[bj], ss); }
#pragma unroll
                for (int bj = 0; bj < 2; ++bj) { float mm = mx[bj];
#pragma unroll
                    for (int o = 1; o < 16; o <<= 1) mm = fmaxf(mm, __shfl_xor(mm, o));
                    if (fr == 0 && fq == 0) __hip_atomic_fetch_max(qkmax + (((u.pm >> 5) * 16 + (u.pn & 7) * 2 + bj) * 2 + t) * 4 + wc, __float_as_uint(mm), __ATOMIC_RELAXED, __HIP_MEMORY_SCOPE_AGENT); }
            }
        } else {
            const int col0 = (u.pn - 32) * HALF + wc * 32 + 8 * fq;
            const auto rs = PG8_RSRC(CU, (size_t)16384 * 2048 * 2);
#pragma unroll
            for (int ai = 0; ai < 2; ++ai)
#pragma unroll
                for (int m = 0; m < 4; ++m) { const unsigned ro = ((unsigned)(row0 + ai * HALF + m * 16) * 2048u + (unsigned)col0) * 2u;
                    const f32x4 v0 = acc[ai][0][m][0] * acc[ai][1][m][0], v1 = acc[ai][0][m][1] * acc[ai][1][m][1];
                    u32x4 w; w.x = cvt_pk_bf16(v0[0], v0[1]); w.y = cvt_pk_bf16(v0[2], v0[3]); w.z = cvt_pk_bf16(v1[0], v1[1]); w.w = cvt_pk_bf16(v1[2], v1[3]);
                    PG8_ST16(w, rs, ro); }
        }
    }
};
struct EpiSwiGLU {
    static constexpr bool PERM = true, AFTER_DRAIN = false;
    bf16_t* O; int ldc;
    __device__ __forceinline__ void operator()(const f32x4 (&acc)[2][2][4][2], const Unit& u, int wr, int wc, int fr, int fq) const {
        const int row0 = u.pm * BM + wr * 64 + fr, col0 = u.pn * HALF + wc * 32 + 8 * fq;
        const auto rs = PG8_RSRC(O, (size_t)16384 * ldc * 2);
#pragma unroll
        for (int ai = 0; ai < 2; ++ai)
#pragma unroll
            for (int m = 0; m < 4; ++m) { const unsigned ro = ((unsigned)(row0 + ai * HALF + m * 16) * (unsigned)ldc + (unsigned)col0) * 2u;
                f32x4 r[2];
#pragma unroll
                for (int n = 0; n < 2; ++n) { const f32x4 g = acc[ai][0][m][n], up = acc[ai][1][m][n];
#pragma unroll
                    for (int j = 0; j < 4; ++j) { const float e = __builtin_amdgcn_exp2f(g[j] * -1.4426950408889634f); r[n][j] = g[j] * up[j] * __builtin_amdgcn_rcpf(1.0f + e); } }
                u32x4 w; w.x = cvt_pk_bf16(r[0][0], r[0][1]); w.y = cvt_pk_bf16(r[0][2], r[0][3]); w.z = cvt_pk_bf16(r[1][0], r[1][1]); w.w = cvt_pk_bf16(r[1][2], r[1][3]);
                PG8_ST16(w, rs, ro); }
    }
};

template <class Epi, class Sched, bool ALIGN_EPI = false, bool SP2 = false>
__device__ __forceinline__ void gemm_phase(PG8_LAS unsigned char* lds, const Gemm g, const Sched& S, const Epi& E, const int tid) {
    const int wid = __builtin_amdgcn_readfirstlane(tid >> 6), lane = tid & 63, wr = wid >> 2, wc = wid & 3, fr = lane & 15, fq = lane >> 4;
    const int K = g.K, nt = K / BK;
    unsigned voffA[2], voffB[2];
#pragma unroll
    for (int i = 0; i < 2; ++i) { int R, C; stage_rc(tid * 16 + i * 8192, R, C); const int Rb = Epi::PERM ? ((R & ~31) + perm32(R & 31)) : R;
        voffA[i] = (unsigned)(R * K + C) * 2u; voffB[i] = (unsigned)(Rb * K + C) * 2u; }
    const size_t kstep = (size_t)(BK * 2);
    const size_t hstep = (size_t)HALF * K * 2;
    const size_t tstep = 2 * hstep;
    const unsigned ldsw = (unsigned)wid * 1024u;
    const int aoff = lds_byte(wr * 64 + fr, fq * 8), boff = lds_byte(wc * 32 + fr, fq * 8);
#define PG8_SA(b, h) (((b) * 2 + (h)) * HTB)
#define PG8_SB(b, h) ((4 + (b) * 2 + (h)) * HTB)
#define PG8_STAGE(bufoff, gbase, voff) do { _Pragma("unroll") for (int _i = 0; _i < 2; ++_i) \
        __builtin_amdgcn_global_load_lds((const unsigned*)((const char*)(gbase) + (voff)[_i]), (PG8_LAS unsigned*)(lds + (bufoff) + ldsw + _i * 8192), 16, 0, 0); } while (0)
#define PG8_LDA(dst, b, h) do { _Pragma("unroll") for (int m = 0; m < 4; ++m) _Pragma("unroll") for (int k = 0; k < 2; ++k) dst[m][k] = *(const PG8_LAS bf16x8*)(lds + PG8_SA(b, h) + aoff + m * 2048 + k * 1024); } while (0)
#define PG8_LDB(dst, b, h) do { _Pragma("unroll") for (int n = 0; n < 2; ++n) _Pragma("unroll") for (int k = 0; k < 2; ++k) dst[n][k] = *(const PG8_LAS bf16x8*)(lds + PG8_SB(b, h) + boff + n * 2048 + k * 1024); } while (0)
#define PG8_MMA(ai, bj, At, Bt) do { __builtin_amdgcn_s_setprio(1); _Pragma("unroll") for (int m = 0; m < 4; ++m) _Pragma("unroll") for (int n = 0; n < 2; ++n) _Pragma("unroll") for (int k = 0; k < 2; ++k) \
        acc[ai][bj][m][n] = __builtin_amdgcn_mfma_f32_16x16x32_bf16(Bt[n][k], At[m][k], acc[ai][bj][m][n], 0, 0, 0); __builtin_amdgcn_s_setprio(0); } while (0)
#define PG8_WAIT_V(n) asm volatile("s_waitcnt vmcnt(" #n ")" ::: "memory")
#define PG8_WAIT_L(n) asm volatile("s_waitcnt lgkmcnt(" #n ")" ::: "memory")
#define PG8_BAR __builtin_amdgcn_s_barrier()
#define PG8_SCHED __builtin_amdgcn_sched_barrier(0)
    Unit cur, nxt; int ui = 0;
    if (!S.next(0, cur)) return;
    f32x4 acc[2][2][4][2];
#pragma unroll
    for (int a = 0; a < 2; ++a)
#pragma unroll
        for (int b = 0; b < 2; ++b)
#pragma unroll
            for (int m = 0; m < 4; ++m)
#pragma unroll
                for (int n = 0; n < 2; ++n) acc[a][b][m][n] = (f32x4){0.f, 0.f, 0.f, 0.f};
    bf16x8 At[4][2], B0[2][2], B1[2][2];
    const char* cA = (const char*)g.A + (size_t)cur.pm * tstep; const char* cB = (const char*)g.Bt + (size_t)cur.pn * tstep;
    S.a_ready(cur);
    if constexpr (SP2) {
        PG8_STAGE(PG8_SB(0, 0), cB, voffB); PG8_STAGE(PG8_SB(0, 1), cB + hstep, voffB); PG8_STAGE(PG8_SA(0, 0), cA, voffA); PG8_STAGE(PG8_SA(0, 1), cA + hstep, voffA);
        if (wr == 1) PG8_BAR;
        PG8_WAIT_V(2); PG8_BAR;
        PG8_STAGE(PG8_SB(1, 0), cB + kstep, voffB); PG8_STAGE(PG8_SA(1, 0), cA + kstep, voffA); PG8_STAGE(PG8_SB(1, 1), cB + hstep + kstep, voffB);
        PG8_WAIT_V(6); PG8_BAR;
    } else {
        PG8_STAGE(PG8_SB(0, 0), cB, voffB); PG8_STAGE(PG8_SA(0, 0), cA, voffA); PG8_STAGE(PG8_SB(0, 1), cB + hstep, voffB); PG8_STAGE(PG8_SA(0, 1), cA + hstep, voffA);
        if (wr == 1) PG8_BAR;
        PG8_WAIT_V(4); PG8_BAR;
        PG8_STAGE(PG8_SB(1, 0), cB + kstep, voffB); PG8_STAGE(PG8_SA(1, 0), cA + kstep, voffA); PG8_STAGE(PG8_SB(1, 1), cB + hstep + kstep, voffB);
        PG8_WAIT_V(6); PG8_BAR;
    }
    for (;;) {
        const bool has_next = S.next(ui + 1, nxt);
        const char* nA = has_next ? (const char*)g.A + (size_t)nxt.pm * tstep : cA; const char* nB = has_next ? (const char*)g.Bt + (size_t)nxt.pn * tstep : cB;
        for (int t = 0; t < nt; t += 2) {
            const bool last = (t == nt - 2);
            const char* a1 = cA + (size_t)(t + 1) * kstep;
            const char* a2 = last ? nA : cA + (size_t)(t + 2) * kstep; const char* b2 = last ? nB : cB + (size_t)(t + 2) * kstep;
            const char* a3 = a2 + kstep; const char* b3 = b2 + kstep;
            if (last && has_next) S.a_ready(nxt);
            if constexpr (SP2) {
            PG8_LDB(B0, 0, 0); PG8_LDB(B1, 0, 1); PG8_SCHED; PG8_LDA(At, 0, 0); PG8_STAGE(PG8_SA(1, 1), a1 + hstep, voffA);
            PG8_WAIT_V(8); PG8_WAIT_L(0); PG8_BAR; PG8_MMA(0, 0, At, B0); PG8_MMA(0, 1, At, B1); PG8_BAR; PG8_SCHED;
            PG8_LDA(At, 0, 1); PG8_STAGE(PG8_SB(0, 0), b2, voffB); PG8_STAGE(PG8_SB(0, 1), b2 + hstep, voffB); PG8_STAGE(PG8_SA(0, 0), a2, voffA);
            PG8_WAIT_V(8); PG8_WAIT_L(0); PG8_BAR; PG8_MMA(1, 0, At, B0); PG8_MMA(1, 1, At, B1); PG8_BAR; PG8_SCHED;
            PG8_LDB(B0, 1, 0); PG8_LDB(B1, 1, 1); PG8_SCHED; PG8_LDA(At, 1, 0); PG8_STAGE(PG8_SA(0, 1), a2 + hstep, voffA);
            PG8_WAIT_V(8); PG8_WAIT_L(0); PG8_BAR; PG8_MMA(0, 0, At, B0); PG8_MMA(0, 1, At, B1); PG8_BAR; PG8_SCHED;
            PG8_LDA(At, 1, 1); PG8_STAGE(PG8_SB(1, 0), b3, voffB); PG8_STAGE(PG8_SB(1, 1), b3 + hstep, voffB); PG8_STAGE(PG8_SA(1, 0), a3, voffA);
            PG8_WAIT_V(8); PG8_WAIT_L(0); PG8_BAR; PG8_MMA(1, 0, At, B0); PG8_MMA(1, 1, At, B1); PG8_BAR; PG8_SCHED;
            } else {
            PG8_LDB(B0, 0, 0); PG8_SCHED; PG8_LDA(At, 0, 0); PG8_STAGE(PG8_SA(1, 1), a1 + hstep, voffA);
            PG8_WAIT_L(8); PG8_BAR; PG8_WAIT_L(0); PG8_MMA(0, 0, At, B0); PG8_BAR; PG8_SCHED;
            PG8_LDB(B1, 0, 1); PG8_STAGE(PG8_SB(0, 0), b2, voffB);
            PG8_BAR; PG8_WAIT_L(0); PG8_MMA(0, 1, At, B1); PG8_BAR;
            PG8_LDA(At, 0, 1); PG8_STAGE(PG8_SA(0, 0), a2, voffA);
            PG8_BAR; PG8_WAIT_L(0); PG8_MMA(1, 0, At, B0); PG8_BAR; PG8_SCHED;
            PG8_STAGE(PG8_SB(0, 1), b2 + hstep, voffB);
            PG8_WAIT_V(6); PG8_BAR; PG8_MMA(1, 1, At, B1); PG8_BAR;
            PG8_LDB(B0, 1, 0); PG8_SCHED; PG8_LDA(At, 1, 0); PG8_STAGE(PG8_SA(0, 1), a2 + hstep, voffA);
            PG8_WAIT_L(8); PG8_BAR; PG8_WAIT_L(0); PG8_MMA(0, 0, At, B0); PG8_BAR; PG8_SCHED;
            PG8_LDB(B1, 1, 1); PG8_STAGE(PG8_SB(1, 0), b3, voffB);
            PG8_BAR; PG8_WAIT_L(0); PG8_MMA(0, 1, At, B1); PG8_BAR;
            PG8_LDA(At, 1, 1); PG8_STAGE(PG8_SA(1, 0), a3, voffA);
            PG8_BAR; PG8_WAIT_L(0); PG8_MMA(1, 0, At, B0); PG8_BAR; PG8_SCHED;
            PG8_STAGE(PG8_SB(1, 1), b3 + hstep, voffB);
            PG8_WAIT_V(6); PG8_BAR; PG8_MMA(1, 1, At, B1); PG8_BAR;
            }
        }
        if constexpr (ALIGN_EPI) { if (wr == 0) PG8_BAR; }
        if constexpr (!Epi::AFTER_DRAIN) { E(acc, cur, wr, wc, fr, fq); S.done(cur); }
        if (!has_next) break;
#pragma unroll
        for (int a = 0; a < 2; ++a)
#pragma unroll
            for (int b = 0; b < 2; ++b)
#pragma unroll
                for (int m = 0; m < 4; ++m)
#pragma unroll
                    for (int n = 0; n < 2; ++n) acc[a][b][m][n] = (f32x4){0.f, 0.f, 0.f, 0.f};
        cur = nxt; cA = nA; cB = nB; ++ui;
        if constexpr (ALIGN_EPI) { if (wr == 1) PG8_BAR; }
    }
    PG8_WAIT_V(0);
    if constexpr (!ALIGN_EPI) { if (wr == 0) PG8_BAR; }
    PG8_BAR;
    if constexpr (Epi::AFTER_DRAIN) { E.fused(acc, cur, wr, wc, fr, fq, lds, wid, lane); S.done(cur); }
#undef PG8_SA
#undef PG8_SB
#undef PG8_STAGE
#undef PG8_LDA
#undef PG8_LDB
#undef PG8_MMA
#undef PG8_WAIT_V
#undef PG8_WAIT_L
#undef PG8_BAR
#undef PG8_SCHED
}
}
namespace fa {
typedef unsigned short bf16;
typedef short bf16x8 __attribute__((ext_vector_type(8)));
typedef short s16x4 __attribute__((ext_vector_type(4)));
typedef float f32x16 __attribute__((ext_vector_type(16)));
typedef float f32x4 __attribute__((ext_vector_type(4)));
typedef unsigned u32x4 __attribute__((ext_vector_type(4)));
constexpr int D = 128, PITCH = 2048, SEQ = 8192, NHEAD = 16;
constexpr int NW = 8, QBLK = 32, KVBLK = 64, QB = NW * QBLK, NQB = SEQ / QB;
constexpr int SHM_V = KVBLK * D * 2, SHM_K = KVBLK * D * 2;
constexpr int F_OFF = 2 * SHM_V + 2 * SHM_K + NW * 64 * 4 + 2048;
constexpr int ATT_LDS_BYTES = F_OFF + SEQ * 4 + 256;
constexpr float THR2 = 11.5415603f;
#define FA_KSWZ(row, colB) ((row) * 256 + ((colB) ^ (((row) & 7) << 4)))
#define FA_SBAR() __builtin_amdgcn_sched_barrier(0)
__device__ __forceinline__ int v_st(int k, int c) { const int kk = (k & ~0xC) | ((k & 4) << 1) | ((k & 8) >> 1); return ((kk >> 3) * 4 + (c >> 5)) * 512 + ((kk & 7) * 32 + (c & 31)) * 2; }
__device__ __forceinline__ int v_rd_base(int lane) { return ((lane & 3) << 3) | (((lane >> 2) & 3) << 6) | (((lane >> 4) & 1) << 5) | (((lane >> 5) & 1) << 8); }
constexpr int v_rd_off(int d0, int ks, int half) { return d0 * 512 + ks * 4096 + half * 2048; }
__device__ __forceinline__ int crow(int r, int hi) { return (r & 3) + 8 * (r >> 2) + 4 * hi; }
__device__ __forceinline__ unsigned cvtpk(float lo, float hi) { unsigned r; asm volatile("v_cvt_pk_bf16_f32 %0, %1, %2" : "=v"(r) : "v"(lo), "v"(hi)); return r; }
__device__ __forceinline__ bf16x8 load8(const bf16* p) { return *reinterpret_cast<const bf16x8*>(p); }
__device__ __forceinline__ void mask_tile(f32x16& p0, f32x16& p1, int dq) {
#pragma unroll
    for (int r = 0; r < 16; ++r) { const int c = (r & 3) + 8 * (r >> 2);
        const float t0 = __uint_as_float(0x7f800000u | ((unsigned)(dq - c) & 0x80000000u)), t1 = __uint_as_float(0x7f800000u | ((unsigned)(dq - c - 32) & 0x80000000u));
        p0[r] = fminf(p0[r], t0); p1[r] = fminf(p1[r], t1); }
}
__device__ __forceinline__ void partialSM(f32x16& p0, f32x16& p1, float& m_reg, float& mn, float& alpha) {
    float pmax = p0[0];
#pragma unroll
    for (int r = 1; r < 16; ++r) pmax = fmaxf(pmax, p0[r]);
#pragma unroll
    for (int r = 0; r < 16; ++r) pmax = fmaxf(pmax, p1[r]);
    { auto rr = __builtin_amdgcn_permlane32_swap(__float_as_uint(pmax), __float_as_uint(pmax), false, false);
      pmax = fmaxf(__uint_as_float(rr[0]), __uint_as_float(rr[1])); }
    if (__builtin_expect(__all((pmax - m_reg) <= THR2), 1)) { mn = m_reg; alpha = 1.f; }
    else { mn = fmaxf(m_reg, pmax); alpha = __builtin_amdgcn_exp2f(m_reg - mn); m_reg = mn; }
#pragma unroll
    for (int r = 0; r < 16; ++r) p0[r] = p0[r] - mn;
#pragma unroll
    for (int r = 0; r < 16; ++r) p1[r] = p1[r] - mn;
#pragma unroll
    for (int r = 0; r < 16; ++r) p0[r] = __builtin_amdgcn_exp2f(p0[r]);
}
__device__ __forceinline__ void finishSM(f32x16& p0, f32x16& p1, float alpha, float& l_reg, bf16x8& pa0, bf16x8& pa1, bf16x8& pa2, bf16x8& pa3) {
#pragma unroll
    for (int r = 0; r < 16; ++r) p1[r] = __builtin_amdgcn_exp2f(p1[r]);
    float ps = 0;
#pragma unroll
    for (int r = 0; r < 16; ++r) ps += p0[r];
#pragma unroll
    for (int r = 0; r < 16; ++r) ps += p1[r];
    { auto rr = __builtin_amdgcn_permlane32_swap(__float_as_uint(ps), __float_as_uint(ps), false, false);
      ps = __uint_as_float(rr[0]) + __uint_as_float(rr[1]); }
    l_reg = l_reg * alpha + ps;
#define FA_PK4(P, B_, OUT) do { unsigned a0 = cvtpk(P[B_+0], P[B_+1]), a1 = cvtpk(P[B_+2], P[B_+3]);                          \
        unsigned b0 = cvtpk(P[B_+4], P[B_+5]), b1 = cvtpk(P[B_+6], P[B_+7]);                                             \
        auto r0 = __builtin_amdgcn_permlane32_swap(a0, b0, false, false); auto r1 = __builtin_amdgcn_permlane32_swap(a1, b1, false, false); \
        u32x4 w = {r0[0], r1[0], r0[1], r1[1]}; OUT = *reinterpret_cast<bf16x8*>(&w); } while (0)
    FA_PK4(p0, 0, pa0); FA_PK4(p0, 8, pa1); FA_PK4(p1, 0, pa2); FA_PK4(p1, 8, pa3);
#undef FA_PK4
}
template <int KB>
__device__ __forceinline__ void qkt(f32x16& p0, f32x16& p1, const char* K_lds, int r32, int hi, const bf16x8* qr, const __attribute__((address_space(3))) float* fl) {
#pragma unroll
    for (int g = 0; g < 4; ++g) { const f32x4 a = *(const __attribute__((address_space(3))) f32x4*)(fl + 8 * g), b = *(const __attribute__((address_space(3))) f32x4*)(fl + 32 + 8 * g);
#pragma unroll
        for (int i = 0; i < 4; ++i) { p0[4 * g + i] = a[i]; p1[4 * g + i] = b[i]; } }
    const char* kb[4];
#pragma unroll
    for (int dd = 0; dd < 4; ++dd) kb[dd] = K_lds + KB * SHM_K + FA_KSWZ(r32, (dd * 16 + hi * 8) * 2);
#pragma unroll
    for (int d0 = 0; d0 < 8; ++d0) { const char* a = kb[d0 & 3] + (d0 >> 2) * 128;
        bf16x8 b0 = *reinterpret_cast<const bf16x8*>(a);
        bf16x8 b1 = *reinterpret_cast<const bf16x8*>(a + 32 * 256);
        p0 = __builtin_amdgcn_mfma_f32_32x32x16_bf16(b0, qr[d0], p0, 0, 0, 0);
        p1 = __builtin_amdgcn_mfma_f32_32x32x16_bf16(b1, qr[d0], p1, 0, 0, 0); }
}
template <int VB>
__device__ __forceinline__ void pv_tile(f32x16* o, int vb0, bf16x8 pa0, bf16x8 pa1, bf16x8 pa2, bf16x8 pa3) {
#define FA_TRRD(dst, off) asm volatile("ds_read_b64_tr_b16 %0, %1 offset:%2" : "=&v"(dst) : "v"(vb0), "i"(off) : "memory")
#define FA_PV_D0(d0) do { s16x4 l0, l1, l2, l3, h0, h1, h2, h3; constexpr int b_ = VB * SHM_V + v_rd_off(d0, 0, 0); \
        FA_TRRD(l0, b_); FA_TRRD(h0, b_ + 2048); FA_TRRD(l1, b_ + 4096); FA_TRRD(h1, b_ + 6144); FA_TRRD(l2, b_ + 8192); FA_TRRD(h2, b_ + 10240); FA_TRRD(l3, b_ + 12288); FA_TRRD(h3, b_ + 14336); \
        asm volatile("s_waitcnt lgkmcnt(0)" ::: "memory"); FA_SBAR();   \
        o[d0] = __builtin_amdgcn_mfma_f32_32x32x16_bf16(pa0, (bf16x8){l0[0], l0[1], l0[2], l0[3], h0[0], h0[1], h0[2], h0[3]}, o[d0], 0, 0, 0);   \
        o[d0] = __builtin_amdgcn_mfma_f32_32x32x16_bf16(pa1, (bf16x8){l1[0], l1[1], l1[2], l1[3], h1[0], h1[1], h1[2], h1[3]}, o[d0], 0, 0, 0);   \
        o[d0] = __builtin_amdgcn_mfma_f32_32x32x16_bf16(pa2, (bf16x8){l2[0], l2[1], l2[2], l2[3], h2[0], h2[1], h2[2], h2[3]}, o[d0], 0, 0, 0);   \
        o[d0] = __builtin_amdgcn_mfma_f32_32x32x16_bf16(pa3, (bf16x8){l3[0], l3[1], l3[2], l3[3], h3[0], h3[1], h3[2], h3[3]}, o[d0], 0, 0, 0); } while (0)
    FA_PV_D0(0); FA_PV_D0(1); FA_PV_D0(2); FA_PV_D0(3);
#undef FA_PV_D0
#undef FA_TRRD
}
constexpr size_t BUF = (size_t)16384 * 2048;
struct BlockRef { const bf16* Q; const bf16* K; int P0; int jlo; };
#ifndef FA_SELFCHECK
#define FA_SELFCHECK 0
#endif
#if FA_SELFCHECK
#endif
struct Seam { bf16x8 qr[8]; bf16x8 st_v0, st_v1, st_k0, st_k1; };
#define FA_TILE(p, k0, half) ((const char*)(p) + ((size_t)((k0) + 32 * (half)) * PITCH * 2))
#define FA_VMW() asm volatile("s_waitcnt vmcnt(0)" ::: "memory")
#define FA_VMWN(n) asm volatile("s_waitcnt vmcnt(%0)" :: "i"(n) : "memory")
#define FA_SLOAD(Kp, Vp, k0) do { S.st_v0 = load8((const bf16*)(FA_TILE(Vp, k0, 0) + svoff)); S.st_v1 = load8((const bf16*)(FA_TILE(Vp, k0, 1) + svoff));              \
                         S.st_k0 = load8((const bf16*)(FA_TILE(Kp, k0, 0) + svoff)); S.st_k1 = load8((const bf16*)(FA_TILE(Kp, k0, 1) + svoff)); } while (0)
#define FA_SWRITE_K(bf) do { *(bf16x8*)(K_lds + (bf) * SHM_K + kws) = S.st_k0; *(bf16x8*)(K_lds + (bf) * SHM_K + kws + 32 * 256) = S.st_k1; } while (0)
#define FA_SWRITE_V(bf) do { *(bf16x8*)(V_lds + (bf) * SHM_V + vst0) = S.st_v0; *(bf16x8*)(V_lds + (bf) * SHM_V + vst1) = S.st_v1; } while (0)
#define FA_SWRITE(bf) do { FA_SWRITE_V(bf); FA_SWRITE_K(bf); } while (0)
__device__ __forceinline__ void attn_prime(const BlockRef& cur, char* lds, Seam& S, const int tid) {
    const int wid = __builtin_amdgcn_readfirstlane(tid >> 6), lane = tid & 63, r32 = lane & 31, hi = lane >> 5;
    const int sr = tid >> 4, sc = (tid & 15) * 8, kws = FA_KSWZ(sr, sc * 2); const unsigned svoff = (unsigned)(sr * PITCH + sc) * 2u; char* K_lds = lds + 2 * SHM_V;
#pragma unroll
    for (int d0 = 0; d0 < 8; ++d0) S.qr[d0] = load8(cur.Q + (size_t)(wid * QBLK + r32) * PITCH + d0 * 16 + hi * 8);
    FA_SLOAD(cur.K, cur.K + BUF, cur.jlo * KVBLK); FA_VMW(); FA_SWRITE_K(0);
    __syncthreads();
}
__device__ __forceinline__ void attn_block(const BlockRef& cur, const BlockRef& nxt, char* lds, Seam& S, const int tid, const int obuf = 5) {
    const int wid = __builtin_amdgcn_readfirstlane(tid >> 6), lane = tid & 63, r32 = lane & 31, hi = lane >> 5;
    const int j_lo = cur.jlo, NT = cur.P0 / KVBLK + QB / KVBLK - j_lo;
    const int qlo = cur.P0 + wid * QBLK, qm = qlo + r32 - 4 * hi;
    char* V_lds = lds; char* K_lds = lds + 2 * SHM_V;
    float* ws = (float*)(lds + 2 * SHM_V + 2 * SHM_K) + wid * 64; float* li_l = ws, * al_l = ws + 32;
    const __attribute__((address_space(3))) float* Fl = (const __attribute__((address_space(3))) float*)((__attribute__((address_space(3))) char*)lds + F_OFF) + 4 * hi;
    float m_reg = -1e30f, l_reg = 0; f32x16 o[4] = {};
    const int sr = tid >> 4, sc = (tid & 15) * 8, vst0 = v_st(sr, sc), vst1 = vst0 + 8192  , kws = FA_KSWZ(sr, sc * 2); const unsigned svoff = (unsigned)(sr * PITCH + sc) * 2u;
    const int vb0 = (int)(uintptr_t)V_lds + v_rd_base(lane);
    const bf16* Kh = cur.K; const bf16* Vh = cur.K + BUF;
#define FA_RESC(a) do { if (__any((a) < 1.f)) { if (hi == 0) al_l[r32] = (a); asm volatile("s_waitcnt lgkmcnt(0)" ::: "memory");              \
                     for (int d_ = 0; d_ < 4; ++d_) for (int r = 0; r < 16; ++r) o[d_][r] *= al_l[crow(r, hi)]; } } while (0)
#define FA_KBASE(t) ((j_lo + (t)) * KVBLK)
#define FA_BIASMASK(P0_, P1_, t) do { const int kb_ = FA_KBASE(t); if (kb_ + KVBLK - 1 > qlo) mask_tile(P0_, P1_, qm - kb_); } while (0)
    constexpr int NQL = 8;
#define FA_SEAM_K0() do { FA_VMWN(NQL); FA_SWRITE_K(0); FA_SBAR(); } while (0)
    f32x16 pA0, pA1, pB0, pB1; float mnA, mnB, alA, alB; bf16x8 pa0, pa1, pa2, pa3;
    FA_SWRITE_V(0); FA_SBAR();
    if (NT > 1) { FA_SLOAD(Kh, Vh, FA_KBASE(1)); }
    FA_SBAR(); qkt<0>(pA0, pA1, K_lds, r32, hi, S.qr, Fl + FA_KBASE(0));
    FA_BIASMASK(pA0, pA1, 0); partialSM(pA0, pA1, m_reg, mnA, alA);
    if (NT > 1) { FA_VMW(); FA_SWRITE(1); }
    __syncthreads();
#define FA_HALF_STEP(PX0, PX1, mnX, alX, PY0, PY1, alY, t, KB, VB, SB) do {                                                      \
        FA_SBAR(); qkt<KB>(PX0, PX1, K_lds, r32, hi, S.qr, Fl + FA_KBASE(t));                                             \
        finishSM(PY0, PY1, alY, l_reg, pa0, pa1, pa2, pa3); FA_SBAR();                                                           \
        if ((t) + 1 < NT) { FA_SLOAD(Kh, Vh, FA_KBASE((t) + 1)); FA_SBAR(); }                                               \
        pv_tile<VB>(o, vb0, pa0, pa1, pa2, pa3); FA_BIASMASK(PX0, PX1, (t)); partialSM(PX0, PX1, m_reg, mnX, alX);                                        \
        __syncthreads();                                                                                                      \
        if ((t) + 1 < NT) { FA_VMW(); FA_SWRITE(SB); }                                                                          \
        FA_RESC(alX); __syncthreads(); } while (0)
    for (int t = 1; t + 1 < NT; t += 2) {
        FA_HALF_STEP(pB0, pB1, mnB, alB, pA0, pA1, alA, t, 1, 0, 0);
        FA_HALF_STEP(pA0, pA1, mnA, alA, pB0, pB1, alB, t + 1, 0, 1, 1);
    }
    const bool even = (NT & 1) == 0;
    if (even) { FA_SBAR(); qkt<1>(pB0, pB1, K_lds, r32, hi, S.qr, Fl + FA_KBASE(NT - 1)); FA_SBAR(); }
    FA_SLOAD(nxt.K, nxt.K + BUF, nxt.jlo * KVBLK); FA_SBAR();
#pragma unroll
    for (int d0 = 0; d0 < 8; ++d0) S.qr[d0] = load8(nxt.Q + (size_t)(wid * QBLK + r32) * PITCH + d0 * 16 + hi * 8);
    FA_SBAR();
    finishSM(pA0, pA1, alA, l_reg, pa0, pa1, pa2, pa3); FA_SBAR();
    pv_tile<0>(o, vb0, pa0, pa1, pa2, pa3);
    if (even) { FA_BIASMASK(pB0, pB1, NT - 1); partialSM(pB0, pB1, m_reg, mnB, alB); __syncthreads(); FA_RESC(alB);
        finishSM(pB0, pB1, alB, l_reg, pa0, pa1, pa2, pa3); FA_SBAR(); pv_tile<1>(o, vb0, pa0, pa1, pa2, pa3); }
    FA_SBAR(); FA_SEAM_K0();
    if (hi == 0) li_l[r32] = l_reg; asm volatile("s_waitcnt lgkmcnt(0)" ::: "memory");
    float rli[16];
#pragma unroll
    for (int r = 0; r < 16; ++r) rli[r] = __builtin_amdgcn_rcpf(li_l[crow(r, hi)]);
    bf16* Ow = const_cast<bf16*>(cur.Q) + (size_t)obuf * BUF + (size_t)(wid * QBLK) * PITCH;
#pragma unroll
    for (int r = 0; r < 16; ++r) { const int orow = crow(r, hi);
#pragma unroll
        for (int d0 = 0; d0 < 4; ++d0) { const float v = o[d0][r] * rli[r];
            const float vn = __shfl_xor(v, 1);
            if ((r32 & 1) == 0) *(unsigned*)(Ow + (size_t)orow * PITCH + d0 * 32 + r32) = cvtpk(v, vn); } }
    __syncthreads();
#undef FA_RESC
#undef FA_KBASE
#undef FA_BIASMASK
#undef FA_SEAM_K0
#undef FA_HALF_STEP
}
#undef FA_TILE
#undef FA_VMW
#undef FA_VMWN
#undef FA_SLOAD
#undef FA_SWRITE_K
#undef FA_SWRITE_V
#undef FA_SWRITE
__device__ __forceinline__ BlockRef block_ref(int bh, int qb, int jlo, const bf16* Q) {
    const int b = bh >> 4, h = bh & 15; BlockRef r;
    r.Q = Q + ((size_t)b * SEQ + (size_t)qb * QB) * PITCH + (size_t)h * D; r.K = Q + BUF + (size_t)b * SEQ * PITCH + (size_t)h * D; r.P0 = qb * QB; r.jlo = jlo; return r;
}
__device__ __forceinline__ void load_bias(char* lds, const float* FB, int bh, int k_lo, int k_hi, const int tid) {
    const f32x4* src = (const f32x4*)(FB + (size_t)bh * SEQ); __attribute__((address_space(3))) f32x4* dst = (__attribute__((address_space(3))) f32x4*)((__attribute__((address_space(3))) char*)lds + F_OFF);
    int t0 = tid; asm volatile("" : "+v"(t0));
    for (int i = k_lo / 4 + t0; i < k_hi / 4; i += NW * 64) dst[i] = src[i];
    __syncthreads();
}
#ifndef FA_PRUNE
#define FA_PRUNE 1
#endif
constexpr float PRUNE_T2 = 44.0f;
constexpr int NTICKETS = (1 + (((DUP_MASK) >> 3) & 1)) * 2 * NHEAD * NQB;
constexpr int XQ_OFF = F_OFF + SEQ * 4;
struct Ticket { int idx, bh, qb, jlo; };
__device__ __forceinline__ Ticket next_block(char* lds, const bf16* Q, const float* FB, const unsigned* qkmax, unsigned* qhead, const int tid, const bool prune = true) {
    __attribute__((address_space(3))) int* xi = (__attribute__((address_space(3))) int*)((__attribute__((address_space(3))) char*)lds + XQ_OFF);
    __attribute__((address_space(3))) float* xf = (__attribute__((address_space(3))) float*)(xi + 16);
    int t0 = tid; asm volatile("" : "+v"(t0));
    const int wid = __builtin_amdgcn_readfirstlane(t0 >> 6), lane = t0 & 63;
    if (t0 == 0) xi[0] = (int)__hip_atomic_fetch_add(qhead, 1u, __ATOMIC_RELAXED, __HIP_MEMORY_SCOPE_AGENT);
    __syncthreads();
    Ticket T; T.idx = xi[0]; { const int id = T.idx % (2 * NHEAD * NQB); T.qb = NQB - 1 - (id >> 5); T.bh = id & 31; } T.jlo = 0;
    if (T.idx >= NTICKETS) { __syncthreads(); return T; }
    const int b = T.bh >> 4, h = T.bh & 15, P0 = T.qb * QB;
#if FA_PRUNE
    const int row = t0 >> 1, half = t0 & 1;
    const bf16* qp = Q + ((size_t)b * SEQ + P0 + row) * PITCH + (size_t)h * D + 64 * half; const bf16* kp = qp + BUF;
    float d = 0.f;
#pragma unroll
    for (int c = 0; c < 8; ++c) { const u32x4 qa = *(const u32x4*)(qp + 8 * c), ka = *(const u32x4*)(kp + 8 * c);
#pragma unroll
        for (int e = 0; e < 4; ++e) { d += __uint_as_float(qa[e] << 16) * __uint_as_float(ka[e] << 16); d += __uint_as_float(qa[e] & 0xffff0000u) * __uint_as_float(ka[e] & 0xffff0000u); } }
    d += __shfl_xor(d, 1);
    d += FB[(size_t)T.bh * SEQ + P0 + row];
#pragma unroll
    for (int o = 2; o < 64; o <<= 1) d = fminf(d, __shfl_xor(d, o));
    if (lane == 0) xf[wid] = d;
    float smax = 0.f;
#pragma unroll
    for (int w = 0; w < 4; ++w) smax += sqrtf(__uint_as_float(qkmax[(T.bh * 2 + 0) * 4 + w]) * __uint_as_float(qkmax[(T.bh * 2 + 1) * 4 + w]));
    smax = smax * 1.02f + 0.5f;
    __syncthreads();
    float mmin = xf[0];
#pragma unroll
    for (int w = 1; w < 8; ++w) mmin = fminf(mmin, xf[w]);
    const float thresh = prune ? mmin - PRUNE_T2 - smax : -__builtin_inff();
    const int nb0 = P0 / KVBLK;
    const bool skip = (t0 < nb0) && (FB[(size_t)T.bh * SEQ + t0 * KVBLK + KVBLK - 1] < thresh);
    const unsigned long long bal = __ballot(skip);
    if (lane == 0) xi[8 + wid] = __popcll(bal);
    __syncthreads();
    T.jlo = xi[8] + xi[9];
    __syncthreads();
#else
    __syncthreads();
#endif
    return T;
}
__device__ __forceinline__ void attn_phase(char* lds, const bf16* Q, const float* FB, const unsigned* qkmax, unsigned* qhead, const int tid, const bool prune = true, const int obuf = 5) {
    Ticket tc = next_block(lds, Q, FB, qkmax, qhead, tid, prune);
    if (tc.idx >= NTICKETS) return;
    BlockRef cur = block_ref(tc.bh, tc.qb, tc.jlo, Q);
    Seam S;
    load_bias(lds, FB, tc.bh, tc.jlo * KVBLK, (tc.qb + 1) * QB, tid);
    attn_prime(cur, lds, S, tid);
    for (;;) {
        const Ticket tn = next_block(lds, Q, FB, qkmax, qhead, tid, prune);
        const bool last = tn.idx >= NTICKETS;
        const BlockRef nxt = last ? cur : block_ref(tn.bh, tn.qb, tn.jlo, Q);
        attn_block(cur, nxt, lds, S, tid, obuf);
        if (last) break;
        load_bias(lds, FB, tn.bh, tn.jlo * KVBLK, (tn.qb + 1) * QB, tid);
        cur = nxt;
    }
}
}

constexpr int NWAVES = 8;
constexpr int BATCH = 2, SEQ = 8192, DM = 4096, NH = 16, HD = 128, AW = 2048, CW = 2048, DFF = 11008, NIN = 12304;
constexpr int M = BATCH * SEQ;
constexpr int NPROJ = 12288;
constexpr int NGU = 2 * DFF;
constexpr float EPS = 1e-6f;
constexpr float QSCALE = 0.08838834764831845f * 1.4426950408889634f;
#ifndef MK_N_LAUNCHES
#define MK_N_LAUNCHES 1
#endif
constexpr int N_PHASES = 10;

#ifndef PG8_ALIGN
#define PG8_ALIGN true
#endif
#ifndef PG8_SP2
#define PG8_SP2 true
#endif
constexpr size_t MiB = 1u << 20;
constexpr size_t WS_CTL = 0, CTL_ZERO_BYTES = 1 * MiB;
constexpr size_t WS_MOD = 512 * 1024;
constexpr size_t WS_WF = 1 * MiB;
constexpr size_t WS_FT = 2 * MiB;
constexpr size_t WS_FB = 3 * MiB;
constexpr size_t WS_WIN = 4 * MiB;
constexpr size_t WS_WOUT = WS_WIN + (size_t)NPROJ * DM * 2;
constexpr size_t WS_WGU = WS_WOUT + (size_t)DM * DM * 2;
constexpr size_t WS_WD = WS_WGU + (size_t)NGU * DM * 2;
constexpr size_t WS_H = WS_WD + (size_t)DM * DFF * 2;
constexpr size_t WS_Q = WS_H + (size_t)M * DM * 2;
constexpr size_t WS_K = WS_Q + (size_t)M * 2048 * 2, WS_V = WS_K + (size_t)M * 2048 * 2, WS_GB = WS_V + (size_t)M * 2048 * 2, WS_CU = WS_GB + (size_t)M * 2048 * 2, WS_YA = WS_CU + (size_t)M * 2048 * 2;
constexpr size_t WS_ACT = WS_Q;
constexpr size_t WS_HM = WS_YA + (size_t)M * 2048 * 2;
constexpr size_t WS_END = WS_HM + (size_t)M * DM * 2;
static_assert(WS_ACT + (size_t)M * DFF * 2 <= WS_HM, "ACT overlay fits inside Q..YA");
static_assert(WS_WIN % 256 == 0 && WS_WOUT % 256 == 0 && WS_WGU % 256 == 0 && WS_WD % 256 == 0 && WS_H % 256 == 0 && WS_Q % 256 == 0 && WS_HM % 256 == 0, "alignment");
constexpr int CW_BAR = 4096;
constexpr int CW_QHEAD = 512, CW_QKMAX = 1024;
constexpr int RING_BYTES = 131072, LDSCTL_OFF = RING_BYTES, MISC_OFF = LDSCTL_OFF + 320, LDS_BYTES = 147456;
static_assert(fa::ATT_LDS_BYTES <= RING_BYTES, "attention LDS");
static_assert(WS_K - WS_Q == fa::BUF * 2 && WS_V - WS_K == fa::BUF * 2 && WS_YA - WS_Q == 5 * fa::BUF * 2, "attention tensor spacing");

#define GAS __attribute__((address_space(1)))
#define LAS __attribute__((address_space(3)))
typedef unsigned short bf16;
typedef unsigned v4u __attribute__((ext_vector_type(4)));
typedef unsigned v2u __attribute__((ext_vector_type(2)));
typedef float f32x4 __attribute__((ext_vector_type(4)));
typedef short bf16x8 __attribute__((ext_vector_type(8)));
typedef GAS unsigned gu32;
#define RLX_AGENT __ATOMIC_RELAXED, __HIP_MEMORY_SCOPE_AGENT
#define LDS_WAIT() asm volatile("s_waitcnt lgkmcnt(0)" ::: "memory")
#define VM_WAIT() asm volatile("s_waitcnt vmcnt(0)" ::: "memory")
__device__ __forceinline__ unsigned f2bf(float f) { unsigned u = __builtin_bit_cast(unsigned, f); return (u + 0x7fffu + ((u >> 16) & 1u)) >> 16; }
__device__ __forceinline__ unsigned pk2(float lo, float hi) { return f2bf(lo) | (f2bf(hi) << 16); }
__device__ __forceinline__ float bflo(unsigned w) { return __builtin_bit_cast(float, w << 16); }
__device__ __forceinline__ float bfhi(unsigned w) { return __builtin_bit_cast(float, w & 0xffff0000u); }
__device__ __forceinline__ float wave_sum(float v) {
#pragma unroll
    for (int o = 1; o < 64; o <<= 1) v += __shfl_xor(v, o);
    return v;
}
#define XB_TMO      128
#define XB_XCNT(j)  (256  + 64 * (j))
#define XB_XSUB(j)  (1280 + 64 * (j))
#define XB_XGEN(j)  (2304 + 64 * (j))
#define XB_TOP      3328
#define XB_TOPGEN   3392
#define XCD_BAR_WORDS 3456
#define XB_SPIN_CAP (1u << 18)

__device__ __forceinline__ unsigned xb_ld(unsigned* p)              { return __hip_atomic_load(p, __ATOMIC_RELAXED, __HIP_MEMORY_SCOPE_AGENT); }
__device__ __forceinline__ unsigned xb_add(unsigned* p, unsigned v) { return __hip_atomic_fetch_add(p, v, __ATOMIC_RELAXED, __HIP_MEMORY_SCOPE_AGENT); }
__device__ __forceinline__ unsigned xb_xcc_id() { return (unsigned)__builtin_amdgcn_s_getreg((3 << 11) | 20) & 0xFu; }
#define XB_SPIN(cond, bar) do { unsigned _sp = 0; while (cond) { __builtin_amdgcn_s_sleep(1); \
    if ((++_sp & 255u) == 0u) { if (xb_ld(&(bar)[XB_TMO])) break; if (_sp > XB_SPIN_CAP) { atomicAdd(&(bar)[XB_TMO], 1u); break; } } } } while (0)

struct XcdBarrier {
    unsigned* bar; unsigned x;
    volatile LAS unsigned* st;
};

__device__ __forceinline__ XcdBarrier xcd_barrier_post(unsigned* bar, volatile LAS unsigned* st, const int tid) {
    XcdBarrier b; b.bar = bar; b.x = xb_xcc_id(); b.st = st;
    if (tid == 0) (void)xb_add(&bar[XB_XCNT(b.x)], 1u);
    return b;
}
__device__ __forceinline__ void xcd_barrier_complete(unsigned* bar, unsigned x, unsigned& nloc, unsigned& nx) {
    const unsigned G = gridDim.x * gridDim.y * gridDim.z;
    unsigned sum, cnt, mine, sp = 0u;
    for (;;) {
        sum = 0u; cnt = 0u; mine = 0u;
#pragma unroll
        for (unsigned j = 0; j < 16; ++j) { const unsigned c = xb_ld(&bar[XB_XCNT(j)]); sum += c; cnt += (c > 0u) ? 1u : 0u; mine = (j == x) ? c : mine; }
        if (sum == G) break;
        __builtin_amdgcn_s_sleep(1);
        if ((++sp & 255u) == 0u) { if (xb_ld(&bar[XB_TMO])) break; if (sp > XB_SPIN_CAP) { atomicAdd(&bar[XB_TMO], 1u); break; } }
    }
    nloc = mine > 0u ? mine : 1u; nx = cnt > 0u ? cnt : 1u;
}

__device__ __forceinline__ void xcd_barrier(const XcdBarrier& b, const int tid) {
    asm volatile("s_waitcnt vmcnt(0)" ::: "memory");
    __syncthreads();
    if (tid == 0) {
        unsigned* bar = b.bar;
        __builtin_amdgcn_s_waitcnt(0);
        unsigned nloc = b.st[0], nx = b.st[1];
        if (nloc == 0u) { xcd_barrier_complete(bar, b.x, nloc, nx); b.st[0] = nloc; b.st[1] = nx; }
        const unsigned old = xb_add(&bar[XB_XSUB(b.x)], 1u);
        const unsigned gen = old / nloc;
        if (old + 1u == (gen + 1u) * nloc) {
            __builtin_amdgcn_fence(__ATOMIC_RELEASE, "agent");
            asm volatile("s_waitcnt vmcnt(0)" ::: "memory");
            const unsigned og = xb_add(&bar[XB_TOP], 1u);
            const unsigned tg = og / nx;
            if (og + 1u == (tg + 1u) * nx) xb_add(&bar[XB_TOPGEN], 1u);
            else XB_SPIN(xb_ld(&bar[XB_TOPGEN]) == tg, bar);
            __builtin_amdgcn_fence(__ATOMIC_ACQUIRE, "agent");
            xb_add(&bar[XB_XGEN(b.x)], 1u);
            asm volatile("s_waitcnt vmcnt(0)" ::: "memory");
        } else {
            XB_SPIN(xb_ld(&bar[XB_XGEN(b.x)]) == gen, bar);
            __builtin_amdgcn_fence(__ATOMIC_ACQUIRE, "agent");
            asm volatile("s_waitcnt vmcnt(0)" ::: "memory");
        }
    }
    __syncthreads();
}
struct DestWin { bf16* W; __device__ __forceinline__ bf16* operator()(int n) const {
    if (n < 6144) return W + (size_t)n * DM;
    if (n < 6160) return nullptr;
    if (n < 8208) return W + (size_t)(6144 + (n - 6160)) * DM;
    if (n < 10256) { const int j = n - 8208; return W + (size_t)(8192 + (j >> 7) * 256 + (j & 127)) * DM; }
    const int j = n - 10256; return W + (size_t)(8192 + (j >> 7) * 256 + 128 + (j & 127)) * DM; } };
struct DestPlain { bf16* W; int K; __device__ __forceinline__ bf16* operator()(int n) const { return W + (size_t)n * K; } };
struct DestGU { bf16* W; int half; __device__ __forceinline__ bf16* operator()(int n) const { return W + (size_t)((n >> 7) * 256 + half * 128 + (n & 127)) * DM; } };
template <class Dest>
__device__ __forceinline__ void p0_transpose_item(const float* W, int K, int N, int item, int lane, const Dest dest) {
    const int nblk = (N + 63) / 64, kb = item / nblk, nb = item - kb * nblk, k0 = 64 * kb, n0 = 64 * nb;
    const int c4 = lane & 15, rs = lane >> 4, n = n0 + 4 * c4; const bool nok = n < N;
    const float* wp = W + (size_t)(k0 + 8 * rs) * N + n;
    f32x4 v[2][8];
#pragma unroll
    for (int jj = 0; jj < 2; ++jj)
#pragma unroll
        for (int kk = 0; kk < 8; ++kk) v[jj][kk] = nok ? __builtin_nontemporal_load((const GAS f32x4*)(wp + (size_t)(32 * jj + kk) * N)) : (f32x4){0.f, 0.f, 0.f, 0.f};
#pragma unroll
    for (int q = 0; q < 4; ++q) { bf16* drow = nok ? dest(n + q) : nullptr;
        if (drow) {
#pragma unroll
            for (int jj = 0; jj < 2; ++jj) { v4u o; o.x = pg8::cvt_pk_bf16(v[jj][0][q], v[jj][1][q]); o.y = pg8::cvt_pk_bf16(v[jj][2][q], v[jj][3][q]); o.z = pg8::cvt_pk_bf16(v[jj][4][q], v[jj][5][q]); o.w = pg8::cvt_pk_bf16(v[jj][6][q], v[jj][7][q]);
                *(GAS v4u*)(drow + k0 + 8 * (rs + 4 * jj)) = o; } } }
}
constexpr int P0_REPS = 1 + ((DUP_MASK) & 1);
struct P0Args { const float *c, *w_ada, *b_ada, *w_in, *w_out, *w_gate, *w_up, *w_down; float* mod; bf16 *WF, *WIN, *WOUT, *WGU, *WD; };
constexpr int P0_I_IN = (DM / 64) * ((NIN + 63) / 64), P0_I_OUT = (DM / 64) * (DM / 64), P0_I_G = (DM / 64) * (DFF / 64), P0_NITEMS = P0_I_IN + P0_I_OUT + 2 * P0_I_G;
struct P0Item { const float* W; bf16* Dst; int N, kind, k0, n0; };
__device__ __forceinline__ P0Item p0_decode(const P0Args& A, int it) {
    P0Item I; int r = it;
    if (r < P0_I_IN) { I.W = A.w_in; I.Dst = A.WIN; I.N = NIN; I.kind = 0; }
    else if ((r -= P0_I_IN) < P0_I_OUT) { I.W = A.w_out; I.Dst = A.WOUT; I.N = DM; I.kind = 1; }
    else if ((r -= P0_I_OUT) < P0_I_G) { I.W = A.w_gate; I.Dst = A.WGU; I.N = DFF; I.kind = 2; }
    else { r -= P0_I_G; I.W = A.w_up; I.Dst = A.WGU; I.N = DFF; I.kind = 3; }
    const int nblk = (I.N + 63) / 64, kb = r / nblk, nb = r - kb * nblk; I.k0 = 64 * kb; I.n0 = 64 * nb; return I;
}
__device__ __forceinline__ bf16* p0_dest(const P0Item& I, int n) {
    if (I.kind == 0) return DestWin{I.Dst}(n);
    if (I.kind == 1) return I.Dst + (size_t)n * DM;
    return DestGU{I.Dst, I.kind - 2}(n);
}
__device__ __forceinline__ void p0_load(const P0Item& I, int lane, f32x4 (&v)[2][8]) {
    const int c4 = lane & 15, rs = lane >> 4, n = I.n0 + 4 * c4; const bool nok = n < I.N;
    const float* wp = I.W + (size_t)(I.k0 + 8 * rs) * I.N + n;
#pragma unroll
    for (int jj = 0; jj < 2; ++jj)
#pragma unroll
        for (int kk = 0; kk < 8; ++kk) v[jj][kk] = nok ? __builtin_nontemporal_load((const GAS f32x4*)(wp + (size_t)(32 * jj + kk) * I.N)) : (f32x4){0.f, 0.f, 0.f, 0.f};
}
__device__ __forceinline__ void p0_store(const P0Item& I, int lane, const f32x4 (&v)[2][8]) {
    const int c4 = lane & 15, rs = lane >> 4, n = I.n0 + 4 * c4; const bool nok = n < I.N;
#pragma unroll
    for (int q = 0; q < 4; ++q) { bf16* drow = nok ? p0_dest(I, n + q) : nullptr;
        if (drow) {
#pragma unroll
            for (int jj = 0; jj < 2; ++jj) { v4u o; o.x = pg8::cvt_pk_bf16(v[jj][0][q], v[jj][1][q]); o.y = pg8::cvt_pk_bf16(v[jj][2][q], v[jj][3][q]); o.z = pg8::cvt_pk_bf16(v[jj][4][q], v[jj][5][q]); o.w = pg8::cvt_pk_bf16(v[jj][6][q], v[jj][7][q]);
                *(GAS v4u*)(drow + I.k0 + 8 * (rs + 4 * jj)) = o; } } }
}
__device__ __forceinline__ void p0_prologue(LAS unsigned char* lds, const P0Args& A, int G, int bid, int tid, int wave, int lane) {
    LAS float* cact = (LAS float*)(lds + 73728);
    for (int i = tid; i < 2 * DM; i += NWAVES * 64) { const float v = A.c[i]; cact[i] = v / (1.f + expf(-v)); }
    __syncthreads();
    for (int rep0 = 0; rep0 < P0_REPS; ++rep0)
    for (int it = bid; it < 12 * 64; it += G) {
        const int cg = it % 12, kc = it / 12, n = cg * 2048 + tid * 4;
        const float* wp = A.w_ada + (size_t)(kc * 64) * (6 * DM) + n;
        f32x4 a0 = {0.f, 0.f, 0.f, 0.f}, a1 = {0.f, 0.f, 0.f, 0.f};
#pragma unroll 32
        for (int kk = 0; kk < 64; ++kk) { const f32x4 w = __builtin_nontemporal_load((const GAS f32x4*)(wp + (size_t)kk * (6 * DM))); const float c0 = cact[kc * 64 + kk], c1 = cact[DM + kc * 64 + kk]; a0 += w * c0; a1 += w * c1; }
        if (kc == 0) { const f32x4 b = *(const f32x4*)(A.b_ada + n); a0 += b; a1 += b; }
        float* m0 = A.mod + n; float* m1 = A.mod + 6 * DM + n;
        if (rep0 == 0 || a0[0] == 1.2345678e30f)
#pragma unroll
        for (int j = 0; j < 4; ++j) { __hip_atomic_fetch_add(m0 + j, a0[j], __ATOMIC_RELAXED, __HIP_MEMORY_SCOPE_AGENT); __hip_atomic_fetch_add(m1 + j, a1[j], __ATOMIC_RELAXED, __HIP_MEMORY_SCOPE_AGENT); }
    }
    { const int g = bid * NWAVES * 64 + tid; if (g < 16 * DM) { const int k = g >> 4, n = g & 15; A.WF[(size_t)n * DM + k] = (bf16)f2bf(A.w_in[(size_t)k * NIN + 6144 + n]); } }
    const int gw = bid * NWAVES + wave, NGW = G * NWAVES;
    constexpr int NVIRT = P0_REPS * P0_NITEMS;
    f32x4 va[2][8], vb[2][8];
    int it = gw;
    if (it < NVIRT) { const P0Item I = p0_decode(A, it % P0_NITEMS); p0_load(I, lane, va); }
    while (it < NVIRT) {
        const int i1 = it + NGW, i2 = it + 2 * NGW;
        if (i1 < NVIRT) { const P0Item I = p0_decode(A, i1 % P0_NITEMS); p0_load(I, lane, vb); }
        { const P0Item I = p0_decode(A, it % P0_NITEMS); p0_store(I, lane, va); }
        if (i1 >= NVIRT) break;
        if (i2 < NVIRT) { const P0Item I = p0_decode(A, i2 % P0_NITEMS); p0_load(I, lane, va); }
        { const P0Item I = p0_decode(A, i1 % P0_NITEMS); p0_store(I, lane, vb); }
        it = i2;
    }
}
__device__ __forceinline__ void convert_w_down(const float* w_down, bf16* WD, int b, int nb, int wave, int lane) {
    constexpr int I_D = (DFF / 64) * (DM / 64);
    for (int it = b * NWAVES + wave; it < I_D; it += nb * NWAVES) p0_transpose_item(w_down, DFF, DM, it, lane, DestPlain{WD, DFF});
}
__device__ __forceinline__ void p1_norm1(LAS unsigned char* lds, const float* x, const float* pre_norm_mix, const float* mod, const bf16* WF, bf16* H1, float* FT, int G, int bid, int tid, int wave, int lane) {
    LAS float* G1 = (LAS float*)lds; LAS float* SH1 = G1 + DM; LAS float* ssqp = SH1 + DM; LAS f32x4* fpart = (LAS f32x4*)(ssqp + 256);
    int cur_b = -1, par = 0; const int r = lane & 15, kq = lane >> 4;
    for (int tile = bid; tile < M / 16; tile += G) {
        const int b = tile / (SEQ / 16);
        if (b != cur_b) { __syncthreads();
            for (int i = tid; i < DM; i += NWAVES * 64) { G1[i] = pre_norm_mix[i] * (1.f + mod[b * 6 * DM + DM + i]); SH1[i] = mod[b * 6 * DM + i]; }
            __syncthreads(); cur_b = b; }
        const int row = tile * 16 + r, kbase = wave * 512 + kq * 8;
        const float* xp = x + (size_t)row * DM + kbase;
        f32x4 xv[16][2];
#pragma unroll
        for (int i = 0; i < 16; ++i) { xv[i][0] = __builtin_nontemporal_load((const GAS f32x4*)(xp + 32 * i)); xv[i][1] = __builtin_nontemporal_load((const GAS f32x4*)(xp + 32 * i + 4)); }
        float ss = 0.f;
#pragma unroll
        for (int i = 0; i < 16; ++i)
#pragma unroll
            for (int h = 0; h < 2; ++h) { const f32x4 v = xv[i][h]; ss += (v[0] * v[0] + v[1] * v[1]) + (v[2] * v[2] + v[3] * v[3]); }
        ss += __shfl_xor(ss, 16); ss += __shfl_xor(ss, 32);
        if (kq == 0) ssqp[(par * 8 + wave) * 16 + r] = ss;
        __syncthreads();
        float tot = 0.f;
#pragma unroll
        for (int w = 0; w < 8; ++w) tot += ssqp[(par * 8 + w) * 16 + r];
        const float rstd = 1.0f / sqrtf(tot * (1.0f / DM) + EPS);
        f32x4 acc = {0.f, 0.f, 0.f, 0.f};
        bf16* hp = H1 + (size_t)row * DM + kbase; const bf16* wfp = WF + (size_t)r * DM + kbase;
#pragma unroll
        for (int i = 0; i < 16; ++i) {
            const f32x4 g0 = *(const LAS f32x4*)(G1 + kbase + 32 * i), g1 = *(const LAS f32x4*)(G1 + kbase + 32 * i + 4);
            const f32x4 s0 = *(const LAS f32x4*)(SH1 + kbase + 32 * i), s1 = *(const LAS f32x4*)(SH1 + kbase + 32 * i + 4);
            const f32x4 v0 = xv[i][0] * rstd * g0 + s0, v1 = xv[i][1] * rstd * g1 + s1;
            v4u w; w.x = pg8::cvt_pk_bf16(v0[0], v0[1]); w.y = pg8::cvt_pk_bf16(v0[2], v0[3]); w.z = pg8::cvt_pk_bf16(v1[0], v1[1]); w.w = pg8::cvt_pk_bf16(v1[2], v1[3]);
            *(GAS v4u*)(hp + 32 * i) = w;
            const bf16x8 af = __builtin_bit_cast(bf16x8, w); const bf16x8 bfr = *(const GAS bf16x8*)(wfp + 32 * i);
            acc = __builtin_amdgcn_mfma_f32_16x16x32_bf16(af, bfr, acc, 0, 0, 0);
        }
        fpart[(par * 8 + wave) * 64 + lane] = acc;
        __syncthreads();
        if (wave == 0) { f32x4 s = fpart[(par * 8) * 64 + lane];
#pragma unroll
            for (int w = 1; w < 8; ++w) s += fpart[(par * 8 + w) * 64 + lane];
            const int t0 = (tile * 16) % SEQ + 4 * kq;
            *(GAS f32x4*)(FT + (size_t)(b * NH + r) * SEQ + t0) = s; }
        par ^= 1;
    }
}
__device__ __forceinline__ void p2_scan(LAS unsigned char* lds, const float* FT, const float* b_f, float* FB, int bh, int tid, int wave, int lane) {
    const float bias = b_f[bh & 15];
    const GAS f32x4* src = (const GAS f32x4*)(FT + (size_t)bh * SEQ + tid * 16);
    double pre[16]; double run = 0.0;
#pragma unroll
    for (int q = 0; q < 4; ++q) { const f32x4 v = src[q];
#pragma unroll
        for (int j = 0; j < 4; ++j) { const float z = v[j] + bias; const float ls = (z >= 0.f) ? -log1pf(expf(-z)) : z - log1pf(expf(z)); run += (double)ls; pre[4 * q + j] = run; } }
    double incl = run;
#pragma unroll
    for (int o = 1; o < 64; o <<= 1) { const double t = __shfl_up(incl, o); if (lane >= o) incl += t; }
    LAS double* wt = (LAS double*)lds;
    if (lane == 63) wt[wave] = incl;
    __syncthreads();
    double off = incl - run;
    for (int w = 0; w < wave; ++w) off += wt[w];
    GAS f32x4* dst = (GAS f32x4*)(FB + (size_t)bh * SEQ + tid * 16);
#pragma unroll
    for (int q = 0; q < 4; ++q) { f32x4 o;
#pragma unroll
        for (int j = 0; j < 4; ++j) o[j] = (float)(-(off + pre[4 * q + j]) * 1.4426950408889634);
        dst[q] = o; }
    __syncthreads();
}
__device__ __forceinline__ void unpack8(const v4u w, float (&f)[8]) { f[0] = bflo(w.x); f[1] = bfhi(w.x); f[2] = bflo(w.y); f[3] = bfhi(w.y); f[4] = bflo(w.z); f[5] = bfhi(w.z); f[6] = bflo(w.w); f[7] = bfhi(w.w); }
__device__ __forceinline__ void p4_ynorm_conv(LAS unsigned char* lds, const bf16* YA, const bf16* GB, const bf16* CU, const float* conv_w, const float* attn_g, const float* conv_g, bf16* Y, int G, int bid, int tid, int wave, int lane) {
    LAS float* CWl = (LAS float*)lds; LAS float* AGl = CWl + 3 * CW; LAS float* CGl = AGl + AW;
    for (int i = tid; i < 3 * CW; i += NWAVES * 64) CWl[i] = conv_w[i];
    for (int i = tid; i < AW; i += NWAVES * 64) { AGl[i] = attn_g[i]; CGl[i] = conv_g[i]; }
    __syncthreads();
    const int gw = bid * NWAVES + wave, NGW = G * NWAVES;
    for (int chunk = gw; chunk < M / 8; chunk += NGW) {
        const int m0 = chunk * 8, t0 = m0 % SEQ;
        v4u c1[4], c2[4];
#pragma unroll
        for (int j = 0; j < 4; ++j) { c1[j] = (v4u){0u, 0u, 0u, 0u}; c2[j] = (v4u){0u, 0u, 0u, 0u}; }
        if (t0 != 0) {
#pragma unroll
            for (int j = 0; j < 4; ++j) { c1[j] = *(const GAS v4u*)(CU + (size_t)(m0 - 1) * CW + j * 512 + lane * 8); c2[j] = *(const GAS v4u*)(CU + (size_t)(m0 - 2) * CW + j * 512 + lane * 8); } }
#pragma unroll 1
        for (int rr = 0; rr < 8; ++rr) { const int m = m0 + rr; __builtin_amdgcn_sched_barrier(0);
            v4u a[4], c0[4], gb[4];
#pragma unroll
            for (int j = 0; j < 4; ++j) { a[j] = __builtin_nontemporal_load((const GAS v4u*)(YA + (size_t)m * AW + j * 512 + lane * 8)); c0[j] = __builtin_nontemporal_load((const GAS v4u*)(CU + (size_t)m * CW + j * 512 + lane * 8)); gb[j] = __builtin_nontemporal_load((const GAS v4u*)(GB + (size_t)m * CW + j * 512 + lane * 8)); }
            float ssa = 0.f;
#pragma unroll
            for (int j = 0; j < 4; ++j) { float f[8]; unpack8(a[j], f);
#pragma unroll
                for (int i = 0; i < 8; ++i) ssa += f[i] * f[i]; }
            __builtin_amdgcn_sched_barrier(0);
            const float rsa = 1.0f / sqrtf(wave_sum(ssa) * (1.0f / AW) + EPS);
#pragma unroll
            for (int j = 0; j < 4; ++j) { float f[8]; unpack8(a[j], f); const int cb = j * 512 + lane * 8;
                const f32x4 g0 = *(const LAS f32x4*)(AGl + cb), g1 = *(const LAS f32x4*)(AGl + cb + 4);
                v4u w; w.x = pg8::cvt_pk_bf16(f[0] * rsa * g0[0], f[1] * rsa * g0[1]); w.y = pg8::cvt_pk_bf16(f[2] * rsa * g0[2], f[3] * rsa * g0[3]);
                w.z = pg8::cvt_pk_bf16(f[4] * rsa * g1[0], f[5] * rsa * g1[1]); w.w = pg8::cvt_pk_bf16(f[6] * rsa * g1[2], f[7] * rsa * g1[3]);
                *(GAS v4u*)(Y + (size_t)m * DM + cb) = w; __builtin_amdgcn_sched_barrier(0); }
            float yc[4][8]; float ssc = 0.f;
#pragma unroll
            for (int j = 0; j < 4; ++j) { float f0[8], f1[8], f2[8], fg[8]; unpack8(c0[j], f0); unpack8(c1[j], f1); unpack8(c2[j], f2); unpack8(gb[j], fg); const int cb = j * 512 + lane * 8;
#pragma unroll
                for (int h = 0; h < 2; ++h) { const f32x4 w0 = *(const LAS f32x4*)(CWl + cb + 4 * h), w1 = *(const LAS f32x4*)(CWl + CW + cb + 4 * h), w2 = *(const LAS f32x4*)(CWl + 2 * CW + cb + 4 * h);
#pragma unroll
                    for (int i = 0; i < 4; ++i) { const float v = fg[4 * h + i] * (w0[i] * f2[4 * h + i] + w1[i] * f1[4 * h + i] + w2[i] * f0[4 * h + i]); yc[j][4 * h + i] = v; ssc += v * v; } }
                __builtin_amdgcn_sched_barrier(0); }
            const float rsc = 1.0f / sqrtf(wave_sum(ssc) * (1.0f / CW) + EPS);
#pragma unroll
            for (int j = 0; j < 4; ++j) { const int cb = j * 512 + lane * 8;
                const f32x4 g0 = *(const LAS f32x4*)(CGl + cb), g1 = *(const LAS f32x4*)(CGl + cb + 4);
                v4u w; w.x = pg8::cvt_pk_bf16(yc[j][0] * rsc * g0[0], yc[j][1] * rsc * g0[1]); w.y = pg8::cvt_pk_bf16(yc[j][2] * rsc * g0[2], yc[j][3] * rsc * g0[3]);
                w.z = pg8::cvt_pk_bf16(yc[j][4] * rsc * g1[0], yc[j][5] * rsc * g1[1]); w.w = pg8::cvt_pk_bf16(yc[j][6] * rsc * g1[2], yc[j][7] * rsc * g1[3]);
                *(GAS v4u*)(Y + (size_t)m * DM + AW + cb) = w; __builtin_amdgcn_sched_barrier(0); }
#pragma unroll
            for (int j = 0; j < 4; ++j) { c2[j] = c1[j]; c1[j] = c0[j]; }
        }
    }
}
__device__ __forceinline__ void p6_resid1(LAS unsigned char* lds, const float* x, const bf16* HM, const float* mod, const float* post_norm_mix, const float* pre_norm_ffn, float* out, bf16* H2, int G, int bid, int tid, int wave, int lane) {
    LAS float* V1 = (LAS float*)lds; LAS float* G2 = V1 + DM; LAS float* S2 = G2 + DM;
    int cur_b = -1;
    for (int blk = bid; blk < M / 64; blk += G) {
        const int b = blk / (SEQ / 64);
        if (b != cur_b) { __syncthreads();
            for (int i = tid; i < DM; i += NWAVES * 64) { const float* mb = mod + b * 6 * DM; V1[i] = mb[2 * DM + i] * post_norm_mix[i]; G2[i] = pre_norm_ffn[i] * (1.f + mb[4 * DM + i]); S2[i] = mb[3 * DM + i]; }
            __syncthreads(); cur_b = b; }
#pragma unroll 1
        for (int rr = 0; rr < 8; ++rr) { const int m = blk * 64 + wave * 8 + rr; __builtin_amdgcn_sched_barrier(0);
            f32x4 xv[16]; v2u hv[16];
#pragma unroll
            for (int j = 0; j < 16; ++j) { xv[j] = __builtin_nontemporal_load((const GAS f32x4*)(x + (size_t)m * DM + j * 256 + lane * 4)); hv[j] = __builtin_nontemporal_load((const GAS v2u*)(HM + (size_t)m * DM + j * 256 + lane * 4)); }
            float ss = 0.f;
#pragma unroll
            for (int j = 0; j < 16; ++j) { const float h0 = bflo(hv[j].x), h1 = bfhi(hv[j].x), h2 = bflo(hv[j].y), h3 = bfhi(hv[j].y); ss += (h0 * h0 + h1 * h1) + (h2 * h2 + h3 * h3); }
            const float r1 = 1.0f / sqrtf(wave_sum(ss) * (1.0f / DM) + EPS);
            float ss2 = 0.f;
#pragma unroll
            for (int j = 0; j < 16; ++j) { const f32x4 v1 = *(const LAS f32x4*)(V1 + j * 256 + lane * 4);
                f32x4 h = {bflo(hv[j].x), bfhi(hv[j].x), bflo(hv[j].y), bfhi(hv[j].y)};
                const f32x4 x1 = xv[j] + v1 * h * r1; xv[j] = x1;
                __builtin_nontemporal_store(x1, (GAS f32x4*)(out + (size_t)m * DM + j * 256 + lane * 4));
                ss2 += (x1[0] * x1[0] + x1[1] * x1[1]) + (x1[2] * x1[2] + x1[3] * x1[3]); }
            const float r2 = 1.0f / sqrtf(wave_sum(ss2) * (1.0f / DM) + EPS);
#pragma unroll
            for (int j = 0; j < 16; ++j) { const f32x4 g2 = *(const LAS f32x4*)(G2 + j * 256 + lane * 4), s2 = *(const LAS f32x4*)(S2 + j * 256 + lane * 4);
                const f32x4 h = xv[j] * r2 * g2 + s2; v2u w; w.x = pg8::cvt_pk_bf16(h[0], h[1]); w.y = pg8::cvt_pk_bf16(h[2], h[3]);
                *(GAS v2u*)(H2 + (size_t)m * DM + j * 256 + lane * 4) = w; }
        }
    }
}
__device__ __forceinline__ void p9_final(LAS unsigned char* lds, const bf16* HM, const float* mod, const float* post_norm_ffn, float* out, int G, int bid, int tid, int wave, int lane) {
    LAS float* V2 = (LAS float*)lds;
    int cur_b = -1;
    for (int blk = bid; blk < M / 64; blk += G) {
        const int b = blk / (SEQ / 64);
        if (b != cur_b) { __syncthreads();
            for (int i = tid; i < DM; i += NWAVES * 64) V2[i] = mod[b * 6 * DM + 5 * DM + i] * post_norm_ffn[i];
            __syncthreads(); cur_b = b; }
#pragma unroll 1
        for (int rr = 0; rr < 8; ++rr) { const int m = blk * 64 + wave * 8 + rr; __builtin_amdgcn_sched_barrier(0);
            f32x4 xv[16]; v2u hv[16];
#pragma unroll
            for (int j = 0; j < 16; ++j) { xv[j] = __builtin_nontemporal_load((const GAS f32x4*)(out + (size_t)m * DM + j * 256 + lane * 4)); hv[j] = __builtin_nontemporal_load((const GAS v2u*)(HM + (size_t)m * DM + j * 256 + lane * 4)); }
            float ss = 0.f;
#pragma unroll
            for (int j = 0; j < 16; ++j) { const float h0 = bflo(hv[j].x), h1 = bfhi(hv[j].x), h2 = bflo(hv[j].y), h3 = bfhi(hv[j].y); ss += (h0 * h0 + h1 * h1) + (h2 * h2 + h3 * h3); }
            const float r1 = 1.0f / sqrtf(wave_sum(ss) * (1.0f / DM) + EPS);
#pragma unroll
            for (int j = 0; j < 16; ++j) { const f32x4 v2 = *(const LAS f32x4*)(V2 + j * 256 + lane * 4);
                f32x4 h = {bflo(hv[j].x), bfhi(hv[j].x), bflo(hv[j].y), bfhi(hv[j].y)};
                __builtin_nontemporal_store(xv[j] + v2 * h * r1, (GAS f32x4*)(out + (size_t)m * DM + j * 256 + lane * 4)); }
        }
    }
}
struct Args { const float* in[17]; float* out; unsigned char* ws; int ph_lo, ph_hi, grid, pad; };
#define KARGP() const __attribute__((address_space(4))) char* kp = (const __attribute__((address_space(4))) char*)__builtin_amdgcn_kernarg_segment_ptr(); asm volatile("" : "+s"(kp))
#define INP(i) (*(const float* const __attribute__((address_space(4)))*)(kp + 8 * (i)))
#define OUTP() (*(float* const __attribute__((address_space(4)))*)(kp + 136))
#define WSP(T, off) ((T*)(*(unsigned char* const __attribute__((address_space(4)))*)(kp + 144) + (off)))
#define KINT(off) (*(const int __attribute__((address_space(4)))*)(kp + (off)))
#define TIDS() const int tid = opaque_tid(wave_s), lane = tid & 63, wave = wave_s
#ifndef PH_MASK
#define PH_MASK 0x3ff
#endif
#define REPS(k) for (int rep_ = 0; rep_ < 1 + (((DUP_MASK) >> (k)) & 1); ++rep_)
#define IN(k) ((((PHM) >> (k)) & 1) != 0)
#define SEAM(k) do { KARGP(); if (IN(k) && IN((k) + 1)) { const int tid = opaque_tid(wave_s); XcdBarrier bar; bar.bar = WSP(unsigned, WS_CTL) + CW_BAR; bar.x = xb_xcc_id(); bar.st = (volatile LAS unsigned*)(lds + MISC_OFF) + 8; xcd_barrier(bar, tid); } } while (0)
template <int PHM> __global__ void __launch_bounds__(NWAVES * 64, 2) hymba_fwd(Args args) {
    constexpr bool HAS_SEAM = (PHM & (PHM >> 1)) != 0;
    extern __shared__ __attribute__((aligned(16))) unsigned char lds_raw[];
    LAS unsigned char* lds = (LAS unsigned char*)lds_raw;
    const int wave_s = __builtin_amdgcn_readfirstlane((int)(threadIdx.x >> 6));
    const int bid = blockIdx.x;
    { KARGP(); TIDS(); (void)lane; (void)wave;
      for (int u = tid; u < (LDS_BYTES - LDSCTL_OFF) / 4; u += NWAVES * 64) ((LAS unsigned*)(lds + LDSCTL_OFF))[u] = 0u;
      __syncthreads();
      if (HAS_SEAM) (void)xcd_barrier_post(WSP(unsigned, WS_CTL) + CW_BAR, (volatile LAS unsigned*)(lds + MISC_OFF) + 8, tid); }

    { KARGP(); if (IN(0)) { TIDS(); const int G = KINT(160); P0Args A{INP(1), INP(2), INP(3), INP(5), INP(10), INP(13), INP(14), INP(15), WSP(float, WS_MOD), WSP(bf16, WS_WF), WSP(bf16, WS_WIN), WSP(bf16, WS_WOUT), WSP(bf16, WS_WGU), WSP(bf16, WS_WD)};
        p0_prologue(lds, A, G, bid, tid, wave, lane); } }
    SEAM(0);
    { KARGP(); if (IN(1)) REPS(1) { TIDS(); const int G = KINT(160); p1_norm1(lds, INP(0), INP(4), WSP(float, WS_MOD), WSP(bf16, WS_WF), WSP(bf16, WS_H), WSP(float, WS_FT), G, bid, tid, wave, lane); } }
    SEAM(1);
    { KARGP(); if (IN(2)) REPS(2) { const int G = KINT(160);
        if (bid < BATCH * NH) { TIDS(); p2_scan(lds, WSP(float, WS_FT), INP(6), WSP(float, WS_FB), bid, tid, wave, lane); }
        pg8::Gemm g{WSP(bf16, WS_H), WSP(bf16, WS_WIN), M, NPROJ, DM}; pg8::StaticOrder S; S.init(M, NPROJ, G, bid);
        pg8::EpiInProj E{WSP(bf16, WS_Q), WSP(bf16, WS_K), WSP(bf16, WS_V), WSP(bf16, WS_GB), WSP(bf16, WS_CU), QSCALE, WSP(unsigned, WS_CTL) + CW_QKMAX};
        pg8::gemm_phase<pg8::EpiInProj, pg8::StaticOrder, PG8_ALIGN, PG8_SP2>(lds, g, S, E, opaque_tid(wave_s)); } }
    SEAM(2);
    { KARGP(); if (IN(3)) { fa::attn_phase((char*)lds_raw, WSP(bf16, WS_Q), WSP(float, WS_FB), WSP(unsigned, WS_CTL) + CW_QKMAX, WSP(unsigned, WS_CTL) + CW_QHEAD, opaque_tid(wave_s)); } }
    SEAM(3);
#if FA_SELFCHECK
    { KARGP(); fa::attn_phase((char*)lds_raw, WSP(bf16, WS_Q), WSP(float, WS_FB), WSP(unsigned, WS_CTL) + CW_QKMAX, WSP(unsigned, WS_CTL) + CW_QHEAD + 64, opaque_tid(wave_s), false, 6); }
    SEAM(3);
    { KARGP(); TIDS(); (void)lane; (void)wave; const unsigned short* a = (const unsigned short*)WSP(bf16, WS_YA); const unsigned short* b = (const unsigned short*)WSP(bf16, WS_HM); unsigned bad = 0;
      for (size_t i = (size_t)bid * 512 + tid; i < (size_t)M * 2048; i += (size_t)KINT(160) * 512) { const float x = __uint_as_float((unsigned)a[i] << 16), y = __uint_as_float((unsigned)b[i] << 16);
          const float tol = fmaxf(fabsf(y), 1e-30f) * (1.0f / 100.0f);
          if (!(fabsf(x - y) <= tol)) bad++; }
      if (bad) __hip_atomic_fetch_add(WSP(unsigned, WS_CTL) + CW_QHEAD + 128, bad, __ATOMIC_RELAXED, __HIP_MEMORY_SCOPE_AGENT); }
    SEAM(3);
#endif
    { KARGP(); if (IN(4)) REPS(4) { TIDS(); const int G = KINT(160); p4_ynorm_conv(lds, WSP(bf16, WS_YA), WSP(bf16, WS_GB), WSP(bf16, WS_CU), INP(7), INP(8), INP(9), WSP(bf16, WS_H), G, bid, tid, wave, lane); } }
    SEAM(4);
    { KARGP(); if (IN(5)) REPS(5) { const int G = KINT(160);
        pg8::Gemm g{WSP(bf16, WS_H), WSP(bf16, WS_WOUT), M, DM, DM}; pg8::StaticOrder S; S.init(M, DM, G, bid);
        pg8::EpiPlain E{WSP(bf16, WS_HM), DM};
        pg8::gemm_phase<pg8::EpiPlain, pg8::StaticOrder, PG8_ALIGN, PG8_SP2>(lds, g, S, E, opaque_tid(wave_s)); } }
    SEAM(5);
    { KARGP(); if (IN(6)) REPS(6) { TIDS(); const int G = KINT(160); p6_resid1(lds, INP(0), WSP(bf16, WS_HM), WSP(float, WS_MOD), INP(11), INP(12), OUTP(), WSP(bf16, WS_H), G, bid, tid, wave, lane); } }
    SEAM(6);
    { KARGP(); if (IN(7)) REPS(7) { const int G = KINT(160);
        pg8::Gemm g{WSP(bf16, WS_H), WSP(bf16, WS_WGU), M, NGU, DM}; pg8::StaticOrder S; S.init(M, NGU, G, bid);
        pg8::EpiSwiGLU E{WSP(bf16, WS_ACT), DFF};
        pg8::gemm_phase<pg8::EpiSwiGLU, pg8::StaticOrder, PG8_ALIGN, PG8_SP2>(lds, g, S, E, opaque_tid(wave_s));
        constexpr int NU7 = (M / 256) * (NGU / 256); const int rem = NU7 % G, first_idle = (rem == 0) ? 0 : rem, nidle = G - first_idle;
        if (bid >= first_idle) { TIDS(); (void)tid; convert_w_down(INP(15), WSP(bf16, WS_WD), bid - first_idle, nidle, wave, lane); } } }
    SEAM(7);
    { KARGP(); if (IN(8)) REPS(8) { const int G = KINT(160);
        pg8::Gemm g{WSP(bf16, WS_ACT), WSP(bf16, WS_WD), M, DM, DFF}; pg8::StaticOrder S; S.init(M, DM, G, bid);
        pg8::EpiPlain E{WSP(bf16, WS_HM), DM};
        pg8::gemm_phase<pg8::EpiPlain, pg8::StaticOrder, PG8_ALIGN, PG8_SP2>(lds, g, S, E, opaque_tid(wave_s)); } }
    SEAM(8);
    { KARGP(); if (IN(9)) { TIDS(); const int G = KINT(160); p9_final(lds, WSP(bf16, WS_HM), WSP(float, WS_MOD), INP(16), OUTP(), G, bid, tid, wave, lane); } }
#if FA_SELFCHECK
    SEAM(8);
    { KARGP(); const int tid = opaque_tid(wave_s); if (bid == 0 && tid == 0 && __hip_atomic_load(WSP(unsigned, WS_CTL) + CW_QHEAD + 128, __ATOMIC_RELAXED, __HIP_MEMORY_SCOPE_AGENT) != 0u) OUTP()[0] = __builtin_nanf(""); }
#endif
}
#undef IN
#undef SEAM
#undef INP
#undef WSP
#undef OUTP
#undef KARGP
#undef KINT
#undef TIDS

typedef void (*kern_t)(Args);
template <int PHM> static bool set_attr() { return hipFuncSetAttribute((const void*)hymba_fwd<PHM>, hipFuncAttributeMaxDynamicSharedMemorySize, LDS_BYTES) == hipSuccess; }
extern "C" void kernel_launch(void* const* d_in, const int* in_sizes, int n_in, void* d_out, int out_size, void* d_ws, size_t ws_size, hipStream_t stream) {
    static int grid = 0;
#if MK_N_LAUNCHES == 1
    static const kern_t kerns[1] = {hymba_fwd<(PH_MASK)>};
#else
    static const kern_t kerns[N_PHASES] = {hymba_fwd<1>, hymba_fwd<2>, hymba_fwd<4>, hymba_fwd<8>, hymba_fwd<16>, hymba_fwd<32>, hymba_fwd<64>, hymba_fwd<128>, hymba_fwd<256>, hymba_fwd<512>};
#endif
    if (grid == 0) {
        if (n_in != 17 || in_sizes[0] != M * DM || out_size != M * DM || ws_size < WS_END) {
            fprintf(stderr, "kernel_launch: built for 17 inputs, x/out of %d floats, >= %zu bytes of workspace; got n_in %d, in0 %d, out %d, ws %zu; nothing launched\n", M * DM, (size_t)WS_END, n_in, n_in > 0 ? in_sizes[0] : -1, out_size, ws_size);
            grid = -1; return; }
        int dev = 0, cus = 0, per_cu = 0;
        if (hipGetDevice(&dev) != hipSuccess || hipDeviceGetAttribute(&cus, hipDeviceAttributeMultiprocessorCount, dev) != hipSuccess) { fprintf(stderr, "kernel_launch: device query failed\n"); grid = -1; return; }
#if MK_N_LAUNCHES == 1
        bool ok = set_attr<(PH_MASK)>();
#else
        bool ok = set_attr<1>() && set_attr<2>() && set_attr<4>() && set_attr<8>() && set_attr<16>() && set_attr<32>() && set_attr<64>() && set_attr<128>() && set_attr<256>() && set_attr<512>();
#endif
        if (!ok) { fprintf(stderr, "kernel_launch: hipFuncSetAttribute failed\n"); grid = -1; return; }
        if (hipOccupancyMaxActiveBlocksPerMultiprocessor(&per_cu, (const void*)kerns[0], NWAVES * 64, LDS_BYTES) != hipSuccess || per_cu < 1)
            fprintf(stderr, "kernel_launch: note: occupancy query reports %d workgroups per CU\n", per_cu);
        (void)hipGetLastError();
        grid = cus;
    }
    if (grid < 0) return;
    if (hipMemsetAsync((char*)d_ws + WS_CTL, 0, CTL_ZERO_BYTES, stream) != hipSuccess) { fprintf(stderr, "kernel_launch: memset failed\n"); return; }
    Args a{};
    for (int i = 0; i < 17; ++i) a.in[i] = (const float*)d_in[i];
    a.out = (float*)d_out; a.ws = (unsigned char*)d_ws; a.grid = grid; a.pad = 0; a.ph_lo = 0; a.ph_hi = N_PHASES;
    for (int li = 0; li < MK_N_LAUNCHES; ++li) {
        hipLaunchKernelGGL(kerns[li], dim3(grid), dim3(NWAVES * 64), LDS_BYTES, stream, a);
        const hipError_t le = hipPeekAtLastError();
        if (le != hipSuccess) { fprintf(stderr, "kernel_launch: launch %d failed: %s\n", li, hipGetErrorName(le)); break; }
    }
}
```

```cpp
#include <hip/hip_runtime.h>
#include <cstdio>
#include <cstdint>
#include <cmath>
#ifndef DUP_MASK
#define DUP_MASK 0
#endif
__device__ __forceinline__ int opaque_tid(int wave_s) { int l; asm volatile("v_mbcnt_lo_u32_b32 %0, -1, 0\n\tv_mbcnt_hi_u32_b32 %0, -1, %0" : "=v"(l)); return (wave_s << 6) | l; }
namespace pg8 {
#define PG8_LAS __attribute__((address_space(3)))
typedef unsigned short bf16_t;
typedef short bf16x8 __attribute__((ext_vector_type(8)));
typedef float f32x4 __attribute__((ext_vector_type(4)));
typedef unsigned u32x4 __attribute__((ext_vector_type(4)));
constexpr int BM = 256, BK = 64, HALF = 128, HTB = HALF * BK * 2  , STAGE_BYTES = 8 * HTB, NXCD = 8, WGM = 8;

__host__ __device__ __forceinline__ int lds_byte(int r, int c) { const int st = (r >> 4) * 2 + (c >> 5), rr = r & 15, cc = c & 31, ob = rr * 64 + cc * 2; return st * 1024 + (ob ^ (((ob >> 9) & 1) << 5)); }
__host__ __device__ __forceinline__ void stage_rc(int b, int& R, int& C) { const int st = b / 1024, sb = b % 1024, swz = sb ^ (((sb >> 9) & 1) << 5); R = (st >> 1) * 16 + swz / 64; C = (st & 1) * 32 + (swz % 64) / 2; }
__host__ __device__ __forceinline__ int perm32(int rho) { const int n = rho >> 4, i = rho & 15; return 8 * (i >> 2) + 4 * n + (i & 3); }

struct Unit { int pm, pn; };
struct Gemm { const bf16_t* A; const bf16_t* Bt; int M, N, K; };

struct StaticOrder {
    int nM, nN, nwg, G, c;
    __host__ __device__ void init(int M, int N, int G_, int c_) { nM = M / BM; nN = N / BM; nwg = nM * nN; G = G_; c = c_; }
    __host__ __device__ bool next(int i, Unit& u) const {
        const long L = (long)i * G + c; if (L >= nwg) return false;
        int wgid = (int)L; { const int q = nwg / NXCD, r = nwg % NXCD, xcd = wgid % NXCD, off = wgid / NXCD; wgid = (xcd < r ? xcd * (q + 1) : r * (q + 1) + (xcd - r) * q) + off; }
        const int nig = WGM * nN, gid = wgid / nig, fm = gid * WGM, gsz = (nM - fm) < WGM ? (nM - fm) : WGM;
        u.pm = fm + ((wgid % nig) % gsz); u.pn = (wgid % nig) / gsz; return true;
    }
    __device__ __forceinline__ void a_ready(const Unit&) const {}
    __device__ __forceinline__ void done(const Unit&) const {}
};
__device__ __forceinline__ unsigned cvt_pk_bf16(float lo, float hi) { unsigned r; asm volatile("v_cvt_pk_bf16_f32 %0, %1, %2" : "=v"(r) : "v"(lo), "v"(hi)); return r; }
typedef float f32x2 __attribute__((ext_vector_type(2)));
struct EpiPlain {
    static constexpr bool PERM = true, AFTER_DRAIN = false;
    bf16_t* O; int ldc;
    __device__ __forceinline__ void operator()(const f32x4 (&acc)[2][2][4][2], const Unit& u, int wr, int wc, int fr, int fq) const {
        const int row0 = u.pm * BM + wr * 64 + fr, col0 = u.pn * BM + wc * 32 + 8 * fq;
#pragma unroll
        for (int ai = 0; ai < 2; ++ai)
#pragma unroll
            for (int m = 0; m < 4; ++m) { bf16_t* rowp = O + (size_t)(row0 + ai * HALF + m * 16) * ldc + col0;
#pragma unroll
                for (int bj = 0; bj < 2; ++bj) { const f32x4 v0 = acc[ai][bj][m][0], v1 = acc[ai][bj][m][1];
                    u32x4 w; w.x = cvt_pk_bf16(v0[0], v0[1]); w.y = cvt_pk_bf16(v0[2], v0[3]); w.z = cvt_pk_bf16(v1[0], v1[1]); w.w = cvt_pk_bf16(v1[2], v1[3]);
                    *(u32x4*)(rowp + bj * HALF) = w; } }
    }
};
struct EpiInProj {
    static constexpr bool PERM = true, AFTER_DRAIN = false;
    bf16_t *Q, *K, *V, *GB, *CU; float qscale; unsigned* qkmax;
    __device__ __forceinline__ void operator()(const f32x4 (&acc)[2][2][4][2], const Unit& u, int wr, int wc, int fr, int fq) const {
        const int row0 = u.pm * BM + wr * 64 + fr;
        if (u.pn < 32) {
            const int t = u.pn >> 3; bf16_t* base = (t == 0) ? Q : (t == 1) ? K : (t == 2) ? V : GB; const float s = (t == 0) ? qscale : 1.f;
            const int col0 = (u.pn & 7) * BM + wc * 32 + 8 * fq;
#pragma unroll
            for (int ai = 0; ai < 2; ++ai)
#pragma unroll
                for (int m = 0; m < 4; ++m) { bf16_t* rowp = base + (size_t)(row0 + ai * HALF + m * 16) * 2048 + col0;
#pragma unroll
                    for (int bj = 0; bj < 2; ++bj) { const f32x4 v0 = acc[ai][bj][m][0] * s, v1 = acc[ai][bj][m][1] * s;
                        u32x4 w; w.x = cvt_pk_bf16(v0[0], v0[1]); w.y = cvt_pk_bf16(v0[2], v0[3]); w.z = cvt_pk_bf16(v1[0], v1[1]); w.w = cvt_pk_bf16(v1[2], v1[3]);
                        *(u32x4*)(rowp + bj * HALF) = w; } }
            if (t <= 1) {
                float mx[2] = {0.f, 0.f};
#pragma unroll
                for (int ai = 0; ai < 2; ++ai)
#pragma unroll
                    for (int m = 0; m < 4; ++m)
#pragma unroll
                        for (int bj = 0; bj < 2; ++bj) { const f32x4 v0 = acc[ai][bj][m][0] * s, v1 = acc[ai][bj][m][1] * s;
                            float ss = (v0[0] * v0[0] + v0[1] * v0[1]) + (v0[2] * v0[2] + v0[3] * v0[3]) + (v1[0] * v1[0] + v1[1] * v1[1]) + (v1[2] * v1[2] + v1[3] * v1[3]);
                            ss += __shfl_xor(ss, 16); ss += __shfl_xor(ss, 32); mx[bj] = fmaxf(mx[bj], ss); }
#pragma unroll
                for (int bj = 0; bj < 2; ++bj) { float mm = mx[bj];
#pragma unroll
                    for (int o = 1; o < 16; o <<= 1) mm = fmaxf(mm, __shfl_xor(mm, o));
                    if (fr == 0 && fq == 0) __hip_atomic_fetch_max(qkmax + (((u.pm >> 5) * 16 + (u.pn & 7) * 2 + bj) * 2 + t) * 4 + wc, __float_as_uint(mm), __ATOMIC_RELAXED, __HIP_MEMORY_SCOPE_AGENT); }
            }
        } else {
            const int col0 = (u.pn - 32) * HALF + wc * 32 + 8 * fq;
#pragma unroll
            for (int ai = 0; ai < 2; ++ai)
#pragma unroll
                for (int m = 0; m < 4; ++m) { bf16_t* rowp = CU + (size_t)(row0 + ai * HALF + m * 16) * 2048 + col0;
                    const f32x4 v0 = acc[ai][0][m][0] * acc[ai][1][m][0], v1 = acc[ai][0][m][1] * acc[ai][1][m][1];
                    u32x4 w; w.x = cvt_pk_bf16(v0[0], v0[1]); w.y = cvt_pk_bf16(v0[2], v0[3]); w.z = cvt_pk_bf16(v1[0], v1[1]); w.w = cvt_pk_bf16(v1[2], v1[3]);
                    *(u32x4*)rowp = w; }
        }
    }
};
struct EpiSwiGLU {
    static constexpr bool PERM = true, AFTER_DRAIN = false;
    bf16_t* O; int ldc;
    __device__ __forceinline__ void operator()(const f32x4 (&acc)[2][2][4][2], const Unit& u, int wr, int wc, int fr, int fq) const {
        const int row0 = u.pm * BM + wr * 64 + fr, col0 = u.pn * HALF + wc * 32 + 8 * fq;
#pragma unroll
        for (int ai = 0; ai < 2; ++ai)
#pragma unroll
            for (int m = 0; m < 4; ++m) { bf16_t* rowp = O + (size_t)(row0 + ai * HALF + m * 16) * ldc + col0;
                f32x4 r[2];
#pragma unroll
                for (int n = 0; n < 2; ++n) { const f32x4 g = acc[ai][0][m][n], up = acc[ai][1][m][n];
#pragma unroll
                    for (int j = 0; j < 4; ++j) { const float e = __builtin_amdgcn_exp2f(g[j] * -1.4426950408889634f); r[n][j] = g[j] * up[j] * __builtin_amdgcn_rcpf(1.0f + e); } }
                u32x4 w; w.x = cvt_pk_bf16(r[0][0], r[0][1]); w.y = cvt_pk_bf16(r[0][2], r[0][3]); w.z = cvt_pk_bf16(r[1][0], r[1][1]); w.w = cvt_pk_bf16(r[1][2], r[1][3]);
                *(u32x4*)rowp = w; }
    }
};

template <class Epi, class Sched, bool ALIGN_EPI = false, bool SP2 = false>
__device__ __forceinline__ void gemm_phase(PG8_LAS unsigned char* lds, const Gemm g, const Sched& S, const Epi& E, const int tid) {
    const int wid = __builtin_amdgcn_readfirstlane(tid >> 6), lane = tid & 63, wr = wid >> 2, wc = wid & 3, fr = lane & 15, fq = lane >> 4;
    const int K = g.K, nt = K / BK;
    unsigned voffA[2], voffB[2];
#pragma unroll
    for (int i = 0; i < 2; ++i) { int R, C; stage_rc(tid * 16 + i * 8192, R, C); const int Rb = Epi::PERM ? ((R & ~31) + perm32(R & 31)) : R;
        voffA[i] = (unsigned)(R * K + C) * 2u; voffB[i] = (unsigned)(Rb * K + C) * 2u; }
    const size_t kstep = (size_t)(BK * 2);
    const size_t hstep = (size_t)HALF * K * 2;
    const size_t tstep = 2 * hstep;
    const unsigned ldsw = (unsigned)wid * 1024u;
    const int aoff = lds_byte(wr * 64 + fr, fq * 8), boff = lds_byte(wc * 32 + fr, fq * 8);
#define PG8_SA(b, h) (((b) * 2 + (h)) * HTB)
#define PG8_SB(b, h) ((4 + (b) * 2 + (h)) * HTB)
#define PG8_STAGE(bufoff, gbase, voff) do { _Pragma("unroll") for (int _i = 0; _i < 2; ++_i) \
        __builtin_amdgcn_global_load_lds((const unsigned*)((const char*)(gbase) + (voff)[_i]), (PG8_LAS unsigned*)(lds + (bufoff) + ldsw + _i * 8192), 16, 0, 0); } while (0)
#define PG8_LDA(dst, b, h) do { _Pragma("unroll") for (int m = 0; m < 4; ++m) _Pragma("unroll") for (int k = 0; k < 2; ++k) dst[m][k] = *(const PG8_LAS bf16x8*)(lds + PG8_SA(b, h) + aoff + m * 2048 + k * 1024); } while (0)
#define PG8_LDB(dst, b, h) do { _Pragma("unroll") for (int n = 0; n < 2; ++n) _Pragma("unroll") for (int k = 0; k < 2; ++k) dst[n][k] = *(const PG8_LAS bf16x8*)(lds + PG8_SB(b, h) + boff + n * 2048 + k * 1024); } while (0)
#define PG8_MMA(ai, bj, At, Bt) do { __builtin_amdgcn_s_setprio(1); _Pragma("unroll") for (int m = 0; m < 4; ++m) _Pragma("unroll") for (int n = 0; n < 2; ++n) _Pragma("unroll") for (int k = 0; k < 2; ++k) \
        acc[ai][bj][m][n] = __builtin_amdgcn_mfma_f32_16x16x32_bf16(Bt[n][k], At[m][k], acc[ai][bj][m][n], 0, 0, 0); __builtin_amdgcn_s_setprio(0); } while (0)
#define PG8_WAIT_V(n) asm volatile("s_waitcnt vmcnt(" #n ")" ::: "memory")
#define PG8_WAIT_L(n) asm volatile("s_waitcnt lgkmcnt(" #n ")" ::: "memory")
#define PG8_BAR __builtin_amdgcn_s_barrier()
#define PG8_SCHED __builtin_amdgcn_sched_barrier(0)
    Unit cur, nxt; int ui = 0;
    if (!S.next(0, cur)) return;
    f32x4 acc[2][2][4][2];
#pragma unroll
    for (int a = 0; a < 2; ++a)
#pragma unroll
        for (int b = 0; b < 2; ++b)
#pragma unroll
            for (int m = 0; m < 4; ++m)
#pragma unroll
                for (int n = 0; n < 2; ++n) acc[a][b][m][n] = (f32x4){0.f, 0.f, 0.f, 0.f};
    bf16x8 At[4][2], B0[2][2], B1[2][2];
    const char* cA = (const char*)g.A + (size_t)cur.pm * tstep; const char* cB = (const char*)g.Bt + (size_t)cur.pn * tstep;
    S.a_ready(cur);
    if constexpr (SP2) {
        PG8_STAGE(PG8_SB(0, 0), cB, voffB); PG8_STAGE(PG8_SB(0, 1), cB + hstep, voffB); PG8_STAGE(PG8_SA(0, 0), cA, voffA); PG8_STAGE(PG8_SA(0, 1), cA + hstep, voffA);
        if (wr == 1) PG8_BAR;
        PG8_WAIT_V(2); PG8_BAR;
        PG8_STAGE(PG8_SB(1, 0), cB + kstep, voffB); PG8_STAGE(PG8_SA(1, 0), cA + kstep, voffA); PG8_STAGE(PG8_SB(1, 1), cB + hstep + kstep, voffB);
        PG8_WAIT_V(6); PG8_BAR;
    } else {
        PG8_STAGE(PG8_SB(0, 0), cB, voffB); PG8_STAGE(PG8_SA(0, 0), cA, voffA); PG8_STAGE(PG8_SB(0, 1), cB + hstep, voffB); PG8_STAGE(PG8_SA(0, 1), cA + hstep, voffA);
        if (wr == 1) PG8_BAR;
        PG8_WAIT_V(4); PG8_BAR;
        PG8_STAGE(PG8_SB(1, 0), cB + kstep, voffB); PG8_STAGE(PG8_SA(1, 0), cA + kstep, voffA); PG8_STAGE(PG8_SB(1, 1), cB + hstep + kstep, voffB);
        PG8_WAIT_V(6); PG8_BAR;
    }
    for (;;) {
        const bool has_next = S.next(ui + 1, nxt);
        const char* nA = has_next ? (const char*)g.A + (size_t)nxt.pm * tstep : cA; const char* nB = has_next ? (const char*)g.Bt + (size_t)nxt.pn * tstep : cB;
        for (int t = 0; t < nt; t += 2) {
            const bool last = (t == nt - 2);
            const char* a1 = cA + (size_t)(t + 1) * kstep;
            const char* a2 = last ? nA : cA + (size_t)(t + 2) * kstep; const char* b2 = last ? nB : cB + (size_t)(t + 2) * kstep;
            const char* a3 = a2 + kstep; const char* b3 = b2 + kstep;
            if (last && has_next) S.a_ready(nxt);
            if constexpr (SP2) {
            PG8_LDB(B0, 0, 0); PG8_LDB(B1, 0, 1); PG8_SCHED; PG8_LDA(At, 0, 0); PG8_STAGE(PG8_SA(1, 1), a1 + hstep, voffA);
            PG8_WAIT_V(8); PG8_WAIT_L(0); PG8_BAR; PG8_MMA(0, 0, At, B0); PG8_MMA(0, 1, At, B1); PG8_BAR; PG8_SCHED;
            PG8_LDA(At, 0, 1); PG8_STAGE(PG8_SB(0, 0), b2, voffB); PG8_STAGE(PG8_SB(0, 1), b2 + hstep, voffB); PG8_STAGE(PG8_SA(0, 0), a2, voffA);
            PG8_WAIT_V(8); PG8_WAIT_L(0); PG8_BAR; PG8_MMA(1, 0, At, B0); PG8_MMA(1, 1, At, B1); PG8_BAR; PG8_SCHED;
            PG8_LDB(B0, 1, 0); PG8_LDB(B1, 1, 1); PG8_SCHED; PG8_LDA(At, 1, 0); PG8_STAGE(PG8_SA(0, 1), a2 + hstep, voffA);
            PG8_WAIT_V(8); PG8_WAIT_L(0); PG8_BAR; PG8_MMA(0, 0, At, B0); PG8_MMA(0, 1, At, B1); PG8_BAR; PG8_SCHED;
            PG8_LDA(At, 1, 1); PG8_STAGE(PG8_SB(1, 0), b3, voffB); PG8_STAGE(PG8_SB(1, 1), b3 + hstep, voffB); PG8_STAGE(PG8_SA(1, 0), a3, voffA);
            PG8_WAIT_V(8); PG8_WAIT_L(0); PG8_BAR; PG8_MMA(1, 0, At, B0); PG8_MMA(1, 1, At, B1); PG8_BAR; PG8_SCHED;
            } else {
            PG8_LDB(B0, 0, 0); PG8_SCHED; PG8_LDA(At, 0, 0); PG8_STAGE(PG8_SA(1, 1), a1 + hstep, voffA);
            PG8_WAIT_L(8); PG8_BAR; PG8_WAIT_L(0); PG8_MMA(0, 0, At, B0); PG8_BAR; PG8_SCHED;
            PG8_LDB(B1, 0, 1); PG8_STAGE(PG8_SB(0, 0), b2, voffB);
            PG8_BAR; PG8_WAIT_L(0); PG8_MMA(0, 1, At, B1); PG8_BAR;
            PG8_LDA(At, 0, 1); PG8_STAGE(PG8_SA(0, 0), a2, voffA);
            PG8_BAR; PG8_WAIT_L(0); PG8_MMA(1, 0, At, B0); PG8_BAR; PG8_SCHED;
            PG8_STAGE(PG8_SB(0, 1), b2 + hstep, voffB);
            PG8_WAIT_V(6); PG8_BAR; PG8_MMA(1, 1, At, B1); PG8_BAR;
            PG8_LDB(B0, 1, 0); PG8_SCHED; PG8_LDA(At, 1, 0); PG8_STAGE(PG8_SA(0, 1), a2 + hstep, voffA);
            PG8_WAIT_L(8); PG8_BAR; PG8_WAIT_L(0); PG8_MMA(0, 0, At, B0); PG8_BAR; PG8_SCHED;
            PG8_LDB(B1, 1, 1); PG8_STAGE(PG8_SB(1, 0), b3, voffB);
            PG8_BAR; PG8_WAIT_L(0); PG8_MMA(0, 1, At, B1); PG8_BAR;
            PG8_LDA(At, 1, 1); PG8_STAGE(PG8_SA(1, 0), a3, voffA);
            PG8_BAR; PG8_WAIT_L(0); PG8_MMA(1, 0, At, B0); PG8_BAR; PG8_SCHED;
            PG8_STAGE(PG8_SB(1, 1), b3 + hstep, voffB);
            PG8_WAIT_V(6); PG8_BAR; PG8_MMA(1, 1, At, B1); PG8_BAR;
            }
        }
        if constexpr (ALIGN_EPI) { if (wr == 0) PG8_BAR; }
        if constexpr (!Epi::AFTER_DRAIN) { E(acc, cur, wr, wc, fr, fq); S.done(cur); }
        if (!has_next) break;
#pragma unroll
        for (int a = 0; a < 2; ++a)
#pragma unroll
            for (int b = 0; b < 2; ++b)
#pragma unroll
                for (int m = 0; m < 4; ++m)
#pragma unroll
                    for (int n = 0; n < 2; ++n) acc[a][b][m][n] = (f32x4){0.f, 0.f, 0.f, 0.f};
        cur = nxt; cA = nA; cB = nB; ++ui;
        if constexpr (ALIGN_EPI) { if (wr == 1) PG8_BAR; }
    }
    PG8_WAIT_V(0);
    if constexpr (!ALIGN_EPI) { if (wr == 0) PG8_BAR; }
    PG8_BAR;
    if constexpr (Epi::AFTER_DRAIN) { E.fused(acc, cur, wr, wc, fr, fq, lds, wid, lane); S.done(cur); }
#undef PG8_SA
#undef PG8_SB
#undef PG8_STAGE
#undef PG8_LDA
#undef PG8_LDB
#undef PG8_MMA
#undef PG8_WAIT_V
#undef PG8_WAIT_L
#undef PG8_BAR
#undef PG8_SCHED
}
}
namespace fa {
typedef unsigned short bf16;
typedef short bf16x8 __attribute__((ext_vector_type(8)));
typedef short s16x4 __attribute__((ext_vector_type(4)));
typedef float f32x16 __attribute__((ext_vector_type(16)));
typedef float f32x4 __attribute__((ext_vector_type(4)));
typedef unsigned u32x4 __attribute__((ext_vector_type(4)));
constexpr int D = 128, PITCH = 2048, SEQ = 8192, NHEAD = 16;
constexpr int NW = 8, QBLK = 32, KVBLK = 64, QB = NW * QBLK, NQB = SEQ / QB;
constexpr int SHM_V = KVBLK * D * 2, SHM_K = KVBLK * D * 2;
constexpr int F_OFF = 2 * SHM_V + 2 * SHM_K + NW * 64 * 4 + 2048;
constexpr int ATT_LDS_BYTES = F_OFF + SEQ * 4 + 256;
constexpr float THR2 = 60.0f;
#define FA_KSWZ(row, colB) ((row) * 256 + ((colB) ^ (((row) & 7) << 4)))
#define FA_SBAR() __builtin_amdgcn_sched_barrier(0)
__device__ __forceinline__ int v_st(int k, int c) { const int kk = (k & ~0xC) | ((k & 4) << 1) | ((k & 8) >> 1); return ((kk >> 3) * 4 + (c >> 5)) * 512 + ((kk & 7) * 32 + (c & 31)) * 2; }
__device__ __forceinline__ int v_rd_base(int lane) { return ((lane & 3) << 3) | (((lane >> 2) & 3) << 6) | (((lane >> 4) & 1) << 5) | (((lane >> 5) & 1) << 8); }
constexpr int v_rd_off(int d0, int ks, int half) { return d0 * 512 + ks * 4096 + half * 2048; }
__device__ __forceinline__ int crow(int r, int hi) { return (r & 3) + 8 * (r >> 2) + 4 * hi; }
__device__ __forceinline__ unsigned cvtpk(float lo, float hi) { unsigned r; asm volatile("v_cvt_pk_bf16_f32 %0, %1, %2" : "=v"(r) : "v"(lo), "v"(hi)); return r; }
__device__ __forceinline__ bf16x8 load8(const bf16* p) { return *reinterpret_cast<const bf16x8*>(p); }
__device__ __forceinline__ void mask_tile(f32x16& p0, f32x16& p1, int dq) {
#pragma unroll
    for (int r = 0; r < 16; ++r) { const int c = (r & 3) + 8 * (r >> 2);
        const float t0 = __uint_as_float(0x7f800000u | ((unsigned)(dq - c) & 0x80000000u)), t1 = __uint_as_float(0x7f800000u | ((unsigned)(dq - c - 32) & 0x80000000u));
        p0[r] = fminf(p0[r], t0); p1[r] = fminf(p1[r], t1); }
}
__device__ __forceinline__ void partialSM(f32x16& p0, f32x16& p1, float& m_reg, float& mn, float& alpha) {
    float pmax = p0[0];
#pragma unroll
    for (int r = 1; r < 16; ++r) pmax = fmaxf(pmax, p0[r]);
#pragma unroll
    for (int r = 0; r < 16; ++r) pmax = fmaxf(pmax, p1[r]);
    { auto rr = __builtin_amdgcn_permlane32_swap(__float_as_uint(pmax), __float_as_uint(pmax), false, false);
      pmax = fmaxf(__uint_as_float(rr[0]), __uint_as_float(rr[1])); }
    if (__builtin_expect(__all((pmax - m_reg) <= THR2), 1)) { mn = m_reg; alpha = 1.f; }
    else { mn = fmaxf(m_reg, pmax); alpha = __builtin_amdgcn_exp2f(m_reg - mn); m_reg = mn; }
#pragma unroll
    for (int r = 0; r < 16; ++r) p0[r] = p0[r] - mn;
#pragma unroll
    for (int r = 0; r < 16; ++r) p1[r] = p1[r] - mn;
#pragma unroll
    for (int r = 0; r < 16; ++r) p0[r] = __builtin_amdgcn_exp2f(p0[r]);
}
__device__ __forceinline__ void finishSM(f32x16& p0, f32x16& p1, float alpha, float& l_reg, bf16x8& pa0, bf16x8& pa1, bf16x8& pa2, bf16x8& pa3) {
#pragma unroll
    for (int r = 0; r < 16; ++r) p1[r] = __builtin_amdgcn_exp2f(p1[r]);
    float ps = 0;
#pragma unroll
    for (int r = 0; r < 16; ++r) ps += p0[r];
#pragma unroll
    for (int r = 0; r < 16; ++r) ps += p1[r];
    { auto rr = __builtin_amdgcn_permlane32_swap(__float_as_uint(ps), __float_as_uint(ps), false, false);
      ps = __uint_as_float(rr[0]) + __uint_as_float(rr[1]); }
    l_reg = l_reg * alpha + ps;
#define FA_PK4(P, B_, OUT) do { unsigned a0 = cvtpk(P[B_+0], P[B_+1]), a1 = cvtpk(P[B_+2], P[B_+3]);                          \
        unsigned b0 = cvtpk(P[B_+4], P[B_+5]), b1 = cvtpk(P[B_+6], P[B_+7]);                                             \
        auto r0 = __builtin_amdgcn_permlane32_swap(a0, b0, false, false); auto r1 = __builtin_amdgcn_permlane32_swap(a1, b1, false, false); \
        u32x4 w = {r0[0], r1[0], r0[1], r1[1]}; OUT = *reinterpret_cast<bf16x8*>(&w); } while (0)
    FA_PK4(p0, 0, pa0); FA_PK4(p0, 8, pa1); FA_PK4(p1, 0, pa2); FA_PK4(p1, 8, pa3);
#undef FA_PK4
}
template <int KB>
__device__ __forceinline__ void qkt(f32x16& p0, f32x16& p1, const char* K_lds, int r32, int hi, const bf16x8* qr, const __attribute__((address_space(3))) float* fl) {
#pragma unroll
    for (int g = 0; g < 4; ++g) { const f32x4 a = *(const __attribute__((address_space(3))) f32x4*)(fl + 8 * g), b = *(const __attribute__((address_space(3))) f32x4*)(fl + 32 + 8 * g);
#pragma unroll
        for (int i = 0; i < 4; ++i) { p0[4 * g + i] = a[i]; p1[4 * g + i] = b[i]; } }
    const char* kb[4];
#pragma unroll
    for (int dd = 0; dd < 4; ++dd) kb[dd] = K_lds + KB * SHM_K + FA_KSWZ(r32, (dd * 16 + hi * 8) * 2);
#pragma unroll
    for (int d0 = 0; d0 < 8; ++d0) { const char* a = kb[d0 & 3] + (d0 >> 2) * 128;
        bf16x8 b0 = *reinterpret_cast<const bf16x8*>(a);
        bf16x8 b1 = *reinterpret_cast<const bf16x8*>(a + 32 * 256);
        p0 = __builtin_amdgcn_mfma_f32_32x32x16_bf16(b0, qr[d0], p0, 0, 0, 0);
        p1 = __builtin_amdgcn_mfma_f32_32x32x16_bf16(b1, qr[d0], p1, 0, 0, 0); }
}
template <int VB>
__device__ __forceinline__ void pv_tile(f32x16* o, int vb0, bf16x8 pa0, bf16x8 pa1, bf16x8 pa2, bf16x8 pa3) {
#define FA_TRRD(dst, off) asm volatile("ds_read_b64_tr_b16 %0, %1 offset:%2" : "=&v"(dst) : "v"(vb0), "i"(off) : "memory")
#define FA_PV_D0(d0) do { s16x4 l0, l1, l2, l3, h0, h1, h2, h3; constexpr int b_ = VB * SHM_V + v_rd_off(d0, 0, 0); \
        FA_TRRD(l0, b_); FA_TRRD(h0, b_ + 2048); FA_TRRD(l1, b_ + 4096); FA_TRRD(h1, b_ + 6144); FA_TRRD(l2, b_ + 8192); FA_TRRD(h2, b_ + 10240); FA_TRRD(l3, b_ + 12288); FA_TRRD(h3, b_ + 14336); \
        asm volatile("s_waitcnt lgkmcnt(0)" ::: "memory"); FA_SBAR();   \
        o[d0] = __builtin_amdgcn_mfma_f32_32x32x16_bf16(pa0, (bf16x8){l0[0], l0[1], l0[2], l0[3], h0[0], h0[1], h0[2], h0[3]}, o[d0], 0, 0, 0);   \
        o[d0] = __builtin_amdgcn_mfma_f32_32x32x16_bf16(pa1, (bf16x8){l1[0], l1[1], l1[2], l1[3], h1[0], h1[1], h1[2], h1[3]}, o[d0], 0, 0, 0);   \
        o[d0] = __builtin_amdgcn_mfma_f32_32x32x16_bf16(pa2, (bf16x8){l2[0], l2[1], l2[2], l2[3], h2[0], h2[1], h2[2], h2[3]}, o[d0], 0, 0, 0);   \
        o[d0] = __builtin_amdgcn_mfma_f32_32x32x16_bf16(pa3, (bf16x8){l3[0], l3[1], l3[2], l3[3], h3[0], h3[1], h3[2], h3[3]}, o[d0], 0, 0, 0); } while (0)
    FA_PV_D0(0); FA_PV_D0(1); FA_PV_D0(2); FA_PV_D0(3);
#undef FA_PV_D0
#undef FA_TRRD
}
constexpr size_t BUF = (size_t)16384 * 2048;
struct BlockRef { const bf16* Q; const bf16* K; int P0; int jlo; };
#ifndef FA_SELFCHECK
#define FA_SELFCHECK 0
#endif
#if FA_SELFCHECK
#endif
struct Seam { bf16x8 qr[8]; bf16x8 st_v0, st_v1, st_k0, st_k1; };
#define FA_TILE(p, k0, half) ((const char*)(p) + ((size_t)((k0) + 32 * (half)) * PITCH * 2))
#define FA_VMW() asm volatile("s_waitcnt vmcnt(0)" ::: "memory")
#define FA_VMWN(n) asm volatile("s_waitcnt vmcnt(%0)" :: "i"(n) : "memory")
#define FA_SLOAD(Kp, Vp, k0) do { S.st_v0 = load8((const bf16*)(FA_TILE(Vp, k0, 0) + svoff)); S.st_v1 = load8((const bf16*)(FA_TILE(Vp, k0, 1) + svoff));              \
                         S.st_k0 = load8((const bf16*)(FA_TILE(Kp, k0, 0) + svoff)); S.st_k1 = load8((const bf16*)(FA_TILE(Kp, k0, 1) + svoff)); } while (0)
#define FA_SWRITE_K(bf) do { *(bf16x8*)(K_lds + (bf) * SHM_K + kws) = S.st_k0; *(bf16x8*)(K_lds + (bf) * SHM_K + kws + 32 * 256) = S.st_k1; } while (0)
#define FA_SWRITE_V(bf) do { *(bf16x8*)(V_lds + (bf) * SHM_V + vst0) = S.st_v0; *(bf16x8*)(V_lds + (bf) * SHM_V + vst1) = S.st_v1; } while (0)
#define FA_SWRITE(bf) do { FA_SWRITE_V(bf); FA_SWRITE_K(bf); } while (0)
__device__ __forceinline__ void attn_prime(const BlockRef& cur, char* lds, Seam& S, const int tid) {
    const int wid = __builtin_amdgcn_readfirstlane(tid >> 6), lane = tid & 63, r32 = lane & 31, hi = lane >> 5;
    const int sr = tid >> 4, sc = (tid & 15) * 8, kws = FA_KSWZ(sr, sc * 2); const unsigned svoff = (unsigned)(sr * PITCH + sc) * 2u; char* K_lds = lds + 2 * SHM_V;
#pragma unroll
    for (int d0 = 0; d0 < 8; ++d0) S.qr[d0] = load8(cur.Q + (size_t)(wid * QBLK + r32) * PITCH + d0 * 16 + hi * 8);
    FA_SLOAD(cur.K, cur.K + BUF, cur.jlo * KVBLK); FA_VMW(); FA_SWRITE_K(0);
    __syncthreads();
}
__device__ __forceinline__ void attn_block(const BlockRef& cur, const BlockRef& nxt, char* lds, Seam& S, const int tid, const int obuf = 5) {
    const int wid = __builtin_amdgcn_readfirstlane(tid >> 6), lane = tid & 63, r32 = lane & 31, hi = lane >> 5;
    const int j_lo = cur.jlo, NT = cur.P0 / KVBLK + QB / KVBLK - j_lo;
    const int qlo = cur.P0 + wid * QBLK, qm = qlo + r32 - 4 * hi;
    char* V_lds = lds; char* K_lds = lds + 2 * SHM_V;
    float* ws = (float*)(lds + 2 * SHM_V + 2 * SHM_K) + wid * 64; float* li_l = ws, * al_l = ws + 32;
    const __attribute__((address_space(3))) float* Fl = (const __attribute__((address_space(3))) float*)((__attribute__((address_space(3))) char*)lds + F_OFF) + 4 * hi;
    float m_reg = -1e30f, l_reg = 0; f32x16 o[4] = {};
    const int sr = tid >> 4, sc = (tid & 15) * 8, vst0 = v_st(sr, sc), vst1 = vst0 + 8192  , kws = FA_KSWZ(sr, sc * 2); const unsigned svoff = (unsigned)(sr * PITCH + sc) * 2u;
    const int vb0 = (int)(uintptr_t)V_lds + v_rd_base(lane);
    const bf16* Kh = cur.K; const bf16* Vh = cur.K + BUF;
#define FA_RESC(a) do { if (__any((a) < 1.f)) { if (hi == 0) al_l[r32] = (a); asm volatile("s_waitcnt lgkmcnt(0)" ::: "memory");              \
                     for (int d_ = 0; d_ < 4; ++d_) for (int r = 0; r < 16; ++r) o[d_][r] *= al_l[crow(r, hi)]; } } while (0)
#define FA_KBASE(t) ((j_lo + (t)) * KVBLK)
#define FA_BIASMASK(P0_, P1_, t) do { const int kb_ = FA_KBASE(t); if (kb_ + KVBLK - 1 > qlo) mask_tile(P0_, P1_, qm - kb_); } while (0)
    constexpr int NQL = 8;
#define FA_SEAM_K0() do { FA_VMWN(NQL); FA_SWRITE_K(0); FA_SBAR(); } while (0)
    f32x16 pA0, pA1, pB0, pB1; float mnA, mnB, alA, alB; bf16x8 pa0, pa1, pa2, pa3;
    FA_SWRITE_V(0); FA_SBAR();
    if (NT > 1) { FA_SLOAD(Kh, Vh, FA_KBASE(1)); }
    FA_SBAR(); qkt<0>(pA0, pA1, K_lds, r32, hi, S.qr, Fl + FA_KBASE(0));
    FA_BIASMASK(pA0, pA1, 0); partialSM(pA0, pA1, m_reg, mnA, alA);
    if (NT > 1) { FA_VMW(); FA_SWRITE(1); }
    __syncthreads();
#define FA_HALF_STEP(PX0, PX1, mnX, alX, PY0, PY1, alY, t, KB, VB, SB) do {                                                      \
        FA_SBAR(); qkt<KB>(PX0, PX1, K_lds, r32, hi, S.qr, Fl + FA_KBASE(t));                                             \
        finishSM(PY0, PY1, alY, l_reg, pa0, pa1, pa2, pa3); FA_SBAR();                                                           \
        if ((t) + 1 < NT) { FA_SLOAD(Kh, Vh, FA_KBASE((t) + 1)); FA_SBAR(); }                                               \
        pv_tile<VB>(o, vb0, pa0, pa1, pa2, pa3); FA_BIASMASK(PX0, PX1, (t)); partialSM(PX0, PX1, m_reg, mnX, alX);                                        \
        __syncthreads();                                                                                                      \
        if ((t) + 1 < NT) { FA_VMW(); FA_SWRITE(SB); }                                                                          \
        FA_RESC(alX); __syncthreads(); } while (0)
    for (int t = 1; t + 1 < NT; t += 2) {
        FA_HALF_STEP(pB0, pB1, mnB, alB, pA0, pA1, alA, t, 1, 0, 0);
        FA_HALF_STEP(pA0, pA1, mnA, alA, pB0, pB1, alB, t + 1, 0, 1, 1);
    }
    const bool even = (NT & 1) == 0;
    if (even) { FA_SBAR(); qkt<1>(pB0, pB1, K_lds, r32, hi, S.qr, Fl + FA_KBASE(NT - 1)); FA_SBAR(); }
    FA_SLOAD(nxt.K, nxt.K + BUF, nxt.jlo * KVBLK); FA_SBAR();
#pragma unroll
    for (int d0 = 0; d0 < 8; ++d0) S.qr[d0] = load8(nxt.Q + (size_t)(wid * QBLK + r32) * PITCH + d0 * 16 + hi * 8);
    FA_SBAR();
    finishSM(pA0, pA1, alA, l_reg, pa0, pa1, pa2, pa3); FA_SBAR();
    pv_tile<0>(o, vb0, pa0, pa1, pa2, pa3);
    if (even) { FA_BIASMASK(pB0, pB1, NT - 1); partialSM(pB0, pB1, m_reg, mnB, alB); __syncthreads(); FA_RESC(alB);
        finishSM(pB0, pB1, alB, l_reg, pa0, pa1, pa2, pa3); FA_SBAR(); pv_tile<1>(o, vb0, pa0, pa1, pa2, pa3); }
    FA_SBAR(); FA_SEAM_K0();
    if (hi == 0) li_l[r32] = l_reg; asm volatile("s_waitcnt lgkmcnt(0)" ::: "memory");
    float rli[16];
#pragma unroll
    for (int r = 0; r < 16; ++r) rli[r] = __builtin_amdgcn_rcpf(li_l[crow(r, hi)]);
    bf16* Ow = const_cast<bf16*>(cur.Q) + (size_t)obuf * BUF + (size_t)(wid * QBLK) * PITCH;
#pragma unroll
    for (int r = 0; r < 16; ++r) { const int orow = crow(r, hi);
#pragma unroll
        for (int d0 = 0; d0 < 4; ++d0) { const float v = o[d0][r] * rli[r];
            const float vn = __shfl_xor(v, 1);
            if ((r32 & 1) == 0) *(unsigned*)(Ow + (size_t)orow * PITCH + d0 * 32 + r32) = cvtpk(v, vn); } }
    __syncthreads();
#undef FA_RESC
#undef FA_KBASE
#undef FA_BIASMASK
#undef FA_SEAM_K0
#undef FA_HALF_STEP
}
#undef FA_TILE
#undef FA_VMW
#undef FA_VMWN
#undef FA_SLOAD
#undef FA_SWRITE_K
#undef FA_SWRITE_V
#undef FA_SWRITE
__device__ __forceinline__ BlockRef block_ref(int bh, int qb, int jlo, const bf16* Q) {
    const int b = bh >> 4, h = bh & 15; BlockRef r;
    r.Q = Q + ((size_t)b * SEQ + (size_t)qb * QB) * PITCH + (size_t)h * D; r.K = Q + BUF + (size_t)b * SEQ * PITCH + (size_t)h * D; r.P0 = qb * QB; r.jlo = jlo; return r;
}
__device__ __forceinline__ void load_bias(char* lds, const float* FB, int bh, int k_lo, int k_hi, const int tid) {
    const f32x4* src = (const f32x4*)(FB + (size_t)bh * SEQ); __attribute__((address_space(3))) f32x4* dst = (__attribute__((address_space(3))) f32x4*)((__attribute__((address_space(3))) char*)lds + F_OFF);
    int t0 = tid; asm volatile("" : "+v"(t0));
    for (int i = k_lo / 4 + t0; i < k_hi / 4; i += NW * 64) dst[i] = src[i];
    __syncthreads();
}
#ifndef FA_PRUNE
#define FA_PRUNE 1
#endif
constexpr float PRUNE_T2 = 44.0f;
constexpr int NTICKETS = (1 + (((DUP_MASK) >> 3) & 1)) * 2 * NHEAD * NQB;
constexpr int XQ_OFF = F_OFF + SEQ * 4;
struct Ticket { int idx, bh, qb, jlo; };
__device__ __forceinline__ Ticket next_block(char* lds, const bf16* Q, const float* FB, const unsigned* qkmax, unsigned* qhead, const int tid, const bool prune = true) {
    __attribute__((address_space(3))) int* xi = (__attribute__((address_space(3))) int*)((__attribute__((address_space(3))) char*)lds + XQ_OFF);
    __attribute__((address_space(3))) float* xf = (__attribute__((address_space(3))) float*)(xi + 16);
    int t0 = tid; asm volatile("" : "+v"(t0));
    const int wid = __builtin_amdgcn_readfirstlane(t0 >> 6), lane = t0 & 63;
    if (t0 == 0) xi[0] = (int)__hip_atomic_fetch_add(qhead, 1u, __ATOMIC_RELAXED, __HIP_MEMORY_SCOPE_AGENT);
    __syncthreads();
    Ticket T; T.idx = xi[0]; { const int id = T.idx % (2 * NHEAD * NQB); T.qb = NQB - 1 - (id >> 5); T.bh = id & 31; } T.jlo = 0;
    if (T.idx >= NTICKETS) { __syncthreads(); return T; }
    const int b = T.bh >> 4, h = T.bh & 15, P0 = T.qb * QB;
#if FA_PRUNE
    const int row = t0 >> 1, half = t0 & 1;
    const bf16* qp = Q + ((size_t)b * SEQ + P0 + row) * PITCH + (size_t)h * D + 64 * half; const bf16* kp = qp + BUF;
    float d = 0.f;
#pragma unroll
    for (int c = 0; c < 8; ++c) { const u32x4 qa = *(const u32x4*)(qp + 8 * c), ka = *(const u32x4*)(kp + 8 * c);
#pragma unroll
        for (int e = 0; e < 4; ++e) { d += __uint_as_float(qa[e] << 16) * __uint_as_float(ka[e] << 16); d += __uint_as_float(qa[e] & 0xffff0000u) * __uint_as_float(ka[e] & 0xffff0000u); } }
    d += __shfl_xor(d, 1);
    d += FB[(size_t)T.bh * SEQ + P0 + row];
#pragma unroll
    for (int o = 2; o < 64; o <<= 1) d = fminf(d, __shfl_xor(d, o));
    if (lane == 0) xf[wid] = d;
    float smax = 0.f;
#pragma unroll
    for (int w = 0; w < 4; ++w) smax += sqrtf(__uint_as_float(qkmax[(T.bh * 2 + 0) * 4 + w]) * __uint_as_float(qkmax[(T.bh * 2 + 1) * 4 + w]));
    smax = smax * 1.02f + 0.5f;
    __syncthreads();
    float mmin = xf[0];
#pragma unroll
    for (int w = 1; w < 8; ++w) mmin = fminf(mmin, xf[w]);
    const float thresh = prune ? mmin - PRUNE_T2 - smax : -__builtin_inff();
    const int nb0 = P0 / KVBLK;
    const bool skip = (t0 < nb0) && (FB[(size_t)T.bh * SEQ + t0 * KVBLK + KVBLK - 1] < thresh);
    const unsigned long long bal = __ballot(skip);
    if (lane == 0) xi[8 + wid] = __popcll(bal);
    __syncthreads();
    T.jlo = xi[8] + xi[9];
    __syncthreads();
#else
    __syncthreads();
#endif
    return T;
}
__device__ __forceinline__ void attn_phase(char* lds, const bf16* Q, const float* FB, const unsigned* qkmax, unsigned* qhead, const int tid, const bool prune = true, const int obuf = 5) {
    Ticket tc = next_block(lds, Q, FB, qkmax, qhead, tid, prune);
    if (tc.idx >= NTICKETS) return;
    BlockRef cur = block_ref(tc.bh, tc.qb, tc.jlo, Q);
    Seam S;
    load_bias(lds, FB, tc.bh, tc.jlo * KVBLK, (tc.qb + 1) * QB, tid);
    attn_prime(cur, lds, S, tid);
    for (;;) {
        const Ticket tn = next_block(lds, Q, FB, qkmax, qhead, tid, prune);
        const bool last = tn.idx >= NTICKETS;
        const BlockRef nxt = last ? cur : block_ref(tn.bh, tn.qb, tn.jlo, Q);
        attn_block(cur, nxt, lds, S, tid, obuf);
        if (last) break;
        load_bias(lds, FB, tn.bh, tn.jlo * KVBLK, (tn.qb + 1) * QB, tid);
        cur = nxt;
    }
}
}

constexpr int NWAVES = 8;
constexpr int BATCH = 2, SEQ = 8192, DM = 4096, NH = 16, HD = 128, AW = 2048, CW = 2048, DFF = 11008, NIN = 12304;
constexpr int M = BATCH * SEQ;
constexpr int NPROJ = 12288;
constexpr int NGU = 2 * DFF;
constexpr float EPS = 1e-6f;
constexpr float QSCALE = 0.08838834764831845f * 1.4426950408889634f;
#ifndef MK_N_LAUNCHES
#define MK_N_LAUNCHES 1
#endif
constexpr int N_PHASES = 10;

#ifndef PG8_ALIGN
#define PG8_ALIGN true
#endif
#ifndef PG8_SP2
#define PG8_SP2 true
#endif
constexpr size_t MiB = 1u << 20;
constexpr size_t WS_CTL = 0, CTL_ZERO_BYTES = 1 * MiB;
constexpr size_t WS_MOD = 512 * 1024;
constexpr size_t WS_WF = 1 * MiB;
constexpr size_t WS_FT = 2 * MiB;
constexpr size_t WS_FB = 3 * MiB;
constexpr size_t WS_WIN = 4 * MiB;
constexpr size_t WS_WOUT = WS_WIN + (size_t)NPROJ * DM * 2;
constexpr size_t WS_WGU = WS_WOUT + (size_t)DM * DM * 2;
constexpr size_t WS_WD = WS_WGU + (size_t)NGU * DM * 2;
constexpr size_t WS_H = WS_WD + (size_t)DM * DFF * 2;
constexpr size_t WS_Q = WS_H + (size_t)M * DM * 2;
constexpr size_t WS_K = WS_Q + (size_t)M * 2048 * 2, WS_V = WS_K + (size_t)M * 2048 * 2, WS_GB = WS_V + (size_t)M * 2048 * 2, WS_CU = WS_GB + (size_t)M * 2048 * 2, WS_YA = WS_CU + (size_t)M * 2048 * 2;
constexpr size_t WS_ACT = WS_Q;
constexpr size_t WS_HM = WS_YA + (size_t)M * 2048 * 2;
constexpr size_t WS_END = WS_HM + (size_t)M * DM * 2;
static_assert(WS_ACT + (size_t)M * DFF * 2 <= WS_HM, "ACT overlay fits inside Q..YA");
static_assert(WS_WIN % 256 == 0 && WS_WOUT % 256 == 0 && WS_WGU % 256 == 0 && WS_WD % 256 == 0 && WS_H % 256 == 0 && WS_Q % 256 == 0 && WS_HM % 256 == 0, "alignment");
constexpr int CW_BAR = 4096;
constexpr int CW_QHEAD = 512, CW_QKMAX = 1024;
constexpr int RING_BYTES = 131072, LDSCTL_OFF = RING_BYTES, MISC_OFF = LDSCTL_OFF + 320, LDS_BYTES = 147456;
static_assert(fa::ATT_LDS_BYTES <= RING_BYTES, "attention LDS");
static_assert(WS_K - WS_Q == fa::BUF * 2 && WS_V - WS_K == fa::BUF * 2 && WS_YA - WS_Q == 5 * fa::BUF * 2, "attention tensor spacing");

#define GAS __attribute__((address_space(1)))
#define LAS __attribute__((address_space(3)))
typedef unsigned short bf16;
typedef unsigned v4u __attribute__((ext_vector_type(4)));
typedef unsigned v2u __attribute__((ext_vector_type(2)));
typedef float f32x4 __attribute__((ext_vector_type(4)));
typedef short bf16x8 __attribute__((ext_vector_type(8)));
typedef GAS unsigned gu32;
#define RLX_AGENT __ATOMIC_RELAXED, __HIP_MEMORY_SCOPE_AGENT
#define LDS_WAIT() asm volatile("s_waitcnt lgkmcnt(0)" ::: "memory")
#define VM_WAIT() asm volatile("s_waitcnt vmcnt(0)" ::: "memory")
__device__ __forceinline__ unsigned f2bf(float f) { unsigned u = __builtin_bit_cast(unsigned, f); return (u + 0x7fffu + ((u >> 16) & 1u)) >> 16; }
__device__ __forceinline__ unsigned pk2(float lo, float hi) { return f2bf(lo) | (f2bf(hi) << 16); }
__device__ __forceinline__ float bflo(unsigned w) { return __builtin_bit_cast(float, w << 16); }
__device__ __forceinline__ float bfhi(unsigned w) { return __builtin_bit_cast(float, w & 0xffff0000u); }
__device__ __forceinline__ float wave_sum(float v) {
#pragma unroll
    for (int o = 1; o < 64; o <<= 1) v += __shfl_xor(v, o);
    return v;
}
#define XB_TMO      128
#define XB_XCNT(j)  (256  + 64 * (j))
#define XB_XSUB(j)  (1280 + 64 * (j))
#define XB_XGEN(j)  (2304 + 64 * (j))
#define XB_TOP      3328
#define XB_TOPGEN   3392
#define XCD_BAR_WORDS 3456
#define XB_SPIN_CAP (1u << 18)

__device__ __forceinline__ unsigned xb_ld(unsigned* p)              { return __hip_atomic_load(p, __ATOMIC_RELAXED, __HIP_MEMORY_SCOPE_AGENT); }
__device__ __forceinline__ unsigned xb_add(unsigned* p, unsigned v) { return __hip_atomic_fetch_add(p, v, __ATOMIC_RELAXED, __HIP_MEMORY_SCOPE_AGENT); }
__device__ __forceinline__ unsigned xb_xcc_id() { return (unsigned)__builtin_amdgcn_s_getreg((3 << 11) | 20) & 0xFu; }
#define XB_SPIN(cond, bar) do { unsigned _sp = 0; while (cond) { __builtin_amdgcn_s_sleep(1); \
    if ((++_sp & 255u) == 0u) { if (xb_ld(&(bar)[XB_TMO])) break; if (_sp > XB_SPIN_CAP) { atomicAdd(&(bar)[XB_TMO], 1u); break; } } } } while (0)

struct XcdBarrier {
    unsigned* bar; unsigned x;
    volatile LAS unsigned* st;
};

__device__ __forceinline__ XcdBarrier xcd_barrier_post(unsigned* bar, volatile LAS unsigned* st, const int tid) {
    XcdBarrier b; b.bar = bar; b.x = xb_xcc_id(); b.st = st;
    if (tid == 0) (void)xb_add(&bar[XB_XCNT(b.x)], 1u);
    return b;
}
__device__ __forceinline__ void xcd_barrier_complete(unsigned* bar, unsigned x, unsigned& nloc, unsigned& nx) {
    const unsigned G = gridDim.x * gridDim.y * gridDim.z;
    unsigned sum, cnt, mine, sp = 0u;
    for (;;) {
        sum = 0u; cnt = 0u; mine = 0u;
#pragma unroll
        for (unsigned j = 0; j < 16; ++j) { const unsigned c = xb_ld(&bar[XB_XCNT(j)]); sum += c; cnt += (c > 0u) ? 1u : 0u; mine = (j == x) ? c : mine; }
        if (sum == G) break;
        __builtin_amdgcn_s_sleep(1);
        if ((++sp & 255u) == 0u) { if (xb_ld(&bar[XB_TMO])) break; if (sp > XB_SPIN_CAP) { atomicAdd(&bar[XB_TMO], 1u); break; } }
    }
    nloc = mine > 0u ? mine : 1u; nx = cnt > 0u ? cnt : 1u;
}

__device__ __forceinline__ void xcd_barrier(const XcdBarrier& b, const int tid) {
    asm volatile("s_waitcnt vmcnt(0)" ::: "memory");
    __syncthreads();
    if (tid == 0) {
        unsigned* bar = b.bar;
        __builtin_amdgcn_s_waitcnt(0);
        unsigned nloc = b.st[0], nx = b.st[1];
        if (nloc == 0u) { xcd_barrier_complete(bar, b.x, nloc, nx); b.st[0] = nloc; b.st[1] = nx; }
        const unsigned old = xb_add(&bar[XB_XSUB(b.x)], 1u);
        const unsigned gen = old / nloc;
        if (old + 1u == (gen + 1u) * nloc) {
            __builtin_amdgcn_fence(__ATOMIC_RELEASE, "agent");
            asm volatile("s_waitcnt vmcnt(0)" ::: "memory");
            const unsigned og = xb_add(&bar[XB_TOP], 1u);
            const unsigned tg = og / nx;
            if (og + 1u == (tg + 1u) * nx) xb_add(&bar[XB_TOPGEN], 1u);
            else XB_SPIN(xb_ld(&bar[XB_TOPGEN]) == tg, bar);
            __builtin_amdgcn_fence(__ATOMIC_ACQUIRE, "agent");
            xb_add(&bar[XB_XGEN(b.x)], 1u);
            asm volatile("s_waitcnt vmcnt(0)" ::: "memory");
        } else {
            XB_SPIN(xb_ld(&bar[XB_XGEN(b.x)]) == gen, bar);
            __builtin_amdgcn_fence(__ATOMIC_ACQUIRE, "agent");
            asm volatile("s_waitcnt vmcnt(0)" ::: "memory");
        }
    }
    __syncthreads();
}
struct DestWin { bf16* W; __device__ __forceinline__ bf16* operator()(int n) const {
    if (n < 6144) return W + (size_t)n * DM;
    if (n < 6160) return nullptr;
    if (n < 8208) return W + (size_t)(6144 + (n - 6160)) * DM;
    if (n < 10256) { const int j = n - 8208; return W + (size_t)(8192 + (j >> 7) * 256 + (j & 127)) * DM; }
    const int j = n - 10256; return W + (size_t)(8192 + (j >> 7) * 256 + 128 + (j & 127)) * DM; } };
struct DestPlain { bf16* W; int K; __device__ __forceinline__ bf16* operator()(int n) const { return W + (size_t)n * K; } };
struct DestGU { bf16* W; int half; __device__ __forceinline__ bf16* operator()(int n) const { return W + (size_t)((n >> 7) * 256 + half * 128 + (n & 127)) * DM; } };
template <class Dest>
__device__ __forceinline__ void p0_transpose_item(const float* W, int K, int N, int item, int lane, const Dest dest) {
    const int nblk = (N + 63) / 64, kb = item / nblk, nb = item - kb * nblk, k0 = 64 * kb, n0 = 64 * nb;
    const int c4 = lane & 15, rs = lane >> 4, n = n0 + 4 * c4; const bool nok = n < N;
    const float* wp = W + (size_t)(k0 + 8 * rs) * N + n;
    f32x4 v[2][8];
#pragma unroll
    for (int jj = 0; jj < 2; ++jj)
#pragma unroll
        for (int kk = 0; kk < 8; ++kk) v[jj][kk] = nok ? __builtin_nontemporal_load((const GAS f32x4*)(wp + (size_t)(32 * jj + kk) * N)) : (f32x4){0.f, 0.f, 0.f, 0.f};
#pragma unroll
    for (int q = 0; q < 4; ++q) { bf16* drow = nok ? dest(n + q) : nullptr;
        if (drow) {
#pragma unroll
            for (int jj = 0; jj < 2; ++jj) { v4u o; o.x = pg8::cvt_pk_bf16(v[jj][0][q], v[jj][1][q]); o.y = pg8::cvt_pk_bf16(v[jj][2][q], v[jj][3][q]); o.z = pg8::cvt_pk_bf16(v[jj][4][q], v[jj][5][q]); o.w = pg8::cvt_pk_bf16(v[jj][6][q], v[jj][7][q]);
                *(GAS v4u*)(drow + k0 + 8 * (rs + 4 * jj)) = o; } } }
}
constexpr int P0_REPS = 1 + ((DUP_MASK) & 1);
struct P0Args { const float *c, *w_ada, *b_ada, *w_in, *w_out, *w_gate, *w_up, *w_down; float* mod; bf16 *WF, *WIN, *WOUT, *WGU, *WD; };
constexpr int P0_I_IN = (DM / 64) * ((NIN + 63) / 64), P0_I_OUT = (DM / 64) * (DM / 64), P0_I_G = (DM / 64) * (DFF / 64), P0_NITEMS = P0_I_IN + P0_I_OUT + 2 * P0_I_G;
struct P0Item { const float* W; bf16* Dst; int N, kind, k0, n0; };
__device__ __forceinline__ P0Item p0_decode(const P0Args& A, int it) {
    P0Item I; int r = it;
    if (r < P0_I_IN) { I.W = A.w_in; I.Dst = A.WIN; I.N = NIN; I.kind = 0; }
    else if ((r -= P0_I_IN) < P0_I_OUT) { I.W = A.w_out; I.Dst = A.WOUT; I.N = DM; I.kind = 1; }
    else if ((r -= P0_I_OUT) < P0_I_G) { I.W = A.w_gate; I.Dst = A.WGU; I.N = DFF; I.kind = 2; }
    else { r -= P0_I_G; I.W = A.w_up; I.Dst = A.WGU; I.N = DFF; I.kind = 3; }
    const int nblk = (I.N + 63) / 64, kb = r / nblk, nb = r - kb * nblk; I.k0 = 64 * kb; I.n0 = 64 * nb; return I;
}
__device__ __forceinline__ bf16* p0_dest(const P0Item& I, int n) {
    if (I.kind == 0) return DestWin{I.Dst}(n);
    if (I.kind == 1) return I.Dst + (size_t)n * DM;
    return DestGU{I.Dst, I.kind - 2}(n);
}
__device__ __forceinline__ void p0_load(const P0Item& I, int lane, f32x4 (&v)[2][8]) {
    const int c4 = lane & 15, rs = lane >> 4, n = I.n0 + 4 * c4; const bool nok = n < I.N;
    const float* wp = I.W + (size_t)(I.k0 + 8 * rs) * I.N + n;
#pragma unroll
    for (int jj = 0; jj < 2; ++jj)
#pragma unroll
        for (int kk = 0; kk < 8; ++kk) v[jj][kk] = nok ? __builtin_nontemporal_load((const GAS f32x4*)(wp + (size_t)(32 * jj + kk) * I.N)) : (f32x4){0.f, 0.f, 0.f, 0.f};
}
__device__ __forceinline__ void p0_store(const P0Item& I, int lane, const f32x4 (&v)[2][8]) {
    const int c4 = lane & 15, rs = lane >> 4, n = I.n0 + 4 * c4; const bool nok = n < I.N;
#pragma unroll
    for (int q = 0; q < 4; ++q) { bf16* drow = nok ? p0_dest(I, n + q) : nullptr;
        if (drow) {
#pragma unroll
            for (int jj = 0; jj < 2; ++jj) { v4u o; o.x = pg8::cvt_pk_bf16(v[jj][0][q], v[jj][1][q]); o.y = pg8::cvt_pk_bf16(v[jj][2][q], v[jj][3][q]); o.z = pg8::cvt_pk_bf16(v[jj][4][q], v[jj][5][q]); o.w = pg8::cvt_pk_bf16(v[jj][6][q], v[jj][7][q]);
                *(GAS v4u*)(drow + I.k0 + 8 * (rs + 4 * jj)) = o; } } }
}
__device__ __forceinline__ void p0_prologue(LAS unsigned char* lds, const P0Args& A, int G, int bid, int tid, int wave, int lane) {
    LAS float* cact = (LAS float*)(lds + 73728);
    for (int i = tid; i < 2 * DM; i += NWAVES * 64) { const float v = A.c[i]; cact[i] = v / (1.f + expf(-v)); }
    __syncthreads();
    for (int rep0 = 0; rep0 < P0_REPS; ++rep0)
    for (int it = bid; it < 12 * 64; it += G) {
        const int cg = it % 12, kc = it / 12, n = cg * 2048 + tid * 4;
        const float* wp = A.w_ada + (size_t)(kc * 64) * (6 * DM) + n;
        f32x4 a0 = {0.f, 0.f, 0.f, 0.f}, a1 = {0.f, 0.f, 0.f, 0.f};
#pragma unroll 32
        for (int kk = 0; kk < 64; ++kk) { const f32x4 w = __builtin_nontemporal_load((const GAS f32x4*)(wp + (size_t)kk * (6 * DM))); const float c0 = cact[kc * 64 + kk], c1 = cact[DM + kc * 64 + kk]; a0 += w * c0; a1 += w * c1; }
        if (kc == 0) { const f32x4 b = *(const f32x4*)(A.b_ada + n); a0 += b; a1 += b; }
        float* m0 = A.mod + n; float* m1 = A.mod + 6 * DM + n;
        if (rep0 == 0 || a0[0] == 1.2345678e30f)
#pragma unroll
        for (int j = 0; j < 4; ++j) { __hip_atomic_fetch_add(m0 + j, a0[j], __ATOMIC_RELAXED, __HIP_MEMORY_SCOPE_AGENT); __hip_atomic_fetch_add(m1 + j, a1[j], __ATOMIC_RELAXED, __HIP_MEMORY_SCOPE_AGENT); }
    }
    { const int g = bid * NWAVES * 64 + tid; if (g < 16 * DM) { const int k = g >> 4, n = g & 15; A.WF[(size_t)n * DM + k] = (bf16)f2bf(A.w_in[(size_t)k * NIN + 6144 + n]); } }
    const int gw = bid * NWAVES + wave, NGW = G * NWAVES;
    constexpr int NVIRT = P0_REPS * P0_NITEMS;
    f32x4 va[2][8], vb[2][8];
    int it = gw;
    if (it < NVIRT) { const P0Item I = p0_decode(A, it % P0_NITEMS); p0_load(I, lane, va); }
    while (it < NVIRT) {
        const int i1 = it + NGW, i2 = it + 2 * NGW;
        if (i1 < NVIRT) { const P0Item I = p0_decode(A, i1 % P0_NITEMS); p0_load(I, lane, vb); }
        { const P0Item I = p0_decode(A, it % P0_NITEMS); p0_store(I, lane, va); }
        if (i1 >= NVIRT) break;
        if (i2 < NVIRT) { const P0Item I = p0_decode(A, i2 % P0_NITEMS); p0_load(I, lane, va); }
        { const P0Item I = p0_decode(A, i1 % P0_NITEMS); p0_store(I, lane, vb); }
        it = i2;
    }
}
__device__ __forceinline__ void convert_w_down(const float* w_down, bf16* WD, int b, int nb, int wave, int lane) {
    constexpr int I_D = (DFF / 64) * (DM / 64);
    for (int it = b * NWAVES + wave; it < I_D; it += nb * NWAVES) p0_transpose_item(w_down, DFF, DM, it, lane, DestPlain{WD, DFF});
}
__device__ __forceinline__ void p1_norm1(LAS unsigned char* lds, const float* x, const float* pre_norm_mix, const float* mod, const bf16* WF, bf16* H1, float* FT, int G, int bid, int tid, int wave, int lane) {
    LAS float* G1 = (LAS float*)lds; LAS float* SH1 = G1 + DM; LAS float* ssqp = SH1 + DM; LAS f32x4* fpart = (LAS f32x4*)(ssqp + 256);
    int cur_b = -1, par = 0; const int r = lane & 15, kq = lane >> 4;
    for (int tile = bid; tile < M / 16; tile += G) {
        const int b = tile / (SEQ / 16);
        if (b != cur_b) { __syncthreads();
            for (int i = tid; i < DM; i += NWAVES * 64) { G1[i] = pre_norm_mix[i] * (1.f + mod[b * 6 * DM + DM + i]); SH1[i] = mod[b * 6 * DM + i]; }
            __syncthreads(); cur_b = b; }
        const int row = tile * 16 + r, kbase = wave * 512 + kq * 8;
        const float* xp = x + (size_t)row * DM + kbase;
        f32x4 xv[16][2];
#pragma unroll
        for (int i = 0; i < 16; ++i) { xv[i][0] = __builtin_nontemporal_load((const GAS f32x4*)(xp + 32 * i)); xv[i][1] = __builtin_nontemporal_load((const GAS f32x4*)(xp + 32 * i + 4)); }
        float ss = 0.f;
#pragma unroll
        for (int i = 0; i < 16; ++i)
#pragma unroll
            for (int h = 0; h < 2; ++h) { const f32x4 v = xv[i][h]; ss += (v[0] * v[0] + v[1] * v[1]) + (v[2] * v[2] + v[3] * v[3]); }
        ss += __shfl_xor(ss, 16); ss += __shfl_xor(ss, 32);
        if (kq == 0) ssqp[(par * 8 + wave) * 16 + r] = ss;
        __syncthreads();
        float tot = 0.f;
#pragma unroll
        for (int w = 0; w < 8; ++w) tot += ssqp[(par * 8 + w) * 16 + r];
        const float rstd = 1.0f / sqrtf(tot * (1.0f / DM) + EPS);
        f32x4 acc = {0.f, 0.f, 0.f, 0.f};
        bf16* hp = H1 + (size_t)row * DM + kbase; const bf16* wfp = WF + (size_t)r * DM + kbase;
#pragma unroll
        for (int i = 0; i < 16; ++i) {
            const f32x4 g0 = *(const LAS f32x4*)(G1 + kbase + 32 * i), g1 = *(const LAS f32x4*)(G1 + kbase + 32 * i + 4);
            const f32x4 s0 = *(const LAS f32x4*)(SH1 + kbase + 32 * i), s1 = *(const LAS f32x4*)(SH1 + kbase + 32 * i + 4);
            const f32x4 v0 = xv[i][0] * rstd * g0 + s0, v1 = xv[i][1] * rstd * g1 + s1;
            v4u w; w.x = pg8::cvt_pk_bf16(v0[0], v0[1]); w.y = pg8::cvt_pk_bf16(v0[2], v0[3]); w.z = pg8::cvt_pk_bf16(v1[0], v1[1]); w.w = pg8::cvt_pk_bf16(v1[2], v1[3]);
            *(GAS v4u*)(hp + 32 * i) = w;
            const bf16x8 af = __builtin_bit_cast(bf16x8, w); const bf16x8 bfr = *(const GAS bf16x8*)(wfp + 32 * i);
            acc = __builtin_amdgcn_mfma_f32_16x16x32_bf16(af, bfr, acc, 0, 0, 0);
        }
        fpart[(par * 8 + wave) * 64 + lane] = acc;
        __syncthreads();
        if (wave == 0) { f32x4 s = fpart[(par * 8) * 64 + lane];
#pragma unroll
            for (int w = 1; w < 8; ++w) s += fpart[(par * 8 + w) * 64 + lane];
            const int t0 = (tile * 16) % SEQ + 4 * kq;
            *(GAS f32x4*)(FT + (size_t)(b * NH + r) * SEQ + t0) = s; }
        par ^= 1;
    }
}
__device__ __forceinline__ void p2_scan(LAS unsigned char* lds, const float* FT, const float* b_f, float* FB, int bh, int tid, int wave, int lane) {
    const float bias = b_f[bh & 15];
    const GAS f32x4* src = (const GAS f32x4*)(FT + (size_t)bh * SEQ + tid * 16);
    double pre[16]; double run = 0.0;
#pragma unroll
    for (int q = 0; q < 4; ++q) { const f32x4 v = src[q];
#pragma unroll
        for (int j = 0; j < 4; ++j) { const float z = v[j] + bias; const float ls = (z >= 0.f) ? -log1pf(expf(-z)) : z - log1pf(expf(z)); run += (double)ls; pre[4 * q + j] = run; } }
    double incl = run;
#pragma unroll
    for (int o = 1; o < 64; o <<= 1) { const double t = __shfl_up(incl, o); if (lane >= o) incl += t; }
    LAS double* wt = (LAS double*)lds;
    if (lane == 63) wt[wave] = incl;
    __syncthreads();
    double off = incl - run;
    for (int w = 0; w < wave; ++w) off += wt[w];
    GAS f32x4* dst = (GAS f32x4*)(FB + (size_t)bh * SEQ + tid * 16);
#pragma unroll
    for (int q = 0; q < 4; ++q) { f32x4 o;
#pragma unroll
        for (int j = 0; j < 4; ++j) o[j] = (float)(-(off + pre[4 * q + j]) * 1.4426950408889634);
        dst[q] = o; }
    __syncthreads();
}
__device__ __forceinline__ void unpack8(const v4u w, float (&f)[8]) { f[0] = bflo(w.x); f[1] = bfhi(w.x); f[2] = bflo(w.y); f[3] = bfhi(w.y); f[4] = bflo(w.z); f[5] = bfhi(w.z); f[6] = bflo(w.w); f[7] = bfhi(w.w); }
__device__ __forceinline__ void p4_ynorm_conv(LAS unsigned char* lds, const bf16* YA, const bf16* GB, const bf16* CU, const float* conv_w, const float* attn_g, const float* conv_g, bf16* Y, int G, int bid, int tid, int wave, int lane) {
    LAS float* CWl = (LAS float*)lds; LAS float* AGl = CWl + 3 * CW; LAS float* CGl = AGl + AW;
    for (int i = tid; i < 3 * CW; i += NWAVES * 64) CWl[i] = conv_w[i];
    for (int i = tid; i < AW; i += NWAVES * 64) { AGl[i] = attn_g[i]; CGl[i] = conv_g[i]; }
    __syncthreads();
    const int gw = bid * NWAVES + wave, NGW = G * NWAVES;
    for (int chunk = gw; chunk < M / 8; chunk += NGW) {
        const int m0 = chunk * 8, t0 = m0 % SEQ;
        v4u c1[4], c2[4];
#pragma unroll
        for (int j = 0; j < 4; ++j) { c1[j] = (v4u){0u, 0u, 0u, 0u}; c2[j] = (v4u){0u, 0u, 0u, 0u}; }
        if (t0 != 0) {
#pragma unroll
            for (int j = 0; j < 4; ++j) { c1[j] = *(const GAS v4u*)(CU + (size_t)(m0 - 1) * CW + j * 512 + lane * 8); c2[j] = *(const GAS v4u*)(CU + (size_t)(m0 - 2) * CW + j * 512 + lane * 8); } }
#pragma unroll 1
        for (int rr = 0; rr < 8; ++rr) { const int m = m0 + rr; __builtin_amdgcn_sched_barrier(0);
            v4u a[4], c0[4], gb[4];
#pragma unroll
            for (int j = 0; j < 4; ++j) { a[j] = __builtin_nontemporal_load((const GAS v4u*)(YA + (size_t)m * AW + j * 512 + lane * 8)); c0[j] = __builtin_nontemporal_load((const GAS v4u*)(CU + (size_t)m * CW + j * 512 + lane * 8)); gb[j] = __builtin_nontemporal_load((const GAS v4u*)(GB + (size_t)m * CW + j * 512 + lane * 8)); }
            float ssa = 0.f;
#pragma unroll
            for (int j = 0; j < 4; ++j) { float f[8]; unpack8(a[j], f);
#pragma unroll
                for (int i = 0; i < 8; ++i) ssa += f[i] * f[i]; }
            __builtin_amdgcn_sched_barrier(0);
            const float rsa = 1.0f / sqrtf(wave_sum(ssa) * (1.0f / AW) + EPS);
#pragma unroll
            for (int j = 0; j < 4; ++j) { float f[8]; unpack8(a[j], f); const int cb = j * 512 + lane * 8;
                const f32x4 g0 = *(const LAS f32x4*)(AGl + cb), g1 = *(const LAS f32x4*)(AGl + cb + 4);
                v4u w; w.x = pg8::cvt_pk_bf16(f[0] * rsa * g0[0], f[1] * rsa * g0[1]); w.y = pg8::cvt_pk_bf16(f[2] * rsa * g0[2], f[3] * rsa * g0[3]);
                w.z = pg8::cvt_pk_bf16(f[4] * rsa * g1[0], f[5] * rsa * g1[1]); w.w = pg8::cvt_pk_bf16(f[6] * rsa * g1[2], f[7] * rsa * g1[3]);
                *(GAS v4u*)(Y + (size_t)m * DM + cb) = w; __builtin_amdgcn_sched_barrier(0); }
            float yc[4][8]; float ssc = 0.f;
#pragma unroll
            for (int j = 0; j < 4; ++j) { float f0[8], f1[8], f2[8], fg[8]; unpack8(c0[j], f0); unpack8(c1[j], f1); unpack8(c2[j], f2); unpack8(gb[j], fg); const int cb = j * 512 + lane * 8;
#pragma unroll
                for (int h = 0; h < 2; ++h) { const f32x4 w0 = *(const LAS f32x4*)(CWl + cb + 4 * h), w1 = *(const LAS f32x4*)(CWl + CW + cb + 4 * h), w2 = *(const LAS f32x4*)(CWl + 2 * CW + cb + 4 * h);
#pragma unroll
                    for (int i = 0; i < 4; ++i) { const float v = fg[4 * h + i] * (w0[i] * f2[4 * h + i] + w1[i] * f1[4 * h + i] + w2[i] * f0[4 * h + i]); yc[j][4 * h + i] = v; ssc += v * v; } }
                __builtin_amdgcn_sched_barrier(0); }
            const float rsc = 1.0f / sqrtf(wave_sum(ssc) * (1.0f / CW) + EPS);
#pragma unroll
            for (int j = 0; j < 4; ++j) { const int cb = j * 512 + lane * 8;
                const f32x4 g0 = *(const LAS f32x4*)(CGl + cb), g1 = *(const LAS f32x4*)(CGl + cb + 4);
                v4u w; w.x = pg8::cvt_pk_bf16(yc[j][0] * rsc * g0[0], yc[j][1] * rsc * g0[1]); w.y = pg8::cvt_pk_bf16(yc[j][2] * rsc * g0[2], yc[j][3] * rsc * g0[3]);
                w.z = pg8::cvt_pk_bf16(yc[j][4] * rsc * g1[0], yc[j][5] * rsc * g1[1]); w.w = pg8::cvt_pk_bf16(yc[j][6] * rsc * g1[2], yc[j][7] * rsc * g1[3]);
                *(GAS v4u*)(Y + (size_t)m * DM + AW + cb) = w; __builtin_amdgcn_sched_barrier(0); }
#pragma unroll
            for (int j = 0; j < 4; ++j) { c2[j] = c1[j]; c1[j] = c0[j]; }
        }
    }
}
__device__ __forceinline__ void p6_resid1(LAS unsigned char* lds, const float* x, const bf16* HM, const float* mod, const float* post_norm_mix, const float* pre_norm_ffn, float* out, bf16* H2, int G, int bid, int tid, int wave, int lane) {
    LAS float* V1 = (LAS float*)lds; LAS float* G2 = V1 + DM; LAS float* S2 = G2 + DM;
    int cur_b = -1;
    for (int blk = bid; blk < M / 64; blk += G) {
        const int b = blk / (SEQ / 64);
        if (b != cur_b) { __syncthreads();
            for (int i = tid; i < DM; i += NWAVES * 64) { const float* mb = mod + b * 6 * DM; V1[i] = mb[2 * DM + i] * post_norm_mix[i]; G2[i] = pre_norm_ffn[i] * (1.f + mb[4 * DM + i]); S2[i] = mb[3 * DM + i]; }
            __syncthreads(); cur_b = b; }
#pragma unroll 1
        for (int rr = 0; rr < 8; ++rr) { const int m = blk * 64 + wave * 8 + rr; __builtin_amdgcn_sched_barrier(0);
            f32x4 xv[16]; v2u hv[16];
#pragma unroll
            for (int j = 0; j < 16; ++j) { xv[j] = __builtin_nontemporal_load((const GAS f32x4*)(x + (size_t)m * DM + j * 256 + lane * 4)); hv[j] = __builtin_nontemporal_load((const GAS v2u*)(HM + (size_t)m * DM + j * 256 + lane * 4)); }
            float ss = 0.f;
#pragma unroll
            for (int j = 0; j < 16; ++j) { const float h0 = bflo(hv[j].x), h1 = bfhi(hv[j].x), h2 = bflo(hv[j].y), h3 = bfhi(hv[j].y); ss += (h0 * h0 + h1 * h1) + (h2 * h2 + h3 * h3); }
            const float r1 = 1.0f / sqrtf(wave_sum(ss) * (1.0f / DM) + EPS);
            float ss2 = 0.f;
#pragma unroll
            for (int j = 0; j < 16; ++j) { const f32x4 v1 = *(const LAS f32x4*)(V1 + j * 256 + lane * 4);
                f32x4 h = {bflo(hv[j].x), bfhi(hv[j].x), bflo(hv[j].y), bfhi(hv[j].y)};
                const f32x4 x1 = xv[j] + v1 * h * r1; xv[j] = x1;
                __builtin_nontemporal_store(x1, (GAS f32x4*)(out + (size_t)m * DM + j * 256 + lane * 4));
                ss2 += (x1[0] * x1[0] + x1[1] * x1[1]) + (x1[2] * x1[2] + x1[3] * x1[3]); }
            const float r2 = 1.0f / sqrtf(wave_sum(ss2) * (1.0f / DM) + EPS);
#pragma unroll
            for (int j = 0; j < 16; ++j) { const f32x4 g2 = *(const LAS f32x4*)(G2 + j * 256 + lane * 4), s2 = *(const LAS f32x4*)(S2 + j * 256 + lane * 4);
                const f32x4 h = xv[j] * r2 * g2 + s2; v2u w; w.x = pg8::cvt_pk_bf16(h[0], h[1]); w.y = pg8::cvt_pk_bf16(h[2], h[3]);
                *(GAS v2u*)(H2 + (size_t)m * DM + j * 256 + lane * 4) = w; }
        }
    }
}
__device__ __forceinline__ void p9_final(LAS unsigned char* lds, const bf16* HM, const float* mod, const float* post_norm_ffn, float* out, int G, int bid, int tid, int wave, int lane) {
    LAS float* V2 = (LAS float*)lds;
    int cur_b = -1;
    for (int blk = bid; blk < M / 64; blk += G) {
        const int b = blk / (SEQ / 64);
        if (b != cur_b) { __syncthreads();
            for (int i = tid; i < DM; i += NWAVES * 64) V2[i] = mod[b * 6 * DM + 5 * DM + i] * post_norm_ffn[i];
            __syncthreads(); cur_b = b; }
#pragma unroll 1
        for (int rr = 0; rr < 8; ++rr) { const int m = blk * 64 + wave * 8 + rr; __builtin_amdgcn_sched_barrier(0);
            f32x4 xv[16]; v2u hv[16];
#pragma unroll
            for (int j = 0; j < 16; ++j) { xv[j] = __builtin_nontemporal_load((const GAS f32x4*)(out + (size_t)m * DM + j * 256 + lane * 4)); hv[j] = __builtin_nontemporal_load((const GAS v2u*)(HM + (size_t)m * DM + j * 256 + lane * 4)); }
            float ss = 0.f;
#pragma unroll
            for (int j = 0; j < 16; ++j) { const float h0 = bflo(hv[j].x), h1 = bfhi(hv[j].x), h2 = bflo(hv[j].y), h3 = bfhi(hv[j].y); ss += (h0 * h0 + h1 * h1) + (h2 * h2 + h3 * h3); }
            const float r1 = 1.0f / sqrtf(wave_sum(ss) * (1.0f / DM) + EPS);
#pragma unroll
            for (int j = 0; j < 16; ++j) { const f32x4 v2 = *(const LAS f32x4*)(V2 + j * 256 + lane * 4);
                f32x4 h = {bflo(hv[j].x), bfhi(hv[j].x), bflo(hv[j].y), bfhi(hv[j].y)};
                __builtin_nontemporal_store(xv[j] + v2 * h * r1, (GAS f32x4*)(out + (size_t)m * DM + j * 256 + lane * 4)); }
        }
    }
}
struct Args { const float* in[17]; float* out; unsigned char* ws; int ph_lo, ph_hi, grid, pad; };
#define KARGP() const __attribute__((address_space(4))) char* kp = (const __attribute__((address_space(4))) char*)__builtin_amdgcn_kernarg_segment_ptr(); asm volatile("" : "+s"(kp))
#define INP(i) (*(const float* const __attribute__((address_space(4)))*)(kp + 8 * (i)))
#define OUTP() (*(float* const __attribute__((address_space(4)))*)(kp + 136))
#define WSP(T, off) ((T*)(*(unsigned char* const __attribute__((address_space(4)))*)(kp + 144) + (off)))
#define KINT(off) (*(const int __attribute__((address_space(4)))*)(kp + (off)))
#define TIDS() const int tid = opaque_tid(wave_s), lane = tid & 63, wave = wave_s
#ifndef PH_MASK
#define PH_MASK 0x3ff
#endif
#define REPS(k) for (int rep_ = 0; rep_ < 1 + (((DUP_MASK) >> (k)) & 1); ++rep_)
#define IN(k) ((((PHM) >> (k)) & 1) != 0)
#define SEAM(k) do { KARGP(); if (IN(k) && IN((k) + 1)) { const int tid = opaque_tid(wave_s); XcdBarrier bar; bar.bar = WSP(unsigned, WS_CTL) + CW_BAR; bar.x = xb_xcc_id(); bar.st = (volatile LAS unsigned*)(lds + MISC_OFF) + 8; xcd_barrier(bar, tid); } } while (0)
template <int PHM> __global__ void __launch_bounds__(NWAVES * 64, 2) hymba_fwd(Args args) {
    constexpr bool HAS_SEAM = (PHM & (PHM >> 1)) != 0;
    extern __shared__ __attribute__((aligned(16))) unsigned char lds_raw[];
    LAS unsigned char* lds = (LAS unsigned char*)lds_raw;
    const int wave_s = __builtin_amdgcn_readfirstlane((int)(threadIdx.x >> 6));
    const int bid = blockIdx.x;
    { KARGP(); TIDS(); (void)lane; (void)wave;
      for (int u = tid; u < (LDS_BYTES - LDSCTL_OFF) / 4; u += NWAVES * 64) ((LAS unsigned*)(lds + LDSCTL_OFF))[u] = 0u;
      __syncthreads();
      if (HAS_SEAM) (void)xcd_barrier_post(WSP(unsigned, WS_CTL) + CW_BAR, (volatile LAS unsigned*)(lds + MISC_OFF) + 8, tid); }

    { KARGP(); if (IN(0)) { TIDS(); const int G = KINT(160); P0Args A{INP(1), INP(2), INP(3), INP(5), INP(10), INP(13), INP(14), INP(15), WSP(float, WS_MOD), WSP(bf16, WS_WF), WSP(bf16, WS_WIN), WSP(bf16, WS_WOUT), WSP(bf16, WS_WGU), WSP(bf16, WS_WD)};
        p0_prologue(lds, A, G, bid, tid, wave, lane); } }
    SEAM(0);
    { KARGP(); if (IN(1)) REPS(1) { TIDS(); const int G = KINT(160); p1_norm1(lds, INP(0), INP(4), WSP(float, WS_MOD), WSP(bf16, WS_WF), WSP(bf16, WS_H), WSP(float, WS_FT), G, bid, tid, wave, lane); } }
    SEAM(1);
    { KARGP(); if (IN(2)) REPS(2) { const int G = KINT(160);
        if (bid < BATCH * NH) { TIDS(); p2_scan(lds, WSP(float, WS_FT), INP(6), WSP(float, WS_FB), bid, tid, wave, lane); }
        pg8::Gemm g{WSP(bf16, WS_H), WSP(bf16, WS_WIN), M, NPROJ, DM}; pg8::StaticOrder S; S.init(M, NPROJ, G, bid);
        pg8::EpiInProj E{WSP(bf16, WS_Q), WSP(bf16, WS_K), WSP(bf16, WS_V), WSP(bf16, WS_GB), WSP(bf16, WS_CU), QSCALE, WSP(unsigned, WS_CTL) + CW_QKMAX};
        pg8::gemm_phase<pg8::EpiInProj, pg8::StaticOrder, PG8_ALIGN, PG8_SP2>(lds, g, S, E, opaque_tid(wave_s)); } }
    SEAM(2);
    { KARGP(); if (IN(3)) { fa::attn_phase((char*)lds_raw, WSP(bf16, WS_Q), WSP(float, WS_FB), WSP(unsigned, WS_CTL) + CW_QKMAX, WSP(unsigned, WS_CTL) + CW_QHEAD, opaque_tid(wave_s)); } }
    SEAM(3);
#if FA_SELFCHECK
    { KARGP(); fa::attn_phase((char*)lds_raw, WSP(bf16, WS_Q), WSP(float, WS_FB), WSP(unsigned, WS_CTL) + CW_QKMAX, WSP(unsigned, WS_CTL) + CW_QHEAD + 64, opaque_tid(wave_s), false, 6); }
    SEAM(3);
    { KARGP(); TIDS(); (void)lane; (void)wave; const unsigned short* a = (const unsigned short*)WSP(bf16, WS_YA); const unsigned short* b = (const unsigned short*)WSP(bf16, WS_HM); unsigned bad = 0;
      for (size_t i = (size_t)bid * 512 + tid; i < (size_t)M * 2048; i += (size_t)KINT(160) * 512) { const float x = __uint_as_float((unsigned)a[i] << 16), y = __uint_as_float((unsigned)b[i] << 16);
          const float tol = fmaxf(fabsf(y), 1e-30f) * (1.0f / 100.0f);
          if (!(fabsf(x - y) <= tol)) bad++; }
      if (bad) __hip_atomic_fetch_add(WSP(unsigned, WS_CTL) + CW_QHEAD + 128, bad, __ATOMIC_RELAXED, __HIP_MEMORY_SCOPE_AGENT); }
    SEAM(3);
#endif
    { KARGP(); if (IN(4)) REPS(4) { TIDS(); const int G = KINT(160); p4_ynorm_conv(lds, WSP(bf16, WS_YA), WSP(bf16, WS_GB), WSP(bf16, WS_CU), INP(7), INP(8), INP(9), WSP(bf16, WS_H), G, bid, tid, wave, lane); } }
    SEAM(4);
    { KARGP(); if (IN(5)) REPS(5) { const int G = KINT(160);
        pg8::Gemm g{WSP(bf16, WS_H), WSP(bf16, WS_WOUT), M, DM, DM}; pg8::StaticOrder S; S.init(M, DM, G, bid);
        pg8::EpiPlain E{WSP(bf16, WS_HM), DM};
        pg8::gemm_phase<pg8::EpiPlain, pg8::StaticOrder, PG8_ALIGN, PG8_SP2>(lds, g, S, E, opaque_tid(wave_s)); } }
    SEAM(5);
    { KARGP(); if (IN(6)) REPS(6) { TIDS(); const int G = KINT(160); p6_resid1(lds, INP(0), WSP(bf16, WS_HM), WSP(float, WS_MOD), INP(11), INP(12), OUTP(), WSP(bf16, WS_H), G, bid, tid, wave, lane); } }
    SEAM(6);
    { KARGP(); if (IN(7)) REPS(7) { const int G = KINT(160);
        pg8::Gemm g{WSP(bf16, WS_H), WSP(bf16, WS_WGU), M, NGU, DM}; pg8::StaticOrder S; S.init(M, NGU, G, bid);
        pg8::EpiSwiGLU E{WSP(bf16, WS_ACT), DFF};
        pg8::gemm_phase<pg8::EpiSwiGLU, pg8::StaticOrder, PG8_ALIGN, PG8_SP2>(lds, g, S, E, opaque_tid(wave_s));
        constexpr int NU7 = (M / 256) * (NGU / 256); const int rem = NU7 % G, first_idle = (rem == 0) ? 0 : rem, nidle = G - first_idle;
        if (bid >= first_idle) { TIDS(); (void)tid; convert_w_down(INP(15), WSP(bf16, WS_WD), bid - first_idle, nidle, wave, lane); } } }
    SEAM(7);
    { KARGP(); if (IN(8)) REPS(8) { const int G = KINT(160);
        pg8::Gemm g{WSP(bf16, WS_ACT), WSP(bf16, WS_WD), M, DM, DFF}; pg8::StaticOrder S; S.init(M, DM, G, bid);
        pg8::EpiPlain E{WSP(bf16, WS_HM), DM};
        pg8::gemm_phase<pg8::EpiPlain, pg8::StaticOrder, PG8_ALIGN, PG8_SP2>(lds, g, S, E, opaque_tid(wave_s)); } }
    SEAM(8);
    { KARGP(); if (IN(9)) { TIDS(); const int G = KINT(160); p9_final(lds, WSP(bf16, WS_HM), WSP(float, WS_MOD), INP(16), OUTP(), G, bid, tid, wave, lane); } }
#if FA_SELFCHECK
    SEAM(8);
    { KARGP(); const int tid = opaque_tid(wave_s); if (bid == 0 && tid == 0 && __hip_atomic_load(WSP(unsigned, WS_CTL) + CW_QHEAD + 128, __ATOMIC_RELAXED, __HIP_MEMORY_SCOPE_AGENT) != 0u) OUTP()[0] = __builtin_nanf(""); }
#endif
}
#undef IN
#undef SEAM
#undef INP
#undef WSP
#undef OUTP
#undef KARGP
#undef KINT
#undef TIDS

typedef void (*kern_t)(Args);
template <int PHM> static bool set_attr() { return hipFuncSetAttribute((const void*)hymba_fwd<PHM>, hipFuncAttributeMaxDynamicSharedMemorySize, LDS_BYTES) == hipSuccess; }
extern "C" void kernel_launch(void* const* d_in, const int* in_sizes, int n_in, void* d_out, int out_size, void* d_ws, size_t ws_size, hipStream_t stream) {
    static int grid = 0;
#if MK_N_LAUNCHES == 1
    static const kern_t kerns[1] = {hymba_fwd<(PH_MASK)>};
#else
    static const kern_t kerns[N_PHASES] = {hymba_fwd<1>, hymba_fwd<2>, hymba_fwd<4>, hymba_fwd<8>, hymba_fwd<16>, hymba_fwd<32>, hymba_fwd<64>, hymba_fwd<128>, hymba_fwd<256>, hymba_fwd<512>};
#endif
    if (grid == 0) {
        if (n_in != 17 || in_sizes[0] != M * DM || out_size != M * DM || ws_size < WS_END) {
            fprintf(stderr, "kernel_launch: built for 17 inputs, x/out of %d floats, >= %zu bytes of workspace; got n_in %d, in0 %d, out %d, ws %zu; nothing launched\n", M * DM, (size_t)WS_END, n_in, n_in > 0 ? in_sizes[0] : -1, out_size, ws_size);
            grid = -1; return; }
        int dev = 0, cus = 0, per_cu = 0;
        if (hipGetDevice(&dev) != hipSuccess || hipDeviceGetAttribute(&cus, hipDeviceAttributeMultiprocessorCount, dev) != hipSuccess) { fprintf(stderr, "kernel_launch: device query failed\n"); grid = -1; return; }
#if MK_N_LAUNCHES == 1
        bool ok = set_attr<(PH_MASK)>();
#else
        bool ok = set_attr<1>() && set_attr<2>() && set_attr<4>() && set_attr<8>() && set_attr<16>() && set_attr<32>() && set_attr<64>() && set_attr<128>() && set_attr<256>() && set_attr<512>();
#endif
        if (!ok) { fprintf(stderr, "kernel_launch: hipFuncSetAttribute failed\n"); grid = -1; return; }
        if (hipOccupancyMaxActiveBlocksPerMultiprocessor(&per_cu, (const void*)kerns[0], NWAVES * 64, LDS_BYTES) != hipSuccess || per_cu < 1)
            fprintf(stderr, "kernel_launch: note: occupancy query reports %d workgroups per CU\n", per_cu);
        (void)hipGetLastError();
        grid = cus;
    }
    if (grid < 0) return;
    if (hipMemsetAsync((char*)d_ws + WS_CTL, 0, CTL_ZERO_BYTES, stream) != hipSuccess) { fprintf(stderr, "kernel_launch: memset failed\n"); return; }
    Args a{};
    for (int i = 0; i < 17; ++i) a.in[i] = (const float*)d_in[i];
    a.out = (float*)d_out; a.ws = (unsigned char*)d_ws; a.grid = grid; a.pad = 0; a.ph_lo = 0; a.ph_hi = N_PHASES;
    for (int li = 0; li < MK_N_LAUNCHES; ++li) {
        hipLaunchKernelGGL(kerns[li], dim3(grid), dim3(NWAVES * 64), LDS_BYTES, stream, a);
        const hipError_t le = hipPeekAtLastError();
        if (le != hipSuccess) { fprintf(stderr, "kernel_launch: launch %d failed: %s\n", li, hipGetErrorName(le)); break; }
    }
}
```

```cpp
#include <hip/hip_runtime.h>
#include <cstdio>
#include <cstdint>
#include <cmath>
#ifndef DUP_MASK
#define DUP_MASK 0
#endif
__device__ __forceinline__ int opaque_tid(int wave_s) { int l; asm volatile("v_mbcnt_lo_u32_b32 %0, -1, 0\n\tv_mbcnt_hi_u32_b32 %0, -1, %0" : "=v"(l)); return (wave_s << 6) | l; }
namespace pg8 {
#define PG8_LAS __attribute__((address_space(3)))
typedef unsigned short bf16_t;
typedef short bf16x8 __attribute__((ext_vector_type(8)));
typedef float f32x4 __attribute__((ext_vector_type(4)));
typedef unsigned u32x4 __attribute__((ext_vector_type(4)));
constexpr int BM = 256, BK = 64, HALF = 128, HTB = HALF * BK * 2  , STAGE_BYTES = 8 * HTB, NXCD = 8, WGM = 8;

__host__ __device__ __forceinline__ int lds_byte(int r, int c) { const int st = (r >> 4) * 2 + (c >> 5), rr = r & 15, cc = c & 31, ob = rr * 64 + cc * 2; return st * 1024 + (ob ^ (((ob >> 9) & 1) << 5)); }
__host__ __device__ __forceinline__ void stage_rc(int b, int& R, int& C) { const int st = b / 1024, sb = b % 1024, swz = sb ^ (((sb >> 9) & 1) << 5); R = (st >> 1) * 16 + swz / 64; C = (st & 1) * 32 + (swz % 64) / 2; }
__host__ __device__ __forceinline__ int perm32(int rho) { const int n = rho >> 4, i = rho & 15; return 8 * (i >> 2) + 4 * n + (i & 3); }

struct Unit { int pm, pn; };
struct Gemm { const bf16_t* A; const bf16_t* Bt; int M, N, K; };

struct StaticOrder {
    int nM, nN, nwg, G, c;
    __host__ __device__ void init(int M, int N, int G_, int c_) { nM = M / BM; nN = N / BM; nwg = nM * nN; G = G_; c = c_; }
    __host__ __device__ bool next(int i, Unit& u) const {
        const long L = (long)i * G + c; if (L >= nwg) return false;
        int wgid = (int)L; { const int q = nwg / NXCD, r = nwg % NXCD, xcd = wgid % NXCD, off = wgid / NXCD; wgid = (xcd < r ? xcd * (q + 1) : r * (q + 1) + (xcd - r) * q) + off; }
        const int nig = WGM * nN, gid = wgid / nig, fm = gid * WGM, gsz = (nM - fm) < WGM ? (nM - fm) : WGM;
        u.pm = fm + ((wgid % nig) % gsz); u.pn = (wgid % nig) / gsz; return true;
    }
    __device__ __forceinline__ void a_ready(const Unit&) const {}
    __device__ __forceinline__ void done(const Unit&) const {}
};
__device__ __forceinline__ unsigned cvt_pk_bf16(float lo, float hi) { unsigned r; asm volatile("v_cvt_pk_bf16_f32 %0, %1, %2" : "=v"(r) : "v"(lo), "v"(hi)); return r; }
typedef float f32x2 __attribute__((ext_vector_type(2)));
struct EpiPlain {
    static constexpr bool PERM = true, AFTER_DRAIN = false;
    bf16_t* O; int ldc;
    __device__ __forceinline__ void operator()(const f32x4 (&acc)[2][2][4][2], const Unit& u, int wr, int wc, int fr, int fq) const {
        const int row0 = u.pm * BM + wr * 64 + fr, col0 = u.pn * BM + wc * 32 + 8 * fq;
#pragma unroll
        for (int ai = 0; ai < 2; ++ai)
#pragma unroll
            for (int m = 0; m < 4; ++m) { bf16_t* rowp = O + (size_t)(row0 + ai * HALF + m * 16) * ldc + col0;
#pragma unroll
                for (int bj = 0; bj < 2; ++bj) { const f32x4 v0 = acc[ai][bj][m][0], v1 = acc[ai][bj][m][1];
                    u32x4 w; w.x = cvt_pk_bf16(v0[0], v0[1]); w.y = cvt_pk_bf16(v0[2], v0[3]); w.z = cvt_pk_bf16(v1[0], v1[1]); w.w = cvt_pk_bf16(v1[2], v1[3]);
                    *(u32x4*)(rowp + bj * HALF) = w; } }
    }
};
struct EpiInProj {
    static constexpr bool PERM = true, AFTER_DRAIN = false;
    bf16_t *Q, *K, *V, *GB, *CU; float qscale; unsigned* qkmax;
    __device__ __forceinline__ void operator()(const f32x4 (&acc)[2][2][4][2], const Unit& u, int wr, int wc, int fr, int fq) const {
        const int row0 = u.pm * BM + wr * 64 + fr;
        if (u.pn < 32) {
            const int t = u.pn >> 3; bf16_t* base = (t == 0) ? Q : (t == 1) ? K : (t == 2) ? V : GB; const float s = (t == 0) ? qscale : 1.f;
            const int col0 = (u.pn & 7) * BM + wc * 32 + 8 * fq;
#pragma unroll
            for (int ai = 0; ai < 2; ++ai)
#pragma unroll
                for (int m = 0; m < 4; ++m) { bf16_t* rowp = base + (size_t)(row0 + ai * HALF + m * 16) * 2048 + col0;
#pragma unroll
                    for (int bj = 0; bj < 2; ++bj) { const f32x4 v0 = acc[ai][bj][m][0] * s, v1 = acc[ai][bj][m][1] * s;
                        u32x4 w; w.x = cvt_pk_bf16(v0[0], v0[1]); w.y = cvt_pk_bf16(v0[2], v0[3]); w.z = cvt_pk_bf16(v1[0], v1[1]); w.w = cvt_pk_bf16(v1[2], v1[3]);
                        *(u32x4*)(rowp + bj * HALF) = w; } }
            if (t <= 1) {
                float mx[2] = {0.f, 0.f};
#pragma unroll
                for (int ai = 0; ai < 2; ++ai)
#pragma unroll
                    for (int m = 0; m < 4; ++m)
#pragma unroll
                        for (int bj = 0; bj < 2; ++bj) { const f32x4 v0 = acc[ai][bj][m][0] * s, v1 = acc[ai][bj][m][1] * s;
                            float ss = (v0[0] * v0[0] + v0[1] * v0[1]) + (v0[2] * v0[2] + v0[3] * v0[3]) + (v1[0] * v1[0] + v1[1] * v1[1]) + (v1[2] * v1[2] + v1[3] * v1[3]);
                            ss += __shfl_xor(ss, 16); ss += __shfl_xor(ss, 32); mx[bj] = fmaxf(mx[bj], ss); }
#pragma unroll
                for (int bj = 0; bj < 2; ++bj) { float mm = mx[bj];
#pragma unroll
                    for (int o = 1; o < 16; o <<= 1) mm = fmaxf(mm, __shfl_xor(mm, o));
                    if (fr == 0 && fq == 0) __hip_atomic_fetch_max(qkmax + (((u.pm >> 5) * 16 + (u.pn & 7) * 2 + bj) * 2 + t) * 4 + wc, __float_as_uint(mm), __ATOMIC_RELAXED, __HIP_MEMORY_SCOPE_AGENT); }
            }
        } else {
            const int col0 = (u.pn - 32) * HALF + wc * 32 + 8 * fq;
#pragma unroll
            for (int ai = 0; ai < 2; ++ai)
#pragma unroll
                for (int m = 0; m < 4; ++m) { bf16_t* rowp = CU + (size_t)(row0 + ai * HALF + m * 16) * 2048 + col0;
                    const f32x4 v0 = acc[ai][0][m][0] * acc[ai][1][m][0], v1 = acc[ai][0][m][1] * acc[ai][1][m][1];
                    u32x4 w; w.x = cvt_pk_bf16(v0[0], v0[1]); w.y = cvt_pk_bf16(v0[2], v0[3]); w.z = cvt_pk_bf16(v1[0], v1[1]); w.w = cvt_pk_bf16(v1[2], v1[3]);
                    *(u32x4*)rowp = w; }
        }
    }
};
struct EpiSwiGLU {
    static constexpr bool PERM = true, AFTER_DRAIN = false;
    bf16_t* O; int ldc;
    __device__ __forceinline__ void operator()(const f32x4 (&acc)[2][2][4][2], const Unit& u, int wr, int wc, int fr, int fq) const {
        const int row0 = u.pm * BM + wr * 64 + fr, col0 = u.pn * HALF + wc * 32 + 8 * fq;
#pragma unroll
        for (int ai = 0; ai < 2; ++ai)
#pragma unroll
            for (int m = 0; m < 4; ++m) { bf16_t* rowp = O + (size_t)(row0 + ai * HALF + m * 16) * ldc + col0;
                f32x4 r[2];
#pragma unroll
                for (int n = 0; n < 2; ++n) { const f32x4 g = acc[ai][0][m][n], up = acc[ai][1][m][n];
#pragma unroll
                    for (int j = 0; j < 4; ++j) { const float e = __builtin_amdgcn_exp2f(g[j] * -1.4426950408889634f); r[n][j] = g[j] * up[j] * __builtin_amdgcn_rcpf(1.0f + e); } }
                u32x4 w; w.x = cvt_pk_bf16(r[0][0], r[0][1]); w.y = cvt_pk_bf16(r[0][2], r[0][3]); w.z = cvt_pk_bf16(r[1][0], r[1][1]); w.w = cvt_pk_bf16(r[1][2], r[1][3]);
                *(u32x4*)rowp = w; }
    }
};

template <class Epi, class Sched, bool ALIGN_EPI = false, bool SP2 = false>
__device__ __forceinline__ void gemm_phase(PG8_LAS unsigned char* lds, const Gemm g, const Sched& S, const Epi& E, const int tid) {
    const int wid = __builtin_amdgcn_readfirstlane(tid >> 6), lane = tid & 63, wr = wid >> 2, wc = wid & 3, fr = lane & 15, fq = lane >> 4;
    const int K = g.K, nt = K / BK;
    unsigned voffA[2], voffB[2];
#pragma unroll
    for (int i = 0; i < 2; ++i) { int R, C; stage_rc(tid * 16 + i * 8192, R, C); const int Rb = Epi::PERM ? ((R & ~31) + perm32(R & 31)) : R;
        voffA[i] = (unsigned)(R * K + C) * 2u; voffB[i] = (unsigned)(Rb * K + C) * 2u; }
    const size_t kstep = (size_t)(BK * 2);
    const size_t hstep = (size_t)HALF * K * 2;
    const size_t tstep = 2 * hstep;
    const unsigned ldsw = (unsigned)wid * 1024u;
    const int aoff = lds_byte(wr * 64 + fr, fq * 8), boff = lds_byte(wc * 32 + fr, fq * 8);
#define PG8_SA(b, h) (((b) * 2 + (h)) * HTB)
#define PG8_SB(b, h) ((4 + (b) * 2 + (h)) * HTB)
#define PG8_STAGE(bufoff, gbase, voff) do { _Pragma("unroll") for (int _i = 0; _i < 2; ++_i) \
        __builtin_amdgcn_global_load_lds((const unsigned*)((const char*)(gbase) + (voff)[_i]), (PG8_LAS unsigned*)(lds + (bufoff) + ldsw + _i * 8192), 16, 0, 0); } while (0)
#define PG8_LDA(dst, b, h) do { _Pragma("unroll") for (int m = 0; m < 4; ++m) _Pragma("unroll") for (int k = 0; k < 2; ++k) dst[m][k] = *(const PG8_LAS bf16x8*)(lds + PG8_SA(b, h) + aoff + m * 2048 + k * 1024); } while (0)
#define PG8_LDB(dst, b, h) do { _Pragma("unroll") for (int n = 0; n < 2; ++n) _Pragma("unroll") for (int k = 0; k < 2; ++k) dst[n][k] = *(const PG8_LAS bf16x8*)(lds + PG8_SB(b, h) + boff + n * 2048 + k * 1024); } while (0)
#define PG8_MMA(ai, bj, At, Bt) do { __builtin_amdgcn_s_setprio(1); _Pragma("unroll") for (int m = 0; m < 4; ++m) _Pragma("unroll") for (int n = 0; n < 2; ++n) _Pragma("unroll") for (int k = 0; k < 2; ++k) \
        acc[ai][bj][m][n] = __builtin_amdgcn_mfma_f32_16x16x32_bf16(Bt[n][k], At[m][k], acc[ai][bj][m][n], 0, 0, 0); __builtin_amdgcn_s_setprio(0); } while (0)
#define PG8_WAIT_V(n) asm volatile("s_waitcnt vmcnt(" #n ")" ::: "memory")
#define PG8_WAIT_L(n) asm volatile("s_waitcnt lgkmcnt(" #n ")" ::: "memory")
#define PG8_BAR __builtin_amdgcn_s_barrier()
#define PG8_SCHED __builtin_amdgcn_sched_barrier(0)
    Unit cur, nxt; int ui = 0;
    if (!S.next(0, cur)) return;
    f32x4 acc[2][2][4][2];
#pragma unroll
    for (int a = 0; a < 2; ++a)
#pragma unroll
        for (int b = 0; b < 2; ++b)
#pragma unroll
            for (int m = 0; m < 4; ++m)
#pragma unroll
                for (int n = 0; n < 2; ++n) acc[a][b][m][n] = (f32x4){0.f, 0.f, 0.f, 0.f};
    bf16x8 At[4][2], B0[2][2], B1[2][2];
    const char* cA = (const char*)g.A + (size_t)cur.pm * tstep; const char* cB = (const char*)g.Bt + (size_t)cur.pn * tstep;
    S.a_ready(cur);
    if constexpr (SP2) {
        PG8_STAGE(PG8_SB(0, 0), cB, voffB); PG8_STAGE(PG8_SB(0, 1), cB + hstep, voffB); PG8_STAGE(PG8_SA(0, 0), cA, voffA); PG8_STAGE(PG8_SA(0, 1), cA + hstep, voffA);
        if (wr == 1) PG8_BAR;
        PG8_WAIT_V(2); PG8_BAR;
        PG8_STAGE(PG8_SB(1, 0), cB + kstep, voffB); PG8_STAGE(PG8_SA(1, 0), cA + kstep, voffA); PG8_STAGE(PG8_SB(1, 1), cB + hstep + kstep, voffB);
        PG8_WAIT_V(6); PG8_BAR;
    } else {
        PG8_STAGE(PG8_SB(0, 0), cB, voffB); PG8_STAGE(PG8_SA(0, 0), cA, voffA); PG8_STAGE(PG8_SB(0, 1), cB + hstep, voffB); PG8_STAGE(PG8_SA(0, 1), cA + hstep, voffA);
        if (wr == 1) PG8_BAR;
        PG8_WAIT_V(4); PG8_BAR;
        PG8_STAGE(PG8_SB(1, 0), cB + kstep, voffB); PG8_STAGE(PG8_SA(1, 0), cA + kstep, voffA); PG8_STAGE(PG8_SB(1, 1), cB + hstep + kstep, voffB);
        PG8_WAIT_V(6); PG8_BAR;
    }
    for (;;) {
        const bool has_next = S.next(ui + 1, nxt);
        const char* nA = has_next ? (const char*)g.A + (size_t)nxt.pm * tstep : cA; const char* nB = has_next ? (const char*)g.Bt + (size_t)nxt.pn * tstep : cB;
        for (int t = 0; t < nt; t += 2) {
            const bool last = (t == nt - 2);
            const char* a1 = cA + (size_t)(t + 1) * kstep;
            const char* a2 = last ? nA : cA + (size_t)(t + 2) * kstep; const char* b2 = last ? nB : cB + (size_t)(t + 2) * kstep;
            const char* a3 = a2 + kstep; const char* b3 = b2 + kstep;
            if (last && has_next) S.a_ready(nxt);
            if constexpr (SP2) {
            PG8_LDB(B0, 0, 0); PG8_LDB(B1, 0, 1); PG8_SCHED; PG8_LDA(At, 0, 0); PG8_STAGE(PG8_SA(1, 1), a1 + hstep, voffA);
            PG8_WAIT_V(8); PG8_WAIT_L(0); PG8_BAR; PG8_MMA(0, 0, At, B0); PG8_MMA(0, 1, At, B1); PG8_BAR; PG8_SCHED;
            PG8_LDA(At, 0, 1); PG8_STAGE(PG8_SB(0, 0), b2, voffB); PG8_STAGE(PG8_SB(0, 1), b2 + hstep, voffB); PG8_STAGE(PG8_SA(0, 0), a2, voffA);
            PG8_WAIT_V(8); PG8_WAIT_L(0); PG8_BAR; PG8_MMA(1, 0, At, B0); PG8_MMA(1, 1, At, B1); PG8_BAR; PG8_SCHED;
            PG8_LDB(B0, 1, 0); PG8_LDB(B1, 1, 1); PG8_SCHED; PG8_LDA(At, 1, 0); PG8_STAGE(PG8_SA(0, 1), a2 + hstep, voffA);
            PG8_WAIT_V(8); PG8_WAIT_L(0); PG8_BAR; PG8_MMA(0, 0, At, B0); PG8_MMA(0, 1, At, B1); PG8_BAR; PG8_SCHED;
            PG8_LDA(At, 1, 1); PG8_STAGE(PG8_SB(1, 0), b3, voffB); PG8_STAGE(PG8_SB(1, 1), b3 + hstep, voffB); PG8_STAGE(PG8_SA(1, 0), a3, voffA);
            PG8_WAIT_V(8); PG8_WAIT_L(0); PG8_BAR; PG8_MMA(1, 0, At, B0); PG8_MMA(1, 1, At, B1); PG8_BAR; PG8_SCHED;
            } else {
            PG8_LDB(B0, 0, 0); PG8_SCHED; PG8_LDA(At, 0, 0); PG8_STAGE(PG8_SA(1, 1), a1 + hstep, voffA);
            PG8_WAIT_L(8); PG8_BAR; PG8_WAIT_L(0); PG8_MMA(0, 0, At, B0); PG8_BAR; PG8_SCHED;
            PG8_LDB(B1, 0, 1); PG8_STAGE(PG8_SB(0, 0), b2, voffB);
            PG8_BAR; PG8_WAIT_L(0); PG8_MMA(0, 1, At, B1); PG8_BAR;
            PG8_LDA(At, 0, 1); PG8_STAGE(PG8_SA(0, 0), a2, voffA);
            PG8_BAR; PG8_WAIT_L(0); PG8_MMA(1, 0, At, B0); PG8_BAR; PG8_SCHED;
            PG8_STAGE(PG8_SB(0, 1), b2 + hstep, voffB);
            PG8_WAIT_V(6); PG8_BAR; PG8_MMA(1, 1, At, B1); PG8_BAR;
            PG8_LDB(B0, 1, 0); PG8_SCHED; PG8_LDA(At, 1, 0); PG8_STAGE(PG8_SA(0, 1), a2 + hstep, voffA);
            PG8_WAIT_L(8); PG8_BAR; PG8_WAIT_L(0); PG8_MMA(0, 0, At, B0); PG8_BAR; PG8_SCHED;
            PG8_LDB(B1, 1, 1); PG8_STAGE(PG8_SB(1, 0), b3, voffB);
            PG8_BAR; PG8_WAIT_L(0); PG8_MMA(0, 1, At, B1); PG8_BAR;
            PG8_LDA(At, 1, 1); PG8_STAGE(PG8_SA(1, 0), a3, voffA);
            PG8_BAR; PG8_WAIT_L(0); PG8_MMA(1, 0, At, B0); PG8_BAR; PG8_SCHED;
            PG8_STAGE(PG8_SB(1, 1), b3 + hstep, voffB);
            PG8_WAIT_V(6); PG8_BAR; PG8_MMA(1, 1, At, B1); PG8_BAR;
            }
        }
        if constexpr (ALIGN_EPI) { if (wr == 0) PG8_BAR; }
        if constexpr (!Epi::AFTER_DRAIN) { E(acc, cur, wr, wc, fr, fq); S.done(cur); }
        if (!has_next) break;
#pragma unroll
        for (int a = 0; a < 2; ++a)
#pragma unroll
            for (int b = 0; b < 2; ++b)
#pragma unroll
                for (int m = 0; m < 4; ++m)
#pragma unroll
                    for (int n = 0; n < 2; ++n) acc[a][b][m][n] = (f32x4){0.f, 0.f, 0.f, 0.f};
        cur = nxt; cA = nA; cB = nB; ++ui;
        if constexpr (ALIGN_EPI) { if (wr == 1) PG8_BAR; }
    }
    PG8_WAIT_V(0);
    if constexpr (!ALIGN_EPI) { if (wr == 0) PG8_BAR; }
    PG8_BAR;
    if constexpr (Epi::AFTER_DRAIN) { E.fused(acc, cur, wr, wc, fr, fq, lds, wid, lane); S.done(cur); }
#undef PG8_SA
#undef PG8_SB
#undef PG8_STAGE
#undef PG8_LDA
#undef PG8_LDB
#undef PG8_MMA
#undef PG8_WAIT_V
#undef PG8_WAIT_L
#undef PG8_BAR
#undef PG8_SCHED
}
}
namespace fa {
typedef unsigned short bf16;
typedef short bf16x8 __attribute__((ext_vector_type(8)));
typedef short s16x4 __attribute__((ext_vector_type(4)));
typedef float f32x16 __attribute__((ext_vector_type(16)));
typedef float f32x4 __attribute__((ext_vector_type(4)));
typedef unsigned u32x4 __attribute__((ext_vector_type(4)));
constexpr int D = 128, PITCH = 2048, SEQ = 8192, NHEAD = 16;
constexpr int NW = 8, QBLK = 32, KVBLK = 64, QB = NW * QBLK, NQB = SEQ / QB;
constexpr int SHM_V = KVBLK * D * 2, SHM_K = KVBLK * D * 2;
constexpr int F_OFF = 2 * SHM_V + 2 * SHM_K + NW * 64 * 4 + 2048;
constexpr int ATT_LDS_BYTES = F_OFF + SEQ * 4 + 256;
constexpr float THR2 = 60.0f;
#define FA_KSWZ(row, colB) ((row) * 256 + ((colB) ^ (((row) & 7) << 4)))
#define FA_SBAR() __builtin_amdgcn_sched_barrier(0)
__device__ __forceinline__ int v_st(int k, int c) { const int kk = (k & ~0xC) | ((k & 4) << 1) | ((k & 8) >> 1); return ((kk >> 3) * 4 + (c >> 5)) * 512 + ((kk & 7) * 32 + (c & 31)) * 2; }
__device__ __forceinline__ int v_rd_base(int lane) { return ((lane & 3) << 3) | (((lane >> 2) & 3) << 6) | (((lane >> 4) & 1) << 5) | (((lane >> 5) & 1) << 8); }
constexpr int v_rd_off(int d0, int ks, int half) { return d0 * 512 + ks * 4096 + half * 2048; }
__device__ __forceinline__ int crow(int r, int hi) { return (r & 3) + 8 * (r >> 2) + 4 * hi; }
__device__ __forceinline__ unsigned cvtpk(float lo, float hi) { unsigned r; asm volatile("v_cvt_pk_bf16_f32 %0, %1, %2" : "=v"(r) : "v"(lo), "v"(hi)); return r; }
__device__ __forceinline__ bf16x8 load8(const bf16* p) { return *reinterpret_cast<const bf16x8*>(p); }
__device__ __forceinline__ void mask_tile(f32x16& p0, f32x16& p1, int dq) {
#pragma unroll
    for (int r = 0; r < 16; ++r) { const int c = (r & 3) + 8 * (r >> 2);
        const float t0 = __uint_as_float(0x7f800000u | ((unsigned)(dq - c) & 0x80000000u)), t1 = __uint_as_float(0x7f800000u | ((unsigned)(dq - c - 32) & 0x80000000u));
        p0[r] = fminf(p0[r], t0); p1[r] = fminf(p1[r], t1); }
}
__device__ __forceinline__ void partialSM(f32x16& p0, f32x16& p1, float& m_reg, float& mn, float& alpha) {
    float pmax = p0[0];
#pragma unroll
    for (int r = 1; r < 16; ++r) pmax = fmaxf(pmax, p0[r]);
#pragma unroll
    for (int r = 0; r < 16; ++r) pmax = fmaxf(pmax, p1[r]);
    { auto rr = __builtin_amdgcn_permlane32_swap(__float_as_uint(pmax), __float_as_uint(pmax), false, false);
      pmax = fmaxf(__uint_as_float(rr[0]), __uint_as_float(rr[1])); }
    if (__builtin_expect(__all((pmax - m_reg) <= THR2), 1)) { mn = m_reg; alpha = 1.f; }
    else { mn = fmaxf(m_reg, pmax); alpha = __builtin_amdgcn_exp2f(m_reg - mn); m_reg = mn; }
#pragma unroll
    for (int r = 0; r < 16; ++r) p0[r] = p0[r] - mn;
#pragma unroll
    for (int r = 0; r < 16; ++r) p1[r] = p1[r] - mn;
#pragma unroll
    for (int r = 0; r < 16; ++r) p0[r] = __builtin_amdgcn_exp2f(p0[r]);
}
__device__ __forceinline__ void finishSM(f32x16& p0, f32x16& p1, float alpha, float& l_reg, bf16x8& pa0, bf16x8& pa1, bf16x8& pa2, bf16x8& pa3) {
#pragma unroll
    for (int r = 0; r < 16; ++r) p1[r] = __builtin_amdgcn_exp2f(p1[r]);
    float ps = 0;
#pragma unroll
    for (int r = 0; r < 16; ++r) ps += p0[r];
#pragma unroll
    for (int r = 0; r < 16; ++r) ps += p1[r];
    { auto rr = __builtin_amdgcn_permlane32_swap(__float_as_uint(ps), __float_as_uint(ps), false, false);
      ps = __uint_as_float(rr[0]) + __uint_as_float(rr[1]); }
    l_reg = l_reg * alpha + ps;
#define FA_PK4(P, B_, OUT) do { unsigned a0 = cvtpk(P[B_+0], P[B_+1]), a1 = cvtpk(P[B_+2], P[B_+3]);                          \
        unsigned b0 = cvtpk(P[B_+4], P[B_+5]), b1 = cvtpk(P[B_+6], P[B_+7]);                                             \
        auto r0 = __builtin_amdgcn_permlane32_swap(a0, b0, false, false); auto r1 = __builtin_amdgcn_permlane32_swap(a1, b1, false, false); \
        u32x4 w = {r0[0], r1[0], r0[1], r1[1]}; OUT = *reinterpret_cast<bf16x8*>(&w); } while (0)
    FA_PK4(p0, 0, pa0); FA_PK4(p0, 8, pa1); FA_PK4(p1, 0, pa2); FA_PK4(p1, 8, pa3);
#undef FA_PK4
}
template <int KB>
__device__ __forceinline__ void qkt(f32x16& p0, f32x16& p1, const char* K_lds, int r32, int hi, const bf16x8* qr, const __attribute__((address_space(3))) float* fl) {
#pragma unroll
    for (int g = 0; g < 4; ++g) { const f32x4 a = *(const __attribute__((address_space(3))) f32x4*)(fl + 8 * g), b = *(const __attribute__((address_space(3))) f32x4*)(fl + 32 + 8 * g);
#pragma unroll
        for (int i = 0; i < 4; ++i) { p0[4 * g + i] = a[i]; p1[4 * g + i] = b[i]; } }
    const char* kb[4];
#pragma unroll
    for (int dd = 0; dd < 4; ++dd) kb[dd] = K_lds + KB * SHM_K + FA_KSWZ(r32, (dd * 16 + hi * 8) * 2);
#pragma unroll
    for (int d0 = 0; d0 < 8; ++d0) { const char* a = kb[d0 & 3] + (d0 >> 2) * 128;
        bf16x8 b0 = *reinterpret_cast<const bf16x8*>(a);
        bf16x8 b1 = *reinterpret_cast<const bf16x8*>(a + 32 * 256);
        p0 = __builtin_amdgcn_mfma_f32_32x32x16_bf16(b0, qr[d0], p0, 0, 0, 0);
        p1 = __builtin_amdgcn_mfma_f32_32x32x16_bf16(b1, qr[d0], p1, 0, 0, 0); }
}
template <int VB>
__device__ __forceinline__ void pv_tile(f32x16* o, int vb0, bf16x8 pa0, bf16x8 pa1, bf16x8 pa2, bf16x8 pa3) {
#define FA_TRRD(dst, off) asm volatile("ds_read_b64_tr_b16 %0, %1 offset:%2" : "=&v"(dst) : "v"(vb0), "i"(off) : "memory")
#define FA_PV_D0(d0) do { s16x4 l0, l1, l2, l3, h0, h1, h2, h3; constexpr int b_ = VB * SHM_V + v_rd_off(d0, 0, 0); \
        FA_TRRD(l0, b_); FA_TRRD(h0, b_ + 2048); FA_TRRD(l1, b_ + 4096); FA_TRRD(h1, b_ + 6144); FA_TRRD(l2, b_ + 8192); FA_TRRD(h2, b_ + 10240); FA_TRRD(l3, b_ + 12288); FA_TRRD(h3, b_ + 14336); \
        asm volatile("s_waitcnt lgkmcnt(0)" ::: "memory"); FA_SBAR();   \
        o[d0] = __builtin_amdgcn_mfma_f32_32x32x16_bf16(pa0, (bf16x8){l0[0], l0[1], l0[2], l0[3], h0[0], h0[1], h0[2], h0[3]}, o[d0], 0, 0, 0);   \
        o[d0] = __builtin_amdgcn_mfma_f32_32x32x16_bf16(pa1, (bf16x8){l1[0], l1[1], l1[2], l1[3], h1[0], h1[1], h1[2], h1[3]}, o[d0], 0, 0, 0);   \
        o[d0] = __builtin_amdgcn_mfma_f32_32x32x16_bf16(pa2, (bf16x8){l2[0], l2[1], l2[2], l2[3], h2[0], h2[1], h2[2], h2[3]}, o[d0], 0, 0, 0);   \
        o[d0] = __builtin_amdgcn_mfma_f32_32x32x16_bf16(pa3, (bf16x8){l3[0], l3[1], l3[2], l3[3], h3[0], h3[1], h3[2], h3[3]}, o[d0], 0, 0, 0); } while (0)
    FA_PV_D0(0); FA_PV_D0(1); FA_PV_D0(2); FA_PV_D0(3);
#undef FA_PV_D0
#undef FA_TRRD
}
constexpr size_t BUF = (size_t)16384 * 2048;
struct BlockRef { const bf16* Q; const bf16* K; int P0; int jlo; };
#ifndef FA_SELFCHECK
#define FA_SELFCHECK 0
#endif
#if FA_SELFCHECK
#endif
struct Seam { bf16x8 qr[8]; bf16x8 st_v0, st_v1, st_k0, st_k1; };
#define FA_TILE(p, k0, half) ((const char*)(p) + ((size_t)((k0) + 32 * (half)) * PITCH * 2))
#define FA_VMW() asm volatile("s_waitcnt vmcnt(0)" ::: "memory")
#define FA_VMWN(n) asm volatile("s_waitcnt vmcnt(%0)" :: "i"(n) : "memory")
#define FA_SLOAD(Kp, Vp, k0) do { S.st_v0 = load8((const bf16*)(FA_TILE(Vp, k0, 0) + svoff)); S.st_v1 = load8((const bf16*)(FA_TILE(Vp, k0, 1) + svoff));              \
                         S.st_k0 = load8((const bf16*)(FA_TILE(Kp, k0, 0) + svoff)); S.st_k1 = load8((const bf16*)(FA_TILE(Kp, k0, 1) + svoff)); } while (0)
#define FA_SWRITE_K(bf) do { *(bf16x8*)(K_lds + (bf) * SHM_K + kws) = S.st_k0; *(bf16x8*)(K_lds + (bf) * SHM_K + kws + 32 * 256) = S.st_k1; } while (0)
#define FA_SWRITE_V(bf) do { *(bf16x8*)(V_lds + (bf) * SHM_V + vst0) = S.st_v0; *(bf16x8*)(V_lds + (bf) * SHM_V + vst1) = S.st_v1; } while (0)
#define FA_SWRITE(bf) do { FA_SWRITE_V(bf); FA_SWRITE_K(bf); } while (0)
__device__ __forceinline__ void attn_prime(const BlockRef& cur, char* lds, Seam& S, const int tid) {
    const int wid = __builtin_amdgcn_readfirstlane(tid >> 6), lane = tid & 63, r32 = lane & 31, hi = lane >> 5;
    const int sr = tid >> 4, sc = (tid & 15) * 8, kws = FA_KSWZ(sr, sc * 2); const unsigned svoff = (unsigned)(sr * PITCH + sc) * 2u; char* K_lds = lds + 2 * SHM_V;
#pragma unroll
    for (int d0 = 0; d0 < 8; ++d0) S.qr[d0] = load8(cur.Q + (size_t)(wid * QBLK + r32) * PITCH + d0 * 16 + hi * 8);
    FA_SLOAD(cur.K, cur.K + BUF, cur.jlo * KVBLK); FA_VMW(); FA_SWRITE_K(0);
    __syncthreads();
}
__device__ __forceinline__ void attn_block(const BlockRef& cur, const BlockRef& nxt, char* lds, Seam& S, const int tid, const int obuf = 5) {
    const int wid = __builtin_amdgcn_readfirstlane(tid >> 6), lane = tid & 63, r32 = lane & 31, hi = lane >> 5;
    const int j_lo = cur.jlo, NT = cur.P0 / KVBLK + QB / KVBLK - j_lo;
    const int qlo = cur.P0 + wid * QBLK, qm = qlo + r32 - 4 * hi;
    char* V_lds = lds; char* K_lds = lds + 2 * SHM_V;
    float* ws = (float*)(lds + 2 * SHM_V + 2 * SHM_K) + wid * 64; float* li_l = ws, * al_l = ws + 32;
    const __attribute__((address_space(3))) float* Fl = (const __attribute__((address_space(3))) float*)((__attribute__((address_space(3))) char*)lds + F_OFF) + 4 * hi;
    float m_reg = -1e30f, l_reg = 0; f32x16 o[4] = {};
    const int sr = tid >> 4, sc = (tid & 15) * 8, vst0 = v_st(sr, sc), vst1 = vst0 + 8192  , kws = FA_KSWZ(sr, sc * 2); const unsigned svoff = (unsigned)(sr * PITCH + sc) * 2u;
    const int vb0 = (int)(uintptr_t)V_lds + v_rd_base(lane);
    const bf16* Kh = cur.K; const bf16* Vh = cur.K + BUF;
#define FA_RESC(a) do { if (__any((a) < 1.f)) { if (hi == 0) al_l[r32] = (a); asm volatile("s_waitcnt lgkmcnt(0)" ::: "memory");              \
                     for (int d_ = 0; d_ < 4; ++d_) for (int r = 0; r < 16; ++r) o[d_][r] *= al_l[crow(r, hi)]; } } while (0)
#define FA_KBASE(t) ((j_lo + (t)) * KVBLK)
#define FA_BIASMASK(P0_, P1_, t) do { const int kb_ = FA_KBASE(t); if (kb_ + KVBLK - 1 > qlo) mask_tile(P0_, P1_, qm - kb_); } while (0)
    constexpr int NQL = 8;
#define FA_SEAM_K0() do { FA_VMWN(NQL); FA_SWRITE_K(0); FA_SBAR(); } while (0)
    f32x16 pA0, pA1, pB0, pB1; float mnA, mnB, alA, alB; bf16x8 pa0, pa1, pa2, pa3;
    FA_SWRITE_V(0); FA_SBAR();
    if (NT > 1) { FA_SLOAD(Kh, Vh, FA_KBASE(1)); }
    FA_SBAR(); qkt<0>(pA0, pA1, K_lds, r32, hi, S.qr, Fl + FA_KBASE(0));
    FA_BIASMASK(pA0, pA1, 0); partialSM(pA0, pA1, m_reg, mnA, alA);
    if (NT > 1) { FA_VMW(); FA_SWRITE(1); }
    __syncthreads();
#define FA_HALF_STEP(PX0, PX1, mnX, alX, PY0, PY1, alY, t, KB, VB, SB) do {                                                      \
        FA_SBAR(); qkt<KB>(PX0, PX1, K_lds, r32, hi, S.qr, Fl + FA_KBASE(t));                                             \
        finishSM(PY0, PY1, alY, l_reg, pa0, pa1, pa2, pa3); FA_SBAR();                                                           \
        if ((t) + 1 < NT) { FA_SLOAD(Kh, Vh, FA_KBASE((t) + 1)); FA_SBAR(); }                                               \
        pv_tile<VB>(o, vb0, pa0, pa1, pa2, pa3); FA_BIASMASK(PX0, PX1, (t)); partialSM(PX0, PX1, m_reg, mnX, alX);                                        \
        __syncthreads();                                                                                                      \
        if ((t) + 1 < NT) { FA_VMW(); FA_SWRITE(SB); }                                                                          \
        FA_RESC(alX); __syncthreads(); } while (0)
    for (int t = 1; t + 1 < NT; t += 2) {
        FA_HALF_STEP(pB0, pB1, mnB, alB, pA0, pA1, alA, t, 1, 0, 0);
        FA_HALF_STEP(pA0, pA1, mnA, alA, pB0, pB1, alB, t + 1, 0, 1, 1);
    }
    const bool even = (NT & 1) == 0;
    if (even) { FA_SBAR(); qkt<1>(pB0, pB1, K_lds, r32, hi, S.qr, Fl + FA_KBASE(NT - 1)); FA_SBAR(); }
    FA_SLOAD(nxt.K, nxt.K + BUF, nxt.jlo * KVBLK); FA_SBAR();
#pragma unroll
    for (int d0 = 0; d0 < 8; ++d0) S.qr[d0] = load8(nxt.Q + (size_t)(wid * QBLK + r32) * PITCH + d0 * 16 + hi * 8);
    FA_SBAR();
    finishSM(pA0, pA1, alA, l_reg, pa0, pa1, pa2, pa3); FA_SBAR();
    pv_tile<0>(o, vb0, pa0, pa1, pa2, pa3);
    if (even) { FA_BIASMASK(pB0, pB1, NT - 1); partialSM(pB0, pB1, m_reg, mnB, alB); __syncthreads(); FA_RESC(alB);
        finishSM(pB0, pB1, alB, l_reg, pa0, pa1, pa2, pa3); FA_SBAR(); pv_tile<1>(o, vb0, pa0, pa1, pa2, pa3); }
    FA_SBAR(); FA_SEAM_K0();
    if (hi == 0) li_l[r32] = l_reg; asm volatile("s_waitcnt lgkmcnt(0)" ::: "memory");
    float rli[16];
#pragma unroll
    for (int r = 0; r < 16; ++r) rli[r] = __builtin_amdgcn_rcpf(li_l[crow(r, hi)]);
    bf16* Ow = const_cast<bf16*>(cur.Q) + (size_t)obuf * BUF + (size_t)(wid * QBLK) * PITCH;
#pragma unroll
    for (int r = 0; r < 16; ++r) { const int orow = crow(r, hi);
#pragma unroll
        for (int d0 = 0; d0 < 4; ++d0) { const float v = o[d0][r] * rli[r];
            const float vn = __shfl_xor(v, 1);
            if ((r32 & 1) == 0) *(unsigned*)(Ow + (size_t)orow * PITCH + d0 * 32 + r32) = cvtpk(v, vn); } }
    __syncthreads();
#undef FA_RESC
#undef FA_KBASE
#undef FA_BIASMASK
#undef FA_SEAM_K0
#undef FA_HALF_STEP
}
#undef FA_TILE
#undef FA_VMW
#undef FA_VMWN
#undef FA_SLOAD
#undef FA_SWRITE_K
#undef FA_SWRITE_V
#undef FA_SWRITE
__device__ __forceinline__ BlockRef block_ref(int bh, int qb, int jlo, const bf16* Q) {
    const int b = bh >> 4, h = bh & 15; BlockRef r;
    r.Q = Q + ((size_t)b * SEQ + (size_t)qb * QB) * PITCH + (size_t)h * D; r.K = Q + BUF + (size_t)b * SEQ * PITCH + (size_t)h * D; r.P0 = qb * QB; r.jlo = jlo; return r;
}
__device__ __forceinline__ void load_bias(char* lds, const float* FB, int bh, int k_lo, int k_hi, const int tid) {
    const f32x4* src = (const f32x4*)(FB + (size_t)bh * SEQ); __attribute__((address_space(3))) f32x4* dst = (__attribute__((address_space(3))) f32x4*)((__attribute__((address_space(3))) char*)lds + F_OFF);
    int t0 = tid; asm volatile("" : "+v"(t0));
    for (int i = k_lo / 4 + t0; i < k_hi / 4; i += NW * 64) dst[i] = src[i];
    __syncthreads();
}
#ifndef FA_PRUNE
#define FA_PRUNE 1
#endif
constexpr float PRUNE_T2 = 44.0f;
constexpr int NTICKETS = (1 + (((DUP_MASK) >> 3) & 1)) * 2 * NHEAD * NQB;
constexpr int XQ_OFF = F_OFF + SEQ * 4;
struct Ticket { int idx, bh, qb, jlo; };
__device__ __forceinline__ Ticket next_block(char* lds, const bf16* Q, const float* FB, const unsigned* qkmax, unsigned* qhead, const int tid, const bool prune = true) {
    __attribute__((address_space(3))) int* xi = (__attribute__((address_space(3))) int*)((__attribute__((address_space(3))) char*)lds + XQ_OFF);
    __attribute__((address_space(3))) float* xf = (__attribute__((address_space(3))) float*)(xi + 16);
    int t0 = tid; asm volatile("" : "+v"(t0));
    const int wid = __builtin_amdgcn_readfirstlane(t0 >> 6), lane = t0 & 63;
    if (t0 == 0) xi[0] = (int)__hip_atomic_fetch_add(qhead, 1u, __ATOMIC_RELAXED, __HIP_MEMORY_SCOPE_AGENT);
    __syncthreads();
    Ticket T; T.idx = xi[0]; { const int id = T.idx % (2 * NHEAD * NQB); T.qb = NQB - 1 - (id >> 5); T.bh = id & 31; } T.jlo = 0;
    if (T.idx >= NTICKETS) { __syncthreads(); return T; }
    const int b = T.bh >> 4, h = T.bh & 15, P0 = T.qb * QB;
#if FA_PRUNE
    const int row = t0 >> 1, half = t0 & 1;
    const bf16* qp = Q + ((size_t)b * SEQ + P0 + row) * PITCH + (size_t)h * D + 64 * half; const bf16* kp = qp + BUF;
    float d = 0.f;
#pragma unroll
    for (int c = 0; c < 8; ++c) { const u32x4 qa = *(const u32x4*)(qp + 8 * c), ka = *(const u32x4*)(kp + 8 * c);
#pragma unroll
        for (int e = 0; e < 4; ++e) { d += __uint_as_float(qa[e] << 16) * __uint_as_float(ka[e] << 16); d += __uint_as_float(qa[e] & 0xffff0000u) * __uint_as_float(ka[e] & 0xffff0000u); } }
    d += __shfl_xor(d, 1);
    d += FB[(size_t)T.bh * SEQ + P0 + row];
#pragma unroll
    for (int o = 2; o < 64; o <<= 1) d = fminf(d, __shfl_xor(d, o));
    if (lane == 0) xf[wid] = d;
    float smax = 0.f;
#pragma unroll
    for (int w = 0; w < 4; ++w) smax += sqrtf(__uint_as_float(qkmax[(T.bh * 2 + 0) * 4 + w]) * __uint_as_float(qkmax[(T.bh * 2 + 1) * 4 + w]));
    smax = smax * 1.02f + 0.5f;
    __syncthreads();
    float mmin = xf[0];
#pragma unroll
    for (int w = 1; w < 8; ++w) mmin = fminf(mmin, xf[w]);
    const float thresh = prune ? mmin - PRUNE_T2 - smax : -__builtin_inff();
    const int nb0 = P0 / KVBLK;
    const bool skip = (t0 < nb0) && (FB[(size_t)T.bh * SEQ + t0 * KVBLK + KVBLK - 1] < thresh);
    const unsigned long long bal = __ballot(skip);
    if (lane == 0) xi[8 + wid] = __popcll(bal);
    __syncthreads();
    T.jlo = xi[8] + xi[9];
    __syncthreads();
#else
    __syncthreads();
#endif
    return T;
}
__device__ __forceinline__ void attn_phase(char* lds, const bf16* Q, const float* FB, const unsigned* qkmax, unsigned* qhead, const int tid, const bool prune = true, const int obuf = 5) {
    Ticket tc = next_block(lds, Q, FB, qkmax, qhead, tid, prune);
    if (tc.idx >= NTICKETS) return;
    BlockRef cur = block_ref(tc.bh, tc.qb, tc.jlo, Q);
    Seam S;
    load_bias(lds, FB, tc.bh, tc.jlo * KVBLK, (tc.qb + 1) * QB, tid);
    attn_prime(cur, lds, S, tid);
    for (;;) {
        const Ticket tn = next_block(lds, Q, FB, qkmax, qhead, tid, prune);
        const bool last = tn.idx >= NTICKETS;
        const BlockRef nxt = last ? cur : block_ref(tn.bh, tn.qb, tn.jlo, Q);
        attn_block(cur, nxt, lds, S, tid, obuf);
        if (last) break;
        load_bias(lds, FB, tn.bh, tn.jlo * KVBLK, (tn.qb + 1) * QB, tid);
        cur = nxt;
    }
}
}

constexpr int NWAVES = 8;
constexpr int BATCH = 2, SEQ = 8192, DM = 4096, NH = 16, HD = 128, AW = 2048, CW = 2048, DFF = 11008, NIN = 12304;
constexpr int M = BATCH * SEQ;
constexpr int NPROJ = 12288;
constexpr int NGU = 2 * DFF;
constexpr float EPS = 1e-6f;
constexpr float QSCALE = 0.08838834764831845f * 1.4426950408889634f;
#ifndef MK_N_LAUNCHES
#define MK_N_LAUNCHES 1
#endif
constexpr int N_PHASES = 10;

#ifndef PG8_ALIGN
#define PG8_ALIGN true
#endif
#ifndef PG8_SP2
#define PG8_SP2 true
#endif
constexpr size_t MiB = 1u << 20;
constexpr size_t WS_CTL = 0, CTL_ZERO_BYTES = 1 * MiB;
constexpr size_t WS_MOD = 512 * 1024;
constexpr size_t WS_WF = 1 * MiB;
constexpr size_t WS_FT = 2 * MiB;
constexpr size_t WS_FB = 3 * MiB;
constexpr size_t WS_WIN = 4 * MiB;
constexpr size_t WS_WOUT = WS_WIN + (size_t)NPROJ * DM * 2;
constexpr size_t WS_WGU = WS_WOUT + (size_t)DM * DM * 2;
constexpr size_t WS_WD = WS_WGU + (size_t)NGU * DM * 2;
constexpr size_t WS_H = WS_WD + (size_t)DM * DFF * 2;
constexpr size_t WS_Q = WS_H + (size_t)M * DM * 2;
constexpr size_t WS_K = WS_Q + (size_t)M * 2048 * 2, WS_V = WS_K + (size_t)M * 2048 * 2, WS_GB = WS_V + (size_t)M * 2048 * 2, WS_CU = WS_GB + (size_t)M * 2048 * 2, WS_YA = WS_CU + (size_t)M * 2048 * 2;
constexpr size_t WS_ACT = WS_Q;
constexpr size_t WS_HM = WS_YA + (size_t)M * 2048 * 2;
constexpr size_t WS_END = WS_HM + (size_t)M * DM * 2;
static_assert(WS_ACT + (size_t)M * DFF * 2 <= WS_HM, "ACT overlay fits inside Q..YA");
static_assert(WS_WIN % 256 == 0 && WS_WOUT % 256 == 0 && WS_WGU % 256 == 0 && WS_WD % 256 == 0 && WS_H % 256 == 0 && WS_Q % 256 == 0 && WS_HM % 256 == 0, "alignment");
constexpr int CW_BAR = 4096;
constexpr int CW_QHEAD = 512, CW_QKMAX = 1024;
constexpr int RING_BYTES = 131072, LDSCTL_OFF = RING_BYTES, MISC_OFF = LDSCTL_OFF + 320, LDS_BYTES = 147456;
static_assert(fa::ATT_LDS_BYTES <= RING_BYTES, "attention LDS");
static_assert(WS_K - WS_Q == fa::BUF * 2 && WS_V - WS_K == fa::BUF * 2 && WS_YA - WS_Q == 5 * fa::BUF * 2, "attention tensor spacing");

#define GAS __attribute__((address_space(1)))
#define LAS __attribute__((address_space(3)))
typedef unsigned short bf16;
typedef unsigned v4u __attribute__((ext_vector_type(4)));
typedef unsigned v2u __attribute__((ext_vector_type(2)));
typedef float f32x4 __attribute__((ext_vector_type(4)));
typedef short bf16x8 __attribute__((ext_vector_type(8)));
typedef GAS unsigned gu32;
#define RLX_AGENT __ATOMIC_RELAXED, __HIP_MEMORY_SCOPE_AGENT
#define LDS_WAIT() asm volatile("s_waitcnt lgkmcnt(0)" ::: "memory")
#define VM_WAIT() asm volatile("s_waitcnt vmcnt(0)" ::: "memory")
__device__ __forceinline__ unsigned f2bf(float f) { unsigned u = __builtin_bit_cast(unsigned, f); return (u + 0x7fffu + ((u >> 16) & 1u)) >> 16; }
__device__ __forceinline__ unsigned pk2(float lo, float hi) { return f2bf(lo) | (f2bf(hi) << 16); }
__device__ __forceinline__ float bflo(unsigned w) { return __builtin_bit_cast(float, w << 16); }
__device__ __forceinline__ float bfhi(unsigned w) { return __builtin_bit_cast(float, w & 0xffff0000u); }
__device__ __forceinline__ float wave_sum(float v) {
#pragma unroll
    for (int o = 1; o < 64; o <<= 1) v += __shfl_xor(v, o);
    return v;
}
#define XB_TMO      128
#define XB_XCNT(j)  (256  + 64 * (j))
#define XB_XSUB(j)  (1280 + 64 * (j))
#define XB_XGEN(j)  (2304 + 64 * (j))
#define XB_TOP      3328
#define XB_TOPGEN   3392
#define XCD_BAR_WORDS 3456
#define XB_SPIN_CAP (1u << 18)

__device__ __forceinline__ unsigned xb_ld(unsigned* p)              { return __hip_atomic_load(p, __ATOMIC_RELAXED, __HIP_MEMORY_SCOPE_AGENT); }
__device__ __forceinline__ unsigned xb_add(unsigned* p, unsigned v) { return __hip_atomic_fetch_add(p, v, __ATOMIC_RELAXED, __HIP_MEMORY_SCOPE_AGENT); }
__device__ __forceinline__ unsigned xb_xcc_id() { return (unsigned)__builtin_amdgcn_s_getreg((3 << 11) | 20) & 0xFu; }
#define XB_SPIN(cond, bar) do { unsigned _sp = 0; while (cond) { __builtin_amdgcn_s_sleep(1); \
    if ((++_sp & 255u) == 0u) { if (xb_ld(&(bar)[XB_TMO])) break; if (_sp > XB_SPIN_CAP) { atomicAdd(&(bar)[XB_TMO], 1u); break; } } } } while (0)

struct XcdBarrier {
    unsigned* bar; unsigned x;
    volatile LAS unsigned* st;
};

__device__ __forceinline__ XcdBarrier xcd_barrier_post(unsigned* bar, volatile LAS unsigned* st, const int tid) {
    XcdBarrier b; b.bar = bar; b.x = xb_xcc_id(); b.st = st;
    if (tid == 0) (void)xb_add(&bar[XB_XCNT(b.x)], 1u);
    return b;
}
__device__ __forceinline__ void xcd_barrier_complete(unsigned* bar, unsigned x, unsigned& nloc, unsigned& nx) {
    const unsigned G = gridDim.x * gridDim.y * gridDim.z;
    unsigned sum, cnt, mine, sp = 0u;
    for (;;) {
        sum = 0u; cnt = 0u; mine = 0u;
#pragma unroll
        for (unsigned j = 0; j < 16; ++j) { const unsigned c = xb_ld(&bar[XB_XCNT(j)]); sum += c; cnt += (c > 0u) ? 1u : 0u; mine = (j == x) ? c : mine; }
        if (sum == G) break;
        __builtin_amdgcn_s_sleep(1);
        if ((++sp & 255u) == 0u) { if (xb_ld(&bar[XB_TMO])) break; if (sp > XB_SPIN_CAP) { atomicAdd(&bar[XB_TMO], 1u); break; } }
    }
    nloc = mine > 0u ? mine : 1u; nx = cnt > 0u ? cnt : 1u;
}

__device__ __forceinline__ void xcd_barrier(const XcdBarrier& b, const int tid) {
    asm volatile("s_waitcnt vmcnt(0)" ::: "memory");
    __syncthreads();
    if (tid == 0) {
        unsigned* bar = b.bar;
        __builtin_amdgcn_s_waitcnt(0);
        unsigned nloc = b.st[0], nx = b.st[1];
        if (nloc == 0u) { xcd_barrier_complete(bar, b.x, nloc, nx); b.st[0] = nloc; b.st[1] = nx; }
        const unsigned old = xb_add(&bar[XB_XSUB(b.x)], 1u);
        const unsigned gen = old / nloc;
        if (old + 1u == (gen + 1u) * nloc) {
            __builtin_amdgcn_fence(__ATOMIC_RELEASE, "agent");
            asm volatile("s_waitcnt vmcnt(0)" ::: "memory");
            const unsigned og = xb_add(&bar[XB_TOP], 1u);
            const unsigned tg = og / nx;
            if (og + 1u == (tg + 1u) * nx) xb_add(&bar[XB_TOPGEN], 1u);
            else XB_SPIN(xb_ld(&bar[XB_TOPGEN]) == tg, bar);
            __builtin_amdgcn_fence(__ATOMIC_ACQUIRE, "agent");
            xb_add(&bar[XB_XGEN(b.x)], 1u);
            asm volatile("s_waitcnt vmcnt(0)" ::: "memory");
        } else {
            XB_SPIN(xb_ld(&bar[XB_XGEN(b.x)]) == gen, bar);
            __builtin_amdgcn_fence(__ATOMIC_ACQUIRE, "agent");
            asm volatile("s_waitcnt vmcnt(0)" ::: "memory");
        }
    }
    __syncthreads();
}
struct DestWin { bf16* W; __device__ __forceinline__ bf16* operator()(int n) const {
    if (n < 6144) return W + (size_t)n * DM;
    if (n < 6160) return nullptr;
    if (n < 8208) return W + (size_t)(6144 + (n - 6160)) * DM;
    if (n < 10256) { const int j = n - 8208; return W + (size_t)(8192 + (j >> 7) * 256 + (j & 127)) * DM; }
    const int j = n - 10256; return W + (size_t)(8192 + (j >> 7) * 256 + 128 + (j & 127)) * DM; } };
struct DestPlain { bf16* W; int K; __device__ __forceinline__ bf16* operator()(int n) const { return W + (size_t)n * K; } };
struct DestGU { bf16* W; int half; __device__ __forceinline__ bf16* operator()(int n) const { return W + (size_t)((n >> 7) * 256 + half * 128 + (n & 127)) * DM; } };
template <class Dest>
__device__ __forceinline__ void p0_transpose_item(const float* W, int K, int N, int item, int lane, const Dest dest) {
    const int nblk = (N + 63) / 64, kb = item / nblk, nb = item - kb * nblk, k0 = 64 * kb, n0 = 64 * nb;
    const int c4 = lane & 15, rs = lane >> 4, n = n0 + 4 * c4; const bool nok = n < N;
    const float* wp = W + (size_t)(k0 + 8 * rs) * N + n;
    f32x4 v[2][8];
#pragma unroll
    for (int jj = 0; jj < 2; ++jj)
#pragma unroll
        for (int kk = 0; kk < 8; ++kk) v[jj][kk] = nok ? __builtin_nontemporal_load((const GAS f32x4*)(wp + (size_t)(32 * jj + kk) * N)) : (f32x4){0.f, 0.f, 0.f, 0.f};
#pragma unroll
    for (int q = 0; q < 4; ++q) { bf16* drow = nok ? dest(n + q) : nullptr;
        if (drow) {
#pragma unroll
            for (int jj = 0; jj < 2; ++jj) { v4u o; o.x = pg8::cvt_pk_bf16(v[jj][0][q], v[jj][1][q]); o.y = pg8::cvt_pk_bf16(v[jj][2][q], v[jj][3][q]); o.z = pg8::cvt_pk_bf16(v[jj][4][q], v[jj][5][q]); o.w = pg8::cvt_pk_bf16(v[jj][6][q], v[jj][7][q]);
                *(GAS v4u*)(drow + k0 + 8 * (rs + 4 * jj)) = o; } } }
}
constexpr int P0_REPS = 1 + ((DUP_MASK) & 1);
struct P0Args { const float *c, *w_ada, *b_ada, *w_in, *w_out, *w_gate, *w_up, *w_down; float* mod; bf16 *WF, *WIN, *WOUT, *WGU, *WD; };
constexpr int P0_I_IN = (DM / 64) * ((NIN + 63) / 64), P0_I_OUT = (DM / 64) * (DM / 64), P0_I_G = (DM / 64) * (DFF / 64), P0_NITEMS = P0_I_IN + P0_I_OUT + 2 * P0_I_G;
struct P0Item { const float* W; bf16* Dst; int N, kind, k0, n0; };
__device__ __forceinline__ P0Item p0_decode(const P0Args& A, int it) {
    P0Item I; int r = it;
    if (r < P0_I_IN) { I.W = A.w_in; I.Dst = A.WIN; I.N = NIN; I.kind = 0; }
    else if ((r -= P0_I_IN) < P0_I_OUT) { I.W = A.w_out; I.Dst = A.WOUT; I.N = DM; I.kind = 1; }
    else if ((r -= P0_I_OUT) < P0_I_G) { I.W = A.w_gate; I.Dst = A.WGU; I.N = DFF; I.kind = 2; }
    else { r -= P0_I_G; I.W = A.w_up; I.Dst = A.WGU; I.N = DFF; I.kind = 3; }
    const int nblk = (I.N + 63) / 64, kb = r / nblk, nb = r - kb * nblk; I.k0 = 64 * kb; I.n0 = 64 * nb; return I;
}
__device__ __forceinline__ bf16* p0_dest(const P0Item& I, int n) {
    if (I.kind == 0) return DestWin{I.Dst}(n);
    if (I.kind == 1) return I.Dst + (size_t)n * DM;
    return DestGU{I.Dst, I.kind - 2}(n);
}
__device__ __forceinline__ void p0_load(const P0Item& I, int lane, f32x4 (&v)[2][8]) {
    const int c4 = lane & 15, rs = lane >> 4, n = I.n0 + 4 * c4; const bool nok = n < I.N;
    const float* wp = I.W + (size_t)(I.k0 + 8 * rs) * I.N + n;
#pragma unroll
    for (int jj = 0; jj < 2; ++jj)
#pragma unroll
        for (int kk = 0; kk < 8; ++kk) v[jj][kk] = nok ? __builtin_nontemporal_load((const GAS f32x4*)(wp + (size_t)(32 * jj + kk) * I.N)) : (f32x4){0.f, 0.f, 0.f, 0.f};
}
__device__ __forceinline__ void p0_store(const P0Item& I, int lane, const f32x4 (&v)[2][8]) {
    const int c4 = lane & 15, rs = lane >> 4, n = I.n0 + 4 * c4; const bool nok = n < I.N;
#pragma unroll
    for (int q = 0; q < 4; ++q) { bf16* drow = nok ? p0_dest(I, n + q) : nullptr;
        if (drow) {
#pragma unroll
            for (int jj = 0; jj < 2; ++jj) { v4u o; o.x = pg8::cvt_pk_bf16(v[jj][0][q], v[jj][1][q]); o.y = pg8::cvt_pk_bf16(v[jj][2][q], v[jj][3][q]); o.z = pg8::cvt_pk_bf16(v[jj][4][q], v[jj][5][q]); o.w = pg8::cvt_pk_bf16(v[jj][6][q], v[jj][7][q]);
                *(GAS v4u*)(drow + I.k0 + 8 * (rs + 4 * jj)) = o; } } }
}
__device__ __forceinline__ void p0_prologue(LAS unsigned char* lds, const P0Args& A, int G, int bid, int tid, int wave, int lane) {
    LAS float* cact = (LAS float*)(lds + 73728);
    for (int i = tid; i < 2 * DM; i += NWAVES * 64) { const float v = A.c[i]; cact[i] = v / (1.f + expf(-v)); }
    __syncthreads();
    for (int rep0 = 0; rep0 < P0_REPS; ++rep0)
    for (int it = bid; it < 12 * 64; it += G) {
        const int cg = it % 12, kc = it / 12, n = cg * 2048 + tid * 4;
        const float* wp = A.w_ada + (size_t)(kc * 64) * (6 * DM) + n;
        f32x4 a0 = {0.f, 0.f, 0.f, 0.f}, a1 = {0.f, 0.f, 0.f, 0.f};
#pragma unroll 32
        for (int kk = 0; kk < 64; ++kk) { const f32x4 w = __builtin_nontemporal_load((const GAS f32x4*)(wp + (size_t)kk * (6 * DM))); const float c0 = cact[kc * 64 + kk], c1 = cact[DM + kc * 64 + kk]; a0 += w * c0; a1 += w * c1; }
        if (kc == 0) { const f32x4 b = *(const f32x4*)(A.b_ada + n); a0 += b; a1 += b; }
        float* m0 = A.mod + n; float* m1 = A.mod + 6 * DM + n;
        if (rep0 == 0 || a0[0] == 1.2345678e30f)
#pragma unroll
        for (int j = 0; j < 4; ++j) { __hip_atomic_fetch_add(m0 + j, a0[j], __ATOMIC_RELAXED, __HIP_MEMORY_SCOPE_AGENT); __hip_atomic_fetch_add(m1 + j, a1[j], __ATOMIC_RELAXED, __HIP_MEMORY_SCOPE_AGENT); }
    }
    { const int g = bid * NWAVES * 64 + tid; if (g < 16 * DM) { const int k = g >> 4, n = g & 15; A.WF[(size_t)n * DM + k] = (bf16)f2bf(A.w_in[(size_t)k * NIN + 6144 + n]); } }
    const int gw = bid * NWAVES + wave, NGW = G * NWAVES;
    constexpr int NVIRT = P0_REPS * P0_NITEMS;
    f32x4 va[2][8], vb[2][8];
    int it = gw;
    if (it < NVIRT) { const P0Item I = p0_decode(A, it % P0_NITEMS); p0_load(I, lane, va); }
    while (it < NVIRT) {
        const int i1 = it + NGW, i2 = it + 2 * NGW;
        if (i1 < NVIRT) { const P0Item I = p0_decode(A, i1 % P0_NITEMS); p0_load(I, lane, vb); }
        { const P0Item I = p0_decode(A, it % P0_NITEMS); p0_store(I, lane, va); }
        if (i1 >= NVIRT) break;
        if (i2 < NVIRT) { const P0Item I = p0_decode(A, i2 % P0_NITEMS); p0_load(I, lane, va); }
        { const P0Item I = p0_decode(A, i1 % P0_NITEMS); p0_store(I, lane, vb); }
        it = i2;
    }
}
__device__ __forceinline__ void convert_w_down(const float* w_down, bf16* WD, int b, int nb, int wave, int lane) {
    constexpr int I_D = (DFF / 64) * (DM / 64);
    for (int it = b * NWAVES + wave; it < I_D; it += nb * NWAVES) p0_transpose_item(w_down, DFF, DM, it, lane, DestPlain{WD, DFF});
}
__device__ __forceinline__ void p1_norm1(LAS unsigned char* lds, const float* x, const float* pre_norm_mix, const float* mod, const bf16* WF, bf16* H1, float* FT, int G, int bid, int tid, int wave, int lane) {
    LAS float* G1 = (LAS float*)lds; LAS float* SH1 = G1 + DM; LAS float* ssqp = SH1 + DM; LAS f32x4* fpart = (LAS f32x4*)(ssqp + 256);
    int cur_b = -1, par = 0; const int r = lane & 15, kq = lane >> 4;
    for (int tile = bid; tile < M / 16; tile += G) {
        const int b = tile / (SEQ / 16);
        if (b != cur_b) { __syncthreads();
            for (int i = tid; i < DM; i += NWAVES * 64) { G1[i] = pre_norm_mix[i] * (1.f + mod[b * 6 * DM + DM + i]); SH1[i] = mod[b * 6 * DM + i]; }
            __syncthreads(); cur_b = b; }
        const int row = tile * 16 + r, kbase = wave * 512 + kq * 8;
        const float* xp = x + (size_t)row * DM + kbase;
        f32x4 xv[16][2];
#pragma unroll
        for (int i = 0; i < 16; ++i) { xv[i][0] = __builtin_nontemporal_load((const GAS f32x4*)(xp + 32 * i)); xv[i][1] = __builtin_nontemporal_load((const GAS f32x4*)(xp + 32 * i + 4)); }
        float ss = 0.f;
#pragma unroll
        for (int i = 0; i < 16; ++i)
#pragma unroll
            for (int h = 0; h < 2; ++h) { const f32x4 v = xv[i][h]; ss += (v[0] * v[0] + v[1] * v[1]) + (v[2] * v[2] + v[3] * v[3]); }
        ss += __shfl_xor(ss, 16); ss += __shfl_xor(ss, 32);
        if (kq == 0) ssqp[(par * 8 + wave) * 16 + r] = ss;
        __syncthreads();
        float tot = 0.f;
#pragma unroll
        for (int w = 0; w < 8; ++w) tot += ssqp[(par * 8 + w) * 16 + r];
        const float rstd = 1.0f / sqrtf(tot * (1.0f / DM) + EPS);
        f32x4 acc = {0.f, 0.f, 0.f, 0.f};
        bf16* hp = H1 + (size_t)row * DM + kbase; const bf16* wfp = WF + (size_t)r * DM + kbase;
#pragma unroll
        for (int i = 0; i < 16; ++i) {
            const f32x4 g0 = *(const LAS f32x4*)(G1 + kbase + 32 * i), g1 = *(const LAS f32x4*)(G1 + kbase + 32 * i + 4);
            const f32x4 s0 = *(const LAS f32x4*)(SH1 + kbase + 32 * i), s1 = *(const LAS f32x4*)(SH1 + kbase + 32 * i + 4);
            const f32x4 v0 = xv[i][0] * rstd * g0 + s0, v1 = xv[i][1] * rstd * g1 + s1;
            v4u w; w.x = pg8::cvt_pk_bf16(v0[0], v0[1]); w.y = pg8::cvt_pk_bf16(v0[2], v0[3]); w.z = pg8::cvt_pk_bf16(v1[0], v1[1]); w.w = pg8::cvt_pk_bf16(v1[2], v1[3]);
            *(GAS v4u*)(hp + 32 * i) = w;
            const bf16x8 af = __builtin_bit_cast(bf16x8, w); const bf16x8 bfr = *(const GAS bf16x8*)(wfp + 32 * i);
            acc = __builtin_amdgcn_mfma_f32_16x16x32_bf16(af, bfr, acc, 0, 0, 0);
        }
        fpart[(par * 8 + wave) * 64 + lane] = acc;
        __syncthreads();
        if (wave == 0) { f32x4 s = fpart[(par * 8) * 64 + lane];
#pragma unroll
            for (int w = 1; w < 8; ++w) s += fpart[(par * 8 + w) * 64 + lane];
            const int t0 = (tile * 16) % SEQ + 4 * kq;
            *(GAS f32x4*)(FT + (size_t)(b * NH + r) * SEQ + t0) = s; }
        par ^= 1;
    }
}
__device__ __forceinline__ void p2_scan(LAS unsigned char* lds, const float* FT, const float* b_f, float* FB, int bh, int tid, int wave, int lane) {
    const float bias = b_f[bh & 15];
    const GAS f32x4* src = (const GAS f32x4*)(FT + (size_t)bh * SEQ + tid * 16);
    double pre[16]; double run = 0.0;
#pragma unroll
    for (int q = 0; q < 4; ++q) { const f32x4 v = src[q];
#pragma unroll
        for (int j = 0; j < 4; ++j) { const float z = v[j] + bias; const float ls = (z >= 0.f) ? -log1pf(expf(-z)) : z - log1pf(expf(z)); run += (double)ls; pre[4 * q + j] = run; } }
    double incl = run;
#pragma unroll
    for (int o = 1; o < 64; o <<= 1) { const double t = __shfl_up(incl, o); if (lane >= o) incl += t; }
    LAS double* wt = (LAS double*)lds;
    if (lane == 63) wt[wave] = incl;
    __syncthreads();
    double off = incl - run;
    for (int w = 0; w < wave; ++w) off += wt[w];
    GAS f32x4* dst = (GAS f32x4*)(FB + (size_t)bh * SEQ + tid * 16);
#pragma unroll
    for (int q = 0; q < 4; ++q) { f32x4 o;
#pragma unroll
        for (int j = 0; j < 4; ++j) o[j] = (float)(-(off + pre[4 * q + j]) * 1.4426950408889634);
        dst[q] = o; }
    __syncthreads();
}
__device__ __forceinline__ void unpack8(const v4u w, float (&f)[8]) { f[0] = bflo(w.x); f[1] = bfhi(w.x); f[2] = bflo(w.y); f[3] = bfhi(w.y); f[4] = bflo(w.z); f[5] = bfhi(w.z); f[6] = bflo(w.w); f[7] = bfhi(w.w); }
__device__ __forceinline__ void p4_ynorm_conv(LAS unsigned char* lds, const bf16* YA, const bf16* GB, const bf16* CU, const float* conv_w, const float* attn_g, const float* conv_g, bf16* Y, int G, int bid, int tid, int wave, int lane) {
    LAS float* CWl = (LAS float*)lds; LAS float* AGl = CWl + 3 * CW; LAS float* CGl = AGl + AW;
    for (int i = tid; i < 3 * CW; i += NWAVES * 64) CWl[i] = conv_w[i];
    for (int i = tid; i < AW; i += NWAVES * 64) { AGl[i] = attn_g[i]; CGl[i] = conv_g[i]; }
    __syncthreads();
    const int gw = bid * NWAVES + wave, NGW = G * NWAVES;
    for (int chunk = gw; chunk < M / 8; chunk += NGW) {
        const int m0 = chunk * 8, t0 = m0 % SEQ;
        v4u c1[4], c2[4];
#pragma unroll
        for (int j = 0; j < 4; ++j) { c1[j] = (v4u){0u, 0u, 0u, 0u}; c2[j] = (v4u){0u, 0u, 0u, 0u}; }
        if (t0 != 0) {
#pragma unroll
            for (int j = 0; j < 4; ++j) { c1[j] = *(const GAS v4u*)(CU + (size_t)(m0 - 1) * CW + j * 512 + lane * 8); c2[j] = *(const GAS v4u*)(CU + (size_t)(m0 - 2) * CW + j * 512 + lane * 8); } }
#pragma unroll 1
        for (int rr = 0; rr < 8; ++rr) { const int m = m0 + rr; __builtin_amdgcn_sched_barrier(0);
            v4u a[4], c0[4], gb[4];
#pragma unroll
            for (int j = 0; j < 4; ++j) { a[j] = __builtin_nontemporal_load((const GAS v4u*)(YA + (size_t)m * AW + j * 512 + lane * 8)); c0[j] = __builtin_nontemporal_load((const GAS v4u*)(CU + (size_t)m * CW + j * 512 + lane * 8)); gb[j] = __builtin_nontemporal_load((const GAS v4u*)(GB + (size_t)m * CW + j * 512 + lane * 8)); }
            float ssa = 0.f;
#pragma unroll
            for (int j = 0; j < 4; ++j) { float f[8]; unpack8(a[j], f);
#pragma unroll
                for (int i = 0; i < 8; ++i) ssa += f[i] * f[i]; }
            __builtin_amdgcn_sched_barrier(0);
            const float rsa = 1.0f / sqrtf(wave_sum(ssa) * (1.0f / AW) + EPS);
#pragma unroll
            for (int j = 0; j < 4; ++j) { float f[8]; unpack8(a[j], f); const int cb = j * 512 + lane * 8;
                const f32x4 g0 = *(const LAS f32x4*)(AGl + cb), g1 = *(const LAS f32x4*)(AGl + cb + 4);
                v4u w; w.x = pg8::cvt_pk_bf16(f[0] * rsa * g0[0], f[1] * rsa * g0[1]); w.y = pg8::cvt_pk_bf16(f[2] * rsa * g0[2], f[3] * rsa * g0[3]);
                w.z = pg8::cvt_pk_bf16(f[4] * rsa * g1[0], f[5] * rsa * g1[1]); w.w = pg8::cvt_pk_bf16(f[6] * rsa * g1[2], f[7] * rsa * g1[3]);
                *(GAS v4u*)(Y + (size_t)m * DM + cb) = w; __builtin_amdgcn_sched_barrier(0); }
            float yc[4][8]; float ssc = 0.f;
#pragma unroll
            for (int j = 0; j < 4; ++j) { float f0[8], f1[8], f2[8], fg[8]; unpack8(c0[j], f0); unpack8(c1[j], f1); unpack8(c2[j], f2); unpack8(gb[j], fg); const int cb = j * 512 + lane * 8;
#pragma unroll
                for (int h = 0; h < 2; ++h) { const f32x4 w0 = *(const LAS f32x4*)(CWl + cb + 4 * h), w1 = *(const LAS f32x4*)(CWl + CW + cb + 4 * h), w2 = *(const LAS f32x4*)(CWl + 2 * CW + cb + 4 * h);
#pragma unroll
                    for (int i = 0; i < 4; ++i) { const float v = fg[4 * h + i] * (w0[i] * f2[4 * h + i] + w1[i] * f1[4 * h + i] + w2[i] * f0[4 * h + i]); yc[j][4 * h + i] = v; ssc += v * v; } }
                __builtin_amdgcn_sched_barrier(0); }
            const float rsc = 1.0f / sqrtf(wave_sum(ssc) * (1.0f / CW) + EPS);
#pragma unroll
            for (int j = 0; j < 4; ++j) { const int cb = j * 512 + lane * 8;
                const f32x4 g0 = *(const LAS f32x4*)(CGl + cb), g1 = *(const LAS f32x4*)(CGl + cb + 4);
                v4u w; w.x = pg8::cvt_pk_bf16(yc[j][0] * rsc * g0[0], yc[j][1] * rsc * g0[1]); w.y = pg8::cvt_pk_bf16(yc[j][2] * rsc * g0[2], yc[j][3] * rsc * g0[3]);
                w.z = pg8::cvt_pk_bf16(yc[j][4] * rsc * g1[0], yc[j][5] * rsc * g1[1]); w.w = pg8::cvt_pk_bf16(yc[j][6] * rsc * g1[2], yc[j][7] * rsc * g1[3]);
                *(GAS v4u*)(Y + (size_t)m * DM + AW + cb) = w; __builtin_amdgcn_sched_barrier(0); }
#pragma unroll
            for (int j = 0; j < 4; ++j) { c2[j] = c1[j]; c1[j] = c0[j]; }
        }
    }
}
__device__ __forceinline__ void p6_resid1(LAS unsigned char* lds, const float* x, const bf16* HM, const float* mod, const float* post_norm_mix, const float* pre_norm_ffn, bf16* H2, int G, int bid, int tid, int wave, int lane) {
    LAS float* V1 = (LAS float*)lds; LAS float* G2 = V1 + DM; LAS float* S2 = G2 + DM;
    int cur_b = -1;
    for (int blk = bid; blk < M / 64; blk += G) {
        const int b = blk / (SEQ / 64);
        if (b != cur_b) { __syncthreads();
            for (int i = tid; i < DM; i += NWAVES * 64) { const float* mb = mod + b * 6 * DM; V1[i] = mb[2 * DM + i] * post_norm_mix[i]; G2[i] = pre_norm_ffn[i] * (1.f + mb[4 * DM + i]); S2[i] = mb[3 * DM + i]; }
            __syncthreads(); cur_b = b; }
#pragma unroll 1
        for (int rr = 0; rr < 8; ++rr) { const int m = blk * 64 + wave * 8 + rr; __builtin_amdgcn_sched_barrier(0);
            f32x4 xv[16]; v2u hv[16];
#pragma unroll
            for (int j = 0; j < 16; ++j) { xv[j] = __builtin_nontemporal_load((const GAS f32x4*)(x + (size_t)m * DM + j * 256 + lane * 4)); hv[j] = __builtin_nontemporal_load((const GAS v2u*)(HM + (size_t)m * DM + j * 256 + lane * 4)); }
            float ss = 0.f;
#pragma unroll
            for (int j = 0; j < 16; ++j) { const float h0 = bflo(hv[j].x), h1 = bfhi(hv[j].x), h2 = bflo(hv[j].y), h3 = bfhi(hv[j].y); ss += (h0 * h0 + h1 * h1) + (h2 * h2 + h3 * h3); }
            const float r1 = 1.0f / sqrtf(wave_sum(ss) * (1.0f / DM) + EPS);
            float ss2 = 0.f;
#pragma unroll
            for (int j = 0; j < 16; ++j) { const f32x4 v1 = *(const LAS f32x4*)(V1 + j * 256 + lane * 4);
                f32x4 h = {bflo(hv[j].x), bfhi(hv[j].x), bflo(hv[j].y), bfhi(hv[j].y)};
                const f32x4 x1 = xv[j] + v1 * h * r1; xv[j] = x1;
                ss2 += (x1[0] * x1[0] + x1[1] * x1[1]) + (x1[2] * x1[2] + x1[3] * x1[3]); }
            const float r2 = 1.0f / sqrtf(wave_sum(ss2) * (1.0f / DM) + EPS);
#pragma unroll
            for (int j = 0; j < 16; ++j) { const f32x4 g2 = *(const LAS f32x4*)(G2 + j * 256 + lane * 4), s2 = *(const LAS f32x4*)(S2 + j * 256 + lane * 4);
                const f32x4 h = xv[j] * r2 * g2 + s2; v2u w; w.x = pg8::cvt_pk_bf16(h[0], h[1]); w.y = pg8::cvt_pk_bf16(h[2], h[3]);
                *(GAS v2u*)(H2 + (size_t)m * DM + j * 256 + lane * 4) = w; }
        }
    }
}
__device__ __forceinline__ void p9_final(LAS unsigned char* lds, const float* x, const bf16* HMIX, const bf16* HFFN, const float* mod, const float* post_norm_mix, const float* post_norm_ffn, float* out, int G, int bid, int tid, int wave, int lane) {
    LAS float* V1 = (LAS float*)lds; LAS float* V2 = V1 + DM;
    int cur_b = -1;
    for (int blk = bid; blk < M / 64; blk += G) {
        const int b = blk / (SEQ / 64);
        if (b != cur_b) { __syncthreads();
            for (int i = tid; i < DM; i += NWAVES * 64) { const float* mb = mod + b * 6 * DM; V1[i] = mb[2 * DM + i] * post_norm_mix[i]; V2[i] = mb[5 * DM + i] * post_norm_ffn[i]; }
            __syncthreads(); cur_b = b; }
#pragma unroll 1
        for (int rr = 0; rr < 8; ++rr) { const int m = blk * 64 + wave * 8 + rr; __builtin_amdgcn_sched_barrier(0);
            f32x4 xv[16]; v2u hv[16], fv[16];
#pragma unroll
            for (int j = 0; j < 16; ++j) { xv[j] = __builtin_nontemporal_load((const GAS f32x4*)(x + (size_t)m * DM + j * 256 + lane * 4)); hv[j] = __builtin_nontemporal_load((const GAS v2u*)(HMIX + (size_t)m * DM + j * 256 + lane * 4));
                fv[j] = __builtin_nontemporal_load((const GAS v2u*)(HFFN + (size_t)m * DM + j * 256 + lane * 4)); }
            float ss = 0.f, sf = 0.f;
#pragma unroll
            for (int j = 0; j < 16; ++j) { const float h0 = bflo(hv[j].x), h1 = bfhi(hv[j].x), h2 = bflo(hv[j].y), h3 = bfhi(hv[j].y); ss += (h0 * h0 + h1 * h1) + (h2 * h2 + h3 * h3);
                const float f0 = bflo(fv[j].x), f1 = bfhi(fv[j].x), f2 = bflo(fv[j].y), f3 = bfhi(fv[j].y); sf += (f0 * f0 + f1 * f1) + (f2 * f2 + f3 * f3); }
            const float r1 = 1.0f / sqrtf(wave_sum(ss) * (1.0f / DM) + EPS), r2 = 1.0f / sqrtf(wave_sum(sf) * (1.0f / DM) + EPS);
#pragma unroll
            for (int j = 0; j < 16; ++j) { const f32x4 v1 = *(const LAS f32x4*)(V1 + j * 256 + lane * 4), v2 = *(const LAS f32x4*)(V2 + j * 256 + lane * 4);
                f32x4 h = {bflo(hv[j].x), bfhi(hv[j].x), bflo(hv[j].y), bfhi(hv[j].y)}, f = {bflo(fv[j].x), bfhi(fv[j].x), bflo(fv[j].y), bfhi(fv[j].y)};
                const f32x4 x1 = xv[j] + v1 * h * r1;
                __builtin_nontemporal_store(x1 + v2 * f * r2, (GAS f32x4*)(out + (size_t)m * DM + j * 256 + lane * 4)); }
        }
    }
}
struct Args { const float* in[17]; float* out; unsigned char* ws; int ph_lo, ph_hi, grid, pad; };
#define KARGP() const __attribute__((address_space(4))) char* kp = (const __attribute__((address_space(4))) char*)__builtin_amdgcn_kernarg_segment_ptr(); asm volatile("" : "+s"(kp))
#define INP(i) (*(const float* const __attribute__((address_space(4)))*)(kp + 8 * (i)))
#define OUTP() (*(float* const __attribute__((address_space(4)))*)(kp + 136))
#define WSP(T, off) ((T*)(*(unsigned char* const __attribute__((address_space(4)))*)(kp + 144) + (off)))
#define KINT(off) (*(const int __attribute__((address_space(4)))*)(kp + (off)))
#define TIDS() const int tid = opaque_tid(wave_s), lane = tid & 63, wave = wave_s
#ifndef PH_MASK
#define PH_MASK 0x3ff
#endif
#define REPS(k) for (int rep_ = 0; rep_ < 1 + (((DUP_MASK) >> (k)) & 1); ++rep_)
#define IN(k) ((((PHM) >> (k)) & 1) != 0)
#define SEAM(k) do { KARGP(); if (IN(k) && IN((k) + 1)) { const int tid = opaque_tid(wave_s); XcdBarrier bar; bar.bar = WSP(unsigned, WS_CTL) + CW_BAR; bar.x = xb_xcc_id(); bar.st = (volatile LAS unsigned*)(lds + MISC_OFF) + 8; xcd_barrier(bar, tid); } } while (0)
template <int PHM> __global__ void __launch_bounds__(NWAVES * 64, 2) hymba_fwd(Args args) {
    constexpr bool HAS_SEAM = (PHM & (PHM >> 1)) != 0;
    extern __shared__ __attribute__((aligned(16))) unsigned char lds_raw[];
    LAS unsigned char* lds = (LAS unsigned char*)lds_raw;
    const int wave_s = __builtin_amdgcn_readfirstlane((int)(threadIdx.x >> 6));
    const int bid = blockIdx.x;
    { KARGP(); TIDS(); (void)lane; (void)wave;
      for (int u = tid; u < (LDS_BYTES - LDSCTL_OFF) / 4; u += NWAVES * 64) ((LAS unsigned*)(lds + LDSCTL_OFF))[u] = 0u;
      __syncthreads();
      if (HAS_SEAM) (void)xcd_barrier_post(WSP(unsigned, WS_CTL) + CW_BAR, (volatile LAS unsigned*)(lds + MISC_OFF) + 8, tid); }

    { KARGP(); if (IN(0)) { TIDS(); const int G = KINT(160); P0Args A{INP(1), INP(2), INP(3), INP(5), INP(10), INP(13), INP(14), INP(15), WSP(float, WS_MOD), WSP(bf16, WS_WF), WSP(bf16, WS_WIN), WSP(bf16, WS_WOUT), WSP(bf16, WS_WGU), WSP(bf16, WS_WD)};
        p0_prologue(lds, A, G, bid, tid, wave, lane); } }
    SEAM(0);
    { KARGP(); if (IN(1)) REPS(1) { TIDS(); const int G = KINT(160); p1_norm1(lds, INP(0), INP(4), WSP(float, WS_MOD), WSP(bf16, WS_WF), WSP(bf16, WS_H), WSP(float, WS_FT), G, bid, tid, wave, lane); } }
    SEAM(1);
    { KARGP(); if (IN(2)) REPS(2) { const int G = KINT(160);
        if (bid < BATCH * NH) { TIDS(); p2_scan(lds, WSP(float, WS_FT), INP(6), WSP(float, WS_FB), bid, tid, wave, lane); }
        pg8::Gemm g{WSP(bf16, WS_H), WSP(bf16, WS_WIN), M, NPROJ, DM}; pg8::StaticOrder S; S.init(M, NPROJ, G, bid);
        pg8::EpiInProj E{WSP(bf16, WS_Q), WSP(bf16, WS_K), WSP(bf16, WS_V), WSP(bf16, WS_GB), WSP(bf16, WS_CU), QSCALE, WSP(unsigned, WS_CTL) + CW_QKMAX};
        pg8::gemm_phase<pg8::EpiInProj, pg8::StaticOrder, PG8_ALIGN, PG8_SP2>(lds, g, S, E, opaque_tid(wave_s)); } }
    SEAM(2);
    { KARGP(); if (IN(3)) { fa::attn_phase((char*)lds_raw, WSP(bf16, WS_Q), WSP(float, WS_FB), WSP(unsigned, WS_CTL) + CW_QKMAX, WSP(unsigned, WS_CTL) + CW_QHEAD, opaque_tid(wave_s)); } }
    SEAM(3);
#if FA_SELFCHECK
    { KARGP(); fa::attn_phase((char*)lds_raw, WSP(bf16, WS_Q), WSP(float, WS_FB), WSP(unsigned, WS_CTL) + CW_QKMAX, WSP(unsigned, WS_CTL) + CW_QHEAD + 64, opaque_tid(wave_s), false, 6); }
    SEAM(3);
    { KARGP(); TIDS(); (void)lane; (void)wave; const unsigned short* a = (const unsigned short*)WSP(bf16, WS_YA); const unsigned short* b = (const unsigned short*)WSP(bf16, WS_HM); unsigned bad = 0;
      for (size_t i = (size_t)bid * 512 + tid; i < (size_t)M * 2048; i += (size_t)KINT(160) * 512) { const float x = __uint_as_float((unsigned)a[i] << 16), y = __uint_as_float((unsigned)b[i] << 16);
          const float tol = fmaxf(fabsf(y), 1e-30f) * (1.0f / 100.0f);
          if (!(fabsf(x - y) <= tol)) bad++; }
      if (bad) __hip_atomic_fetch_add(WSP(unsigned, WS_CTL) + CW_QHEAD + 128, bad, __ATOMIC_RELAXED, __HIP_MEMORY_SCOPE_AGENT); }
    SEAM(3);
#endif
    { KARGP(); if (IN(4)) REPS(4) { TIDS(); const int G = KINT(160); p4_ynorm_conv(lds, WSP(bf16, WS_YA), WSP(bf16, WS_GB), WSP(bf16, WS_CU), INP(7), INP(8), INP(9), WSP(bf16, WS_H), G, bid, tid, wave, lane); } }
    SEAM(4);
    { KARGP(); if (IN(5)) REPS(5) { const int G = KINT(160);
        pg8::Gemm g{WSP(bf16, WS_H), WSP(bf16, WS_WOUT), M, DM, DM}; pg8::StaticOrder S; S.init(M, DM, G, bid);
        pg8::EpiPlain E{WSP(bf16, WS_HM), DM};
        pg8::gemm_phase<pg8::EpiPlain, pg8::StaticOrder, PG8_ALIGN, PG8_SP2>(lds, g, S, E, opaque_tid(wave_s)); } }
    SEAM(5);
    { KARGP(); if (IN(6)) REPS(6) { TIDS(); const int G = KINT(160); p6_resid1(lds, INP(0), WSP(bf16, WS_HM), WSP(float, WS_MOD), INP(11), INP(12), WSP(bf16, WS_H), G, bid, tid, wave, lane); } }
    SEAM(6);
    { KARGP(); if (IN(7)) REPS(7) { const int G = KINT(160);
        pg8::Gemm g{WSP(bf16, WS_H), WSP(bf16, WS_WGU), M, NGU, DM}; pg8::StaticOrder S; S.init(M, NGU, G, bid);
        pg8::EpiSwiGLU E{WSP(bf16, WS_ACT), DFF};
        pg8::gemm_phase<pg8::EpiSwiGLU, pg8::StaticOrder, PG8_ALIGN, PG8_SP2>(lds, g, S, E, opaque_tid(wave_s));
        constexpr int NU7 = (M / 256) * (NGU / 256); const int rem = NU7 % G, first_idle = (rem == 0) ? 0 : rem, nidle = G - first_idle;
        if (bid >= first_idle) { TIDS(); (void)tid; convert_w_down(INP(15), WSP(bf16, WS_WD), bid - first_idle, nidle, wave, lane); } } }
    SEAM(7);
    { KARGP(); if (IN(8)) REPS(8) { const int G = KINT(160);
        pg8::Gemm g{WSP(bf16, WS_ACT), WSP(bf16, WS_WD), M, DM, DFF}; pg8::StaticOrder S; S.init(M, DM, G, bid);
        pg8::EpiPlain E{WSP(bf16, WS_H), DM};
        pg8::gemm_phase<pg8::EpiPlain, pg8::StaticOrder, PG8_ALIGN, PG8_SP2>(lds, g, S, E, opaque_tid(wave_s)); } }
    SEAM(8);
    { KARGP(); if (IN(9)) { TIDS(); const int G = KINT(160); p9_final(lds, INP(0), WSP(bf16, WS_HM), WSP(bf16, WS_H), WSP(float, WS_MOD), INP(11), INP(16), OUTP(), G, bid, tid, wave, lane); } }
#if FA_SELFCHECK
    SEAM(8);
    { KARGP(); const int tid = opaque_tid(wave_s); if (bid == 0 && tid == 0 && __hip_atomic_load(WSP(unsigned, WS_CTL) + CW_QHEAD + 128, __ATOMIC_RELAXED, __HIP_MEMORY_SCOPE_AGENT) != 0u) OUTP()[0] = __builtin_nanf(""); }
#endif
}
#undef IN
#undef SEAM
#undef INP
#undef WSP
#undef OUTP
#undef KARGP
#undef KINT
#undef TIDS

typedef void (*kern_t)(Args);
template <int PHM> static bool set_attr() { return hipFuncSetAttribute((const void*)hymba_fwd<PHM>, hipFuncAttributeMaxDynamicSharedMemorySize, LDS_BYTES) == hipSuccess; }
extern "C" void kernel_launch(void* const* d_in, const int* in_sizes, int n_in, void* d_out, int out_size, void* d_ws, size_t ws_size, hipStream_t stream) {
    static int grid = 0;
#if MK_N_LAUNCHES == 1
    static const kern_t kerns[1] = {hymba_fwd<(PH_MASK)>};
#else
    static const kern_t kerns[N_PHASES] = {hymba_fwd<1>, hymba_fwd<2>, hymba_fwd<4>, hymba_fwd<8>, hymba_fwd<16>, hymba_fwd<32>, hymba_fwd<64>, hymba_fwd<128>, hymba_fwd<256>, hymba_fwd<512>};
#endif
    if (grid == 0) {
        if (n_in != 17 || in_sizes[0] != M * DM || out_size != M * DM || ws_size < WS_END) {
            fprintf(stderr, "kernel_launch: built for 17 inputs, x/out of %d floats, >= %zu bytes of workspace; got n_in %d, in0 %d, out %d, ws %zu; nothing launched\n", M * DM, (size_t)WS_END, n_in, n_in > 0 ? in_sizes[0] : -1, out_size, ws_size);
            grid = -1; return; }
        int dev = 0, cus = 0, per_cu = 0;
        if (hipGetDevice(&dev) != hipSuccess || hipDeviceGetAttribute(&cus, hipDeviceAttributeMultiprocessorCount, dev) != hipSuccess) { fprintf(stderr, "kernel_launch: device query failed\n"); grid = -1; return; }
#if MK_N_LAUNCHES == 1
        bool ok = set_attr<(PH_MASK)>();
#else
        bool ok = set_attr<1>() && set_attr<2>() && set_attr<4>() && set_attr<8>() && set_attr<16>() && set_attr<32>() && set_attr<64>() && set_attr<128>() && set_attr<256>() && set_attr<512>();
#endif
        if (!ok) { fprintf(stderr, "kernel_launch: hipFuncSetAttribute failed\n"); grid = -1; return; }
        if (hipOccupancyMaxActiveBlocksPerMultiprocessor(&per_cu, (const void*)kerns[0], NWAVES * 64, LDS_BYTES) != hipSuccess || per_cu < 1)
            fprintf(stderr, "kernel_launch: note: occupancy query reports %d workgroups per CU\n", per_cu);
        (void)hipGetLastError();
        grid = cus;
    }
    if (grid < 0) return;
    if (hipMemsetAsync((char*)d_ws + WS_CTL, 0, CTL_ZERO_BYTES, stream) != hipSuccess) { fprintf(stderr, "kernel_launch: memset failed\n"); return; }
    Args a{};
    for (int i = 0; i < 17; ++i) a.in[i] = (const float*)d_in[i];
    a.out = (float*)d_out; a.ws = (unsigned char*)d_ws; a.grid = grid; a.pad = 0; a.ph_lo = 0; a.ph_hi = N_PHASES;
    for (int li = 0; li < MK_N_LAUNCHES; ++li) {
        hipLaunchKernelGGL(kerns[li], dim3(grid), dim3(NWAVES * 64), LDS_BYTES, stream, a);
        const hipError_t le = hipPeekAtLastError();
        if (le != hipSuccess) { fprintf(stderr, "kernel_launch: launch %d failed: %s\n", li, hipGetErrorName(le)); break; }
    }
}
```

```cpp
#include <hip/hip_runtime.h>
#include <cstdio>
#include <cstdint>
#include <cmath>
#ifndef STAMP_PROBE
#define STAMP_PROBE 0
#endif
#ifndef STAMP_MASK
#define STAMP_MASK 0x3ff
#define STAMP_MULT 4
#define STAMP_STAT 1
#define STAMP_THR 2000
#endif
#ifndef P7_ENDGAME
#define P7_ENDGAME 1
#endif
#ifndef P2_WGM
#define P2_WGM 8
#endif
#ifndef P5_WGM
#define P5_WGM 8
#endif
#ifndef P7_WGM
#define P7_WGM 8
#endif
#ifndef PG8_PRIO
#define PG8_PRIO 1
#endif
#ifndef P7_ALIGN
#define P7_ALIGN true
#endif
#ifndef P8_WGM
#define P8_WGM 2
#endif
#ifndef DUP_MASK
#define DUP_MASK 0
#endif
__device__ __forceinline__ int opaque_tid(int wave_s) { int l; asm volatile("v_mbcnt_lo_u32_b32 %0, -1, 0\n\tv_mbcnt_hi_u32_b32 %0, -1, %0" : "=v"(l)); return (wave_s << 6) | l; }
namespace pg8 {
#define PG8_LAS __attribute__((address_space(3)))
typedef unsigned short bf16_t;
typedef short bf16x8 __attribute__((ext_vector_type(8)));
typedef float f32x4 __attribute__((ext_vector_type(4)));
typedef unsigned u32x4 __attribute__((ext_vector_type(4)));
constexpr int BM = 256, BK = 64, HALF = 128, HTB = HALF * BK * 2  , STAGE_BYTES = 8 * HTB, NXCD = 8, WGM = 8;

__host__ __device__ __forceinline__ int lds_byte(int r, int c) { const int st = (r >> 4) * 2 + (c >> 5), rr = r & 15, cc = c & 31, ob = rr * 64 + cc * 2; return st * 1024 + (ob ^ (((ob >> 9) & 1) << 5)); }
__host__ __device__ __forceinline__ void stage_rc(int b, int& R, int& C) { const int st = b / 1024, sb = b % 1024, swz = sb ^ (((sb >> 9) & 1) << 5); R = (st >> 1) * 16 + swz / 64; C = (st & 1) * 32 + (swz % 64) / 2; }
__host__ __device__ __forceinline__ int perm32(int rho) { const int n = rho >> 4, i = rho & 15; return 8 * (i >> 2) + 4 * n + (i & 3); }

struct Unit { int pm, pn; };
struct Gemm { const bf16_t* A; const bf16_t* Bt; int M, N, K; };

struct StaticOrder {
    int nM, nN, nwg, G, c, imax, wgm;
    __host__ __device__ void init(int M, int N, int G_, int c_) { nM = M / BM; nN = N / BM; nwg = nM * nN; G = G_; c = c_; imax = 1 << 30; wgm = WGM; }
    __host__ __device__ bool next(int i, Unit& u) const {
        const long L = (long)i * G + c; if (L >= nwg || i >= imax) return false;
        int wgid = (int)L; { const int q = nwg / NXCD, r = nwg % NXCD, xcd = wgid % NXCD, off = wgid / NXCD; wgid = (xcd < r ? xcd * (q + 1) : r * (q + 1) + (xcd - r) * q) + off; }
        const int nig = wgm * nN, gid = wgid / nig, fm = gid * wgm, gsz = (nM - fm) < wgm ? (nM - fm) : wgm;
        u.pm = fm + ((wgid % nig) % gsz); u.pn = (wgid % nig) / gsz; return true;
    }
    __device__ __forceinline__ void a_ready(const Unit&) const {}
    __device__ __forceinline__ void done(const Unit&) const {}
};
struct OneUnit {
    StaticOrder S; int i0;
    __host__ __device__ bool next(int i, Unit& u) const { return i == 0 && S.next(i0, u); }
    __device__ __forceinline__ void a_ready(const Unit&) const {}
    __device__ __forceinline__ void done(const Unit&) const {}
};
__device__ __forceinline__ unsigned cvt_pk_bf16(float lo, float hi) { unsigned r; asm volatile("v_cvt_pk_bf16_f32 %0, %1, %2" : "=v"(r) : "v"(lo), "v"(hi)); return r; }
typedef float f32x2 __attribute__((ext_vector_type(2)));
struct EpiPlain {
    static constexpr bool PERM = true, AFTER_DRAIN = false;
    bf16_t* O; int ldc;
    __device__ __forceinline__ void operator()(const f32x4 (&acc)[2][2][4][2], const Unit& u, int wr, int wc, int fr, int fq) const {
        const int row0 = u.pm * BM + wr * 64 + fr, col0 = u.pn * BM + wc * 32 + 8 * fq;
#pragma unroll
        for (int ai = 0; ai < 2; ++ai)
#pragma unroll
            for (int m = 0; m < 4; ++m) { bf16_t* rowp = O + (size_t)(row0 + ai * HALF + m * 16) * ldc + col0;
#pragma unroll
                for (int bj = 0; bj < 2; ++bj) { const f32x4 v0 = acc[ai][bj][m][0], v1 = acc[ai][bj][m][1];
                    u32x4 w; w.x = cvt_pk_bf16(v0[0], v0[1]); w.y = cvt_pk_bf16(v0[2], v0[3]); w.z = cvt_pk_bf16(v1[0], v1[1]); w.w = cvt_pk_bf16(v1[2], v1[3]);
                    *(u32x4*)(rowp + bj * HALF) = w; } }
    }
};
struct EpiInProj {
    static constexpr bool PERM = true, AFTER_DRAIN = false;
    bf16_t *Q, *K, *V, *GB, *CU; float qscale; unsigned* qkmax;
    __device__ __forceinline__ void operator()(const f32x4 (&acc)[2][2][4][2], const Unit& u, int wr, int wc, int fr, int fq) const {
        const int row0 = u.pm * BM + wr * 64 + fr;
        if (u.pn < 32) {
            const int t = u.pn >> 3; bf16_t* base = (t == 0) ? Q : (t == 1) ? K : (t == 2) ? V : GB; const float s = (t == 0) ? qscale : 1.f;
            const int col0 = (u.pn & 7) * BM + wc * 32 + 8 * fq;
#pragma unroll
            for (int ai = 0; ai < 2; ++ai)
#pragma unroll
                for (int m = 0; m < 4; ++m) { bf16_t* rowp = base + (size_t)(row0 + ai * HALF + m * 16) * 2048 + col0;
#pragma unroll
                    for (int bj = 0; bj < 2; ++bj) { const f32x4 v0 = acc[ai][bj][m][0] * s, v1 = acc[ai][bj][m][1] * s;
                        u32x4 w; w.x = cvt_pk_bf16(v0[0], v0[1]); w.y = cvt_pk_bf16(v0[2], v0[3]); w.z = cvt_pk_bf16(v1[0], v1[1]); w.w = cvt_pk_bf16(v1[2], v1[3]);
                        *(u32x4*)(rowp + bj * HALF) = w; } }
            if (t <= 1) {
                float mx[2] = {0.f, 0.f};
#pragma unroll
                for (int ai = 0; ai < 2; ++ai)
#pragma unroll
                    for (int m = 0; m < 4; ++m)
#pragma unroll
                        for (int bj = 0; bj < 2; ++bj) { const f32x4 v0 = acc[ai][bj][m][0] * s, v1 = acc[ai][bj][m][1] * s;
                            float ss = (v0[0] * v0[0] + v0[1] * v0[1]) + (v0[2] * v0[2] + v0[3] * v0[3]) + (v1[0] * v1[0] + v1[1] * v1[1]) + (v1[2] * v1[2] + v1[3] * v1[3]);
                            ss += __shfl_xor(ss, 16); ss += __shfl_xor(ss, 32); mx[bj] = fmaxf(mx[bj], ss); }
#pragma unroll
                for (int bj = 0; bj < 2; ++bj) { float mm = mx[bj];
#pragma unroll
                    for (int o = 1; o < 16; o <<= 1) mm = fmaxf(mm, __shfl_xor(mm, o));
                    if (fr == 0 && fq == 0) __hip_atomic_fetch_max(qkmax + (((u.pm >> 5) * 16 + (u.pn & 7) * 2 + bj) * 2 + t) * 4 + wc, __float_as_uint(mm), __ATOMIC_RELAXED, __HIP_MEMORY_SCOPE_AGENT); }
            }
        } else {
            const int col0 = (u.pn - 32) * HALF + wc * 32 + 8 * fq;
#pragma unroll
            for (int ai = 0; ai < 2; ++ai)
#pragma unroll
                for (int m = 0; m < 4; ++m) { bf16_t* rowp = CU + (size_t)(row0 + ai * HALF + m * 16) * 2048 + col0;
                    const f32x4 v0 = acc[ai][0][m][0] * acc[ai][1][m][0], v1 = acc[ai][0][m][1] * acc[ai][1][m][1];
                    u32x4 w; w.x = cvt_pk_bf16(v0[0], v0[1]); w.y = cvt_pk_bf16(v0[2], v0[3]); w.z = cvt_pk_bf16(v1[0], v1[1]); w.w = cvt_pk_bf16(v1[2], v1[3]);
                    *(u32x4*)rowp = w; }
        }
    }
};
struct EpiSwiGLU {
    static constexpr bool PERM = true, AFTER_DRAIN = false;
    bf16_t* O; int ldc;
    __device__ __forceinline__ void operator()(const f32x4 (&acc)[2][2][4][2], const Unit& u, int wr, int wc, int fr, int fq) const {
        const int row0 = u.pm * BM + wr * 64 + fr, col0 = u.pn * HALF + wc * 32 + 8 * fq;
#pragma unroll
        for (int ai = 0; ai < 2; ++ai)
#pragma unroll
            for (int m = 0; m < 4; ++m) { bf16_t* rowp = O + (size_t)(row0 + ai * HALF + m * 16) * ldc + col0;
                f32x4 r[2];
#pragma unroll
                for (int n = 0; n < 2; ++n) { const f32x4 g = acc[ai][0][m][n], up = acc[ai][1][m][n];
#pragma unroll
                    for (int j = 0; j < 4; ++j) { const float e = __builtin_amdgcn_exp2f(g[j] * -1.4426950408889634f); r[n][j] = g[j] * up[j] * __builtin_amdgcn_rcpf(1.0f + e); } }
                u32x4 w; w.x = cvt_pk_bf16(r[0][0], r[0][1]); w.y = cvt_pk_bf16(r[0][2], r[0][3]); w.z = cvt_pk_bf16(r[1][0], r[1][1]); w.w = cvt_pk_bf16(r[1][2], r[1][3]);
                *(u32x4*)rowp = w; }
    }
};

template <class Epi, class Sched, bool ALIGN_EPI = false, bool SP2 = false>
__device__ __forceinline__ void gemm_phase(PG8_LAS unsigned char* lds, const Gemm g, const Sched& S, const Epi& E, const int tid) {
    const int wid = __builtin_amdgcn_readfirstlane(tid >> 6), lane = tid & 63, wr = wid >> 2, wc = wid & 3, fr = lane & 15, fq = lane >> 4;
    const int K = g.K, nt = K / BK;
    unsigned voffA[2], voffB[2];
#pragma unroll
    for (int i = 0; i < 2; ++i) { int R, C; stage_rc(tid * 16 + i * 8192, R, C); const int Rb = Epi::PERM ? ((R & ~31) + perm32(R & 31)) : R;
        voffA[i] = (unsigned)(R * K + C) * 2u; voffB[i] = (unsigned)(Rb * K + C) * 2u; }
    const size_t kstep = (size_t)(BK * 2);
    const size_t hstep = (size_t)HALF * K * 2;
    const size_t tstep = 2 * hstep;
    const unsigned ldsw = (unsigned)wid * 1024u;
    const int aoff = lds_byte(wr * 64 + fr, fq * 8), boff = lds_byte(wc * 32 + fr, fq * 8);
#define PG8_SA(b, h) (((b) * 2 + (h)) * HTB)
#define PG8_SB(b, h) ((4 + (b) * 2 + (h)) * HTB)
#define PG8_STAGE(bufoff, gbase, voff) do { _Pragma("unroll") for (int _i = 0; _i < 2; ++_i) \
        __builtin_amdgcn_global_load_lds((const unsigned*)((const char*)(gbase) + (voff)[_i]), (PG8_LAS unsigned*)(lds + (bufoff) + ldsw + _i * 8192), 16, 0, 0); } while (0)
#define PG8_LDA(dst, b, h) do { _Pragma("unroll") for (int m = 0; m < 4; ++m) _Pragma("unroll") for (int k = 0; k < 2; ++k) dst[m][k] = *(const PG8_LAS bf16x8*)(lds + PG8_SA(b, h) + aoff + m * 2048 + k * 1024); } while (0)
#define PG8_LDB(dst, b, h) do { _Pragma("unroll") for (int n = 0; n < 2; ++n) _Pragma("unroll") for (int k = 0; k < 2; ++k) dst[n][k] = *(const PG8_LAS bf16x8*)(lds + PG8_SB(b, h) + boff + n * 2048 + k * 1024); } while (0)
#define PG8_MMA(ai, bj, At, Bt) do { if (PG8_PRIO) __builtin_amdgcn_s_setprio(1); _Pragma("unroll") for (int m = 0; m < 4; ++m) _Pragma("unroll") for (int n = 0; n < 2; ++n) _Pragma("unroll") for (int k = 0; k < 2; ++k) \
        acc[ai][bj][m][n] = __builtin_amdgcn_mfma_f32_16x16x32_bf16(Bt[n][k], At[m][k], acc[ai][bj][m][n], 0, 0, 0); if (PG8_PRIO) __builtin_amdgcn_s_setprio(0); } while (0)
#define PG8_WAIT_V(n) asm volatile("s_waitcnt vmcnt(" #n ")" ::: "memory")
#define PG8_WAIT_L(n) asm volatile("s_waitcnt lgkmcnt(" #n ")" ::: "memory")
#define PG8_BAR __builtin_amdgcn_s_barrier()
#define PG8_SCHED __builtin_amdgcn_sched_barrier(0)
    Unit cur, nxt; int ui = 0;
    if (!S.next(0, cur)) return;
    f32x4 acc[2][2][4][2];
#pragma unroll
    for (int a = 0; a < 2; ++a)
#pragma unroll
        for (int b = 0; b < 2; ++b)
#pragma unroll
            for (int m = 0; m < 4; ++m)
#pragma unroll
                for (int n = 0; n < 2; ++n) acc[a][b][m][n] = (f32x4){0.f, 0.f, 0.f, 0.f};
    bf16x8 At[4][2], B0[2][2], B1[2][2];
    const char* cA = (const char*)g.A + (size_t)cur.pm * tstep; const char* cB = (const char*)g.Bt + (size_t)cur.pn * tstep;
    S.a_ready(cur);
    if constexpr (SP2) {
        PG8_STAGE(PG8_SB(0, 0), cB, voffB); PG8_STAGE(PG8_SB(0, 1), cB + hstep, voffB); PG8_STAGE(PG8_SA(0, 0), cA, voffA); PG8_STAGE(PG8_SA(0, 1), cA + hstep, voffA);
        if (wr == 1) PG8_BAR;
        PG8_WAIT_V(2); PG8_BAR;
        PG8_STAGE(PG8_SB(1, 0), cB + kstep, voffB); PG8_STAGE(PG8_SA(1, 0), cA + kstep, voffA); PG8_STAGE(PG8_SB(1, 1), cB + hstep + kstep, voffB);
        PG8_WAIT_V(6); PG8_BAR;
    } else {
        PG8_STAGE(PG8_SB(0, 0), cB, voffB); PG8_STAGE(PG8_SA(0, 0), cA, voffA); PG8_STAGE(PG8_SB(0, 1), cB + hstep, voffB); PG8_STAGE(PG8_SA(0, 1), cA + hstep, voffA);
        if (wr == 1) PG8_BAR;
        PG8_WAIT_V(4); PG8_BAR;
        PG8_STAGE(PG8_SB(1, 0), cB + kstep, voffB); PG8_STAGE(PG8_SA(1, 0), cA + kstep, voffA); PG8_STAGE(PG8_SB(1, 1), cB + hstep + kstep, voffB);
        PG8_WAIT_V(6); PG8_BAR;
    }
    for (;;) {
        const bool has_next = S.next(ui + 1, nxt);
        const char* nA = has_next ? (const char*)g.A + (size_t)nxt.pm * tstep : cA; const char* nB = has_next ? (const char*)g.Bt + (size_t)nxt.pn * tstep : cB;
        for (int t = 0; t < nt; t += 2) {
            const bool last = (t == nt - 2);
            const char* a1 = cA + (size_t)(t + 1) * kstep;
            const char* a2 = last ? nA : cA + (size_t)(t + 2) * kstep; const char* b2 = last ? nB : cB + (size_t)(t + 2) * kstep;
            const char* a3 = a2 + kstep; const char* b3 = b2 + kstep;
            if (last && has_next) S.a_ready(nxt);
            if constexpr (SP2) {
            PG8_LDB(B0, 0, 0); PG8_LDB(B1, 0, 1); PG8_SCHED; PG8_LDA(At, 0, 0); PG8_STAGE(PG8_SA(1, 1), a1 + hstep, voffA);
            PG8_WAIT_V(8); PG8_WAIT_L(0); PG8_BAR; PG8_MMA(0, 0, At, B0); PG8_MMA(0, 1, At, B1); PG8_BAR; PG8_SCHED;
            PG8_LDA(At, 0, 1); PG8_STAGE(PG8_SB(0, 0), b2, voffB); PG8_STAGE(PG8_SB(0, 1), b2 + hstep, voffB); PG8_STAGE(PG8_SA(0, 0), a2, voffA);
            PG8_WAIT_V(8); PG8_WAIT_L(0); PG8_BAR; PG8_MMA(1, 0, At, B0); PG8_MMA(1, 1, At, B1); PG8_BAR; PG8_SCHED;
            PG8_LDB(B0, 1, 0); PG8_LDB(B1, 1, 1); PG8_SCHED; PG8_LDA(At, 1, 0); PG8_STAGE(PG8_SA(0, 1), a2 + hstep, voffA);
            PG8_WAIT_V(8); PG8_WAIT_L(0); PG8_BAR; PG8_MMA(0, 0, At, B0); PG8_MMA(0, 1, At, B1); PG8_BAR; PG8_SCHED;
            PG8_LDA(At, 1, 1); PG8_STAGE(PG8_SB(1, 0), b3, voffB); PG8_STAGE(PG8_SB(1, 1), b3 + hstep, voffB); PG8_STAGE(PG8_SA(1, 0), a3, voffA);
            PG8_WAIT_V(8); PG8_WAIT_L(0); PG8_BAR; PG8_MMA(1, 0, At, B0); PG8_MMA(1, 1, At, B1); PG8_BAR; PG8_SCHED;
            } else {
            PG8_LDB(B0, 0, 0); PG8_SCHED; PG8_LDA(At, 0, 0); PG8_STAGE(PG8_SA(1, 1), a1 + hstep, voffA);
            PG8_WAIT_L(8); PG8_BAR; PG8_WAIT_L(0); PG8_MMA(0, 0, At, B0); PG8_BAR; PG8_SCHED;
            PG8_LDB(B1, 0, 1); PG8_STAGE(PG8_SB(0, 0), b2, voffB);
            PG8_BAR; PG8_WAIT_L(0); PG8_MMA(0, 1, At, B1); PG8_BAR;
            PG8_LDA(At, 0, 1); PG8_STAGE(PG8_SA(0, 0), a2, voffA);
            PG8_BAR; PG8_WAIT_L(0); PG8_MMA(1, 0, At, B0); PG8_BAR; PG8_SCHED;
            PG8_STAGE(PG8_SB(0, 1), b2 + hstep, voffB);
            PG8_WAIT_V(6); PG8_BAR; PG8_MMA(1, 1, At, B1); PG8_BAR;
            PG8_LDB(B0, 1, 0); PG8_SCHED; PG8_LDA(At, 1, 0); PG8_STAGE(PG8_SA(0, 1), a2 + hstep, voffA);
            PG8_WAIT_L(8); PG8_BAR; PG8_WAIT_L(0); PG8_MMA(0, 0, At, B0); PG8_BAR; PG8_SCHED;
            PG8_LDB(B1, 1, 1); PG8_STAGE(PG8_SB(1, 0), b3, voffB);
            PG8_BAR; PG8_WAIT_L(0); PG8_MMA(0, 1, At, B1); PG8_BAR;
            PG8_LDA(At, 1, 1); PG8_STAGE(PG8_SA(1, 0), a3, voffA);
            PG8_BAR; PG8_WAIT_L(0); PG8_MMA(1, 0, At, B0); PG8_BAR; PG8_SCHED;
            PG8_STAGE(PG8_SB(1, 1), b3 + hstep, voffB);
            PG8_WAIT_V(6); PG8_BAR; PG8_MMA(1, 1, At, B1); PG8_BAR;
            }
        }
#if STAMP_PROBE == 8
        const unsigned long long te0_ = __builtin_amdgcn_s_memrealtime();
#endif
        if constexpr (ALIGN_EPI) { if (wr == 0) PG8_BAR; }
        if constexpr (!Epi::AFTER_DRAIN) { E(acc, cur, wr, wc, fr, fq); S.done(cur); }
#if STAMP_PROBE == 8
        if (tid == 0) *(PG8_LAS unsigned*)(lds + 131072 + 16) += (unsigned)(__builtin_amdgcn_s_memrealtime() - te0_);
#endif
        if (!has_next) break;
#pragma unroll
        for (int a = 0; a < 2; ++a)
#pragma unroll
            for (int b = 0; b < 2; ++b)
#pragma unroll
                for (int m = 0; m < 4; ++m)
#pragma unroll
                    for (int n = 0; n < 2; ++n) acc[a][b][m][n] = (f32x4){0.f, 0.f, 0.f, 0.f};
        cur = nxt; cA = nA; cB = nB; ++ui;
        if constexpr (ALIGN_EPI) { if (wr == 1) PG8_BAR; }
    }
    PG8_WAIT_V(0);
    if constexpr (!ALIGN_EPI) { if (wr == 0) PG8_BAR; }
    PG8_BAR;
    if constexpr (Epi::AFTER_DRAIN) { E.fused(acc, cur, wr, wc, fr, fq, lds, wid, lane); S.done(cur); }
#undef PG8_SA
#undef PG8_SB
#undef PG8_STAGE
#undef PG8_LDA
#undef PG8_LDB
#undef PG8_MMA
#undef PG8_WAIT_V
#undef PG8_WAIT_L
#undef PG8_BAR
#undef PG8_SCHED
}
}
namespace fa {
typedef unsigned short bf16;
typedef short bf16x8 __attribute__((ext_vector_type(8)));
typedef short s16x4 __attribute__((ext_vector_type(4)));
typedef float f32x16 __attribute__((ext_vector_type(16)));
typedef float f32x4 __attribute__((ext_vector_type(4)));
typedef unsigned u32x4 __attribute__((ext_vector_type(4)));
constexpr int D = 128, PITCH = 2048, SEQ = 8192, NHEAD = 16;
constexpr int NW = 8, QBLK = 32, KVBLK = 64, QB = NW * QBLK, NQB = SEQ / QB;
constexpr int SHM_V = KVBLK * D * 2, SHM_K = KVBLK * D * 2;
constexpr int F_OFF = 2 * SHM_V + 2 * SHM_K + NW * 64 * 4 + 2048;
constexpr int ATT_LDS_BYTES = F_OFF + SEQ * 4 + 256;
constexpr float THR2 = 60.0f;
#define FA_KSWZ(row, colB) ((row) * 256 + ((colB) ^ (((row) & 7) << 4)))
#define FA_SBAR() __builtin_amdgcn_sched_barrier(0)
__device__ __forceinline__ int v_st(int k, int c) { const int kk = (k & ~0xC) | ((k & 4) << 1) | ((k & 8) >> 1); return ((kk >> 3) * 4 + (c >> 5)) * 512 + ((kk & 7) * 32 + (c & 31)) * 2; }
__device__ __forceinline__ int v_rd_base(int lane) { return ((lane & 3) << 3) | (((lane >> 2) & 3) << 6) | (((lane >> 4) & 1) << 5) | (((lane >> 5) & 1) << 8); }
constexpr int v_rd_off(int d0, int ks, int half) { return d0 * 512 + ks * 4096 + half * 2048; }
__device__ __forceinline__ int crow(int r, int hi) { return (r & 3) + 8 * (r >> 2) + 4 * hi; }
__device__ __forceinline__ unsigned cvtpk(float lo, float hi) { unsigned r; asm volatile("v_cvt_pk_bf16_f32 %0, %1, %2" : "=v"(r) : "v"(lo), "v"(hi)); return r; }
__device__ __forceinline__ bf16x8 load8(const bf16* p) { return *reinterpret_cast<const bf16x8*>(p); }
__device__ __forceinline__ void mask_tile(f32x16& p0, f32x16& p1, int dq) {
#pragma unroll
    for (int r = 0; r < 16; ++r) { const int c = (r & 3) + 8 * (r >> 2);
        const float t0 = __uint_as_float(0x7f800000u | ((unsigned)(dq - c) & 0x80000000u)), t1 = __uint_as_float(0x7f800000u | ((unsigned)(dq - c - 32) & 0x80000000u));
        p0[r] = fminf(p0[r], t0); p1[r] = fminf(p1[r], t1); }
}
__device__ __forceinline__ void partialSM(f32x16& p0, f32x16& p1, float& m_reg, float& mn, float& alpha) {
    float pmax = p0[0];
#pragma unroll
    for (int r = 1; r < 16; ++r) pmax = fmaxf(pmax, p0[r]);
#pragma unroll
    for (int r = 0; r < 16; ++r) pmax = fmaxf(pmax, p1[r]);
    { auto rr = __builtin_amdgcn_permlane32_swap(__float_as_uint(pmax), __float_as_uint(pmax), false, false);
      pmax = fmaxf(__uint_as_float(rr[0]), __uint_as_float(rr[1])); }
    if (__builtin_expect(__all((pmax - m_reg) <= THR2), 1)) { mn = m_reg; alpha = 1.f; }
    else { mn = fmaxf(m_reg, pmax); alpha = __builtin_amdgcn_exp2f(m_reg - mn); m_reg = mn; }
#pragma unroll
    for (int r = 0; r < 16; ++r) p0[r] = p0[r] - mn;
#pragma unroll
    for (int r = 0; r < 16; ++r) p1[r] = p1[r] - mn;
#pragma unroll
    for (int r = 0; r < 16; ++r) p0[r] = __builtin_amdgcn_exp2f(p0[r]);
}
__device__ __forceinline__ void finishSM(f32x16& p0, f32x16& p1, float alpha, float& l_reg, bf16x8& pa0, bf16x8& pa1, bf16x8& pa2, bf16x8& pa3) {
#pragma unroll
    for (int r = 0; r < 16; ++r) p1[r] = __builtin_amdgcn_exp2f(p1[r]);
    float ps = 0;
#pragma unroll
    for (int r = 0; r < 16; ++r) ps += p0[r];
#pragma unroll
    for (int r = 0; r < 16; ++r) ps += p1[r];
    { auto rr = __builtin_amdgcn_permlane32_swap(__float_as_uint(ps), __float_as_uint(ps), false, false);
      ps = __uint_as_float(rr[0]) + __uint_as_float(rr[1]); }
    l_reg = l_reg * alpha + ps;
#define FA_PK4(P, B_, OUT) do { unsigned a0 = cvtpk(P[B_+0], P[B_+1]), a1 = cvtpk(P[B_+2], P[B_+3]);                          \
        unsigned b0 = cvtpk(P[B_+4], P[B_+5]), b1 = cvtpk(P[B_+6], P[B_+7]);                                             \
        auto r0 = __builtin_amdgcn_permlane32_swap(a0, b0, false, false); auto r1 = __builtin_amdgcn_permlane32_swap(a1, b1, false, false); \
        u32x4 w = {r0[0], r1[0], r0[1], r1[1]}; OUT = *reinterpret_cast<bf16x8*>(&w); } while (0)
    FA_PK4(p0, 0, pa0); FA_PK4(p0, 8, pa1); FA_PK4(p1, 0, pa2); FA_PK4(p1, 8, pa3);
#undef FA_PK4
}
template <int KB>
__device__ __forceinline__ void qkt(f32x16& p0, f32x16& p1, const char* K_lds, int r32, int hi, const bf16x8* qr, const __attribute__((address_space(3))) float* fl) {
#pragma unroll
    for (int g = 0; g < 4; ++g) { const f32x4 a = *(const __attribute__((address_space(3))) f32x4*)(fl + 8 * g), b = *(const __attribute__((address_space(3))) f32x4*)(fl + 32 + 8 * g);
#pragma unroll
        for (int i = 0; i < 4; ++i) { p0[4 * g + i] = a[i]; p1[4 * g + i] = b[i]; } }
    const char* kb[4];
#pragma unroll
    for (int dd = 0; dd < 4; ++dd) kb[dd] = K_lds + KB * SHM_K + FA_KSWZ(r32, (dd * 16 + hi * 8) * 2);
#pragma unroll
    for (int d0 = 0; d0 < 8; ++d0) { const char* a = kb[d0 & 3] + (d0 >> 2) * 128;
        bf16x8 b0 = *reinterpret_cast<const bf16x8*>(a);
        bf16x8 b1 = *reinterpret_cast<const bf16x8*>(a + 32 * 256);
        p0 = __builtin_amdgcn_mfma_f32_32x32x16_bf16(b0, qr[d0], p0, 0, 0, 0);
        p1 = __builtin_amdgcn_mfma_f32_32x32x16_bf16(b1, qr[d0], p1, 0, 0, 0); }
}
template <int VB>
__device__ __forceinline__ void pv_tile(f32x16* o, int vb0, bf16x8 pa0, bf16x8 pa1, bf16x8 pa2, bf16x8 pa3) {
#define FA_TRRD(dst, off) asm volatile("ds_read_b64_tr_b16 %0, %1 offset:%2" : "=&v"(dst) : "v"(vb0), "i"(off) : "memory")
#define FA_PV_D0(d0) do { s16x4 l0, l1, l2, l3, h0, h1, h2, h3; constexpr int b_ = VB * SHM_V + v_rd_off(d0, 0, 0); \
        FA_TRRD(l0, b_); FA_TRRD(h0, b_ + 2048); FA_TRRD(l1, b_ + 4096); FA_TRRD(h1, b_ + 6144); FA_TRRD(l2, b_ + 8192); FA_TRRD(h2, b_ + 10240); FA_TRRD(l3, b_ + 12288); FA_TRRD(h3, b_ + 14336); \
        asm volatile("s_waitcnt lgkmcnt(0)" ::: "memory"); FA_SBAR();   \
        o[d0] = __builtin_amdgcn_mfma_f32_32x32x16_bf16(pa0, (bf16x8){l0[0], l0[1], l0[2], l0[3], h0[0], h0[1], h0[2], h0[3]}, o[d0], 0, 0, 0);   \
        o[d0] = __builtin_amdgcn_mfma_f32_32x32x16_bf16(pa1, (bf16x8){l1[0], l1[1], l1[2], l1[3], h1[0], h1[1], h1[2], h1[3]}, o[d0], 0, 0, 0);   \
        o[d0] = __builtin_amdgcn_mfma_f32_32x32x16_bf16(pa2, (bf16x8){l2[0], l2[1], l2[2], l2[3], h2[0], h2[1], h2[2], h2[3]}, o[d0], 0, 0, 0);   \
        o[d0] = __builtin_amdgcn_mfma_f32_32x32x16_bf16(pa3, (bf16x8){l3[0], l3[1], l3[2], l3[3], h3[0], h3[1], h3[2], h3[3]}, o[d0], 0, 0, 0); } while (0)
    FA_PV_D0(0); FA_PV_D0(1); FA_PV_D0(2); FA_PV_D0(3);
#undef FA_PV_D0
#undef FA_TRRD
}
constexpr size_t BUF = (size_t)16384 * 2048;
struct BlockRef { const bf16* Q; const bf16* K; int P0; int jlo; };
#ifndef FA_SELFCHECK
#define FA_SELFCHECK 0
#endif
#if FA_SELFCHECK
#endif
struct Seam { bf16x8 qr[8]; bf16x8 st_v0, st_v1, st_k0, st_k1; };
#define FA_TILE(p, k0, half) ((const char*)(p) + ((size_t)((k0) + 32 * (half)) * PITCH * 2))
#define FA_VMW() asm volatile("s_waitcnt vmcnt(0)" ::: "memory")
#define FA_VMWN(n) asm volatile("s_waitcnt vmcnt(%0)" :: "i"(n) : "memory")
#define FA_SLOAD(Kp, Vp, k0) do { S.st_v0 = load8((const bf16*)(FA_TILE(Vp, k0, 0) + svoff)); S.st_v1 = load8((const bf16*)(FA_TILE(Vp, k0, 1) + svoff));              \
                         S.st_k0 = load8((const bf16*)(FA_TILE(Kp, k0, 0) + svoff)); S.st_k1 = load8((const bf16*)(FA_TILE(Kp, k0, 1) + svoff)); } while (0)
#define FA_SWRITE_K(bf) do { *(bf16x8*)(K_lds + (bf) * SHM_K + kws) = S.st_k0; *(bf16x8*)(K_lds + (bf) * SHM_K + kws + 32 * 256) = S.st_k1; } while (0)
#define FA_SWRITE_V(bf) do { *(bf16x8*)(V_lds + (bf) * SHM_V + vst0) = S.st_v0; *(bf16x8*)(V_lds + (bf) * SHM_V + vst1) = S.st_v1; } while (0)
#define FA_SWRITE(bf) do { FA_SWRITE_V(bf); FA_SWRITE_K(bf); } while (0)
__device__ __forceinline__ void attn_prime(const BlockRef& cur, char* lds, Seam& S, const int tid) {
    const int wid = __builtin_amdgcn_readfirstlane(tid >> 6), lane = tid & 63, r32 = lane & 31, hi = lane >> 5;
    const int sr = tid >> 4, sc = (tid & 15) * 8, kws = FA_KSWZ(sr, sc * 2); const unsigned svoff = (unsigned)(sr * PITCH + sc) * 2u; char* K_lds = lds + 2 * SHM_V;
#pragma unroll
    for (int d0 = 0; d0 < 8; ++d0) S.qr[d0] = load8(cur.Q + (size_t)(wid * QBLK + r32) * PITCH + d0 * 16 + hi * 8);
    FA_SLOAD(cur.K, cur.K + BUF, cur.jlo * KVBLK); FA_VMW(); FA_SWRITE_K(0);
    __syncthreads();
}
__device__ __forceinline__ void attn_block(const BlockRef& cur, const BlockRef& nxt, char* lds, Seam& S, const int tid, const int obuf = 5) {
    const int wid = __builtin_amdgcn_readfirstlane(tid >> 6), lane = tid & 63, r32 = lane & 31, hi = lane >> 5;
    const int j_lo = cur.jlo, NT = cur.P0 / KVBLK + QB / KVBLK - j_lo;
    const int qlo = cur.P0 + wid * QBLK, qm = qlo + r32 - 4 * hi;
    char* V_lds = lds; char* K_lds = lds + 2 * SHM_V;
    float* ws = (float*)(lds + 2 * SHM_V + 2 * SHM_K) + wid * 64; float* li_l = ws, * al_l = ws + 32;
    const __attribute__((address_space(3))) float* Fl = (const __attribute__((address_space(3))) float*)((__attribute__((address_space(3))) char*)lds + F_OFF) + 4 * hi;
    float m_reg = -1e30f, l_reg = 0; f32x16 o[4] = {};
    const int sr = tid >> 4, sc = (tid & 15) * 8, vst0 = v_st(sr, sc), vst1 = vst0 + 8192  , kws = FA_KSWZ(sr, sc * 2); const unsigned svoff = (unsigned)(sr * PITCH + sc) * 2u;
    const int vb0 = (int)(uintptr_t)V_lds + v_rd_base(lane);
    const bf16* Kh = cur.K; const bf16* Vh = cur.K + BUF;
#define FA_RESC(a) do { if (__any((a) < 1.f)) { if (hi == 0) al_l[r32] = (a); asm volatile("s_waitcnt lgkmcnt(0)" ::: "memory");              \
                     for (int d_ = 0; d_ < 4; ++d_) for (int r = 0; r < 16; ++r) o[d_][r] *= al_l[crow(r, hi)]; } } while (0)
#define FA_KBASE(t) ((j_lo + (t)) * KVBLK)
#define FA_BIASMASK(P0_, P1_, t) do { const int kb_ = FA_KBASE(t); if (kb_ + KVBLK - 1 > qlo) mask_tile(P0_, P1_, qm - kb_); } while (0)
    constexpr int NQL = 8;
#define FA_SEAM_K0() do { FA_VMWN(NQL); FA_SWRITE_K(0); FA_SBAR(); } while (0)
    f32x16 pA0, pA1, pB0, pB1; float mnA, mnB, alA, alB; bf16x8 pa0, pa1, pa2, pa3;
    FA_SWRITE_V(0); FA_SBAR();
    if (NT > 1) { FA_SLOAD(Kh, Vh, FA_KBASE(1)); }
    FA_SBAR(); qkt<0>(pA0, pA1, K_lds, r32, hi, S.qr, Fl + FA_KBASE(0));
    FA_BIASMASK(pA0, pA1, 0); partialSM(pA0, pA1, m_reg, mnA, alA);
    if (NT > 1) { FA_VMW(); FA_SWRITE(1); }
    __syncthreads();
#define FA_HALF_STEP(PX0, PX1, mnX, alX, PY0, PY1, alY, t, KB, VB, SB) do {                                                      \
        FA_SBAR(); qkt<KB>(PX0, PX1, K_lds, r32, hi, S.qr, Fl + FA_KBASE(t));                                             \
        finishSM(PY0, PY1, alY, l_reg, pa0, pa1, pa2, pa3); FA_SBAR();                                                           \
        if ((t) + 1 < NT) { FA_SLOAD(Kh, Vh, FA_KBASE((t) + 1)); FA_SBAR(); }                                               \
        pv_tile<VB>(o, vb0, pa0, pa1, pa2, pa3); FA_BIASMASK(PX0, PX1, (t)); partialSM(PX0, PX1, m_reg, mnX, alX);                                        \
        __syncthreads();                                                                                                      \
        if ((t) + 1 < NT) { FA_VMW(); FA_SWRITE(SB); }                                                                          \
        FA_RESC(alX); __syncthreads(); } while (0)
    for (int t = 1; t + 1 < NT; t += 2) {
        FA_HALF_STEP(pB0, pB1, mnB, alB, pA0, pA1, alA, t, 1, 0, 0);
        FA_HALF_STEP(pA0, pA1, mnA, alA, pB0, pB1, alB, t + 1, 0, 1, 1);
    }
    const bool even = (NT & 1) == 0;
    if (even) { FA_SBAR(); qkt<1>(pB0, pB1, K_lds, r32, hi, S.qr, Fl + FA_KBASE(NT - 1)); FA_SBAR(); }
    FA_SLOAD(nxt.K, nxt.K + BUF, nxt.jlo * KVBLK); FA_SBAR();
#pragma unroll
    for (int d0 = 0; d0 < 8; ++d0) S.qr[d0] = load8(nxt.Q + (size_t)(wid * QBLK + r32) * PITCH + d0 * 16 + hi * 8);
    FA_SBAR();
    finishSM(pA0, pA1, alA, l_reg, pa0, pa1, pa2, pa3); FA_SBAR();
    pv_tile<0>(o, vb0, pa0, pa1, pa2, pa3);
    if (even) { FA_BIASMASK(pB0, pB1, NT - 1); partialSM(pB0, pB1, m_reg, mnB, alB); __syncthreads(); FA_RESC(alB);
        finishSM(pB0, pB1, alB, l_reg, pa0, pa1, pa2, pa3); FA_SBAR(); pv_tile<1>(o, vb0, pa0, pa1, pa2, pa3); }
    FA_SBAR(); FA_SEAM_K0();
    if (hi == 0) li_l[r32] = l_reg; asm volatile("s_waitcnt lgkmcnt(0)" ::: "memory");
    float rli[16];
#pragma unroll
    for (int r = 0; r < 16; ++r) rli[r] = __builtin_amdgcn_rcpf(li_l[crow(r, hi)]);
    bf16* Ow = const_cast<bf16*>(cur.Q) + (size_t)obuf * BUF + (size_t)(wid * QBLK) * PITCH;
    __attribute__((address_space(3))) char* stg = (__attribute__((address_space(3))) char*)lds + F_OFF + wid * 4096;
#pragma unroll
    for (int p = 0; p < 2; ++p) {
#pragma unroll
        for (int rr = 0; rr < 8; ++rr) { const int r = 8 * p + rr, rl = crow(r, hi) - 16 * p;
#pragma unroll
            for (int d0 = 0; d0 < 4; ++d0) { const float v = o[d0][r] * rli[r];
                *(__attribute__((address_space(3))) unsigned short*)(stg + rl * 256 + (d0 * 32 + r32) * 2) = (unsigned short)cvtpk(v, v); } }
        asm volatile("s_waitcnt lgkmcnt(0)" ::: "memory");
#pragma unroll
        for (int k = 0; k < 4; ++k) { const int q = lane + 64 * k; const u32x4 w = *(const __attribute__((address_space(3))) u32x4*)(stg + q * 16);
            *(u32x4*)(Ow + (size_t)(16 * p + (q >> 4)) * PITCH + (q & 15) * 8) = w; }
    }
    __syncthreads();
#undef FA_RESC
#undef FA_KBASE
#undef FA_BIASMASK
#undef FA_SEAM_K0
#undef FA_HALF_STEP
}
#undef FA_TILE
#undef FA_VMW
#undef FA_VMWN
#undef FA_SLOAD
#undef FA_SWRITE_K
#undef FA_SWRITE_V
#undef FA_SWRITE
__device__ __forceinline__ BlockRef block_ref(int bh, int qb, int jlo, const bf16* Q) {
    const int b = bh >> 4, h = bh & 15; BlockRef r;
    r.Q = Q + ((size_t)b * SEQ + (size_t)qb * QB) * PITCH + (size_t)h * D; r.K = Q + BUF + (size_t)b * SEQ * PITCH + (size_t)h * D; r.P0 = qb * QB; r.jlo = jlo; return r;
}
__device__ __forceinline__ void load_bias(char* lds, const float* FB, int bh, int k_lo, int k_hi, const int tid) {
    const f32x4* src = (const f32x4*)(FB + (size_t)bh * SEQ); __attribute__((address_space(3))) f32x4* dst = (__attribute__((address_space(3))) f32x4*)((__attribute__((address_space(3))) char*)lds + F_OFF);
    int t0 = tid; asm volatile("" : "+v"(t0));
    for (int i = k_lo / 4 + t0; i < k_hi / 4; i += NW * 64) dst[i] = src[i];
    __syncthreads();
}
#ifndef FA_PRUNE
#define FA_PRUNE 1
#endif
constexpr float PRUNE_T2 = 44.0f;
constexpr int NTICKETS = (1 + (((DUP_MASK) >> 3) & 1)) * 2 * NHEAD * NQB;
constexpr int XQ_OFF = F_OFF + SEQ * 4;
struct Ticket { int idx, bh, qb, jlo; };
constexpr int ORD_OFF = 104448;
static_assert(ORD_OFF >= ATT_LDS_BYTES, "order table behind the attention image");
__device__ __forceinline__ void build_order(char* lds, const float* FB, const unsigned* qkmax, const int tid) {
    __attribute__((address_space(3))) unsigned short* ord = (__attribute__((address_space(3))) unsigned short*)((__attribute__((address_space(3))) char*)lds + ORD_OFF);
    __attribute__((address_space(3))) int* Wc = (__attribute__((address_space(3))) int*)((__attribute__((address_space(3))) char*)lds + ORD_OFF + 2048);
    int t0 = tid; asm volatile("" : "+v"(t0));
    if (t0 < 2 * NHEAD) { float smax = 0.f;
#pragma unroll
        for (int w = 0; w < 4; ++w) smax += sqrtf(__uint_as_float(qkmax[(t0 * 2 + 0) * 4 + w]) * __uint_as_float(qkmax[(t0 * 2 + 1) * 4 + w]));
        const float fe = FB[(size_t)t0 * SEQ + SEQ - 1];
        const float win = (PRUNE_T2 + smax * 1.02f + 8.5f) * (float)SEQ / fmaxf(fe, 1.0f);
        Wc[t0] = (int)fminf(win * (1.0f / KVBLK) + 1.0f, 124.0f) + 4; }
    __syncthreads();
#pragma unroll 1
    for (int id = t0; id < 2 * NHEAD * NQB; id += NW * 64) {
        const int qb = NQB - 1 - (id >> 5), bh = id & 31, c0 = 4 * qb + 4, c1 = Wc[bh], c = c0 < c1 ? c0 : c1;
        const int fl = c >> 2, qa = (c - 1) >> 2, qe = (c - 4) >> 2; const bool m4 = (c & 3) == 0;
        const int ngt = 32 - (fl < 32 ? fl : 32), neq = (32 - (qa > qb + 1 ? qa : qb + 1)) > 0 ? 32 - (qa > qb + 1 ? qa : qb + 1) : 0;
        int pos = 0;
#pragma unroll 1
        for (int j = 0; j < 2 * NHEAD; ++j) { const int wj = Wc[j];
            if (wj > c) pos += ngt + ((m4 && (qe > qb || (qe == qb && j < bh))) ? 1 : 0);
            else if (wj == c) pos += neq + ((qb >= qa && j < bh) ? 1 : 0); }
        ord[pos] = (unsigned short)id; }
    __syncthreads();
}
__device__ __forceinline__ Ticket next_block(char* lds, const bf16* Q, const float* FB, const unsigned* qkmax, unsigned* qhead, const int tid, const bool prune = true) {
    __attribute__((address_space(3))) int* xi = (__attribute__((address_space(3))) int*)((__attribute__((address_space(3))) char*)lds + XQ_OFF);
    __attribute__((address_space(3))) float* xf = (__attribute__((address_space(3))) float*)(xi + 16);
    int t0 = tid; asm volatile("" : "+v"(t0));
    const int wid = __builtin_amdgcn_readfirstlane(t0 >> 6), lane = t0 & 63;
    if (t0 == 0) xi[0] = (int)__hip_atomic_fetch_add(qhead, 1u, __ATOMIC_RELAXED, __HIP_MEMORY_SCOPE_AGENT);
    __syncthreads();
    Ticket T; T.idx = xi[0]; { const int id = ((const __attribute__((address_space(3))) unsigned short*)((__attribute__((address_space(3))) char*)lds + ORD_OFF))[T.idx % (2 * NHEAD * NQB)]; T.qb = NQB - 1 - (id >> 5); T.bh = id & 31; } T.jlo = 0;
    if (T.idx >= NTICKETS) { __syncthreads(); return T; }
    const int b = T.bh >> 4, h = T.bh & 15, P0 = T.qb * QB;
#if FA_PRUNE
    const int row = t0 >> 1, half = t0 & 1;
    const int nb0 = P0 / KVBLK;
    const float fbend = (t0 < nb0) ? FB[(size_t)T.bh * SEQ + t0 * KVBLK + KVBLK - 1] : 0.f;
    const bf16* qp = Q + ((size_t)b * SEQ + P0 + row) * PITCH + (size_t)h * D + 64 * half; const bf16* kp = qp + BUF;
    float d = 0.f, nq[2] = {0.f, 0.f};
#pragma unroll
    for (int c = 0; c < 8; ++c) { const u32x4 qa = *(const u32x4*)(qp + 8 * c), ka = *(const u32x4*)(kp + 8 * c);
#pragma unroll
        for (int e = 0; e < 4; ++e) { const float q0 = __uint_as_float(qa[e] << 16), q1 = __uint_as_float(qa[e] & 0xffff0000u);
            d += q0 * __uint_as_float(ka[e] << 16); d += q1 * __uint_as_float(ka[e] & 0xffff0000u); nq[c >> 2] += q0 * q0 + q1 * q1; } }
    float bt = sqrtf(nq[0] * __uint_as_float(qkmax[(T.bh * 2 + 1) * 4 + 2 * half])) + sqrtf(nq[1] * __uint_as_float(qkmax[(T.bh * 2 + 1) * 4 + 2 * half + 1]));
    d += __shfl_xor(d, 1); bt += __shfl_xor(bt, 1);
    d += FB[(size_t)T.bh * SEQ + P0 + row];
    d -= bt * 1.02f + 0.5f;
#pragma unroll
    for (int o = 2; o < 64; o <<= 1) d = fminf(d, __shfl_xor(d, o));
    if (lane == 0) xf[wid] = d;
    __syncthreads();
    float mmin = xf[0];
#pragma unroll
    for (int w = 1; w < 8; ++w) mmin = fminf(mmin, xf[w]);
    const float thresh = prune ? mmin - PRUNE_T2 : -__builtin_inff();
    const bool skip = (t0 < nb0) && (fbend < thresh);
    const unsigned long long bal = __ballot(skip);
    if (lane == 0) xi[8 + wid] = __popcll(bal);
    __syncthreads();
    T.jlo = xi[8] + xi[9];
    __syncthreads();
#else
    __syncthreads();
#endif
    return T;
}
__device__ __forceinline__ void attn_phase(char* lds, const bf16* Q, const float* FB, const unsigned* qkmax, unsigned* qhead, const int tid, const bool prune = true, const int obuf = 5) {
    build_order(lds, FB, qkmax, tid);
    Ticket tc = next_block(lds, Q, FB, qkmax, qhead, tid, prune);
    if (tc.idx >= NTICKETS) return;
    BlockRef cur = block_ref(tc.bh, tc.qb, tc.jlo, Q);
    Seam S;
    load_bias(lds, FB, tc.bh, tc.jlo * KVBLK, (tc.qb + 1) * QB, tid);
    attn_prime(cur, lds, S, tid);
    for (;;) {
        const Ticket tn = next_block(lds, Q, FB, qkmax, qhead, tid, prune);
        const bool last = tn.idx >= NTICKETS;
        const BlockRef nxt = last ? cur : block_ref(tn.bh, tn.qb, tn.jlo, Q);
        attn_block(cur, nxt, lds, S, tid, obuf);
        if (last) break;
        load_bias(lds, FB, tn.bh, tn.jlo * KVBLK, (tn.qb + 1) * QB, tid);
        cur = nxt;
    }
}
}

constexpr int NWAVES = 8;
constexpr int BATCH = 2, SEQ = 8192, DM = 4096, NH = 16, HD = 128, AW = 2048, CW = 2048, DFF = 11008, NIN = 12304;
constexpr int M = BATCH * SEQ;
constexpr int NPROJ = 12288;
constexpr int NGU = 2 * DFF;
constexpr float EPS = 1e-6f;
constexpr float QSCALE = 0.08838834764831845f * 1.4426950408889634f;
#ifndef MK_N_LAUNCHES
#define MK_N_LAUNCHES 1
#endif
constexpr int N_PHASES = 10;

#ifndef PG8_ALIGN
#define PG8_ALIGN true
#endif
#ifndef PG8_SP2
#define PG8_SP2 true
#endif
constexpr size_t MiB = 1u << 20;
constexpr size_t WS_CTL = 0, CTL_ZERO_BYTES = 1 * MiB;
constexpr size_t WS_MOD = 512 * 1024;
constexpr size_t WS_WF = 1 * MiB;
constexpr size_t WS_FT = 2 * MiB;
constexpr size_t WS_FB = 3 * MiB;
constexpr size_t WS_WIN = 4 * MiB;
constexpr size_t WS_WOUT = WS_WIN + (size_t)NPROJ * DM * 2;
constexpr size_t WS_WGU = WS_WOUT + (size_t)DM * DM * 2;
constexpr size_t WS_WD = WS_WGU + (size_t)NGU * DM * 2;
constexpr size_t WS_H = WS_WD + (size_t)DM * DFF * 2;
constexpr size_t WS_Q = WS_H + (size_t)M * DM * 2;
constexpr size_t WS_K = WS_Q + (size_t)M * 2048 * 2, WS_V = WS_K + (size_t)M * 2048 * 2, WS_GB = WS_V + (size_t)M * 2048 * 2, WS_CU = WS_GB + (size_t)M * 2048 * 2, WS_YA = WS_CU + (size_t)M * 2048 * 2;
constexpr size_t WS_ACT = WS_Q;
constexpr size_t WS_HM = WS_YA + (size_t)M * 2048 * 2;
constexpr size_t WS_END = WS_HM + (size_t)M * DM * 2;
static_assert(WS_ACT + (size_t)M * DFF * 2 <= WS_HM, "ACT overlay fits inside Q..YA");
static_assert(WS_WIN % 256 == 0 && WS_WOUT % 256 == 0 && WS_WGU % 256 == 0 && WS_WD % 256 == 0 && WS_H % 256 == 0 && WS_Q % 256 == 0 && WS_HM % 256 == 0, "alignment");
constexpr int CW_BAR = 4096;
constexpr int CW_CV = 1536, CW_OWN = 2048;
constexpr int CW_QHEAD = 512, CW_QKMAX = 1024;
constexpr int RING_BYTES = 131072, LDSCTL_OFF = RING_BYTES, MISC_OFF = LDSCTL_OFF + 320, LDS_BYTES = 147456;
static_assert(fa::ATT_LDS_BYTES <= RING_BYTES, "attention LDS");
static_assert(WS_K - WS_Q == fa::BUF * 2 && WS_V - WS_K == fa::BUF * 2 && WS_YA - WS_Q == 5 * fa::BUF * 2, "attention tensor spacing");

#define GAS __attribute__((address_space(1)))
#define LAS __attribute__((address_space(3)))
typedef unsigned short bf16;
typedef unsigned v4u __attribute__((ext_vector_type(4)));
typedef unsigned v2u __attribute__((ext_vector_type(2)));
typedef float f32x4 __attribute__((ext_vector_type(4)));
typedef short bf16x8 __attribute__((ext_vector_type(8)));
typedef GAS unsigned gu32;
#define RLX_AGENT __ATOMIC_RELAXED, __HIP_MEMORY_SCOPE_AGENT
#define LDS_WAIT() asm volatile("s_waitcnt lgkmcnt(0)" ::: "memory")
#define VM_WAIT() asm volatile("s_waitcnt vmcnt(0)" ::: "memory")
__device__ __forceinline__ unsigned f2bf(float f) { unsigned u = __builtin_bit_cast(unsigned, f); return (u + 0x7fffu + ((u >> 16) & 1u)) >> 16; }
__device__ __forceinline__ unsigned pk2(float lo, float hi) { return f2bf(lo) | (f2bf(hi) << 16); }
__device__ __forceinline__ float bflo(unsigned w) { return __builtin_bit_cast(float, w << 16); }
__device__ __forceinline__ float bfhi(unsigned w) { return __builtin_bit_cast(float, w & 0xffff0000u); }
__device__ __forceinline__ float wave_sum(float v) {
#pragma unroll
    for (int o = 1; o < 64; o <<= 1) v += __shfl_xor(v, o);
    return v;
}
#define XB_TMO      128
#define XB_XCNT(j)  (256  + 64 * (j))
#define XB_XSUB(j)  (1280 + 64 * (j))
#define XB_XGEN(j)  (2304 + 64 * (j))
#define XB_TOP      3328
#define XB_TOPGEN   3392
#define XCD_BAR_WORDS 3456
#define XB_SPIN_CAP (1u << 18)
#ifndef XB_DIRECT_RELEASE
#define XB_DIRECT_RELEASE 0
#endif
#ifndef XB_EARLY_WB
#define XB_EARLY_WB 0u
#endif

__device__ __forceinline__ unsigned xb_ld(unsigned* p)              { return __hip_atomic_load(p, __ATOMIC_RELAXED, __HIP_MEMORY_SCOPE_AGENT); }
__device__ __forceinline__ unsigned xb_add(unsigned* p, unsigned v) { return __hip_atomic_fetch_add(p, v, __ATOMIC_RELAXED, __HIP_MEMORY_SCOPE_AGENT); }
__device__ __forceinline__ unsigned xb_xcc_id() { return (unsigned)__builtin_amdgcn_s_getreg((3 << 11) | 20) & 0xFu; }
#define XB_SPIN(cond, bar) do { unsigned _sp = 0; while (cond) { __builtin_amdgcn_s_sleep(1); \
    if ((++_sp & 255u) == 0u) { if (xb_ld(&(bar)[XB_TMO])) break; if (_sp > XB_SPIN_CAP) { atomicAdd(&(bar)[XB_TMO], 1u); break; } } } } while (0)

struct XcdBarrier {
    unsigned* bar; unsigned x;
    volatile LAS unsigned* st;
};

__device__ __forceinline__ XcdBarrier xcd_barrier_post(unsigned* bar, volatile LAS unsigned* st, const int tid) {
    XcdBarrier b; b.bar = bar; b.x = xb_xcc_id(); b.st = st;
    if (tid == 0) (void)xb_add(&bar[XB_XCNT(b.x)], 1u);
    return b;
}
__device__ __forceinline__ void xcd_barrier_complete(unsigned* bar, unsigned x, unsigned& nloc, unsigned& nx) {
    const unsigned G = gridDim.x * gridDim.y * gridDim.z;
    unsigned sum, cnt, mine, sp = 0u;
    for (;;) {
        sum = 0u; cnt = 0u; mine = 0u;
#pragma unroll
        for (unsigned j = 0; j < 16; ++j) { const unsigned c = xb_ld(&bar[XB_XCNT(j)]); sum += c; cnt += (c > 0u) ? 1u : 0u; mine = (j == x) ? c : mine; }
        if (sum == G) break;
        __builtin_amdgcn_s_sleep(1);
        if ((++sp & 255u) == 0u) { if (xb_ld(&bar[XB_TMO])) break; if (sp > XB_SPIN_CAP) { atomicAdd(&bar[XB_TMO], 1u); break; } }
    }
    nloc = mine > 0u ? mine : 1u; nx = cnt > 0u ? cnt : 1u;
}

__device__ __forceinline__ void xcd_barrier(const XcdBarrier& b, const int tid) {
    asm volatile("s_waitcnt vmcnt(0)" ::: "memory");
    __syncthreads();
    if (tid == 0) {
        unsigned* bar = b.bar;
        __builtin_amdgcn_s_waitcnt(0);
        unsigned nloc = b.st[0], nx = b.st[1];
        if (nloc == 0u) { xcd_barrier_complete(bar, b.x, nloc, nx); b.st[0] = nloc; b.st[1] = nx; }
        const unsigned old = xb_add(&bar[XB_XSUB(b.x)], 1u);
        const unsigned gen = old / nloc;
        if (old + 1u == (gen + 1u) * nloc) {
#if XB_DIRECT_RELEASE
            const unsigned cntl = b.st[2]; b.st[2] = cntl + 1u;
#endif
#if STAMP_PROBE == 7
            const unsigned long long tw0_ = __builtin_amdgcn_s_memrealtime();
#endif
            __builtin_amdgcn_fence(__ATOMIC_RELEASE, "agent");
            asm volatile("s_waitcnt vmcnt(0)" ::: "memory");
#if STAMP_PROBE == 7
            xb_add(&bar[XB_TMO + 64], (unsigned)(__builtin_amdgcn_s_memrealtime() - tw0_));
#endif
            const unsigned og = xb_add(&bar[XB_TOP], 1u);
            const unsigned tg = og / nx;
#if XB_DIRECT_RELEASE == 2
            (void)tg; if (og + 1u != (cntl + 1u) * nx) XB_SPIN(xb_ld(&bar[XB_TOP]) < (cntl + 1u) * nx, bar);
#else
            if (og + 1u == (tg + 1u) * nx) xb_add(&bar[XB_TOPGEN], 1u);
            else XB_SPIN(xb_ld(&bar[XB_TOPGEN]) == tg, bar);
#endif
            __builtin_amdgcn_fence(__ATOMIC_ACQUIRE, "agent");
            xb_add(&bar[XB_XGEN(b.x)], 1u);
            asm volatile("s_waitcnt vmcnt(0)" ::: "memory");
        } else {
#if XB_DIRECT_RELEASE
            const unsigned cnt = b.st[2]; b.st[2] = cnt + 1u;
#if XB_DIRECT_RELEASE == 2
            XB_SPIN(xb_ld(&bar[XB_TOP]) < (cnt + 1u) * nx, bar);
#else
            XB_SPIN(xb_ld(&bar[XB_TOPGEN]) == cnt, bar);
#endif
            __builtin_amdgcn_fence(__ATOMIC_ACQUIRE, "agent");
            asm volatile("s_waitcnt vmcnt(0)" ::: "memory");
        } if (false) {
#endif
#if XB_EARLY_WB
            if (((old - gen * nloc) & (XB_EARLY_WB - 1u)) == 0u) { __builtin_amdgcn_fence(__ATOMIC_RELEASE, "agent"); asm volatile("s_waitcnt vmcnt(0)" ::: "memory"); }
#endif
            XB_SPIN(xb_ld(&bar[XB_XGEN(b.x)]) == gen, bar);
            __builtin_amdgcn_fence(__ATOMIC_ACQUIRE, "agent");
            asm volatile("s_waitcnt vmcnt(0)" ::: "memory");
        }
    }
    __syncthreads();
}
struct DestWin { bf16* W; __device__ __forceinline__ bf16* operator()(int n) const {
    if (n < 6144) return W + (size_t)n * DM;
    if (n < 6160) return nullptr;
    if (n < 8208) return W + (size_t)(6144 + (n - 6160)) * DM;
    if (n < 10256) { const int j = n - 8208; return W + (size_t)(8192 + (j >> 7) * 256 + (j & 127)) * DM; }
    const int j = n - 10256; return W + (size_t)(8192 + (j >> 7) * 256 + 128 + (j & 127)) * DM; } };
struct DestPlain { bf16* W; int K; __device__ __forceinline__ bf16* operator()(int n) const { return W + (size_t)n * K; } };
struct DestGU { bf16* W; int half; __device__ __forceinline__ bf16* operator()(int n) const { return W + (size_t)((n >> 7) * 256 + half * 128 + (n & 127)) * DM; } };
template <class Dest>
__device__ __forceinline__ void p0_transpose_item(const float* W, int K, int N, int item, int lane, const Dest dest) {
    const int nblk = (N + 63) / 64, kb = item / nblk, nb = item - kb * nblk, k0 = 64 * kb, n0 = 64 * nb;
    const int c4 = lane & 15, rs = lane >> 4, n = n0 + 4 * c4; const bool nok = n < N;
    const float* wp = W + (size_t)(k0 + 8 * rs) * N + n;
    f32x4 v[2][8];
#pragma unroll
    for (int jj = 0; jj < 2; ++jj)
#pragma unroll
        for (int kk = 0; kk < 8; ++kk) v[jj][kk] = nok ? __builtin_nontemporal_load((const GAS f32x4*)(wp + (size_t)(32 * jj + kk) * N)) : (f32x4){0.f, 0.f, 0.f, 0.f};
#pragma unroll
    for (int q = 0; q < 4; ++q) { bf16* drow = nok ? dest(n + q) : nullptr;
        if (drow) {
#pragma unroll
            for (int jj = 0; jj < 2; ++jj) { v4u o; o.x = pg8::cvt_pk_bf16(v[jj][0][q], v[jj][1][q]); o.y = pg8::cvt_pk_bf16(v[jj][2][q], v[jj][3][q]); o.z = pg8::cvt_pk_bf16(v[jj][4][q], v[jj][5][q]); o.w = pg8::cvt_pk_bf16(v[jj][6][q], v[jj][7][q]);
                *(GAS v4u*)(drow + k0 + 8 * (rs + 4 * jj)) = o; } } }
}
__device__ __forceinline__ unsigned w0_bcast(unsigned v) { return (unsigned)__builtin_amdgcn_readfirstlane((int)v); }
__device__ __forceinline__ int cv_pick(const unsigned* heads, int per, int start, int lane) {
    const unsigned h = (lane < 8) ? __hip_atomic_load(heads + 64 * lane, __ATOMIC_RELAXED, __HIP_MEMORY_SCOPE_AGENT) : 0xffffffffu;
    const unsigned mm = (unsigned)__ballot(h < (unsigned)per) & 0xffu;
    if (mm == 0u) return -1;
    const unsigned rot = ((mm >> start) | (mm << (8 - start))) & 0xffu;
    return (start + __builtin_ctz(rot)) & 7;
}
template <class F>
__device__ __forceinline__ void dyn_walk(unsigned* heads, const int per, int bid, int wave, int lane, F&& item) {
    int shard = cv_pick(heads, per, (bid + wave) & 7, lane);
    if (shard < 0) return;
    unsigned tv = 0u; if (lane == 0) tv = __hip_atomic_fetch_add(heads + 64 * shard, 1u, __ATOMIC_RELAXED, __HIP_MEMORY_SCOPE_AGENT);
    unsigned t = w0_bcast(tv);
#pragma unroll 1
    for (;;) {
        if (t >= (unsigned)per) { shard = cv_pick(heads, per, shard, lane); if (shard < 0) break;
            tv = 0u; if (lane == 0) tv = __hip_atomic_fetch_add(heads + 64 * shard, 1u, __ATOMIC_RELAXED, __HIP_MEMORY_SCOPE_AGENT); t = w0_bcast(tv); continue; }
        tv = 0u; if (lane == 0) tv = __hip_atomic_fetch_add(heads + 64 * shard, 1u, __ATOMIC_RELAXED, __HIP_MEMORY_SCOPE_AGENT);
        item(shard * per + (int)t);
        t = w0_bcast(tv);
    }
}
constexpr int P0_REPS = 1 + ((DUP_MASK) & 1);
struct P0Args { const float *c, *w_ada, *b_ada, *w_in, *w_out, *w_gate, *w_up, *w_down; float* mod; bf16 *WF, *WIN, *WOUT, *WGU, *WD; };
constexpr int P0_I_IN = (DM / 64) * ((NIN + 63) / 64), P0_I_OUT = (DM / 64) * (DM / 64), P0_I_G = (DM / 64) * (DFF / 64), P0_NITEMS = P0_I_IN + P0_I_OUT + 2 * P0_I_G;
struct P0Item { const float* W; bf16* Dst; int N, kind, k0, n0; };
__device__ __forceinline__ P0Item p0_decode(const P0Args& A, int it) {
    P0Item I; int r = it;
    if (r < P0_I_IN) { I.W = A.w_in; I.Dst = A.WIN; I.N = NIN; I.kind = 0; }
    else if ((r -= P0_I_IN) < P0_I_OUT) { I.W = A.w_out; I.Dst = A.WOUT; I.N = DM; I.kind = 1; }
    else if ((r -= P0_I_OUT) < P0_I_G) { I.W = A.w_gate; I.Dst = A.WGU; I.N = DFF; I.kind = 2; }
    else { r -= P0_I_G; I.W = A.w_up; I.Dst = A.WGU; I.N = DFF; I.kind = 3; }
    const int nblk = (I.N + 63) / 64, kb = r / nblk, nb = r - kb * nblk; I.k0 = 64 * kb; I.n0 = 64 * nb; return I;
}
__device__ __forceinline__ bf16* p0_dest(const P0Item& I, int n) {
    if (I.kind == 0) return DestWin{I.Dst}(n);
    if (I.kind == 1) return I.Dst + (size_t)n * DM;
    return DestGU{I.Dst, I.kind - 2}(n);
}
__device__ __forceinline__ void p0_load(const P0Item& I, int lane, f32x4 (&v)[2][8]) {
    const int c4 = lane & 15, rs = lane >> 4, n = I.n0 + 4 * c4; const bool nok = n < I.N;
    const float* wp = I.W + (size_t)(I.k0 + 8 * rs) * I.N + n;
#pragma unroll
    for (int jj = 0; jj < 2; ++jj)
#pragma unroll
        for (int kk = 0; kk < 8; ++kk) v[jj][kk] = nok ? __builtin_nontemporal_load((const GAS f32x4*)(wp + (size_t)(32 * jj + kk) * I.N)) : (f32x4){0.f, 0.f, 0.f, 0.f};
}
__device__ __forceinline__ void p0_store(const P0Item& I, int lane, const f32x4 (&v)[2][8]) {
    const int c4 = lane & 15, rs = lane >> 4, n = I.n0 + 4 * c4; const bool nok = n < I.N;
#pragma unroll
    for (int q = 0; q < 4; ++q) { bf16* drow = nok ? p0_dest(I, n + q) : nullptr;
        if (drow) {
#pragma unroll
            for (int jj = 0; jj < 2; ++jj) { v4u o; o.x = pg8::cvt_pk_bf16(v[jj][0][q], v[jj][1][q]); o.y = pg8::cvt_pk_bf16(v[jj][2][q], v[jj][3][q]); o.z = pg8::cvt_pk_bf16(v[jj][4][q], v[jj][5][q]); o.w = pg8::cvt_pk_bf16(v[jj][6][q], v[jj][7][q]);
                *(GAS v4u*)(drow + I.k0 + 8 * (rs + 4 * jj)) = o; } } }
}
__device__ __forceinline__ void p0_prologue(LAS unsigned char* lds, const P0Args& A, int G, int bid, int tid, int wave, int lane) {
#if STAMP_PROBE == 5
    if (tid == 0) ((unsigned long long*)((char*)A.mod - 524288 + 65536))[11 * 256 + bid] = __builtin_amdgcn_s_memrealtime();
#endif
    LAS float* cact = (LAS float*)(lds + 73728);
    for (int i = tid; i < 2 * DM; i += NWAVES * 64) { const float v = A.c[i]; cact[i] = v / (1.f + expf(-v)); }
    __syncthreads();
    for (int rep0 = 0; rep0 < P0_REPS; ++rep0)
    for (int it = bid; it < 12 * 64; it += G) {
        const int cg = it % 12, kc = it / 12, n = cg * 2048 + tid * 4;
        const float* wp = A.w_ada + (size_t)(kc * 64) * (6 * DM) + n;
        f32x4 a0 = {0.f, 0.f, 0.f, 0.f}, a1 = {0.f, 0.f, 0.f, 0.f};
#pragma unroll 32
        for (int kk = 0; kk < 64; ++kk) { const f32x4 w = __builtin_nontemporal_load((const GAS f32x4*)(wp + (size_t)kk * (6 * DM))); const float c0 = cact[kc * 64 + kk], c1 = cact[DM + kc * 64 + kk]; a0 += w * c0; a1 += w * c1; }
        if (kc == 0) { const f32x4 b = *(const f32x4*)(A.b_ada + n); a0 += b; a1 += b; }
        float* m0 = A.mod + n; float* m1 = A.mod + 6 * DM + n;
        if (rep0 == 0 || a0[0] == 1.2345678e30f)
#pragma unroll
        for (int j = 0; j < 4; ++j) { __hip_atomic_fetch_add(m0 + j, a0[j], __ATOMIC_RELAXED, __HIP_MEMORY_SCOPE_AGENT); __hip_atomic_fetch_add(m1 + j, a1[j], __ATOMIC_RELAXED, __HIP_MEMORY_SCOPE_AGENT); }
    }
#if STAMP_PROBE == 5
    if (tid == 0) ((unsigned long long*)((char*)A.mod - 524288 + 65536))[10 * 256 + bid] = __builtin_amdgcn_s_memrealtime();
#endif
    { const int g = bid * NWAVES * 64 + tid; if (g < 16 * DM) { const int k = g >> 4, n = g & 15; A.WF[(size_t)n * DM + k] = (bf16)f2bf(A.w_in[(size_t)k * NIN + 6144 + n]); } }
    const int gw = bid * NWAVES + wave, NGW = G * NWAVES;
    constexpr int NVIRT = P0_REPS * P0_NITEMS;
    f32x4 va[2][8], vb[2][8];
    int it = gw;
    if (it < NVIRT) { const P0Item I = p0_decode(A, it % P0_NITEMS); p0_load(I, lane, va); }
    while (it < NVIRT) {
        const int i1 = it + NGW, i2 = it + 2 * NGW;
        if (i1 < NVIRT) { const P0Item I = p0_decode(A, i1 % P0_NITEMS); p0_load(I, lane, vb); }
        { const P0Item I = p0_decode(A, it % P0_NITEMS); p0_store(I, lane, va); }
        if (i1 >= NVIRT) break;
        if (i2 < NVIRT) { const P0Item I = p0_decode(A, i2 % P0_NITEMS); p0_load(I, lane, va); }
        { const P0Item I = p0_decode(A, i1 % P0_NITEMS); p0_store(I, lane, vb); }
        it = i2;
    }
}
__device__ __forceinline__ void convert_w_down(const float* w_down, bf16* WD, int b, int nb, int wave, int lane) {
    constexpr int I_D = (DFF / 64) * (DM / 64);
    for (int it = b * NWAVES + wave; it < I_D; it += nb * NWAVES) p0_transpose_item(w_down, DFF, DM, it, lane, DestPlain{WD, DFF});
}
__device__ __forceinline__ int p7_claim(unsigned* ctl, int bid, int lane) {
    unsigned* own = ctl + CW_OWN; const unsigned me = (unsigned)(bid & 7) + 1u;
    int grp = -1; unsigned idx = 0u;
#pragma unroll 1
    for (int s = 0; s < 8 && grp < 0; ++s) { const int w = ((bid & 7) + s) & 7;
        unsigned o = 0u;
        if (lane == 0) { o = __hip_atomic_load(own + 64 * w, __ATOMIC_RELAXED, __HIP_MEMORY_SCOPE_AGENT);
            if (o == 0u) { unsigned e = 0u; __hip_atomic_compare_exchange_strong(own + 64 * w, &e, me, __ATOMIC_RELAXED, __ATOMIC_RELAXED, __HIP_MEMORY_SCOPE_AGENT); o = (e == 0u) ? me : e; } }
        o = w0_bcast(o);
        if (o == me) { unsigned i = 16u; if (lane == 0) i = __hip_atomic_fetch_add(own + 64 * w + 1, 1u, __ATOMIC_RELAXED, __HIP_MEMORY_SCOPE_AGENT); i = w0_bcast(i); if (i < 16u) { grp = w; idx = i; } } }
    return grp < 0 ? -1 : grp + 8 * (int)idx;
}
__device__ __forceinline__ void convert_w_down_dyn(const float* w_down, bf16* WD, unsigned* heads, int bid, int wave, int lane) {
    constexpr int CV_ITEMS = (DFF / 64) * (DM / 64);
    static_assert(CV_ITEMS % 8 == 0, "conversion shards");
    dyn_walk(heads, CV_ITEMS / 8, bid, wave, lane, [&](int it) { p0_transpose_item(w_down, DFF, DM, it, lane, DestPlain{WD, DFF}); });
}
__device__ __forceinline__ void p1_norm1(LAS unsigned char* lds, const float* x, const float* pre_norm_mix, const float* mod, const bf16* WF, bf16* H1, float* FT, int G, int bid, int tid, int wave, int lane) {
    LAS float* G1 = (LAS float*)lds; LAS float* SH1 = G1 + DM; LAS unsigned char* TILE = lds + 32768; LAS f32x4* fpart = (LAS f32x4*)(lds + 98304);
    int cur_b = -1, par = 0; const int r = lane & 15, kq = lane >> 4;
    constexpr int NT1 = M / 8;
    bf16x8 wfr[16];
    { const bf16* wfp0 = WF + (size_t)r * DM + wave * 512 + kq * 8;
#pragma unroll
      for (int i = 0; i < 16; ++i) wfr[i] = *(const GAS bf16x8*)(wfp0 + 32 * i); }
    f32x4 xr[16];
    if (bid < NT1) { const float* xp = x + (size_t)(bid * 8 + wave) * DM + lane * 4;
#pragma unroll
        for (int j = 0; j < 16; ++j) xr[j] = __builtin_nontemporal_load((const GAS f32x4*)(xp + 256 * j)); }
#pragma unroll 1
    for (int tile = bid; tile < NT1; tile += G) {
        const int b = tile / (SEQ / 8), row = tile * 8 + wave;
        if (b != cur_b) { __syncthreads();
            for (int i = tid; i < DM; i += NWAVES * 64) { G1[i] = pre_norm_mix[i] * (1.f + mod[b * 6 * DM + DM + i]); SH1[i] = mod[b * 6 * DM + i]; }
            __syncthreads(); cur_b = b; }
        float ss = 0.f;
#pragma unroll
        for (int j = 0; j < 16; ++j) { const f32x4 v = xr[j]; ss += (v[0] * v[0] + v[1] * v[1]) + (v[2] * v[2] + v[3] * v[3]); }
        ss = wave_sum(ss);
        const float rstd = 1.0f / sqrtf(ss * (1.0f / DM) + EPS);
        const bool has_nx = tile + G < NT1; const float* xn = x + (size_t)(row + 8 * G) * DM + lane * 4;
        bf16* hp = H1 + (size_t)row * DM + lane * 4;
        LAS unsigned char* trow = TILE + wave * (DM * 2) + 8 * (lane & 1);
#pragma unroll
        for (int j = 0; j < 16; ++j) {
            const f32x4 g = *(const LAS f32x4*)(G1 + 256 * j + lane * 4), sh = *(const LAS f32x4*)(SH1 + 256 * j + lane * 4);
            const f32x4 v = xr[j] * rstd * g + sh;
            v2u w; w.x = pg8::cvt_pk_bf16(v[0], v[1]); w.y = pg8::cvt_pk_bf16(v[2], v[3]);
            *(GAS v2u*)(hp + 256 * j) = w;
            *(LAS v2u*)(trow + (((32 * j + (lane >> 1)) ^ wave) << 4)) = w;
            if (has_nx) xr[j] = __builtin_nontemporal_load((const GAS f32x4*)(xn + 256 * j));
        }
        LDS_WAIT(); __builtin_amdgcn_s_barrier();
        f32x4 acc = {0.f, 0.f, 0.f, 0.f};
        const LAS unsigned char* arow = TILE + (r & 7) * (DM * 2);
#pragma unroll
        for (int i = 0; i < 16; ++i) {
            bf16x8 af = *(const LAS bf16x8*)(arow + (((64 * wave + 4 * i + kq) ^ (r & 7)) << 4));
            if (r >= 8) af = (bf16x8){0, 0, 0, 0, 0, 0, 0, 0};
            acc = __builtin_amdgcn_mfma_f32_16x16x32_bf16(af, wfr[i], acc, 0, 0, 0);
        }
        fpart[(par * 8 + wave) * 64 + lane] = acc;
        LDS_WAIT(); __builtin_amdgcn_s_barrier();
        if (wave == 0) { f32x4 s = fpart[(par * 8) * 64 + lane];
#pragma unroll
            for (int w = 1; w < 8; ++w) s += fpart[(par * 8 + w) * 64 + lane];
            const int t0 = (tile * 8) % SEQ + 4 * kq;
            if (kq < 2) *(GAS f32x4*)(FT + (size_t)(b * NH + r) * SEQ + t0) = s; }
        par ^= 1;
    }
}
__device__ __forceinline__ void p2_scan(LAS unsigned char* lds, const float* FT, const float* b_f, float* FB, int bh, int tid, int wave, int lane) {
    const float bias = b_f[bh & 15];
    const GAS f32x4* src = (const GAS f32x4*)(FT + (size_t)bh * SEQ + tid * 16);
    double pre[16]; double run = 0.0;
#pragma unroll
    for (int q = 0; q < 4; ++q) { const f32x4 v = src[q];
#pragma unroll
        for (int j = 0; j < 4; ++j) { const float z = v[j] + bias; const float ls = (z >= 0.f) ? -log1pf(expf(-z)) : z - log1pf(expf(z)); run += (double)ls; pre[4 * q + j] = run; } }
    double incl = run;
#pragma unroll
    for (int o = 1; o < 64; o <<= 1) { const double t = __shfl_up(incl, o); if (lane >= o) incl += t; }
    LAS double* wt = (LAS double*)lds;
    if (lane == 63) wt[wave] = incl;
    __syncthreads();
    double off = incl - run;
    for (int w = 0; w < wave; ++w) off += wt[w];
    GAS f32x4* dst = (GAS f32x4*)(FB + (size_t)bh * SEQ + tid * 16);
#pragma unroll
    for (int q = 0; q < 4; ++q) { f32x4 o;
#pragma unroll
        for (int j = 0; j < 4; ++j) o[j] = (float)(-(off + pre[4 * q + j]) * 1.4426950408889634);
        dst[q] = o; }
    __syncthreads();
}
__device__ __forceinline__ void unpack8(const v4u w, float (&f)[8]) { f[0] = bflo(w.x); f[1] = bfhi(w.x); f[2] = bflo(w.y); f[3] = bfhi(w.y); f[4] = bflo(w.z); f[5] = bfhi(w.z); f[6] = bflo(w.w); f[7] = bfhi(w.w); }
__device__ __forceinline__ void p4_ynorm_conv(LAS unsigned char* lds, const bf16* YA, const bf16* GB, const bf16* CU, const float* conv_w, const float* attn_g, const float* conv_g, bf16* Y, int G, int bid, int tid, int wave, int lane) {
    LAS float* CWl = (LAS float*)lds; LAS float* AGl = CWl + 3 * CW; LAS float* CGl = AGl + AW;
    for (int i = tid; i < 3 * CW; i += NWAVES * 64) CWl[i] = conv_w[i];
    for (int i = tid; i < AW; i += NWAVES * 64) { AGl[i] = attn_g[i]; CGl[i] = conv_g[i]; }
    __syncthreads();
    const int gw = bid * NWAVES + wave, NGW = G * NWAVES;
    for (int chunk = gw; chunk < M / 8; chunk += NGW) {
        const int m0 = chunk * 8, t0 = m0 % SEQ;
        v4u c1[4], c2[4];
#pragma unroll
        for (int j = 0; j < 4; ++j) { c1[j] = (v4u){0u, 0u, 0u, 0u}; c2[j] = (v4u){0u, 0u, 0u, 0u}; }
        if (t0 != 0) {
#pragma unroll
            for (int j = 0; j < 4; ++j) { c1[j] = *(const GAS v4u*)(CU + (size_t)(m0 - 1) * CW + j * 512 + lane * 8); c2[j] = *(const GAS v4u*)(CU + (size_t)(m0 - 2) * CW + j * 512 + lane * 8); } }
#pragma unroll 1
        for (int rr = 0; rr < 8; ++rr) { const int m = m0 + rr; __builtin_amdgcn_sched_barrier(0);
            v4u a[4], c0[4], gb[4];
#pragma unroll
            for (int j = 0; j < 4; ++j) { a[j] = __builtin_nontemporal_load((const GAS v4u*)(YA + (size_t)m * AW + j * 512 + lane * 8)); c0[j] = __builtin_nontemporal_load((const GAS v4u*)(CU + (size_t)m * CW + j * 512 + lane * 8)); gb[j] = __builtin_nontemporal_load((const GAS v4u*)(GB + (size_t)m * CW + j * 512 + lane * 8)); }
            float ssa = 0.f;
#pragma unroll
            for (int j = 0; j < 4; ++j) { float f[8]; unpack8(a[j], f);
#pragma unroll
                for (int i = 0; i < 8; ++i) ssa += f[i] * f[i]; }
            __builtin_amdgcn_sched_barrier(0);
            const float rsa = 1.0f / sqrtf(wave_sum(ssa) * (1.0f / AW) + EPS);
#pragma unroll
            for (int j = 0; j < 4; ++j) { float f[8]; unpack8(a[j], f); const int cb = j * 512 + lane * 8;
                const f32x4 g0 = *(const LAS f32x4*)(AGl + cb), g1 = *(const LAS f32x4*)(AGl + cb + 4);
                v4u w; w.x = pg8::cvt_pk_bf16(f[0] * rsa * g0[0], f[1] * rsa * g0[1]); w.y = pg8::cvt_pk_bf16(f[2] * rsa * g0[2], f[3] * rsa * g0[3]);
                w.z = pg8::cvt_pk_bf16(f[4] * rsa * g1[0], f[5] * rsa * g1[1]); w.w = pg8::cvt_pk_bf16(f[6] * rsa * g1[2], f[7] * rsa * g1[3]);
                *(GAS v4u*)(Y + (size_t)m * DM + cb) = w; __builtin_amdgcn_sched_barrier(0); }
            float yc[4][8]; float ssc = 0.f;
#pragma unroll
            for (int j = 0; j < 4; ++j) { float f0[8], f1[8], f2[8], fg[8]; unpack8(c0[j], f0); unpack8(c1[j], f1); unpack8(c2[j], f2); unpack8(gb[j], fg); const int cb = j * 512 + lane * 8;
#pragma unroll
                for (int h = 0; h < 2; ++h) { const f32x4 w0 = *(const LAS f32x4*)(CWl + cb + 4 * h), w1 = *(const LAS f32x4*)(CWl + CW + cb + 4 * h), w2 = *(const LAS f32x4*)(CWl + 2 * CW + cb + 4 * h);
#pragma unroll
                    for (int i = 0; i < 4; ++i) { const float v = fg[4 * h + i] * (w0[i] * f2[4 * h + i] + w1[i] * f1[4 * h + i] + w2[i] * f0[4 * h + i]); yc[j][4 * h + i] = v; ssc += v * v; } }
                __builtin_amdgcn_sched_barrier(0); }
            const float rsc = 1.0f / sqrtf(wave_sum(ssc) * (1.0f / CW) + EPS);
#pragma unroll
            for (int j = 0; j < 4; ++j) { const int cb = j * 512 + lane * 8;
                const f32x4 g0 = *(const LAS f32x4*)(CGl + cb), g1 = *(const LAS f32x4*)(CGl + cb + 4);
                v4u w; w.x = pg8::cvt_pk_bf16(yc[j][0] * rsc * g0[0], yc[j][1] * rsc * g0[1]); w.y = pg8::cvt_pk_bf16(yc[j][2] * rsc * g0[2], yc[j][3] * rsc * g0[3]);
                w.z = pg8::cvt_pk_bf16(yc[j][4] * rsc * g1[0], yc[j][5] * rsc * g1[1]); w.w = pg8::cvt_pk_bf16(yc[j][6] * rsc * g1[2], yc[j][7] * rsc * g1[3]);
                *(GAS v4u*)(Y + (size_t)m * DM + AW + cb) = w; __builtin_amdgcn_sched_barrier(0); }
#pragma unroll
            for (int j = 0; j < 4; ++j) { c2[j] = c1[j]; c1[j] = c0[j]; }
        }
    }
}
__device__ __forceinline__ void p6_resid1(LAS unsigned char* lds, const float* x, const bf16* HM, const float* mod, const float* post_norm_mix, const float* pre_norm_ffn, bf16* H2, int G, int bid, int tid, int wave, int lane) {
    LAS float* V1 = (LAS float*)lds; LAS float* G2 = V1 + DM; LAS float* S2 = G2 + DM;
    int cur_b = -1;
    for (int blk = bid; blk < M / 64; blk += G) {
        const int b = blk / (SEQ / 64);
        if (b != cur_b) { __syncthreads();
            for (int i = tid; i < DM; i += NWAVES * 64) { const float* mb = mod + b * 6 * DM; V1[i] = mb[2 * DM + i] * post_norm_mix[i]; G2[i] = pre_norm_ffn[i] * (1.f + mb[4 * DM + i]); S2[i] = mb[3 * DM + i]; }
            __syncthreads(); cur_b = b; }
#pragma unroll 1
        for (int rr = 0; rr < 8; ++rr) { const int m = blk * 64 + wave * 8 + rr; __builtin_amdgcn_sched_barrier(0);
            f32x4 xv[16]; v2u hv[16];
#pragma unroll
            for (int j = 0; j < 16; ++j) { xv[j] = __builtin_nontemporal_load((const GAS f32x4*)(x + (size_t)m * DM + j * 256 + lane * 4)); hv[j] = __builtin_nontemporal_load((const GAS v2u*)(HM + (size_t)m * DM + j * 256 + lane * 4)); }
            float ss = 0.f;
#pragma unroll
            for (int j = 0; j < 16; ++j) { const float h0 = bflo(hv[j].x), h1 = bfhi(hv[j].x), h2 = bflo(hv[j].y), h3 = bfhi(hv[j].y); ss += (h0 * h0 + h1 * h1) + (h2 * h2 + h3 * h3); }
            const float r1 = 1.0f / sqrtf(wave_sum(ss) * (1.0f / DM) + EPS);
            float ss2 = 0.f;
#pragma unroll
            for (int j = 0; j < 16; ++j) { const f32x4 v1 = *(const LAS f32x4*)(V1 + j * 256 + lane * 4);
                f32x4 h = {bflo(hv[j].x), bfhi(hv[j].x), bflo(hv[j].y), bfhi(hv[j].y)};
                const f32x4 x1 = xv[j] + v1 * h * r1; xv[j] = x1;
                ss2 += (x1[0] * x1[0] + x1[1] * x1[1]) + (x1[2] * x1[2] + x1[3] * x1[3]); }
            const float r2 = 1.0f / sqrtf(wave_sum(ss2) * (1.0f / DM) + EPS);
#pragma unroll
            for (int j = 0; j < 16; ++j) { const f32x4 g2 = *(const LAS f32x4*)(G2 + j * 256 + lane * 4), s2 = *(const LAS f32x4*)(S2 + j * 256 + lane * 4);
                const f32x4 h = xv[j] * r2 * g2 + s2; v2u w; w.x = pg8::cvt_pk_bf16(h[0], h[1]); w.y = pg8::cvt_pk_bf16(h[2], h[3]);
                *(GAS v2u*)(H2 + (size_t)m * DM + j * 256 + lane * 4) = w; }
        }
    }
}
__device__ __forceinline__ void p9_final(LAS unsigned char* lds, const float* x, const bf16* HMIX, const bf16* HFFN, const float* mod, const float* post_norm_mix, const float* post_norm_ffn, float* out, int G, int bid, int tid, int wave, int lane) {
    LAS float* V1 = (LAS float*)lds; LAS float* V2 = V1 + DM;
    int cur_b = -1;
    for (int blk = bid; blk < M / 64; blk += G) {
        const int b = blk / (SEQ / 64);
        if (b != cur_b) { __syncthreads();
            for (int i = tid; i < DM; i += NWAVES * 64) { const float* mb = mod + b * 6 * DM; V1[i] = mb[2 * DM + i] * post_norm_mix[i]; V2[i] = mb[5 * DM + i] * post_norm_ffn[i]; }
            __syncthreads(); cur_b = b; }
#pragma unroll 1
        for (int rr = 0; rr < 8; ++rr) { const int m = blk * 64 + wave * 8 + rr; __builtin_amdgcn_sched_barrier(0);
            f32x4 xv[16]; v2u hv[16], fv[16];
#pragma unroll
            for (int j = 0; j < 16; ++j) { xv[j] = __builtin_nontemporal_load((const GAS f32x4*)(x + (size_t)m * DM + j * 256 + lane * 4)); hv[j] = __builtin_nontemporal_load((const GAS v2u*)(HMIX + (size_t)m * DM + j * 256 + lane * 4));
                fv[j] = __builtin_nontemporal_load((const GAS v2u*)(HFFN + (size_t)m * DM + j * 256 + lane * 4)); }
            float ss = 0.f, sf = 0.f;
#pragma unroll
            for (int j = 0; j < 16; ++j) { const float h0 = bflo(hv[j].x), h1 = bfhi(hv[j].x), h2 = bflo(hv[j].y), h3 = bfhi(hv[j].y); ss += (h0 * h0 + h1 * h1) + (h2 * h2 + h3 * h3);
                const float f0 = bflo(fv[j].x), f1 = bfhi(fv[j].x), f2 = bflo(fv[j].y), f3 = bfhi(fv[j].y); sf += (f0 * f0 + f1 * f1) + (f2 * f2 + f3 * f3); }
            const float r1 = 1.0f / sqrtf(wave_sum(ss) * (1.0f / DM) + EPS), r2 = 1.0f / sqrtf(wave_sum(sf) * (1.0f / DM) + EPS);
#pragma unroll
            for (int j = 0; j < 16; ++j) { const f32x4 v1 = *(const LAS f32x4*)(V1 + j * 256 + lane * 4), v2 = *(const LAS f32x4*)(V2 + j * 256 + lane * 4);
                f32x4 h = {bflo(hv[j].x), bfhi(hv[j].x), bflo(hv[j].y), bfhi(hv[j].y)}, f = {bflo(fv[j].x), bfhi(fv[j].x), bflo(fv[j].y), bfhi(fv[j].y)};
                const f32x4 x1 = xv[j] + v1 * h * r1;
                __builtin_nontemporal_store(x1 + v2 * f * r2, (GAS f32x4*)(out + (size_t)m * DM + j * 256 + lane * 4)); }
        }
    }
}
struct Args { const float* in[17]; float* out; unsigned char* ws; int ph_lo, ph_hi, grid, pad; };
#define KARGP() const __attribute__((address_space(4))) char* kp = (const __attribute__((address_space(4))) char*)__builtin_amdgcn_kernarg_segment_ptr(); asm volatile("" : "+s"(kp))
#define INP(i) (*(const float* const __attribute__((address_space(4)))*)(kp + 8 * (i)))
#define OUTP() (*(float* const __attribute__((address_space(4)))*)(kp + 136))
#define WSP(T, off) ((T*)(*(unsigned char* const __attribute__((address_space(4)))*)(kp + 144) + (off)))
#define KINT(off) (*(const int __attribute__((address_space(4)))*)(kp + (off)))
#define TIDS() const int tid = opaque_tid(wave_s), lane = tid & 63, wave = wave_s
#ifndef PH_MASK
#define PH_MASK 0x3ff
#endif
#define REPS(k) for (int rep_ = 0; rep_ < 1 + (((DUP_MASK) >> (k)) & 1); ++rep_)
#define IN(k) ((((PHM) >> (k)) & 1) != 0)
#if STAMP_PROBE
#define STAMP(k) if (tid == 0) WSP(unsigned long long, 65536)[(k) * 256 + bid] = __builtin_amdgcn_s_memrealtime()
#else
#define STAMP(k) (void)0
#endif
#define SEAM(k) do { KARGP(); if (IN(k) && IN((k) + 1)) { const int tid = opaque_tid(wave_s); STAMP(k); XcdBarrier bar; bar.bar = WSP(unsigned, WS_CTL) + CW_BAR; bar.x = xb_xcc_id(); bar.st = (volatile LAS unsigned*)(lds + MISC_OFF) + 8; xcd_barrier(bar, tid); STAMP((k) + 12); } } while (0)
template <int PHM> __global__ void __launch_bounds__(NWAVES * 64, 2) hymba_fwd(Args args) {
    constexpr bool HAS_SEAM = (PHM & (PHM >> 1)) != 0;
    extern __shared__ __attribute__((aligned(16))) unsigned char lds_raw[];
    LAS unsigned char* lds = (LAS unsigned char*)lds_raw;
    const int wave_s = __builtin_amdgcn_readfirstlane((int)(threadIdx.x >> 6));
    const int bid = blockIdx.x;
    { KARGP(); TIDS(); (void)lane; (void)wave;
      for (int u = tid; u < (LDS_BYTES - LDSCTL_OFF) / 4; u += NWAVES * 64) ((LAS unsigned*)(lds + LDSCTL_OFF))[u] = 0u;
      __syncthreads();
      if (HAS_SEAM) (void)xcd_barrier_post(WSP(unsigned, WS_CTL) + CW_BAR, (volatile LAS unsigned*)(lds + MISC_OFF) + 8, tid); }

    { KARGP(); if (IN(0)) { TIDS(); const int G = KINT(160); P0Args A{INP(1), INP(2), INP(3), INP(5), INP(10), INP(13), INP(14), INP(15), WSP(float, WS_MOD), WSP(bf16, WS_WF), WSP(bf16, WS_WIN), WSP(bf16, WS_WOUT), WSP(bf16, WS_WGU), WSP(bf16, WS_WD)};
        p0_prologue(lds, A, G, bid, tid, wave, lane); } }
    SEAM(0);
    { KARGP(); if (IN(1)) REPS(1) { TIDS(); const int G = KINT(160); p1_norm1(lds, INP(0), INP(4), WSP(float, WS_MOD), WSP(bf16, WS_WF), WSP(bf16, WS_H), WSP(float, WS_FT), G, bid, tid, wave, lane); } }
    SEAM(1);
    { KARGP(); if (IN(2)) REPS(2) { const int G = KINT(160);
        if (bid < BATCH * NH) { TIDS(); p2_scan(lds, WSP(float, WS_FT), INP(6), WSP(float, WS_FB), bid, tid, wave, lane); }
        pg8::Gemm g{WSP(bf16, WS_H), WSP(bf16, WS_WIN), M, NPROJ, DM}; pg8::StaticOrder S; S.init(M, NPROJ, G, bid); S.wgm = P2_WGM;
        pg8::EpiInProj E{WSP(bf16, WS_Q), WSP(bf16, WS_K), WSP(bf16, WS_V), WSP(bf16, WS_GB), WSP(bf16, WS_CU), QSCALE, WSP(unsigned, WS_CTL) + CW_QKMAX};
        pg8::gemm_phase<pg8::EpiInProj, pg8::StaticOrder, PG8_ALIGN, PG8_SP2>(lds, g, S, E, opaque_tid(wave_s)); } }
    SEAM(2);
    { KARGP(); if (IN(3)) { fa::attn_phase((char*)lds_raw, WSP(bf16, WS_Q), WSP(float, WS_FB), WSP(unsigned, WS_CTL) + CW_QKMAX, WSP(unsigned, WS_CTL) + CW_QHEAD, opaque_tid(wave_s)); } }
    SEAM(3);
#if FA_SELFCHECK
    { KARGP(); fa::attn_phase((char*)lds_raw, WSP(bf16, WS_Q), WSP(float, WS_FB), WSP(unsigned, WS_CTL) + CW_QKMAX, WSP(unsigned, WS_CTL) + CW_QHEAD + 64, opaque_tid(wave_s), false, 6); }
    SEAM(3);
    { KARGP(); TIDS(); (void)lane; (void)wave; const unsigned short* a = (const unsigned short*)WSP(bf16, WS_YA); const unsigned short* b = (const unsigned short*)WSP(bf16, WS_HM); unsigned bad = 0;
      for (size_t i = (size_t)bid * 512 + tid; i < (size_t)M * 2048; i += (size_t)KINT(160) * 512) { const float x = __uint_as_float((unsigned)a[i] << 16), y = __uint_as_float((unsigned)b[i] << 16);
          const float tol = fmaxf(fabsf(y), 1e-30f) * (1.0f / 100.0f);
          if (!(fabsf(x - y) <= tol)) bad++; }
      if (bad) __hip_atomic_fetch_add(WSP(unsigned, WS_CTL) + CW_QHEAD + 128, bad, __ATOMIC_RELAXED, __HIP_MEMORY_SCOPE_AGENT); }
    SEAM(3);
#endif
    { KARGP(); if (IN(4)) REPS(4) { TIDS(); const int G = KINT(160); p4_ynorm_conv(lds, WSP(bf16, WS_YA), WSP(bf16, WS_GB), WSP(bf16, WS_CU), INP(7), INP(8), INP(9), WSP(bf16, WS_H), G, bid, tid, wave, lane); } }
    SEAM(4);
    { KARGP(); if (IN(5)) REPS(5) { const int G = KINT(160);
        pg8::Gemm g{WSP(bf16, WS_H), WSP(bf16, WS_WOUT), M, DM, DM}; pg8::StaticOrder S; S.init(M, DM, G, bid); S.wgm = P5_WGM;
        pg8::EpiPlain E{WSP(bf16, WS_HM), DM};
        pg8::gemm_phase<pg8::EpiPlain, pg8::StaticOrder, PG8_ALIGN, PG8_SP2>(lds, g, S, E, opaque_tid(wave_s)); } }
    SEAM(5);
    { KARGP(); if (IN(6)) REPS(6) { TIDS(); const int G = KINT(160); p6_resid1(lds, INP(0), WSP(bf16, WS_HM), WSP(float, WS_MOD), INP(11), INP(12), WSP(bf16, WS_H), G, bid, tid, wave, lane); } }
    SEAM(6);
    { KARGP(); if (IN(7)) REPS(7) { const int G = KINT(160);
        constexpr int NU7 = (M / 256) * (NGU / 256);
        const bool endgame = (P7_ENDGAME != 0) && (G == 256) && (NU7 == 21 * 256 + 128);
        pg8::Gemm g{WSP(bf16, WS_H), WSP(bf16, WS_WGU), M, NGU, DM}; pg8::StaticOrder S; S.init(M, NGU, G, bid); S.wgm = P7_WGM; if (endgame) S.imax = 21;
        pg8::EpiSwiGLU E{WSP(bf16, WS_ACT), DFF};
        pg8::gemm_phase<pg8::EpiSwiGLU, pg8::StaticOrder, P7_ALIGN, PG8_SP2>(lds, g, S, E, opaque_tid(wave_s));
        if (endgame) {
            { TIDS(); (void)tid; if (wave == 0) { const int c = p7_claim(WSP(unsigned, WS_CTL), bid, lane); if (lane == 0) *(volatile LAS int*)(lds + LDSCTL_OFF) = c; } }
            __syncthreads();
            const int c = __builtin_amdgcn_readfirstlane(*(volatile LAS int*)(lds + LDSCTL_OFF));
            if (c >= 0) { pg8::OneUnit S1; S1.S.init(M, NGU, 256, c); S1.S.wgm = P7_WGM; S1.i0 = 21;
                pg8::gemm_phase<pg8::EpiSwiGLU, pg8::OneUnit, P7_ALIGN, PG8_SP2>(lds, g, S1, E, opaque_tid(wave_s)); }
            { TIDS(); (void)tid; convert_w_down_dyn(INP(15), WSP(bf16, WS_WD), WSP(unsigned, WS_CTL) + CW_CV, bid, wave, lane); }
        } else {
            const int rem = NU7 % G, first_idle = (rem == 0) ? 0 : rem, nidle = G - first_idle;
            if (bid >= first_idle) { TIDS(); (void)tid; convert_w_down(INP(15), WSP(bf16, WS_WD), bid - first_idle, nidle, wave, lane); } } } }
    SEAM(7);
    { KARGP(); if (IN(8)) REPS(8) { const int G = KINT(160);
        pg8::Gemm g{WSP(bf16, WS_ACT), WSP(bf16, WS_WD), M, DM, DFF}; pg8::StaticOrder S; S.init(M, DM, G, bid); S.wgm = P8_WGM;
        pg8::EpiPlain E{WSP(bf16, WS_H), DM};
        pg8::gemm_phase<pg8::EpiPlain, pg8::StaticOrder, PG8_ALIGN, PG8_SP2>(lds, g, S, E, opaque_tid(wave_s)); } }
    SEAM(8);
    { KARGP(); if (IN(9)) { TIDS(); const int G = KINT(160); p9_final(lds, INP(0), WSP(bf16, WS_HM), WSP(bf16, WS_H), WSP(float, WS_MOD), INP(11), INP(16), OUTP(), G, bid, tid, wave, lane); } }
#if STAMP_PROBE == 8
    { KARGP(); const int tid = opaque_tid(wave_s); if (tid == 0) __hip_atomic_fetch_add(WSP(unsigned, WS_CTL) + CW_QHEAD + 40, *(volatile LAS unsigned*)(lds + LDSCTL_OFF + 16), __ATOMIC_RELAXED, __HIP_MEMORY_SCOPE_AGENT); }
#endif
#if STAMP_PROBE
    { KARGP(); const int tid = opaque_tid(wave_s); STAMP(9); XcdBarrier bar; bar.bar = WSP(unsigned, WS_CTL) + CW_BAR; bar.x = xb_xcc_id(); bar.st = (volatile LAS unsigned*)(lds + MISC_OFF) + 8; xcd_barrier(bar, tid);
      if (bid == 0) { LAS int* sh = (LAS int*)lds; const unsigned long long* st = WSP(unsigned long long, 65536);
          if (tid < 66) sh[tid] = (tid == 65) ? -2000000000 : 0;
          __syncthreads();
          for (int k = (STAMP_PROBE == 1 ? 4 : 0); k <= (STAMP_PROBE == 3 ? -1 : 9); ++k) { if (!(((STAMP_MASK) >> k) & 1)) continue;
              if (tid < 64) sh[128 + tid] = -2000000000; if (tid == 64) { sh[192] = 0; sh[193] = -2000000000; }
              __syncthreads();
              if (tid < 256) { const int v = (int)(long long)(st[k * 256 + tid] - st[k * 256]); const int g = 8 * (tid & 7) + ((tid >> 3) & 7);
                  __hip_atomic_fetch_max(sh + 128 + g, v, __ATOMIC_RELAXED, __HIP_MEMORY_SCOPE_WORKGROUP); __hip_atomic_fetch_add(sh + 192, v, __ATOMIC_RELAXED, __HIP_MEMORY_SCOPE_WORKGROUP); }
              __syncthreads();
              if (tid < 64) { const int Lg = sh[128 + tid] * 256 - sh[192]; sh[tid] += Lg; __hip_atomic_fetch_max(sh + 193, Lg, __ATOMIC_RELAXED, __HIP_MEMORY_SCOPE_WORKGROUP); }
              __syncthreads();
              if (tid == 0) sh[64] += sh[193];
              __syncthreads(); }
#if STAMP_PROBE == 3
          if (tid == 0) sh[64] = 0;
          __syncthreads();
          for (int k = 0; k <= 9; ++k) { if (!(((STAMP_MASK) >> k) & 1)) continue;
              if (tid < 16) sh[200 + tid] = (tid == 2 || tid == 3) ? -2000000000 : (tid == 4) ? 2000000000 : 0;
              __syncthreads();
              const int v = (tid < 256) ? (int)(long long)(st[k * 256 + tid] - st[k * 256]) : 0;
              if (tid < 256) { const int h = tid >> 7; __hip_atomic_fetch_add(sh + 200 + h, v, __ATOMIC_RELAXED, __HIP_MEMORY_SCOPE_WORKGROUP); __hip_atomic_fetch_max(sh + 202 + h, v, __ATOMIC_RELAXED, __HIP_MEMORY_SCOPE_WORKGROUP);
                  __hip_atomic_fetch_min(sh + 204, v, __ATOMIC_RELAXED, __HIP_MEMORY_SCOPE_WORKGROUP); __hip_atomic_fetch_add(sh + 208 + (tid & 7), v, __ATOMIC_RELAXED, __HIP_MEMORY_SCOPE_WORKGROUP); }
              __syncthreads();
              if (tid < 256 && STAMP_STAT == 6 && v * 256 > sh[200] + sh[201] + 256 * (STAMP_THR)) __hip_atomic_fetch_add(sh + 205, 1, __ATOMIC_RELAXED, __HIP_MEMORY_SCOPE_WORKGROUP);
              if (STAMP_STAT == 7 && k > 0) { if (tid == 0) sh[207] = -2000000000; __syncthreads();
                  if (tid < 256) __hip_atomic_fetch_max(sh + 207, (int)(long long)(st[(k - 1) * 256 + tid] - st[k * 256]), __ATOMIC_RELAXED, __HIP_MEMORY_SCOPE_WORKGROUP);
                  __syncthreads(); if (tid == 0) { const int mx = sh[202] > sh[203] ? sh[202] : sh[203]; sh[206] = 256 * (mx - sh[207]); } }
              __syncthreads();
              if (tid == 0) { const int sl = sh[200], shh = sh[201], sa = sl + shh; int r = 0;
                  if (STAMP_STAT == 1) r = sh[202] * 256 - 2 * sl; else if (STAMP_STAT == 2) r = sh[203] * 256 - 2 * shh; else if (STAMP_STAT == 3) r = 2 * sl - 2 * shh; else if (STAMP_STAT == 4) r = sa - 256 * sh[204];
                  else if (STAMP_STAT == 5) { int mx = -2000000000; for (int x = 0; x < 8; ++x) mx = sh[208 + x] > mx ? sh[208 + x] : mx; r = 8 * mx - sa; }
                  else if (STAMP_STAT == 6) r = sh[205] * 256 * 100;
                  else if (STAMP_STAT == 7) r = sh[206];
                  sh[64] += r; }
              __syncthreads(); }
#endif
          if (tid < 64) __hip_atomic_fetch_max(sh + 65, sh[tid], __ATOMIC_RELAXED, __HIP_MEMORY_SCOPE_WORKGROUP);
          __syncthreads();
#if STAMP_PROBE == 5
          if (tid == 0) { sh[64] = 0; sh[66] = -2000000000; sh[67] = 2000000000; }
          __syncthreads();
          if (tid < 256) { const int e = (int)(long long)(st[11 * 256 + tid] - st[11 * 256]), g = (int)(long long)(st[10 * 256 + tid] - st[11 * 256]), a = (int)(long long)(st[tid] - st[11 * 256]);
              __hip_atomic_fetch_add(sh + 64, STAMP_STAT == 0 ? g - e : STAMP_STAT == 1 ? a - g : 0, __ATOMIC_RELAXED, __HIP_MEMORY_SCOPE_WORKGROUP);
              __hip_atomic_fetch_max(sh + 66, e, __ATOMIC_RELAXED, __HIP_MEMORY_SCOPE_WORKGROUP); __hip_atomic_fetch_min(sh + 67, e, __ATOMIC_RELAXED, __HIP_MEMORY_SCOPE_WORKGROUP); }
          __syncthreads();
          if (tid == 0 && STAMP_STAT == 2) sh[64] = 256 * (sh[66] - sh[67]);
          __syncthreads();
#endif
#if STAMP_PROBE == 6
          if (tid == 0) sh[64] = 0;
          __syncthreads();
          for (int k = 0; k <= 8; ++k) { if (!(((STAMP_MASK) >> k) & 1)) continue;
              if (tid == 0) { sh[66] = -2000000000; sh[67] = -2000000000; sh[68] = 2000000000; }
              __syncthreads();
              if (tid < 256) { __hip_atomic_fetch_max(sh + 66, (int)(long long)(st[k * 256 + tid] - st[k * 256]), __ATOMIC_RELAXED, __HIP_MEMORY_SCOPE_WORKGROUP);
                  const int o = (int)(long long)(st[(k + 12) * 256 + tid] - st[k * 256]);
                  __hip_atomic_fetch_max(sh + 67, o, __ATOMIC_RELAXED, __HIP_MEMORY_SCOPE_WORKGROUP); __hip_atomic_fetch_min(sh + 68, o, __ATOMIC_RELAXED, __HIP_MEMORY_SCOPE_WORKGROUP); }
              __syncthreads();
              if (tid == 0) sh[64] += 256 * ((STAMP_STAT == 0 ? sh[67] : sh[68]) - sh[66]);
              __syncthreads(); }
#endif
#if STAMP_PROBE == 7
          if (tid == 0) sh[64] = 32 * (int)__hip_atomic_load(WSP(unsigned, WS_CTL) + CW_BAR + XB_TMO + 64, __ATOMIC_RELAXED, __HIP_MEMORY_SCOPE_AGENT);
          __syncthreads();
#endif
#if STAMP_PROBE == 8
          if (tid == 0) sh[64] = (int)__hip_atomic_load(WSP(unsigned, WS_CTL) + CW_QHEAD + 40, __ATOMIC_RELAXED, __HIP_MEMORY_SCOPE_AGENT);
          __syncthreads();
#endif
#if STAMP_PROBE == 4
          if (tid == 0) sh[64] = (int)__hip_atomic_load(WSP(unsigned, WS_CTL) + CW_QHEAD + 32, __ATOMIC_RELAXED, __HIP_MEMORY_SCOPE_AGENT);
          __syncthreads();
#endif
          if (tid == 0) { const long long t256 = (STAMP_PROBE == 1) ? (long long)(sh[64] - sh[65]) : (long long)sh[64]; const long long ticks = t256 * (STAMP_PROBE == 1 ? 16 : STAMP_MULT) / 256;
              const unsigned long long t0 = __builtin_amdgcn_s_memrealtime(); while ((long long)(__builtin_amdgcn_s_memrealtime() - t0) < ticks) __builtin_amdgcn_s_sleep(8); }
          __syncthreads(); }
      xcd_barrier(bar, tid); }
#endif
#if FA_SELFCHECK
    SEAM(8);
    { KARGP(); const int tid = opaque_tid(wave_s); if (bid == 0 && tid == 0 && __hip_atomic_load(WSP(unsigned, WS_CTL) + CW_QHEAD + 128, __ATOMIC_RELAXED, __HIP_MEMORY_SCOPE_AGENT) != 0u) OUTP()[0] = __builtin_nanf(""); }
#endif
}
#undef IN
#undef SEAM
#undef STAMP
#undef INP
#undef WSP
#undef OUTP
#undef KARGP
#undef KINT
#undef TIDS

typedef void (*kern_t)(Args);
template <int PHM> static bool set_attr() { return hipFuncSetAttribute((const void*)hymba_fwd<PHM>, hipFuncAttributeMaxDynamicSharedMemorySize, LDS_BYTES) == hipSuccess; }
extern "C" void kernel_launch(void* const* d_in, const int* in_sizes, int n_in, void* d_out, int out_size, void* d_ws, size_t ws_size, hipStream_t stream) {
    static int grid = 0;
#if MK_N_LAUNCHES == 1
    static const kern_t kerns[1] = {hymba_fwd<(PH_MASK)>};
#else
    static const kern_t kerns[N_PHASES] = {hymba_fwd<1>, hymba_fwd<2>, hymba_fwd<4>, hymba_fwd<8>, hymba_fwd<16>, hymba_fwd<32>, hymba_fwd<64>, hymba_fwd<128>, hymba_fwd<256>, hymba_fwd<512>};
#endif
    if (grid == 0) {
        if (n_in != 17 || in_sizes[0] != M * DM || out_size != M * DM || ws_size < WS_END) {
            fprintf(stderr, "kernel_launch: built for 17 inputs, x/out of %d floats, >= %zu bytes of workspace; got n_in %d, in0 %d, out %d, ws %zu; nothing launched\n", M * DM, (size_t)WS_END, n_in, n_in > 0 ? in_sizes[0] : -1, out_size, ws_size);
            grid = -1; return; }
        int dev = 0, cus = 0, per_cu = 0;
        if (hipGetDevice(&dev) != hipSuccess || hipDeviceGetAttribute(&cus, hipDeviceAttributeMultiprocessorCount, dev) != hipSuccess) { fprintf(stderr, "kernel_launch: device query failed\n"); grid = -1; return; }
#if MK_N_LAUNCHES == 1
        bool ok = set_attr<(PH_MASK)>();
#else
        bool ok = set_attr<1>() && set_attr<2>() && set_attr<4>() && set_attr<8>() && set_attr<16>() && set_attr<32>() && set_attr<64>() && set_attr<128>() && set_attr<256>() && set_attr<512>();
#endif
        if (!ok) { fprintf(stderr, "kernel_launch: hipFuncSetAttribute failed\n"); grid = -1; return; }
        if (hipOccupancyMaxActiveBlocksPerMultiprocessor(&per_cu, (const void*)kerns[0], NWAVES * 64, LDS_BYTES) != hipSuccess || per_cu < 1)
            fprintf(stderr, "kernel_launch: note: occupancy query reports %d workgroups per CU\n", per_cu);
        (void)hipGetLastError();
        grid = cus;
    }
    if (grid < 0) return;
    if (hipMemsetAsync((char*)d_ws + WS_CTL, 0, CTL_ZERO_BYTES, stream) != hipSuccess) { fprintf(stderr, "kernel_launch: memset failed\n"); return; }
    Args a{};
    for (int i = 0; i < 17; ++i) a.in[i] = (const float*)d_in[i];
    a.out = (float*)d_out; a.ws = (unsigned char*)d_ws; a.grid = grid; a.pad = 0; a.ph_lo = 0; a.ph_hi = N_PHASES;
    for (int li = 0; li < MK_N_LAUNCHES; ++li) {
        hipLaunchKernelGGL(kerns[li], dim3(grid), dim3(NWAVES * 64), LDS_BYTES, stream, a);
        const hipError_t le = hipPeekAtLastError();
        if (le != hipSuccess) { fprintf(stderr, "kernel_launch: launch %d failed: %s\n", li, hipGetErrorName(le)); break; }
    }
}
```

```cpp
#include <hip/hip_runtime.h>
#include <cstdio>
#include <cstdint>
#include <cmath>
#ifndef STAMP_PROBE
#define STAMP_PROBE 0
#endif
#ifndef STAMP_MASK
#define STAMP_MASK 0x3ff
#define STAMP_MULT 4
#define STAMP_STAT 1
#define STAMP_THR 2000
#endif
#ifndef P7_ENDGAME
#define P7_ENDGAME 1
#endif
#ifndef P2_WGM
#define P2_WGM 8
#endif
#ifndef P5_WGM
#define P5_WGM 8
#endif
#ifndef P7_WGM
#define P7_WGM 8
#endif
#ifndef PG8_PRIO
#define PG8_PRIO 1
#endif
#ifndef P7_ALIGN
#define P7_ALIGN true
#endif
#ifndef XCD_LOCAL_SEAMS
#define XCD_LOCAL_SEAMS 1
#endif
#ifndef P8_WGM
#define P8_WGM 2
#endif
#ifndef DUP_MASK
#define DUP_MASK 0
#endif
__device__ __forceinline__ int opaque_tid(int wave_s) { int l; asm volatile("v_mbcnt_lo_u32_b32 %0, -1, 0\n\tv_mbcnt_hi_u32_b32 %0, -1, %0" : "=v"(l)); return (wave_s << 6) | l; }
namespace pg8 {
#define PG8_LAS __attribute__((address_space(3)))
typedef unsigned short bf16_t;
typedef short bf16x8 __attribute__((ext_vector_type(8)));
typedef float f32x4 __attribute__((ext_vector_type(4)));
typedef unsigned u32x4 __attribute__((ext_vector_type(4)));
constexpr int BM = 256, BK = 64, HALF = 128, HTB = HALF * BK * 2  , STAGE_BYTES = 8 * HTB, NXCD = 8, WGM = 8;

__host__ __device__ __forceinline__ int lds_byte(int r, int c) { const int st = (r >> 4) * 2 + (c >> 5), rr = r & 15, cc = c & 31, ob = rr * 64 + cc * 2; return st * 1024 + (ob ^ (((ob >> 9) & 1) << 5)); }
__host__ __device__ __forceinline__ void stage_rc(int b, int& R, int& C) { const int st = b / 1024, sb = b % 1024, swz = sb ^ (((sb >> 9) & 1) << 5); R = (st >> 1) * 16 + swz / 64; C = (st & 1) * 32 + (swz % 64) / 2; }
__host__ __device__ __forceinline__ int perm32(int rho) { const int n = rho >> 4, i = rho & 15; return 8 * (i >> 2) + 4 * n + (i & 3); }

struct Unit { int pm, pn; };
struct Gemm { const bf16_t* A; const bf16_t* Bt; int M, N, K; };

struct StaticOrder {
    int nM, nN, nwg, G, c, imax, wgm;
    __host__ __device__ void init(int M, int N, int G_, int c_) { nM = M / BM; nN = N / BM; nwg = nM * nN; G = G_; c = c_; imax = 1 << 30; wgm = WGM; }
    __host__ __device__ bool next(int i, Unit& u) const {
        const long L = (long)i * G + c; if (L >= nwg || i >= imax) return false;
        int wgid = (int)L; { const int q = nwg / NXCD, r = nwg % NXCD, xcd = wgid % NXCD, off = wgid / NXCD; wgid = (xcd < r ? xcd * (q + 1) : r * (q + 1) + (xcd - r) * q) + off; }
        const int nig = wgm * nN, gid = wgid / nig, fm = gid * wgm, gsz = (nM - fm) < wgm ? (nM - fm) : wgm;
        u.pm = fm + ((wgid % nig) % gsz); u.pn = (wgid % nig) / gsz; return true;
    }
    __device__ __forceinline__ void a_ready(const Unit&) const {}
    __device__ __forceinline__ void done(const Unit&) const {}
};
struct OneUnit {
    StaticOrder S; int i0;
    __host__ __device__ bool next(int i, Unit& u) const { return i == 0 && S.next(i0, u); }
    __device__ __forceinline__ void a_ready(const Unit&) const {}
    __device__ __forceinline__ void done(const Unit&) const {}
};
__device__ __forceinline__ unsigned cvt_pk_bf16(float lo, float hi) { unsigned r; asm volatile("v_cvt_pk_bf16_f32 %0, %1, %2" : "=v"(r) : "v"(lo), "v"(hi)); return r; }
typedef float f32x2 __attribute__((ext_vector_type(2)));
struct EpiPlain {
    static constexpr bool PERM = true, AFTER_DRAIN = false;
    bf16_t* O; int ldc;
    __device__ __forceinline__ void operator()(const f32x4 (&acc)[2][2][4][2], const Unit& u, int wr, int wc, int fr, int fq) const {
        const int row0 = u.pm * BM + wr * 64 + fr, col0 = u.pn * BM + wc * 32 + 8 * fq;
#pragma unroll
        for (int ai = 0; ai < 2; ++ai)
#pragma unroll
            for (int m = 0; m < 4; ++m) { bf16_t* rowp = O + (size_t)(row0 + ai * HALF + m * 16) * ldc + col0;
#pragma unroll
                for (int bj = 0; bj < 2; ++bj) { const f32x4 v0 = acc[ai][bj][m][0], v1 = acc[ai][bj][m][1];
                    u32x4 w; w.x = cvt_pk_bf16(v0[0], v0[1]); w.y = cvt_pk_bf16(v0[2], v0[3]); w.z = cvt_pk_bf16(v1[0], v1[1]); w.w = cvt_pk_bf16(v1[2], v1[3]);
                    *(u32x4*)(rowp + bj * HALF) = w; } }
    }
};
struct EpiInProj {
    static constexpr bool PERM = true, AFTER_DRAIN = false;
    bf16_t *Q, *K, *V, *GB, *CU; float qscale; unsigned* qkmax;
    __device__ __forceinline__ void operator()(const f32x4 (&acc)[2][2][4][2], const Unit& u, int wr, int wc, int fr, int fq) const {
        const int row0 = u.pm * BM + wr * 64 + fr;
        if (u.pn < 32) {
            const int t = u.pn >> 3; bf16_t* base = (t == 0) ? Q : (t == 1) ? K : (t == 2) ? V : GB; const float s = (t == 0) ? qscale : 1.f;
            const int col0 = (u.pn & 7) * BM + wc * 32 + 8 * fq;
#pragma unroll
            for (int ai = 0; ai < 2; ++ai)
#pragma unroll
                for (int m = 0; m < 4; ++m) { bf16_t* rowp = base + (size_t)(row0 + ai * HALF + m * 16) * 2048 + col0;
#pragma unroll
                    for (int bj = 0; bj < 2; ++bj) { const f32x4 v0 = acc[ai][bj][m][0] * s, v1 = acc[ai][bj][m][1] * s;
                        u32x4 w; w.x = cvt_pk_bf16(v0[0], v0[1]); w.y = cvt_pk_bf16(v0[2], v0[3]); w.z = cvt_pk_bf16(v1[0], v1[1]); w.w = cvt_pk_bf16(v1[2], v1[3]);
                        *(u32x4*)(rowp + bj * HALF) = w; } }
            if (t <= 1) {
                float mx[2] = {0.f, 0.f};
#pragma unroll
                for (int ai = 0; ai < 2; ++ai)
#pragma unroll
                    for (int m = 0; m < 4; ++m)
#pragma unroll
                        for (int bj = 0; bj < 2; ++bj) { const f32x4 v0 = acc[ai][bj][m][0] * s, v1 = acc[ai][bj][m][1] * s;
                            float ss = (v0[0] * v0[0] + v0[1] * v0[1]) + (v0[2] * v0[2] + v0[3] * v0[3]) + (v1[0] * v1[0] + v1[1] * v1[1]) + (v1[2] * v1[2] + v1[3] * v1[3]);
                            ss += __shfl_xor(ss, 16); ss += __shfl_xor(ss, 32); mx[bj] = fmaxf(mx[bj], ss); }
#pragma unroll
                for (int bj = 0; bj < 2; ++bj) { float mm = mx[bj];
#pragma unroll
                    for (int o = 1; o < 16; o <<= 1) mm = fmaxf(mm, __shfl_xor(mm, o));
                    if (fr == 0 && fq == 0) __hip_atomic_fetch_max(qkmax + (((u.pm >> 5) * 16 + (u.pn & 7) * 2 + bj) * 2 + t) * 4 + wc, __float_as_uint(mm), __ATOMIC_RELAXED, __HIP_MEMORY_SCOPE_AGENT); }
            }
        } else {
            const int col0 = (u.pn - 32) * HALF + wc * 32 + 8 * fq;
#pragma unroll
            for (int ai = 0; ai < 2; ++ai)
#pragma unroll
                for (int m = 0; m < 4; ++m) { bf16_t* rowp = CU + (size_t)(row0 + ai * HALF + m * 16) * 2048 + col0;
                    const f32x4 v0 = acc[ai][0][m][0] * acc[ai][1][m][0], v1 = acc[ai][0][m][1] * acc[ai][1][m][1];
                    u32x4 w; w.x = cvt_pk_bf16(v0[0], v0[1]); w.y = cvt_pk_bf16(v0[2], v0[3]); w.z = cvt_pk_bf16(v1[0], v1[1]); w.w = cvt_pk_bf16(v1[2], v1[3]);
                    *(u32x4*)rowp = w; }
        }
    }
};
struct EpiSwiGLU {
    static constexpr bool PERM = true, AFTER_DRAIN = false;
    bf16_t* O; int ldc;
    __device__ __forceinline__ void operator()(const f32x4 (&acc)[2][2][4][2], const Unit& u, int wr, int wc, int fr, int fq) const {
        const int row0 = u.pm * BM + wr * 64 + fr, col0 = u.pn * HALF + wc * 32 + 8 * fq;
#pragma unroll
        for (int ai = 0; ai < 2; ++ai)
#pragma unroll
            for (int m = 0; m < 4; ++m) { bf16_t* rowp = O + (size_t)(row0 + ai * HALF + m * 16) * ldc + col0;
                f32x4 r[2];
#pragma unroll
                for (int n = 0; n < 2; ++n) { const f32x4 g = acc[ai][0][m][n], up = acc[ai][1][m][n];
#pragma unroll
                    for (int j = 0; j < 4; ++j) { const float e = __builtin_amdgcn_exp2f(g[j] * -1.4426950408889634f); r[n][j] = g[j] * up[j] * __builtin_amdgcn_rcpf(1.0f + e); } }
                u32x4 w; w.x = cvt_pk_bf16(r[0][0], r[0][1]); w.y = cvt_pk_bf16(r[0][2], r[0][3]); w.z = cvt_pk_bf16(r[1][0], r[1][1]); w.w = cvt_pk_bf16(r[1][2], r[1][3]);
                *(u32x4*)rowp = w; }
    }
};

template <class Epi, class Sched, bool ALIGN_EPI = false, bool SP2 = false>
__device__ __forceinline__ void gemm_phase(PG8_LAS unsigned char* lds, const Gemm g, const Sched& S, const Epi& E, const int tid) {
    const int wid = __builtin_amdgcn_readfirstlane(tid >> 6), lane = tid & 63, wr = wid >> 2, wc = wid & 3, fr = lane & 15, fq = lane >> 4;
    const int K = g.K, nt = K / BK;
    unsigned voffA[2], voffB[2];
#pragma unroll
    for (int i = 0; i < 2; ++i) { int R, C; stage_rc(tid * 16 + i * 8192, R, C); const int Rb = Epi::PERM ? ((R & ~31) + perm32(R & 31)) : R;
        voffA[i] = (unsigned)(R * K + C) * 2u; voffB[i] = (unsigned)(Rb * K + C) * 2u; }
    const size_t kstep = (size_t)(BK * 2);
    const size_t hstep = (size_t)HALF * K * 2;
    const size_t tstep = 2 * hstep;
    const unsigned ldsw = (unsigned)wid * 1024u;
    const int aoff = lds_byte(wr * 64 + fr, fq * 8), boff = lds_byte(wc * 32 + fr, fq * 8);
#define PG8_SA(b, h) (((b) * 2 + (h)) * HTB)
#define PG8_SB(b, h) ((4 + (b) * 2 + (h)) * HTB)
#define PG8_STAGE(bufoff, gbase, voff) do { _Pragma("unroll") for (int _i = 0; _i < 2; ++_i) \
        __builtin_amdgcn_global_load_lds((const unsigned*)((const char*)(gbase) + (voff)[_i]), (PG8_LAS unsigned*)(lds + (bufoff) + ldsw + _i * 8192), 16, 0, 0); } while (0)
#define PG8_LDA(dst, b, h) do { _Pragma("unroll") for (int m = 0; m < 4; ++m) _Pragma("unroll") for (int k = 0; k < 2; ++k) dst[m][k] = *(const PG8_LAS bf16x8*)(lds + PG8_SA(b, h) + aoff + m * 2048 + k * 1024); } while (0)
#define PG8_LDB(dst, b, h) do { _Pragma("unroll") for (int n = 0; n < 2; ++n) _Pragma("unroll") for (int k = 0; k < 2; ++k) dst[n][k] = *(const PG8_LAS bf16x8*)(lds + PG8_SB(b, h) + boff + n * 2048 + k * 1024); } while (0)
#define PG8_MMA(ai, bj, At, Bt) do { if (PG8_PRIO) __builtin_amdgcn_s_setprio(1); _Pragma("unroll") for (int m = 0; m < 4; ++m) _Pragma("unroll") for (int n = 0; n < 2; ++n) _Pragma("unroll") for (int k = 0; k < 2; ++k) \
        acc[ai][bj][m][n] = __builtin_amdgcn_mfma_f32_16x16x32_bf16(Bt[n][k], At[m][k], acc[ai][bj][m][n], 0, 0, 0); if (PG8_PRIO) __builtin_amdgcn_s_setprio(0); } while (0)
#define PG8_WAIT_V(n) asm volatile("s_waitcnt vmcnt(" #n ")" ::: "memory")
#define PG8_WAIT_L(n) asm volatile("s_waitcnt lgkmcnt(" #n ")" ::: "memory")
#define PG8_BAR __builtin_amdgcn_s_barrier()
#define PG8_SCHED __builtin_amdgcn_sched_barrier(0)
    Unit cur, nxt; int ui = 0;
    if (!S.next(0, cur)) return;
    f32x4 acc[2][2][4][2];
#pragma unroll
    for (int a = 0; a < 2; ++a)
#pragma unroll
        for (int b = 0; b < 2; ++b)
#pragma unroll
            for (int m = 0; m < 4; ++m)
#pragma unroll
                for (int n = 0; n < 2; ++n) acc[a][b][m][n] = (f32x4){0.f, 0.f, 0.f, 0.f};
    bf16x8 At[4][2], B0[2][2], B1[2][2];
    const char* cA = (const char*)g.A + (size_t)cur.pm * tstep; const char* cB = (const char*)g.Bt + (size_t)cur.pn * tstep;
    S.a_ready(cur);
    if constexpr (SP2) {
        PG8_STAGE(PG8_SB(0, 0), cB, voffB); PG8_STAGE(PG8_SB(0, 1), cB + hstep, voffB); PG8_STAGE(PG8_SA(0, 0), cA, voffA); PG8_STAGE(PG8_SA(0, 1), cA + hstep, voffA);
        if (wr == 1) PG8_BAR;
        PG8_WAIT_V(2); PG8_BAR;
        PG8_STAGE(PG8_SB(1, 0), cB + kstep, voffB); PG8_STAGE(PG8_SA(1, 0), cA + kstep, voffA); PG8_STAGE(PG8_SB(1, 1), cB + hstep + kstep, voffB);
        PG8_WAIT_V(6); PG8_BAR;
    } else {
        PG8_STAGE(PG8_SB(0, 0), cB, voffB); PG8_STAGE(PG8_SA(0, 0), cA, voffA); PG8_STAGE(PG8_SB(0, 1), cB + hstep, voffB); PG8_STAGE(PG8_SA(0, 1), cA + hstep, voffA);
        if (wr == 1) PG8_BAR;
        PG8_WAIT_V(4); PG8_BAR;
        PG8_STAGE(PG8_SB(1, 0), cB + kstep, voffB); PG8_STAGE(PG8_SA(1, 0), cA + kstep, voffA); PG8_STAGE(PG8_SB(1, 1), cB + hstep + kstep, voffB);
        PG8_WAIT_V(6); PG8_BAR;
    }
    for (;;) {
        const bool has_next = S.next(ui + 1, nxt);
        const char* nA = has_next ? (const char*)g.A + (size_t)nxt.pm * tstep : cA; const char* nB = has_next ? (const char*)g.Bt + (size_t)nxt.pn * tstep : cB;
        for (int t = 0; t < nt; t += 2) {
            const bool last = (t == nt - 2);
            const char* a1 = cA + (size_t)(t + 1) * kstep;
            const char* a2 = last ? nA : cA + (size_t)(t + 2) * kstep; const char* b2 = last ? nB : cB + (size_t)(t + 2) * kstep;
            const char* a3 = a2 + kstep; const char* b3 = b2 + kstep;
            if (last && has_next) S.a_ready(nxt);
            if constexpr (SP2) {
            PG8_LDB(B0, 0, 0); PG8_LDB(B1, 0, 1); PG8_SCHED; PG8_LDA(At, 0, 0); PG8_STAGE(PG8_SA(1, 1), a1 + hstep, voffA);
            PG8_WAIT_V(8); PG8_WAIT_L(0); PG8_BAR; PG8_MMA(0, 0, At, B0); PG8_MMA(0, 1, At, B1); PG8_BAR; PG8_SCHED;
            PG8_LDA(At, 0, 1); PG8_STAGE(PG8_SB(0, 0), b2, voffB); PG8_STAGE(PG8_SB(0, 1), b2 + hstep, voffB); PG8_STAGE(PG8_SA(0, 0), a2, voffA);
            PG8_WAIT_V(8); PG8_WAIT_L(0); PG8_BAR; PG8_MMA(1, 0, At, B0); PG8_MMA(1, 1, At, B1); PG8_BAR; PG8_SCHED;
            PG8_LDB(B0, 1, 0); PG8_LDB(B1, 1, 1); PG8_SCHED; PG8_LDA(At, 1, 0); PG8_STAGE(PG8_SA(0, 1), a2 + hstep, voffA);
            PG8_WAIT_V(8); PG8_WAIT_L(0); PG8_BAR; PG8_MMA(0, 0, At, B0); PG8_MMA(0, 1, At, B1); PG8_BAR; PG8_SCHED;
            PG8_LDA(At, 1, 1); PG8_STAGE(PG8_SB(1, 0), b3, voffB); PG8_STAGE(PG8_SB(1, 1), b3 + hstep, voffB); PG8_STAGE(PG8_SA(1, 0), a3, voffA);
            PG8_WAIT_V(8); PG8_WAIT_L(0); PG8_BAR; PG8_MMA(1, 0, At, B0); PG8_MMA(1, 1, At, B1); PG8_BAR; PG8_SCHED;
            } else {
            PG8_LDB(B0, 0, 0); PG8_SCHED; PG8_LDA(At, 0, 0); PG8_STAGE(PG8_SA(1, 1), a1 + hstep, voffA);
            PG8_WAIT_L(8); PG8_BAR; PG8_WAIT_L(0); PG8_MMA(0, 0, At, B0); PG8_BAR; PG8_SCHED;
            PG8_LDB(B1, 0, 1); PG8_STAGE(PG8_SB(0, 0), b2, voffB);
            PG8_BAR; PG8_WAIT_L(0); PG8_MMA(0, 1, At, B1); PG8_BAR;
            PG8_LDA(At, 0, 1); PG8_STAGE(PG8_SA(0, 0), a2, voffA);
            PG8_BAR; PG8_WAIT_L(0); PG8_MMA(1, 0, At, B0); PG8_BAR; PG8_SCHED;
            PG8_STAGE(PG8_SB(0, 1), b2 + hstep, voffB);
            PG8_WAIT_V(6); PG8_BAR; PG8_MMA(1, 1, At, B1); PG8_BAR;
            PG8_LDB(B0, 1, 0); PG8_SCHED; PG8_LDA(At, 1, 0); PG8_STAGE(PG8_SA(0, 1), a2 + hstep, voffA);
            PG8_WAIT_L(8); PG8_BAR; PG8_WAIT_L(0); PG8_MMA(0, 0, At, B0); PG8_BAR; PG8_SCHED;
            PG8_LDB(B1, 1, 1); PG8_STAGE(PG8_SB(1, 0), b3, voffB);
            PG8_BAR; PG8_WAIT_L(0); PG8_MMA(0, 1, At, B1); PG8_BAR;
            PG8_LDA(At, 1, 1); PG8_STAGE(PG8_SA(1, 0), a3, voffA);
            PG8_BAR; PG8_WAIT_L(0); PG8_MMA(1, 0, At, B0); PG8_BAR; PG8_SCHED;
            PG8_STAGE(PG8_SB(1, 1), b3 + hstep, voffB);
            PG8_WAIT_V(6); PG8_BAR; PG8_MMA(1, 1, At, B1); PG8_BAR;
            }
        }
#if STAMP_PROBE == 8 && STAMP_STAT == 0
        const unsigned long long te0_ = __builtin_amdgcn_s_memrealtime();
#endif
        if constexpr (ALIGN_EPI) { if (wr == 0) PG8_BAR; }
#if STAMP_PROBE == 8 && STAMP_STAT != 0
        const unsigned long long te0_ = __builtin_amdgcn_s_memrealtime();
#endif
        if constexpr (!Epi::AFTER_DRAIN) { E(acc, cur, wr, wc, fr, fq); S.done(cur); }
#if STAMP_PROBE == 8
        if (tid == 0) *(PG8_LAS unsigned*)(lds + 131072 + 16) += (unsigned)(__builtin_amdgcn_s_memrealtime() - te0_);
#endif
        if (!has_next) break;
#pragma unroll
        for (int a = 0; a < 2; ++a)
#pragma unroll
            for (int b = 0; b < 2; ++b)
#pragma unroll
                for (int m = 0; m < 4; ++m)
#pragma unroll
                    for (int n = 0; n < 2; ++n) acc[a][b][m][n] = (f32x4){0.f, 0.f, 0.f, 0.f};
        cur = nxt; cA = nA; cB = nB; ++ui;
        if constexpr (ALIGN_EPI) { if (wr == 1) PG8_BAR; }
    }
    PG8_WAIT_V(0);
    if constexpr (!ALIGN_EPI) { if (wr == 0) PG8_BAR; }
    PG8_BAR;
    if constexpr (Epi::AFTER_DRAIN) { E.fused(acc, cur, wr, wc, fr, fq, lds, wid, lane); S.done(cur); }
#undef PG8_SA
#undef PG8_SB
#undef PG8_STAGE
#undef PG8_LDA
#undef PG8_LDB
#undef PG8_MMA
#undef PG8_WAIT_V
#undef PG8_WAIT_L
#undef PG8_BAR
#undef PG8_SCHED
}
}
namespace fa {
typedef unsigned short bf16;
typedef short bf16x8 __attribute__((ext_vector_type(8)));
typedef short s16x4 __attribute__((ext_vector_type(4)));
typedef float f32x16 __attribute__((ext_vector_type(16)));
typedef float f32x4 __attribute__((ext_vector_type(4)));
typedef unsigned u32x4 __attribute__((ext_vector_type(4)));
constexpr int D = 128, PITCH = 2048, SEQ = 8192, NHEAD = 16;
constexpr int NW = 8, QBLK = 32, KVBLK = 64, QB = NW * QBLK, NQB = SEQ / QB;
constexpr int SHM_V = KVBLK * D * 2, SHM_K = KVBLK * D * 2;
constexpr int F_OFF = 2 * SHM_V + 2 * SHM_K + NW * 64 * 4 + 2048;
constexpr int ATT_LDS_BYTES = F_OFF + SEQ * 4 + 256;
constexpr float THR2 = 60.0f;
#define FA_KSWZ(row, colB) ((row) * 256 + ((colB) ^ (((row) & 7) << 4)))
#define FA_SBAR() __builtin_amdgcn_sched_barrier(0)
__device__ __forceinline__ int v_st(int k, int c) { const int kk = (k & ~0xC) | ((k & 4) << 1) | ((k & 8) >> 1); return ((kk >> 3) * 4 + (c >> 5)) * 512 + ((kk & 7) * 32 + (c & 31)) * 2; }
__device__ __forceinline__ int v_rd_base(int lane) { return ((lane & 3) << 3) | (((lane >> 2) & 3) << 6) | (((lane >> 4) & 1) << 5) | (((lane >> 5) & 1) << 8); }
constexpr int v_rd_off(int d0, int ks, int half) { return d0 * 512 + ks * 4096 + half * 2048; }
__device__ __forceinline__ int crow(int r, int hi) { return (r & 3) + 8 * (r >> 2) + 4 * hi; }
__device__ __forceinline__ unsigned cvtpk(float lo, float hi) { unsigned r; asm volatile("v_cvt_pk_bf16_f32 %0, %1, %2" : "=v"(r) : "v"(lo), "v"(hi)); return r; }
__device__ __forceinline__ bf16x8 load8(const bf16* p) { return *reinterpret_cast<const bf16x8*>(p); }
__device__ __forceinline__ void mask_tile(f32x16& p0, f32x16& p1, int dq) {
#pragma unroll
    for (int r = 0; r < 16; ++r) { const int c = (r & 3) + 8 * (r >> 2);
        const float t0 = __uint_as_float(0x7f800000u | ((unsigned)(dq - c) & 0x80000000u)), t1 = __uint_as_float(0x7f800000u | ((unsigned)(dq - c - 32) & 0x80000000u));
        p0[r] = fminf(p0[r], t0); p1[r] = fminf(p1[r], t1); }
}
__device__ __forceinline__ void partialSM(f32x16& p0, f32x16& p1, float& m_reg, float& mn, float& alpha) {
    float pmax = p0[0];
#pragma unroll
    for (int r = 1; r < 16; ++r) pmax = fmaxf(pmax, p0[r]);
#pragma unroll
    for (int r = 0; r < 16; ++r) pmax = fmaxf(pmax, p1[r]);
    { auto rr = __builtin_amdgcn_permlane32_swap(__float_as_uint(pmax), __float_as_uint(pmax), false, false);
      pmax = fmaxf(__uint_as_float(rr[0]), __uint_as_float(rr[1])); }
    if (__builtin_expect(__all((pmax - m_reg) <= THR2), 1)) { mn = m_reg; alpha = 1.f; }
    else { mn = fmaxf(m_reg, pmax); alpha = __builtin_amdgcn_exp2f(m_reg - mn); m_reg = mn; }
#pragma unroll
    for (int r = 0; r < 16; ++r) p0[r] = p0[r] - mn;
#pragma unroll
    for (int r = 0; r < 16; ++r) p1[r] = p1[r] - mn;
#pragma unroll
    for (int r = 0; r < 16; ++r) p0[r] = __builtin_amdgcn_exp2f(p0[r]);
}
__device__ __forceinline__ void finishSM(f32x16& p0, f32x16& p1, float alpha, float& l_reg, bf16x8& pa0, bf16x8& pa1, bf16x8& pa2, bf16x8& pa3) {
#pragma unroll
    for (int r = 0; r < 16; ++r) p1[r] = __builtin_amdgcn_exp2f(p1[r]);
    float ps = 0;
#pragma unroll
    for (int r = 0; r < 16; ++r) ps += p0[r];
#pragma unroll
    for (int r = 0; r < 16; ++r) ps += p1[r];
    { auto rr = __builtin_amdgcn_permlane32_swap(__float_as_uint(ps), __float_as_uint(ps), false, false);
      ps = __uint_as_float(rr[0]) + __uint_as_float(rr[1]); }
    l_reg = l_reg * alpha + ps;
#define FA_PK4(P, B_, OUT) do { unsigned a0 = cvtpk(P[B_+0], P[B_+1]), a1 = cvtpk(P[B_+2], P[B_+3]);                          \
        unsigned b0 = cvtpk(P[B_+4], P[B_+5]), b1 = cvtpk(P[B_+6], P[B_+7]);                                             \
        auto r0 = __builtin_amdgcn_permlane32_swap(a0, b0, false, false); auto r1 = __builtin_amdgcn_permlane32_swap(a1, b1, false, false); \
        u32x4 w = {r0[0], r1[0], r0[1], r1[1]}; OUT = *reinterpret_cast<bf16x8*>(&w); } while (0)
    FA_PK4(p0, 0, pa0); FA_PK4(p0, 8, pa1); FA_PK4(p1, 0, pa2); FA_PK4(p1, 8, pa3);
#undef FA_PK4
}
template <int KB>
__device__ __forceinline__ void qkt(f32x16& p0, f32x16& p1, const char* K_lds, int r32, int hi, const bf16x8* qr, const __attribute__((address_space(3))) float* fl) {
#pragma unroll
    for (int g = 0; g < 4; ++g) { const f32x4 a = *(const __attribute__((address_space(3))) f32x4*)(fl + 8 * g), b = *(const __attribute__((address_space(3))) f32x4*)(fl + 32 + 8 * g);
#pragma unroll
        for (int i = 0; i < 4; ++i) { p0[4 * g + i] = a[i]; p1[4 * g + i] = b[i]; } }
    const char* kb[4];
#pragma unroll
    for (int dd = 0; dd < 4; ++dd) kb[dd] = K_lds + KB * SHM_K + FA_KSWZ(r32, (dd * 16 + hi * 8) * 2);
#pragma unroll
    for (int d0 = 0; d0 < 8; ++d0) { const char* a = kb[d0 & 3] + (d0 >> 2) * 128;
        bf16x8 b0 = *reinterpret_cast<const bf16x8*>(a);
        bf16x8 b1 = *reinterpret_cast<const bf16x8*>(a + 32 * 256);
        p0 = __builtin_amdgcn_mfma_f32_32x32x16_bf16(b0, qr[d0], p0, 0, 0, 0);
        p1 = __builtin_amdgcn_mfma_f32_32x32x16_bf16(b1, qr[d0], p1, 0, 0, 0); }
}
template <int VB>
__device__ __forceinline__ void pv_tile(f32x16* o, int vb0, bf16x8 pa0, bf16x8 pa1, bf16x8 pa2, bf16x8 pa3) {
#define FA_TRRD(dst, off) asm volatile("ds_read_b64_tr_b16 %0, %1 offset:%2" : "=&v"(dst) : "v"(vb0), "i"(off) : "memory")
#define FA_PV_D0(d0) do { s16x4 l0, l1, l2, l3, h0, h1, h2, h3; constexpr int b_ = VB * SHM_V + v_rd_off(d0, 0, 0); \
        FA_TRRD(l0, b_); FA_TRRD(h0, b_ + 2048); FA_TRRD(l1, b_ + 4096); FA_TRRD(h1, b_ + 6144); FA_TRRD(l2, b_ + 8192); FA_TRRD(h2, b_ + 10240); FA_TRRD(l3, b_ + 12288); FA_TRRD(h3, b_ + 14336); \
        asm volatile("s_waitcnt lgkmcnt(0)" ::: "memory"); FA_SBAR();   \
        o[d0] = __builtin_amdgcn_mfma_f32_32x32x16_bf16(pa0, (bf16x8){l0[0], l0[1], l0[2], l0[3], h0[0], h0[1], h0[2], h0[3]}, o[d0], 0, 0, 0);   \
        o[d0] = __builtin_amdgcn_mfma_f32_32x32x16_bf16(pa1, (bf16x8){l1[0], l1[1], l1[2], l1[3], h1[0], h1[1], h1[2], h1[3]}, o[d0], 0, 0, 0);   \
        o[d0] = __builtin_amdgcn_mfma_f32_32x32x16_bf16(pa2, (bf16x8){l2[0], l2[1], l2[2], l2[3], h2[0], h2[1], h2[2], h2[3]}, o[d0], 0, 0, 0);   \
        o[d0] = __builtin_amdgcn_mfma_f32_32x32x16_bf16(pa3, (bf16x8){l3[0], l3[1], l3[2], l3[3], h3[0], h3[1], h3[2], h3[3]}, o[d0], 0, 0, 0); } while (0)
    FA_PV_D0(0); FA_PV_D0(1); FA_PV_D0(2); FA_PV_D0(3);
#undef FA_PV_D0
#undef FA_TRRD
}
constexpr size_t BUF = (size_t)16384 * 2048;
struct BlockRef { const bf16* Q; const bf16* K; int P0; int jlo; };
#ifndef FA_SELFCHECK
#define FA_SELFCHECK 0
#endif
#if FA_SELFCHECK
#endif
struct Seam { bf16x8 qr[8]; bf16x8 st_v0, st_v1, st_k0, st_k1; };
#define FA_TILE(p, k0, half) ((const char*)(p) + ((size_t)((k0) + 32 * (half)) * PITCH * 2))
#define FA_VMW() asm volatile("s_waitcnt vmcnt(0)" ::: "memory")
#define FA_VMWN(n) asm volatile("s_waitcnt vmcnt(%0)" :: "i"(n) : "memory")
#define FA_SLOAD(Kp, Vp, k0) do { S.st_v0 = load8((const bf16*)(FA_TILE(Vp, k0, 0) + svoff)); S.st_v1 = load8((const bf16*)(FA_TILE(Vp, k0, 1) + svoff));              \
                         S.st_k0 = load8((const bf16*)(FA_TILE(Kp, k0, 0) + svoff)); S.st_k1 = load8((const bf16*)(FA_TILE(Kp, k0, 1) + svoff)); } while (0)
#define FA_SWRITE_K(bf) do { *(bf16x8*)(K_lds + (bf) * SHM_K + kws) = S.st_k0; *(bf16x8*)(K_lds + (bf) * SHM_K + kws + 32 * 256) = S.st_k1; } while (0)
#define FA_SWRITE_V(bf) do { *(bf16x8*)(V_lds + (bf) * SHM_V + vst0) = S.st_v0; *(bf16x8*)(V_lds + (bf) * SHM_V + vst1) = S.st_v1; } while (0)
#define FA_SWRITE(bf) do { FA_SWRITE_V(bf); FA_SWRITE_K(bf); } while (0)
__device__ __forceinline__ void attn_prime(const BlockRef& cur, char* lds, Seam& S, const int tid) {
    const int wid = __builtin_amdgcn_readfirstlane(tid >> 6), lane = tid & 63, r32 = lane & 31, hi = lane >> 5;
    const int sr = tid >> 4, sc = (tid & 15) * 8, kws = FA_KSWZ(sr, sc * 2); const unsigned svoff = (unsigned)(sr * PITCH + sc) * 2u; char* K_lds = lds + 2 * SHM_V;
#pragma unroll
    for (int d0 = 0; d0 < 8; ++d0) S.qr[d0] = load8(cur.Q + (size_t)(wid * QBLK + r32) * PITCH + d0 * 16 + hi * 8);
    FA_SLOAD(cur.K, cur.K + BUF, cur.jlo * KVBLK); FA_VMW(); FA_SWRITE_K(0);
    __syncthreads();
}
__device__ __forceinline__ void attn_block(const BlockRef& cur, const BlockRef& nxt, char* lds, Seam& S, const int tid, const int obuf = 5) {
    const int wid = __builtin_amdgcn_readfirstlane(tid >> 6), lane = tid & 63, r32 = lane & 31, hi = lane >> 5;
    const int j_lo = cur.jlo, NT = cur.P0 / KVBLK + QB / KVBLK - j_lo;
    const int qlo = cur.P0 + wid * QBLK, qm = qlo + r32 - 4 * hi;
    char* V_lds = lds; char* K_lds = lds + 2 * SHM_V;
    float* ws = (float*)(lds + 2 * SHM_V + 2 * SHM_K) + wid * 64; float* li_l = ws, * al_l = ws + 32;
    const __attribute__((address_space(3))) float* Fl = (const __attribute__((address_space(3))) float*)((__attribute__((address_space(3))) char*)lds + F_OFF) + 4 * hi;
    float m_reg = -1e30f, l_reg = 0; f32x16 o[4] = {};
    const int sr = tid >> 4, sc = (tid & 15) * 8, vst0 = v_st(sr, sc), vst1 = vst0 + 8192  , kws = FA_KSWZ(sr, sc * 2); const unsigned svoff = (unsigned)(sr * PITCH + sc) * 2u;
    const int vb0 = (int)(uintptr_t)V_lds + v_rd_base(lane);
    const bf16* Kh = cur.K; const bf16* Vh = cur.K + BUF;
#define FA_RESC(a) do { if (__any((a) < 1.f)) { if (hi == 0) al_l[r32] = (a); asm volatile("s_waitcnt lgkmcnt(0)" ::: "memory");              \
                     for (int d_ = 0; d_ < 4; ++d_) for (int r = 0; r < 16; ++r) o[d_][r] *= al_l[crow(r, hi)]; } } while (0)
#define FA_KBASE(t) ((j_lo + (t)) * KVBLK)
#define FA_BIASMASK(P0_, P1_, t) do { const int kb_ = FA_KBASE(t); if (kb_ + KVBLK - 1 > qlo) mask_tile(P0_, P1_, qm - kb_); } while (0)
    constexpr int NQL = 8;
#define FA_SEAM_K0() do { FA_VMWN(NQL); FA_SWRITE_K(0); FA_SBAR(); } while (0)
    f32x16 pA0, pA1, pB0, pB1; float mnA, mnB, alA, alB; bf16x8 pa0, pa1, pa2, pa3;
    FA_SWRITE_V(0); FA_SBAR();
    if (NT > 1) { FA_SLOAD(Kh, Vh, FA_KBASE(1)); }
    FA_SBAR(); qkt<0>(pA0, pA1, K_lds, r32, hi, S.qr, Fl + FA_KBASE(0));
    FA_BIASMASK(pA0, pA1, 0); partialSM(pA0, pA1, m_reg, mnA, alA);
    if (NT > 1) { FA_VMW(); FA_SWRITE(1); }
    __syncthreads();
#define FA_HALF_STEP(PX0, PX1, mnX, alX, PY0, PY1, alY, t, KB, VB, SB) do {                                                      \
        FA_SBAR(); qkt<KB>(PX0, PX1, K_lds, r32, hi, S.qr, Fl + FA_KBASE(t));                                             \
        finishSM(PY0, PY1, alY, l_reg, pa0, pa1, pa2, pa3); FA_SBAR();                                                           \
        if ((t) + 1 < NT) { FA_SLOAD(Kh, Vh, FA_KBASE((t) + 1)); FA_SBAR(); }                                               \
        pv_tile<VB>(o, vb0, pa0, pa1, pa2, pa3); FA_BIASMASK(PX0, PX1, (t)); partialSM(PX0, PX1, m_reg, mnX, alX);                                        \
        __syncthreads();                                                                                                      \
        if ((t) + 1 < NT) { FA_VMW(); FA_SWRITE(SB); }                                                                          \
        FA_RESC(alX); __syncthreads(); } while (0)
    for (int t = 1; t + 1 < NT; t += 2) {
        FA_HALF_STEP(pB0, pB1, mnB, alB, pA0, pA1, alA, t, 1, 0, 0);
        FA_HALF_STEP(pA0, pA1, mnA, alA, pB0, pB1, alB, t + 1, 0, 1, 1);
    }
    const bool even = (NT & 1) == 0;
    if (even) { FA_SBAR(); qkt<1>(pB0, pB1, K_lds, r32, hi, S.qr, Fl + FA_KBASE(NT - 1)); FA_SBAR(); }
    FA_SLOAD(nxt.K, nxt.K + BUF, nxt.jlo * KVBLK); FA_SBAR();
#pragma unroll
    for (int d0 = 0; d0 < 8; ++d0) S.qr[d0] = load8(nxt.Q + (size_t)(wid * QBLK + r32) * PITCH + d0 * 16 + hi * 8);
    FA_SBAR();
    finishSM(pA0, pA1, alA, l_reg, pa0, pa1, pa2, pa3); FA_SBAR();
    pv_tile<0>(o, vb0, pa0, pa1, pa2, pa3);
    if (even) { FA_BIASMASK(pB0, pB1, NT - 1); partialSM(pB0, pB1, m_reg, mnB, alB); __syncthreads(); FA_RESC(alB);
        finishSM(pB0, pB1, alB, l_reg, pa0, pa1, pa2, pa3); FA_SBAR(); pv_tile<1>(o, vb0, pa0, pa1, pa2, pa3); }
    FA_SBAR(); FA_SEAM_K0();
    if (hi == 0) li_l[r32] = l_reg; asm volatile("s_waitcnt lgkmcnt(0)" ::: "memory");
    float rli[16];
#pragma unroll
    for (int r = 0; r < 16; ++r) rli[r] = __builtin_amdgcn_rcpf(li_l[crow(r, hi)]);
    bf16* Ow = const_cast<bf16*>(cur.Q) + (size_t)obuf * BUF + (size_t)(wid * QBLK) * PITCH;
    __attribute__((address_space(3))) char* stg = (__attribute__((address_space(3))) char*)lds + F_OFF + wid * 4096;
#pragma unroll
    for (int p = 0; p < 2; ++p) {
#pragma unroll
        for (int rr = 0; rr < 8; ++rr) { const int r = 8 * p + rr, rl = crow(r, hi) - 16 * p;
#pragma unroll
            for (int d0 = 0; d0 < 4; ++d0) { const float v = o[d0][r] * rli[r];
                *(__attribute__((address_space(3))) unsigned short*)(stg + rl * 256 + (d0 * 32 + r32) * 2) = (unsigned short)cvtpk(v, v); } }
        asm volatile("s_waitcnt lgkmcnt(0)" ::: "memory");
#pragma unroll
        for (int k = 0; k < 4; ++k) { const int q = lane + 64 * k; const u32x4 w = *(const __attribute__((address_space(3))) u32x4*)(stg + q * 16);
            *(u32x4*)(Ow + (size_t)(16 * p + (q >> 4)) * PITCH + (q & 15) * 8) = w; }
    }
    __syncthreads();
#undef FA_RESC
#undef FA_KBASE
#undef FA_BIASMASK
#undef FA_SEAM_K0
#undef FA_HALF_STEP
}
#undef FA_TILE
#undef FA_VMW
#undef FA_VMWN
#undef FA_SLOAD
#undef FA_SWRITE_K
#undef FA_SWRITE_V
#undef FA_SWRITE
__device__ __forceinline__ BlockRef block_ref(int bh, int qb, int jlo, const bf16* Q) {
    const int b = bh >> 4, h = bh & 15; BlockRef r;
    r.Q = Q + ((size_t)b * SEQ + (size_t)qb * QB) * PITCH + (size_t)h * D; r.K = Q + BUF + (size_t)b * SEQ * PITCH + (size_t)h * D; r.P0 = qb * QB; r.jlo = jlo; return r;
}
__device__ __forceinline__ void load_bias(char* lds, const float* FB, int bh, int k_lo, int k_hi, const int tid) {
    const f32x4* src = (const f32x4*)(FB + (size_t)bh * SEQ); __attribute__((address_space(3))) f32x4* dst = (__attribute__((address_space(3))) f32x4*)((__attribute__((address_space(3))) char*)lds + F_OFF);
    int t0 = tid; asm volatile("" : "+v"(t0));
    for (int i = k_lo / 4 + t0; i < k_hi / 4; i += NW * 64) dst[i] = src[i];
    __syncthreads();
}
#ifndef FA_PRUNE
#define FA_PRUNE 1
#endif
constexpr float PRUNE_T2 = 44.0f;
constexpr int NTICKETS = (1 + (((DUP_MASK) >> 3) & 1)) * 2 * NHEAD * NQB;
constexpr int XQ_OFF = F_OFF + SEQ * 4;
struct Ticket { int idx, bh, qb, jlo; };
constexpr int ORD_OFF = 104448;
static_assert(ORD_OFF >= ATT_LDS_BYTES, "order table behind the attention image");
__device__ __forceinline__ void build_order(char* lds, const float* FB, const unsigned* qkmax, const int tid) {
    __attribute__((address_space(3))) unsigned short* ord = (__attribute__((address_space(3))) unsigned short*)((__attribute__((address_space(3))) char*)lds + ORD_OFF);
    __attribute__((address_space(3))) int* Wc = (__attribute__((address_space(3))) int*)((__attribute__((address_space(3))) char*)lds + ORD_OFF + 2048);
    int t0 = tid; asm volatile("" : "+v"(t0));
    if (t0 < 2 * NHEAD) { float smax = 0.f;
#pragma unroll
        for (int w = 0; w < 4; ++w) smax += sqrtf(__uint_as_float(qkmax[(t0 * 2 + 0) * 4 + w]) * __uint_as_float(qkmax[(t0 * 2 + 1) * 4 + w]));
        const float fe = FB[(size_t)t0 * SEQ + SEQ - 1];
        const float win = (PRUNE_T2 + smax * 1.02f + 8.5f) * (float)SEQ / fmaxf(fe, 1.0f);
        Wc[t0] = (int)fminf(win * (1.0f / KVBLK) + 1.0f, 124.0f) + 4; }
    __syncthreads();
#pragma unroll 1
    for (int id = t0; id < 2 * NHEAD * NQB; id += NW * 64) {
        const int qb = NQB - 1 - (id >> 5), bh = id & 31, c0 = 4 * qb + 4, c1 = Wc[bh], c = c0 < c1 ? c0 : c1;
        const int fl = c >> 2, qa = (c - 1) >> 2, qe = (c - 4) >> 2; const bool m4 = (c & 3) == 0;
        const int ngt = 32 - (fl < 32 ? fl : 32), neq = (32 - (qa > qb + 1 ? qa : qb + 1)) > 0 ? 32 - (qa > qb + 1 ? qa : qb + 1) : 0;
        int pos = 0;
#pragma unroll 1
        for (int j = 0; j < 2 * NHEAD; ++j) { const int wj = Wc[j];
            if (wj > c) pos += ngt + ((m4 && (qe > qb || (qe == qb && j < bh))) ? 1 : 0);
            else if (wj == c) pos += neq + ((qb >= qa && j < bh) ? 1 : 0); }
        ord[pos] = (unsigned short)id; }
    __syncthreads();
}
__device__ __forceinline__ Ticket next_block(char* lds, const bf16* Q, const float* FB, const unsigned* qkmax, unsigned* qhead, const int tid, const bool prune = true) {
    __attribute__((address_space(3))) int* xi = (__attribute__((address_space(3))) int*)((__attribute__((address_space(3))) char*)lds + XQ_OFF);
    __attribute__((address_space(3))) float* xf = (__attribute__((address_space(3))) float*)(xi + 16);
    int t0 = tid; asm volatile("" : "+v"(t0));
    const int wid = __builtin_amdgcn_readfirstlane(t0 >> 6), lane = t0 & 63;
    if (t0 == 0) xi[0] = (int)__hip_atomic_fetch_add(qhead, 1u, __ATOMIC_RELAXED, __HIP_MEMORY_SCOPE_AGENT);
    __syncthreads();
    Ticket T; T.idx = xi[0]; { const int id = ((const __attribute__((address_space(3))) unsigned short*)((__attribute__((address_space(3))) char*)lds + ORD_OFF))[T.idx % (2 * NHEAD * NQB)]; T.qb = NQB - 1 - (id >> 5); T.bh = id & 31; } T.jlo = 0;
    if (T.idx >= NTICKETS) { __syncthreads(); return T; }
    const int b = T.bh >> 4, h = T.bh & 15, P0 = T.qb * QB;
#if FA_PRUNE
    const int row = t0 >> 1, half = t0 & 1;
    const int nb0 = P0 / KVBLK;
    const float fbend = (t0 < nb0) ? FB[(size_t)T.bh * SEQ + t0 * KVBLK + KVBLK - 1] : 0.f;
    const bf16* qp = Q + ((size_t)b * SEQ + P0 + row) * PITCH + (size_t)h * D + 64 * half; const bf16* kp = qp + BUF;
    float d = 0.f, nq[2] = {0.f, 0.f};
#pragma unroll
    for (int c = 0; c < 8; ++c) { const u32x4 qa = *(const u32x4*)(qp + 8 * c), ka = *(const u32x4*)(kp + 8 * c);
#pragma unroll
        for (int e = 0; e < 4; ++e) { const float q0 = __uint_as_float(qa[e] << 16), q1 = __uint_as_float(qa[e] & 0xffff0000u);
            d += q0 * __uint_as_float(ka[e] << 16); d += q1 * __uint_as_float(ka[e] & 0xffff0000u); nq[c >> 2] += q0 * q0 + q1 * q1; } }
    float bt = sqrtf(nq[0] * __uint_as_float(qkmax[(T.bh * 2 + 1) * 4 + 2 * half])) + sqrtf(nq[1] * __uint_as_float(qkmax[(T.bh * 2 + 1) * 4 + 2 * half + 1]));
    d += __shfl_xor(d, 1); bt += __shfl_xor(bt, 1);
    d += FB[(size_t)T.bh * SEQ + P0 + row];
    d -= bt * 1.02f + 0.5f;
#pragma unroll
    for (int o = 2; o < 64; o <<= 1) d = fminf(d, __shfl_xor(d, o));
    if (lane == 0) xf[wid] = d;
    __syncthreads();
    float mmin = xf[0];
#pragma unroll
    for (int w = 1; w < 8; ++w) mmin = fminf(mmin, xf[w]);
    const float thresh = prune ? mmin - PRUNE_T2 : -__builtin_inff();
    const bool skip = (t0 < nb0) && (fbend < thresh);
    const unsigned long long bal = __ballot(skip);
    if (lane == 0) xi[8 + wid] = __popcll(bal);
    __syncthreads();
    T.jlo = xi[8] + xi[9];
    __syncthreads();
#else
    __syncthreads();
#endif
    return T;
}
__device__ __forceinline__ void attn_phase(char* lds, const bf16* Q, const float* FB, const unsigned* qkmax, unsigned* qhead, const int tid, const bool prune = true, const int obuf = 5) {
    build_order(lds, FB, qkmax, tid);
    Ticket tc = next_block(lds, Q, FB, qkmax, qhead, tid, prune);
    if (tc.idx >= NTICKETS) return;
    BlockRef cur = block_ref(tc.bh, tc.qb, tc.jlo, Q);
    Seam S;
    load_bias(lds, FB, tc.bh, tc.jlo * KVBLK, (tc.qb + 1) * QB, tid);
    attn_prime(cur, lds, S, tid);
    for (;;) {
        const Ticket tn = next_block(lds, Q, FB, qkmax, qhead, tid, prune);
        const bool last = tn.idx >= NTICKETS;
        const BlockRef nxt = last ? cur : block_ref(tn.bh, tn.qb, tn.jlo, Q);
        attn_block(cur, nxt, lds, S, tid, obuf);
        if (last) break;
        load_bias(lds, FB, tn.bh, tn.jlo * KVBLK, (tn.qb + 1) * QB, tid);
        cur = nxt;
    }
}
}

constexpr int NWAVES = 8;
constexpr int BATCH = 2, SEQ = 8192, DM = 4096, NH = 16, HD = 128, AW = 2048, CW = 2048, DFF = 11008, NIN = 12304;
constexpr int M = BATCH * SEQ;
constexpr int NPROJ = 12288;
constexpr int NGU = 2 * DFF;
constexpr float EPS = 1e-6f;
constexpr float QSCALE = 0.08838834764831845f * 1.4426950408889634f;
#ifndef MK_N_LAUNCHES
#define MK_N_LAUNCHES 1
#endif
constexpr int N_PHASES = 10;

#ifndef PG8_ALIGN
#define PG8_ALIGN true
#endif
#ifndef PG8_SP2
#define PG8_SP2 true
#endif
constexpr size_t MiB = 1u << 20;
constexpr size_t WS_CTL = 0, CTL_ZERO_BYTES = 1 * MiB;
constexpr size_t WS_MOD = 512 * 1024;
constexpr size_t WS_WF = 1 * MiB;
constexpr size_t WS_FT = 2 * MiB;
constexpr size_t WS_FB = 3 * MiB;
constexpr size_t WS_WIN = 4 * MiB;
constexpr size_t WS_WOUT = WS_WIN + (size_t)NPROJ * DM * 2;
constexpr size_t WS_WGU = WS_WOUT + (size_t)DM * DM * 2;
constexpr size_t WS_WD = WS_WGU + (size_t)NGU * DM * 2;
constexpr size_t WS_H = WS_WD + (size_t)DM * DFF * 2;
constexpr size_t WS_Q = WS_H + (size_t)M * DM * 2;
constexpr size_t WS_K = WS_Q + (size_t)M * 2048 * 2, WS_V = WS_K + (size_t)M * 2048 * 2, WS_GB = WS_V + (size_t)M * 2048 * 2, WS_CU = WS_GB + (size_t)M * 2048 * 2, WS_YA = WS_CU + (size_t)M * 2048 * 2;
constexpr size_t WS_ACT = WS_Q;
constexpr size_t WS_HM = WS_YA + (size_t)M * 2048 * 2;
constexpr size_t WS_END = WS_HM + (size_t)M * DM * 2;
static_assert(WS_ACT + (size_t)M * DFF * 2 <= WS_HM, "ACT overlay fits inside Q..YA");
static_assert(WS_WIN % 256 == 0 && WS_WOUT % 256 == 0 && WS_WGU % 256 == 0 && WS_WD % 256 == 0 && WS_H % 256 == 0 && WS_Q % 256 == 0 && WS_HM % 256 == 0, "alignment");
constexpr int CW_BAR = 4096;
constexpr int CW_VX = 7680, CW_BAD = 7744, CW_LB = 8192;
constexpr int CW_CV = 1536, CW_OWN = 2048;
constexpr int CW_QHEAD = 512, CW_QKMAX = 1024;
constexpr int RING_BYTES = 131072, LDSCTL_OFF = RING_BYTES, MISC_OFF = LDSCTL_OFF + 320, LDS_BYTES = 147456;
static_assert(fa::ATT_LDS_BYTES <= RING_BYTES, "attention LDS");
static_assert(WS_K - WS_Q == fa::BUF * 2 && WS_V - WS_K == fa::BUF * 2 && WS_YA - WS_Q == 5 * fa::BUF * 2, "attention tensor spacing");

#define GAS __attribute__((address_space(1)))
#define LAS __attribute__((address_space(3)))
typedef unsigned short bf16;
typedef unsigned v4u __attribute__((ext_vector_type(4)));
typedef unsigned v2u __attribute__((ext_vector_type(2)));
typedef float f32x4 __attribute__((ext_vector_type(4)));
typedef short bf16x8 __attribute__((ext_vector_type(8)));
typedef GAS unsigned gu32;
#define RLX_AGENT __ATOMIC_RELAXED, __HIP_MEMORY_SCOPE_AGENT
#define LDS_WAIT() asm volatile("s_waitcnt lgkmcnt(0)" ::: "memory")
#define VM_WAIT() asm volatile("s_waitcnt vmcnt(0)" ::: "memory")
__device__ __forceinline__ unsigned f2bf(float f) { unsigned u = __builtin_bit_cast(unsigned, f); return (u + 0x7fffu + ((u >> 16) & 1u)) >> 16; }
__device__ __forceinline__ unsigned pk2(float lo, float hi) { return f2bf(lo) | (f2bf(hi) << 16); }
__device__ __forceinline__ float bflo(unsigned w) { return __builtin_bit_cast(float, w << 16); }
__device__ __forceinline__ float bfhi(unsigned w) { return __builtin_bit_cast(float, w & 0xffff0000u); }
__device__ __forceinline__ float wave_sum(float v) {
#pragma unroll
    for (int o = 1; o < 64; o <<= 1) v += __shfl_xor(v, o);
    return v;
}
__device__ __forceinline__ int xcd_row_block(int bid, int G) { return (G == 256) ? 32 * (bid & 7) + (bid >> 3) : bid; }
#define XB_TMO      128
#define XB_XCNT(j)  (256  + 64 * (j))
#define XB_XSUB(j)  (1280 + 64 * (j))
#define XB_XGEN(j)  (2304 + 64 * (j))
#define XB_TOP      3328
#define XB_TOPGEN   3392
#define XCD_BAR_WORDS 3456
#define XB_SPIN_CAP (1u << 18)
#ifndef XB_DIRECT_RELEASE
#define XB_DIRECT_RELEASE 0
#endif
#ifndef XB_EARLY_WB
#define XB_EARLY_WB 0u
#endif

__device__ __forceinline__ unsigned xb_ld(unsigned* p)              { return __hip_atomic_load(p, __ATOMIC_RELAXED, __HIP_MEMORY_SCOPE_AGENT); }
__device__ __forceinline__ unsigned xb_add(unsigned* p, unsigned v) { return __hip_atomic_fetch_add(p, v, __ATOMIC_RELAXED, __HIP_MEMORY_SCOPE_AGENT); }
__device__ __forceinline__ unsigned xb_xcc_id() { return (unsigned)__builtin_amdgcn_s_getreg((3 << 11) | 20) & 0xFu; }
#define XB_SPIN(cond, bar) do { unsigned _sp = 0; while (cond) { __builtin_amdgcn_s_sleep(1); \
    if ((++_sp & 255u) == 0u) { if (xb_ld(&(bar)[XB_TMO])) break; if (_sp > XB_SPIN_CAP) { atomicAdd(&(bar)[XB_TMO], 1u); break; } } } } while (0)

struct XcdBarrier {
    unsigned* bar; unsigned x;
    volatile LAS unsigned* st;
};

__device__ __forceinline__ XcdBarrier xcd_barrier_post(unsigned* bar, volatile LAS unsigned* st, const int tid) {
    XcdBarrier b; b.bar = bar; b.x = xb_xcc_id(); b.st = st;
    if (tid == 0) (void)xb_add(&bar[XB_XCNT(b.x)], 1u);
    return b;
}
__device__ __forceinline__ void xcd_barrier_complete(unsigned* bar, unsigned x, unsigned& nloc, unsigned& nx) {
    const unsigned G = gridDim.x * gridDim.y * gridDim.z;
    unsigned sum, cnt, mine, sp = 0u;
    for (;;) {
        sum = 0u; cnt = 0u; mine = 0u;
#pragma unroll
        for (unsigned j = 0; j < 16; ++j) { const unsigned c = xb_ld(&bar[XB_XCNT(j)]); sum += c; cnt += (c > 0u) ? 1u : 0u; mine = (j == x) ? c : mine; }
        if (sum == G) break;
        __builtin_amdgcn_s_sleep(1);
        if ((++sp & 255u) == 0u) { if (xb_ld(&bar[XB_TMO])) break; if (sp > XB_SPIN_CAP) { atomicAdd(&bar[XB_TMO], 1u); break; } }
    }
    nloc = mine > 0u ? mine : 1u; nx = cnt > 0u ? cnt : 1u;
}

__device__ __forceinline__ void xcd_barrier(const XcdBarrier& b, const int tid) {
    asm volatile("s_waitcnt vmcnt(0)" ::: "memory");
    __syncthreads();
    if (tid == 0) {
        unsigned* bar = b.bar;
        __builtin_amdgcn_s_waitcnt(0);
        unsigned nloc = b.st[0], nx = b.st[1];
        if (nloc == 0u) { xcd_barrier_complete(bar, b.x, nloc, nx); b.st[0] = nloc; b.st[1] = nx; }
        const unsigned old = xb_add(&bar[XB_XSUB(b.x)], 1u);
        const unsigned gen = old / nloc;
        if (old + 1u == (gen + 1u) * nloc) {
#if XB_DIRECT_RELEASE
            const unsigned cntl = b.st[2]; b.st[2] = cntl + 1u;
#endif
#if STAMP_PROBE == 7
            const unsigned long long tw0_ = __builtin_amdgcn_s_memrealtime();
#endif
            __builtin_amdgcn_fence(__ATOMIC_RELEASE, "agent");
            asm volatile("s_waitcnt vmcnt(0)" ::: "memory");
#if STAMP_PROBE == 7
            xb_add(&bar[XB_TMO + 64], (unsigned)(__builtin_amdgcn_s_memrealtime() - tw0_));
#endif
            const unsigned og = xb_add(&bar[XB_TOP], 1u);
            const unsigned tg = og / nx;
#if XB_DIRECT_RELEASE == 2
            (void)tg; if (og + 1u != (cntl + 1u) * nx) XB_SPIN(xb_ld(&bar[XB_TOP]) < (cntl + 1u) * nx, bar);
#else
            if (og + 1u == (tg + 1u) * nx) xb_add(&bar[XB_TOPGEN], 1u);
            else XB_SPIN(xb_ld(&bar[XB_TOPGEN]) == tg, bar);
#endif
            __builtin_amdgcn_fence(__ATOMIC_ACQUIRE, "agent");
            xb_add(&bar[XB_XGEN(b.x)], 1u);
            asm volatile("s_waitcnt vmcnt(0)" ::: "memory");
        } else {
#if XB_DIRECT_RELEASE
            const unsigned cnt = b.st[2]; b.st[2] = cnt + 1u;
#if XB_DIRECT_RELEASE == 2
            XB_SPIN(xb_ld(&bar[XB_TOP]) < (cnt + 1u) * nx, bar);
#else
            XB_SPIN(xb_ld(&bar[XB_TOPGEN]) == cnt, bar);
#endif
            __builtin_amdgcn_fence(__ATOMIC_ACQUIRE, "agent");
            asm volatile("s_waitcnt vmcnt(0)" ::: "memory");
        } if (false) {
#endif
#if XB_EARLY_WB
            if (((old - gen * nloc) & (XB_EARLY_WB - 1u)) == 0u) { __builtin_amdgcn_fence(__ATOMIC_RELEASE, "agent"); asm volatile("s_waitcnt vmcnt(0)" ::: "memory"); }
#endif
            XB_SPIN(xb_ld(&bar[XB_XGEN(b.x)]) == gen, bar);
            __builtin_amdgcn_fence(__ATOMIC_ACQUIRE, "agent");
            asm volatile("s_waitcnt vmcnt(0)" ::: "memory");
        }
    }
    __syncthreads();
}
__device__ __forceinline__ void xcd_local_check(unsigned* ctl, int bid, int G, const int tid) {
    if (tid == 0) { const unsigned me = xb_xcc_id() + 1u; unsigned e = 0u;
        __hip_atomic_compare_exchange_strong(ctl + CW_VX + (bid & 7), &e, me, __ATOMIC_RELAXED, __ATOMIC_RELAXED, __HIP_MEMORY_SCOPE_AGENT);
        if ((e != 0u && e != me) || G != 256) __hip_atomic_store(ctl + CW_BAD, 1u, __ATOMIC_RELAXED, __HIP_MEMORY_SCOPE_AGENT); }
}
__device__ __forceinline__ void xcd_local_seam(unsigned* ctl, int slot, int bid, int G, const int tid) {
    asm volatile("s_waitcnt vmcnt(0)" ::: "memory");
    __syncthreads();
    if (tid == 0) {
        unsigned* bar = ctl + CW_BAR; unsigned* w = ctl + CW_LB + 64 * (8 * slot + (bid & 7));
        const unsigned n = (unsigned)((G + 7 - (bid & 7)) / 8);
        __builtin_amdgcn_s_waitcnt(0);
        (void)xb_add(w, 1u);
        XB_SPIN(xb_ld(w) < n, bar);
        __builtin_amdgcn_fence(__ATOMIC_ACQUIRE, "agent");
        asm volatile("s_waitcnt vmcnt(0)" ::: "memory");
    }
    __syncthreads();
}
struct DestWin { bf16* W; __device__ __forceinline__ bf16* operator()(int n) const {
    if (n < 6144) return W + (size_t)n * DM;
    if (n < 6160) return nullptr;
    if (n < 8208) return W + (size_t)(6144 + (n - 6160)) * DM;
    if (n < 10256) { const int j = n - 8208; return W + (size_t)(8192 + (j >> 7) * 256 + (j & 127)) * DM; }
    const int j = n - 10256; return W + (size_t)(8192 + (j >> 7) * 256 + 128 + (j & 127)) * DM; } };
struct DestPlain { bf16* W; int K; __device__ __forceinline__ bf16* operator()(int n) const { return W + (size_t)n * K; } };
struct DestGU { bf16* W; int half; __device__ __forceinline__ bf16* operator()(int n) const { return W + (size_t)((n >> 7) * 256 + half * 128 + (n & 127)) * DM; } };
template <class Dest>
__device__ __forceinline__ void p0_transpose_item(const float* W, int K, int N, int item, int lane, const Dest dest) {
    const int nblk = (N + 63) / 64, kb = item / nblk, nb = item - kb * nblk, k0 = 64 * kb, n0 = 64 * nb;
    const int c4 = lane & 15, rs = lane >> 4, n = n0 + 4 * c4; const bool nok = n < N;
    const float* wp = W + (size_t)(k0 + 8 * rs) * N + n;
    f32x4 v[2][8];
#pragma unroll
    for (int jj = 0; jj < 2; ++jj)
#pragma unroll
        for (int kk = 0; kk < 8; ++kk) v[jj][kk] = nok ? __builtin_nontemporal_load((const GAS f32x4*)(wp + (size_t)(32 * jj + kk) * N)) : (f32x4){0.f, 0.f, 0.f, 0.f};
#pragma unroll
    for (int q = 0; q < 4; ++q) { bf16* drow = nok ? dest(n + q) : nullptr;
        if (drow) {
#pragma unroll
            for (int jj = 0; jj < 2; ++jj) { v4u o; o.x = pg8::cvt_pk_bf16(v[jj][0][q], v[jj][1][q]); o.y = pg8::cvt_pk_bf16(v[jj][2][q], v[jj][3][q]); o.z = pg8::cvt_pk_bf16(v[jj][4][q], v[jj][5][q]); o.w = pg8::cvt_pk_bf16(v[jj][6][q], v[jj][7][q]);
                *(GAS v4u*)(drow + k0 + 8 * (rs + 4 * jj)) = o; } } }
}
__device__ __forceinline__ unsigned w0_bcast(unsigned v) { return (unsigned)__builtin_amdgcn_readfirstlane((int)v); }
__device__ __forceinline__ int cv_pick(const unsigned* heads, int per, int start, int lane) {
    const unsigned h = (lane < 8) ? __hip_atomic_load(heads + 64 * lane, __ATOMIC_RELAXED, __HIP_MEMORY_SCOPE_AGENT) : 0xffffffffu;
    const unsigned mm = (unsigned)__ballot(h < (unsigned)per) & 0xffu;
    if (mm == 0u) return -1;
    const unsigned rot = ((mm >> start) | (mm << (8 - start))) & 0xffu;
    return (start + __builtin_ctz(rot)) & 7;
}
template <class F>
__device__ __forceinline__ void dyn_walk(unsigned* heads, const int per, int bid, int wave, int lane, F&& item) {
    int shard = cv_pick(heads, per, (bid + wave) & 7, lane);
    if (shard < 0) return;
    unsigned tv = 0u; if (lane == 0) tv = __hip_atomic_fetch_add(heads + 64 * shard, 1u, __ATOMIC_RELAXED, __HIP_MEMORY_SCOPE_AGENT);
    unsigned t = w0_bcast(tv);
#pragma unroll 1
    for (;;) {
        if (t >= (unsigned)per) { shard = cv_pick(heads, per, shard, lane); if (shard < 0) break;
            tv = 0u; if (lane == 0) tv = __hip_atomic_fetch_add(heads + 64 * shard, 1u, __ATOMIC_RELAXED, __HIP_MEMORY_SCOPE_AGENT); t = w0_bcast(tv); continue; }
        tv = 0u; if (lane == 0) tv = __hip_atomic_fetch_add(heads + 64 * shard, 1u, __ATOMIC_RELAXED, __HIP_MEMORY_SCOPE_AGENT);
        item(shard * per + (int)t);
        t = w0_bcast(tv);
    }
}
constexpr int P0_REPS = 1 + ((DUP_MASK) & 1);
struct P0Args { const float *c, *w_ada, *b_ada, *w_in, *w_out, *w_gate, *w_up, *w_down; float* mod; bf16 *WF, *WIN, *WOUT, *WGU, *WD; };
constexpr int P0_I_IN = (DM / 64) * ((NIN + 63) / 64), P0_I_OUT = (DM / 64) * (DM / 64), P0_I_G = (DM / 64) * (DFF / 64), P0_NITEMS = P0_I_IN + P0_I_OUT + 2 * P0_I_G;
struct P0Item { const float* W; bf16* Dst; int N, kind, k0, n0; };
__device__ __forceinline__ P0Item p0_decode(const P0Args& A, int it) {
    P0Item I; int r = it;
    if (r < P0_I_IN) { I.W = A.w_in; I.Dst = A.WIN; I.N = NIN; I.kind = 0; }
    else if ((r -= P0_I_IN) < P0_I_OUT) { I.W = A.w_out; I.Dst = A.WOUT; I.N = DM; I.kind = 1; }
    else if ((r -= P0_I_OUT) < P0_I_G) { I.W = A.w_gate; I.Dst = A.WGU; I.N = DFF; I.kind = 2; }
    else { r -= P0_I_G; I.W = A.w_up; I.Dst = A.WGU; I.N = DFF; I.kind = 3; }
    const int nblk = (I.N + 63) / 64, kb = r / nblk, nb = r - kb * nblk; I.k0 = 64 * kb; I.n0 = 64 * nb; return I;
}
__device__ __forceinline__ bf16* p0_dest(const P0Item& I, int n) {
    if (I.kind == 0) return DestWin{I.Dst}(n);
    if (I.kind == 1) return I.Dst + (size_t)n * DM;
    return DestGU{I.Dst, I.kind - 2}(n);
}
__device__ __forceinline__ void p0_load(const P0Item& I, int lane, f32x4 (&v)[2][8]) {
    const int c4 = lane & 15, rs = lane >> 4, n = I.n0 + 4 * c4; const bool nok = n < I.N;
    const float* wp = I.W + (size_t)(I.k0 + 8 * rs) * I.N + n;
#pragma unroll
    for (int jj = 0; jj < 2; ++jj)
#pragma unroll
        for (int kk = 0; kk < 8; ++kk) v[jj][kk] = nok ? __builtin_nontemporal_load((const GAS f32x4*)(wp + (size_t)(32 * jj + kk) * I.N)) : (f32x4){0.f, 0.f, 0.f, 0.f};
}
__device__ __forceinline__ void p0_store(const P0Item& I, int lane, const f32x4 (&v)[2][8]) {
    const int c4 = lane & 15, rs = lane >> 4, n = I.n0 + 4 * c4; const bool nok = n < I.N;
#pragma unroll
    for (int q = 0; q < 4; ++q) { bf16* drow = nok ? p0_dest(I, n + q) : nullptr;
        if (drow) {
#pragma unroll
            for (int jj = 0; jj < 2; ++jj) { v4u o; o.x = pg8::cvt_pk_bf16(v[jj][0][q], v[jj][1][q]); o.y = pg8::cvt_pk_bf16(v[jj][2][q], v[jj][3][q]); o.z = pg8::cvt_pk_bf16(v[jj][4][q], v[jj][5][q]); o.w = pg8::cvt_pk_bf16(v[jj][6][q], v[jj][7][q]);
                *(GAS v4u*)(drow + I.k0 + 8 * (rs + 4 * jj)) = o; } } }
}
__device__ __forceinline__ void p0_prologue(LAS unsigned char* lds, const P0Args& A, int G, int bid, int tid, int wave, int lane) {
#if STAMP_PROBE == 5
    if (tid == 0) ((unsigned long long*)((char*)A.mod - 524288 + 65536))[11 * 256 + bid] = __builtin_amdgcn_s_memrealtime();
#endif
    LAS float* cact = (LAS float*)(lds + 73728);
    for (int i = tid; i < 2 * DM; i += NWAVES * 64) { const float v = A.c[i]; cact[i] = v / (1.f + expf(-v)); }
    __syncthreads();
    for (int rep0 = 0; rep0 < P0_REPS; ++rep0)
    for (int it = bid; it < 12 * 64; it += G) {
        const int cg = it % 12, kc = it / 12, n = cg * 2048 + tid * 4;
        const float* wp = A.w_ada + (size_t)(kc * 64) * (6 * DM) + n;
        f32x4 a0 = {0.f, 0.f, 0.f, 0.f}, a1 = {0.f, 0.f, 0.f, 0.f};
#pragma unroll 32
        for (int kk = 0; kk < 64; ++kk) { const f32x4 w = __builtin_nontemporal_load((const GAS f32x4*)(wp + (size_t)kk * (6 * DM))); const float c0 = cact[kc * 64 + kk], c1 = cact[DM + kc * 64 + kk]; a0 += w * c0; a1 += w * c1; }
        if (kc == 0) { const f32x4 b = *(const f32x4*)(A.b_ada + n); a0 += b; a1 += b; }
        float* m0 = A.mod + n; float* m1 = A.mod + 6 * DM + n;
        if (rep0 == 0 || a0[0] == 1.2345678e30f)
#pragma unroll
        for (int j = 0; j < 4; ++j) { __hip_atomic_fetch_add(m0 + j, a0[j], __ATOMIC_RELAXED, __HIP_MEMORY_SCOPE_AGENT); __hip_atomic_fetch_add(m1 + j, a1[j], __ATOMIC_RELAXED, __HIP_MEMORY_SCOPE_AGENT); }
    }
#if STAMP_PROBE == 5
    if (tid == 0) ((unsigned long long*)((char*)A.mod - 524288 + 65536))[10 * 256 + bid] = __builtin_amdgcn_s_memrealtime();
#endif
    { const int g = bid * NWAVES * 64 + tid; if (g < 16 * DM) { const int k = g >> 4, n = g & 15; A.WF[(size_t)n * DM + k] = (bf16)f2bf(A.w_in[(size_t)k * NIN + 6144 + n]); } }
    const int gw = bid * NWAVES + wave, NGW = G * NWAVES;
    constexpr int NVIRT = P0_REPS * P0_NITEMS;
    f32x4 va[2][8], vb[2][8];
    int it = gw;
    if (it < NVIRT) { const P0Item I = p0_decode(A, it % P0_NITEMS); p0_load(I, lane, va); }
    while (it < NVIRT) {
        const int i1 = it + NGW, i2 = it + 2 * NGW;
        if (i1 < NVIRT) { const P0Item I = p0_decode(A, i1 % P0_NITEMS); p0_load(I, lane, vb); }
        { const P0Item I = p0_decode(A, it % P0_NITEMS); p0_store(I, lane, va); }
        if (i1 >= NVIRT) break;
        if (i2 < NVIRT) { const P0Item I = p0_decode(A, i2 % P0_NITEMS); p0_load(I, lane, va); }
        { const P0Item I = p0_decode(A, i1 % P0_NITEMS); p0_store(I, lane, vb); }
        it = i2;
    }
}
__device__ __forceinline__ void convert_w_down(const float* w_down, bf16* WD, int b, int nb, int wave, int lane) {
    constexpr int I_D = (DFF / 64) * (DM / 64);
    for (int it = b * NWAVES + wave; it < I_D; it += nb * NWAVES) p0_transpose_item(w_down, DFF, DM, it, lane, DestPlain{WD, DFF});
}
__device__ __forceinline__ int p7_claim(unsigned* ctl, int bid, int lane) {
    unsigned* own = ctl + CW_OWN; const unsigned me = (unsigned)(bid & 7) + 1u;
    int grp = -1; unsigned idx = 0u;
#pragma unroll 1
    for (int s = 0; s < 8 && grp < 0; ++s) { const int w = ((bid & 7) + s) & 7;
        unsigned o = 0u;
        if (lane == 0) { o = __hip_atomic_load(own + 64 * w, __ATOMIC_RELAXED, __HIP_MEMORY_SCOPE_AGENT);
            if (o == 0u) { unsigned e = 0u; __hip_atomic_compare_exchange_strong(own + 64 * w, &e, me, __ATOMIC_RELAXED, __ATOMIC_RELAXED, __HIP_MEMORY_SCOPE_AGENT); o = (e == 0u) ? me : e; } }
        o = w0_bcast(o);
        if (o == me) { unsigned i = 16u; if (lane == 0) i = __hip_atomic_fetch_add(own + 64 * w + 1, 1u, __ATOMIC_RELAXED, __HIP_MEMORY_SCOPE_AGENT); i = w0_bcast(i); if (i < 16u) { grp = w; idx = i; } } }
    return grp < 0 ? -1 : grp + 8 * (int)idx;
}
__device__ __forceinline__ void convert_w_down_dyn(const float* w_down, bf16* WD, unsigned* heads, int bid, int wave, int lane) {
    constexpr int CV_ITEMS = (DFF / 64) * (DM / 64);
    static_assert(CV_ITEMS % 8 == 0, "conversion shards");
    dyn_walk(heads, CV_ITEMS / 8, bid, wave, lane, [&](int it) { p0_transpose_item(w_down, DFF, DM, it, lane, DestPlain{WD, DFF}); });
}
__device__ __forceinline__ void p1_norm1(LAS unsigned char* lds, const float* x, const float* pre_norm_mix, const float* mod, const bf16* WF, bf16* H1, float* FT, int G, int bid, int tid, int wave, int lane) {
    LAS float* G1 = (LAS float*)lds; LAS float* SH1 = G1 + DM; LAS unsigned char* TILE = lds + 32768; LAS f32x4* fpart = (LAS f32x4*)(lds + 98304);
    int cur_b = -1, par = 0; const int r = lane & 15, kq = lane >> 4;
    constexpr int NT1 = M / 8;
    bf16x8 wfr[16];
    { const bf16* wfp0 = WF + (size_t)r * DM + wave * 512 + kq * 8;
#pragma unroll
      for (int i = 0; i < 16; ++i) wfr[i] = *(const GAS bf16x8*)(wfp0 + 32 * i); }
    f32x4 xr[16];
    if (bid < NT1) { const float* xp = x + (size_t)(bid * 8 + wave) * DM + lane * 4;
#pragma unroll
        for (int j = 0; j < 16; ++j) xr[j] = __builtin_nontemporal_load((const GAS f32x4*)(xp + 256 * j)); }
#pragma unroll 1
    for (int tile = bid; tile < NT1; tile += G) {
        const int b = tile / (SEQ / 8), row = tile * 8 + wave;
        if (b != cur_b) { __syncthreads();
            for (int i = tid; i < DM; i += NWAVES * 64) { G1[i] = pre_norm_mix[i] * (1.f + mod[b * 6 * DM + DM + i]); SH1[i] = mod[b * 6 * DM + i]; }
            __syncthreads(); cur_b = b; }
        float ss = 0.f;
#pragma unroll
        for (int j = 0; j < 16; ++j) { const f32x4 v = xr[j]; ss += (v[0] * v[0] + v[1] * v[1]) + (v[2] * v[2] + v[3] * v[3]); }
        ss = wave_sum(ss);
        const float rstd = 1.0f / sqrtf(ss * (1.0f / DM) + EPS);
        const bool has_nx = tile + G < NT1; const float* xn = x + (size_t)(row + 8 * G) * DM + lane * 4;
        bf16* hp = H1 + (size_t)row * DM + lane * 4;
        LAS unsigned char* trow = TILE + wave * (DM * 2) + 8 * (lane & 1);
#pragma unroll
        for (int j = 0; j < 16; ++j) {
            const f32x4 g = *(const LAS f32x4*)(G1 + 256 * j + lane * 4), sh = *(const LAS f32x4*)(SH1 + 256 * j + lane * 4);
            const f32x4 v = xr[j] * rstd * g + sh;
            v2u w; w.x = pg8::cvt_pk_bf16(v[0], v[1]); w.y = pg8::cvt_pk_bf16(v[2], v[3]);
            *(GAS v2u*)(hp + 256 * j) = w;
            *(LAS v2u*)(trow + (((32 * j + (lane >> 1)) ^ wave) << 4)) = w;
            if (has_nx) xr[j] = __builtin_nontemporal_load((const GAS f32x4*)(xn + 256 * j));
        }
        LDS_WAIT(); __builtin_amdgcn_s_barrier();
        f32x4 acc = {0.f, 0.f, 0.f, 0.f};
        const LAS unsigned char* arow = TILE + (r & 7) * (DM * 2);
#pragma unroll
        for (int i = 0; i < 16; ++i) {
            bf16x8 af = *(const LAS bf16x8*)(arow + (((64 * wave + 4 * i + kq) ^ (r & 7)) << 4));
            if (r >= 8) af = (bf16x8){0, 0, 0, 0, 0, 0, 0, 0};
            acc = __builtin_amdgcn_mfma_f32_16x16x32_bf16(af, wfr[i], acc, 0, 0, 0);
        }
        fpart[(par * 8 + wave) * 64 + lane] = acc;
        LDS_WAIT(); __builtin_amdgcn_s_barrier();
        if (wave == 0) { f32x4 s = fpart[(par * 8) * 64 + lane];
#pragma unroll
            for (int w = 1; w < 8; ++w) s += fpart[(par * 8 + w) * 64 + lane];
            const int t0 = (tile * 8) % SEQ + 4 * kq;
            if (kq < 2) *(GAS f32x4*)(FT + (size_t)(b * NH + r) * SEQ + t0) = s; }
        par ^= 1;
    }
}
__device__ __forceinline__ void p2_scan(LAS unsigned char* lds, const float* FT, const float* b_f, float* FB, int bh, int tid, int wave, int lane) {
    const float bias = b_f[bh & 15];
    const GAS f32x4* src = (const GAS f32x4*)(FT + (size_t)bh * SEQ + tid * 16);
    double pre[16]; double run = 0.0;
#pragma unroll
    for (int q = 0; q < 4; ++q) { const f32x4 v = src[q];
#pragma unroll
        for (int j = 0; j < 4; ++j) { const float z = v[j] + bias; const float ls = (z >= 0.f) ? -log1pf(expf(-z)) : z - log1pf(expf(z)); run += (double)ls; pre[4 * q + j] = run; } }
    double incl = run;
#pragma unroll
    for (int o = 1; o < 64; o <<= 1) { const double t = __shfl_up(incl, o); if (lane >= o) incl += t; }
    LAS double* wt = (LAS double*)lds;
    if (lane == 63) wt[wave] = incl;
    __syncthreads();
    double off = incl - run;
    for (int w = 0; w < wave; ++w) off += wt[w];
    GAS f32x4* dst = (GAS f32x4*)(FB + (size_t)bh * SEQ + tid * 16);
#pragma unroll
    for (int q = 0; q < 4; ++q) { f32x4 o;
#pragma unroll
        for (int j = 0; j < 4; ++j) o[j] = (float)(-(off + pre[4 * q + j]) * 1.4426950408889634);
        dst[q] = o; }
    __syncthreads();
}
__device__ __forceinline__ void unpack8(const v4u w, float (&f)[8]) { f[0] = bflo(w.x); f[1] = bfhi(w.x); f[2] = bflo(w.y); f[3] = bfhi(w.y); f[4] = bflo(w.z); f[5] = bfhi(w.z); f[6] = bflo(w.w); f[7] = bfhi(w.w); }
__device__ __forceinline__ void p4_ynorm_conv(LAS unsigned char* lds, const bf16* YA, const bf16* GB, const bf16* CU, const float* conv_w, const float* attn_g, const float* conv_g, bf16* Y, int G, int bid, int tid, int wave, int lane) {
    LAS float* CWl = (LAS float*)lds; LAS float* AGl = CWl + 3 * CW; LAS float* CGl = AGl + AW;
    for (int i = tid; i < 3 * CW; i += NWAVES * 64) CWl[i] = conv_w[i];
    for (int i = tid; i < AW; i += NWAVES * 64) { AGl[i] = attn_g[i]; CGl[i] = conv_g[i]; }
    __syncthreads();
    const int gw = xcd_row_block(bid, G) * NWAVES + wave, NGW = G * NWAVES;
    for (int chunk = gw; chunk < M / 8; chunk += NGW) {
        const int m0 = chunk * 8, t0 = m0 % SEQ;
        v4u c1[4], c2[4];
#pragma unroll
        for (int j = 0; j < 4; ++j) { c1[j] = (v4u){0u, 0u, 0u, 0u}; c2[j] = (v4u){0u, 0u, 0u, 0u}; }
        if (t0 != 0) {
#pragma unroll
            for (int j = 0; j < 4; ++j) { c1[j] = *(const GAS v4u*)(CU + (size_t)(m0 - 1) * CW + j * 512 + lane * 8); c2[j] = *(const GAS v4u*)(CU + (size_t)(m0 - 2) * CW + j * 512 + lane * 8); } }
#pragma unroll 1
        for (int rr = 0; rr < 8; ++rr) { const int m = m0 + rr; __builtin_amdgcn_sched_barrier(0);
            v4u a[4], c0[4], gb[4];
#pragma unroll
            for (int j = 0; j < 4; ++j) { a[j] = __builtin_nontemporal_load((const GAS v4u*)(YA + (size_t)m * AW + j * 512 + lane * 8)); c0[j] = __builtin_nontemporal_load((const GAS v4u*)(CU + (size_t)m * CW + j * 512 + lane * 8)); gb[j] = __builtin_nontemporal_load((const GAS v4u*)(GB + (size_t)m * CW + j * 512 + lane * 8)); }
            float ssa = 0.f;
#pragma unroll
            for (int j = 0; j < 4; ++j) { float f[8]; unpack8(a[j], f);
#pragma unroll
                for (int i = 0; i < 8; ++i) ssa += f[i] * f[i]; }
            __builtin_amdgcn_sched_barrier(0);
            const float rsa = 1.0f / sqrtf(wave_sum(ssa) * (1.0f / AW) + EPS);
#pragma unroll
            for (int j = 0; j < 4; ++j) { float f[8]; unpack8(a[j], f); const int cb = j * 512 + lane * 8;
                const f32x4 g0 = *(const LAS f32x4*)(AGl + cb), g1 = *(const LAS f32x4*)(AGl + cb + 4);
                v4u w; w.x = pg8::cvt_pk_bf16(f[0] * rsa * g0[0], f[1] * rsa * g0[1]); w.y = pg8::cvt_pk_bf16(f[2] * rsa * g0[2], f[3] * rsa * g0[3]);
                w.z = pg8::cvt_pk_bf16(f[4] * rsa * g1[0], f[5] * rsa * g1[1]); w.w = pg8::cvt_pk_bf16(f[6] * rsa * g1[2], f[7] * rsa * g1[3]);
                *(GAS v4u*)(Y + (size_t)m * DM + cb) = w; __builtin_amdgcn_sched_barrier(0); }
            float yc[4][8]; float ssc = 0.f;
#pragma unroll
            for (int j = 0; j < 4; ++j) { float f0[8], f1[8], f2[8], fg[8]; unpack8(c0[j], f0); unpack8(c1[j], f1); unpack8(c2[j], f2); unpack8(gb[j], fg); const int cb = j * 512 + lane * 8;
#pragma unroll
                for (int h = 0; h < 2; ++h) { const f32x4 w0 = *(const LAS f32x4*)(CWl + cb + 4 * h), w1 = *(const LAS f32x4*)(CWl + CW + cb + 4 * h), w2 = *(const LAS f32x4*)(CWl + 2 * CW + cb + 4 * h);
#pragma unroll
                    for (int i = 0; i < 4; ++i) { const float v = fg[4 * h + i] * (w0[i] * f2[4 * h + i] + w1[i] * f1[4 * h + i] + w2[i] * f0[4 * h + i]); yc[j][4 * h + i] = v; ssc += v * v; } }
                __builtin_amdgcn_sched_barrier(0); }
            const float rsc = 1.0f / sqrtf(wave_sum(ssc) * (1.0f / CW) + EPS);
#pragma unroll
            for (int j = 0; j < 4; ++j) { const int cb = j * 512 + lane * 8;
                const f32x4 g0 = *(const LAS f32x4*)(CGl + cb), g1 = *(const LAS f32x4*)(CGl + cb + 4);
                v4u w; w.x = pg8::cvt_pk_bf16(yc[j][0] * rsc * g0[0], yc[j][1] * rsc * g0[1]); w.y = pg8::cvt_pk_bf16(yc[j][2] * rsc * g0[2], yc[j][3] * rsc * g0[3]);
                w.z = pg8::cvt_pk_bf16(yc[j][4] * rsc * g1[0], yc[j][5] * rsc * g1[1]); w.w = pg8::cvt_pk_bf16(yc[j][6] * rsc * g1[2], yc[j][7] * rsc * g1[3]);
                *(GAS v4u*)(Y + (size_t)m * DM + AW + cb) = w; __builtin_amdgcn_sched_barrier(0); }
#pragma unroll
            for (int j = 0; j < 4; ++j) { c2[j] = c1[j]; c1[j] = c0[j]; }
        }
    }
}
__device__ __forceinline__ void p6_resid1(LAS unsigned char* lds, const float* x, const bf16* HM, const float* mod, const float* post_norm_mix, const float* pre_norm_ffn, bf16* H2, int G, int bid, int tid, int wave, int lane) {
    LAS float* V1 = (LAS float*)lds; LAS float* G2 = V1 + DM; LAS float* S2 = G2 + DM;
    int cur_b = -1;
    for (int blk = xcd_row_block(bid, G); blk < M / 64; blk += G) {
        const int b = blk / (SEQ / 64);
        if (b != cur_b) { __syncthreads();
            for (int i = tid; i < DM; i += NWAVES * 64) { const float* mb = mod + b * 6 * DM; V1[i] = mb[2 * DM + i] * post_norm_mix[i]; G2[i] = pre_norm_ffn[i] * (1.f + mb[4 * DM + i]); S2[i] = mb[3 * DM + i]; }
            __syncthreads(); cur_b = b; }
#pragma unroll 1
        for (int rr = 0; rr < 8; ++rr) { const int m = blk * 64 + wave * 8 + rr; __builtin_amdgcn_sched_barrier(0);
            f32x4 xv[16]; v2u hv[16];
#pragma unroll
            for (int j = 0; j < 16; ++j) { xv[j] = __builtin_nontemporal_load((const GAS f32x4*)(x + (size_t)m * DM + j * 256 + lane * 4)); hv[j] = __builtin_nontemporal_load((const GAS v2u*)(HM + (size_t)m * DM + j * 256 + lane * 4)); }
            float ss = 0.f;
#pragma unroll
            for (int j = 0; j < 16; ++j) { const float h0 = bflo(hv[j].x), h1 = bfhi(hv[j].x), h2 = bflo(hv[j].y), h3 = bfhi(hv[j].y); ss += (h0 * h0 + h1 * h1) + (h2 * h2 + h3 * h3); }
            const float r1 = 1.0f / sqrtf(wave_sum(ss) * (1.0f / DM) + EPS);
            float ss2 = 0.f;
#pragma unroll
            for (int j = 0; j < 16; ++j) { const f32x4 v1 = *(const LAS f32x4*)(V1 + j * 256 + lane * 4);
                f32x4 h = {bflo(hv[j].x), bfhi(hv[j].x), bflo(hv[j].y), bfhi(hv[j].y)};
                const f32x4 x1 = xv[j] + v1 * h * r1; xv[j] = x1;
                ss2 += (x1[0] * x1[0] + x1[1] * x1[1]) + (x1[2] * x1[2] + x1[3] * x1[3]); }
            const float r2 = 1.0f / sqrtf(wave_sum(ss2) * (1.0f / DM) + EPS);
#pragma unroll
            for (int j = 0; j < 16; ++j) { const f32x4 g2 = *(const LAS f32x4*)(G2 + j * 256 + lane * 4), s2 = *(const LAS f32x4*)(S2 + j * 256 + lane * 4);
                const f32x4 h = xv[j] * r2 * g2 + s2; v2u w; w.x = pg8::cvt_pk_bf16(h[0], h[1]); w.y = pg8::cvt_pk_bf16(h[2], h[3]);
                *(GAS v2u*)(H2 + (size_t)m * DM + j * 256 + lane * 4) = w; }
        }
    }
}
__device__ __forceinline__ void p9_final(LAS unsigned char* lds, const float* x, const bf16* HMIX, const bf16* HFFN, const float* mod, const float* post_norm_mix, const float* post_norm_ffn, float* out, int G, int bid, int tid, int wave, int lane) {
    LAS float* V1 = (LAS float*)lds; LAS float* V2 = V1 + DM;
    int cur_b = -1;
    for (int blk = xcd_row_block(bid, G); blk < M / 64; blk += G) {
        const int b = blk / (SEQ / 64);
        if (b != cur_b) { __syncthreads();
            for (int i = tid; i < DM; i += NWAVES * 64) { const float* mb = mod + b * 6 * DM; V1[i] = mb[2 * DM + i] * post_norm_mix[i]; V2[i] = mb[5 * DM + i] * post_norm_ffn[i]; }
            __syncthreads(); cur_b = b; }
#pragma unroll 1
        for (int rr = 0; rr < 8; ++rr) { const int m = blk * 64 + wave * 8 + rr; __builtin_amdgcn_sched_barrier(0);
            f32x4 xv[16]; v2u hv[16], fv[16];
#pragma unroll
            for (int j = 0; j < 16; ++j) { xv[j] = __builtin_nontemporal_load((const GAS f32x4*)(x + (size_t)m * DM + j * 256 + lane * 4)); hv[j] = __builtin_nontemporal_load((const GAS v2u*)(HMIX + (size_t)m * DM + j * 256 + lane * 4));
                fv[j] = __builtin_nontemporal_load((const GAS v2u*)(HFFN + (size_t)m * DM + j * 256 + lane * 4)); }
            float ss = 0.f, sf = 0.f;
#pragma unroll
            for (int j = 0; j < 16; ++j) { const float h0 = bflo(hv[j].x), h1 = bfhi(hv[j].x), h2 = bflo(hv[j].y), h3 = bfhi(hv[j].y); ss += (h0 * h0 + h1 * h1) + (h2 * h2 + h3 * h3);
                const float f0 = bflo(fv[j].x), f1 = bfhi(fv[j].x), f2 = bflo(fv[j].y), f3 = bfhi(fv[j].y); sf += (f0 * f0 + f1 * f1) + (f2 * f2 + f3 * f3); }
            const float r1 = 1.0f / sqrtf(wave_sum(ss) * (1.0f / DM) + EPS), r2 = 1.0f / sqrtf(wave_sum(sf) * (1.0f / DM) + EPS);
#pragma unroll
            for (int j = 0; j < 16; ++j) { const f32x4 v1 = *(const LAS f32x4*)(V1 + j * 256 + lane * 4), v2 = *(const LAS f32x4*)(V2 + j * 256 + lane * 4);
                f32x4 h = {bflo(hv[j].x), bfhi(hv[j].x), bflo(hv[j].y), bfhi(hv[j].y)}, f = {bflo(fv[j].x), bfhi(fv[j].x), bflo(fv[j].y), bfhi(fv[j].y)};
                const f32x4 x1 = xv[j] + v1 * h * r1;
                __builtin_nontemporal_store(x1 + v2 * f * r2, (GAS f32x4*)(out + (size_t)m * DM + j * 256 + lane * 4)); }
        }
    }
}
struct Args { const float* in[17]; float* out; unsigned char* ws; int ph_lo, ph_hi, grid, pad; };
#define KARGP() const __attribute__((address_space(4))) char* kp = (const __attribute__((address_space(4))) char*)__builtin_amdgcn_kernarg_segment_ptr(); asm volatile("" : "+s"(kp))
#define INP(i) (*(const float* const __attribute__((address_space(4)))*)(kp + 8 * (i)))
#define OUTP() (*(float* const __attribute__((address_space(4)))*)(kp + 136))
#define WSP(T, off) ((T*)(*(unsigned char* const __attribute__((address_space(4)))*)(kp + 144) + (off)))
#define KINT(off) (*(const int __attribute__((address_space(4)))*)(kp + (off)))
#define TIDS() const int tid = opaque_tid(wave_s), lane = tid & 63, wave = wave_s
#ifndef PH_MASK
#define PH_MASK 0x3ff
#endif
#define REPS(k) for (int rep_ = 0; rep_ < 1 + (((DUP_MASK) >> (k)) & 1); ++rep_)
#define IN(k) ((((PHM) >> (k)) & 1) != 0)
#if STAMP_PROBE
#define STAMP(k) if (tid == 0) WSP(unsigned long long, 65536)[(k) * 256 + bid] = __builtin_amdgcn_s_memrealtime()
#else
#define STAMP(k) (void)0
#endif
#define SEAM(k) do { KARGP(); if (IN(k) && IN((k) + 1)) { const int tid = opaque_tid(wave_s); STAMP(k); XcdBarrier bar; bar.bar = WSP(unsigned, WS_CTL) + CW_BAR; bar.x = xb_xcc_id(); bar.st = (volatile LAS unsigned*)(lds + MISC_OFF) + 8; xcd_barrier(bar, tid); STAMP((k) + 12); } } while (0)
#define SEAML(k, slot) do { KARGP(); if (IN(k) && IN((k) + 1)) { const int tid = opaque_tid(wave_s); const bool loc = (XCD_LOCAL_SEAMS != 0) && __hip_atomic_load(WSP(unsigned, WS_CTL) + CW_BAD, __ATOMIC_RELAXED, __HIP_MEMORY_SCOPE_AGENT) == 0u; \
    if (loc) { STAMP(k); xcd_local_seam(WSP(unsigned, WS_CTL), slot, bid, KINT(160), tid); STAMP((k) + 12); } else { SEAM(k); } } } while (0)
template <int PHM> __global__ void __launch_bounds__(NWAVES * 64, 2) hymba_fwd(Args args) {
    constexpr bool HAS_SEAM = (PHM & (PHM >> 1)) != 0;
    extern __shared__ __attribute__((aligned(16))) unsigned char lds_raw[];
    LAS unsigned char* lds = (LAS unsigned char*)lds_raw;
    const int wave_s = __builtin_amdgcn_readfirstlane((int)(threadIdx.x >> 6));
    const int bid = blockIdx.x;
    { KARGP(); TIDS(); (void)lane; (void)wave;
      for (int u = tid; u < (LDS_BYTES - LDSCTL_OFF) / 4; u += NWAVES * 64) ((LAS unsigned*)(lds + LDSCTL_OFF))[u] = 0u;
      __syncthreads();
      if (HAS_SEAM) { (void)xcd_barrier_post(WSP(unsigned, WS_CTL) + CW_BAR, (volatile LAS unsigned*)(lds + MISC_OFF) + 8, tid); xcd_local_check(WSP(unsigned, WS_CTL), bid, KINT(160), tid); } }

    { KARGP(); if (IN(0)) { TIDS(); const int G = KINT(160); P0Args A{INP(1), INP(2), INP(3), INP(5), INP(10), INP(13), INP(14), INP(15), WSP(float, WS_MOD), WSP(bf16, WS_WF), WSP(bf16, WS_WIN), WSP(bf16, WS_WOUT), WSP(bf16, WS_WGU), WSP(bf16, WS_WD)};
        p0_prologue(lds, A, G, bid, tid, wave, lane); } }
    SEAM(0);
    { KARGP(); if (IN(1)) REPS(1) { TIDS(); const int G = KINT(160); p1_norm1(lds, INP(0), INP(4), WSP(float, WS_MOD), WSP(bf16, WS_WF), WSP(bf16, WS_H), WSP(float, WS_FT), G, bid, tid, wave, lane); } }
    SEAM(1);
    { KARGP(); if (IN(2)) REPS(2) { const int G = KINT(160);
        if (bid < BATCH * NH) { TIDS(); p2_scan(lds, WSP(float, WS_FT), INP(6), WSP(float, WS_FB), bid, tid, wave, lane); }
        pg8::Gemm g{WSP(bf16, WS_H), WSP(bf16, WS_WIN), M, NPROJ, DM}; pg8::StaticOrder S; S.init(M, NPROJ, G, bid); S.wgm = P2_WGM;
        pg8::EpiInProj E{WSP(bf16, WS_Q), WSP(bf16, WS_K), WSP(bf16, WS_V), WSP(bf16, WS_GB), WSP(bf16, WS_CU), QSCALE, WSP(unsigned, WS_CTL) + CW_QKMAX};
        pg8::gemm_phase<pg8::EpiInProj, pg8::StaticOrder, PG8_ALIGN, PG8_SP2>(lds, g, S, E, opaque_tid(wave_s)); } }
    SEAM(2);
    { KARGP(); if (IN(3)) { fa::attn_phase((char*)lds_raw, WSP(bf16, WS_Q), WSP(float, WS_FB), WSP(unsigned, WS_CTL) + CW_QKMAX, WSP(unsigned, WS_CTL) + CW_QHEAD, opaque_tid(wave_s)); } }
    SEAM(3);
#if FA_SELFCHECK
    { KARGP(); fa::attn_phase((char*)lds_raw, WSP(bf16, WS_Q), WSP(float, WS_FB), WSP(unsigned, WS_CTL) + CW_QKMAX, WSP(unsigned, WS_CTL) + CW_QHEAD + 64, opaque_tid(wave_s), false, 6); }
    SEAM(3);
    { KARGP(); TIDS(); (void)lane; (void)wave; const unsigned short* a = (const unsigned short*)WSP(bf16, WS_YA); const unsigned short* b = (const unsigned short*)WSP(bf16, WS_HM); unsigned bad = 0;
      for (size_t i = (size_t)bid * 512 + tid; i < (size_t)M * 2048; i += (size_t)KINT(160) * 512) { const float x = __uint_as_float((unsigned)a[i] << 16), y = __uint_as_float((unsigned)b[i] << 16);
          const float tol = fmaxf(fabsf(y), 1e-30f) * (1.0f / 100.0f);
          if (!(fabsf(x - y) <= tol)) bad++; }
      if (bad) __hip_atomic_fetch_add(WSP(unsigned, WS_CTL) + CW_QHEAD + 128, bad, __ATOMIC_RELAXED, __HIP_MEMORY_SCOPE_AGENT); }
    SEAM(3);
#endif
    { KARGP(); if (IN(4)) REPS(4) { TIDS(); const int G = KINT(160); p4_ynorm_conv(lds, WSP(bf16, WS_YA), WSP(bf16, WS_GB), WSP(bf16, WS_CU), INP(7), INP(8), INP(9), WSP(bf16, WS_H), G, bid, tid, wave, lane); } }
    SEAML(4, 0);
    { KARGP(); if (IN(5)) REPS(5) { const int G = KINT(160);
        pg8::Gemm g{WSP(bf16, WS_H), WSP(bf16, WS_WOUT), M, DM, DM}; pg8::StaticOrder S; S.init(M, DM, G, bid); S.wgm = P5_WGM;
        pg8::EpiPlain E{WSP(bf16, WS_HM), DM};
        pg8::gemm_phase<pg8::EpiPlain, pg8::StaticOrder, PG8_ALIGN, PG8_SP2>(lds, g, S, E, opaque_tid(wave_s)); } }
    SEAML(5, 1);
    { KARGP(); if (IN(6)) REPS(6) { TIDS(); const int G = KINT(160); p6_resid1(lds, INP(0), WSP(bf16, WS_HM), WSP(float, WS_MOD), INP(11), INP(12), WSP(bf16, WS_H), G, bid, tid, wave, lane); } }
    SEAM(6);
    { KARGP(); if (IN(7)) REPS(7) { const int G = KINT(160);
        constexpr int NU7 = (M / 256) * (NGU / 256);
        const bool endgame = (P7_ENDGAME != 0) && (G == 256) && (NU7 == 21 * 256 + 128);
        pg8::Gemm g{WSP(bf16, WS_H), WSP(bf16, WS_WGU), M, NGU, DM}; pg8::StaticOrder S; S.init(M, NGU, G, bid); S.wgm = P7_WGM; if (endgame) S.imax = 21;
        pg8::EpiSwiGLU E{WSP(bf16, WS_ACT), DFF};
        pg8::gemm_phase<pg8::EpiSwiGLU, pg8::StaticOrder, P7_ALIGN, PG8_SP2>(lds, g, S, E, opaque_tid(wave_s));
        if (endgame) {
            { TIDS(); (void)tid; if (wave == 0) { const int c = p7_claim(WSP(unsigned, WS_CTL), bid, lane); if (lane == 0) *(volatile LAS int*)(lds + LDSCTL_OFF) = c; } }
            __syncthreads();
            const int c = __builtin_amdgcn_readfirstlane(*(volatile LAS int*)(lds + LDSCTL_OFF));
            if (c >= 0) { pg8::OneUnit S1; S1.S.init(M, NGU, 256, c); S1.S.wgm = P7_WGM; S1.i0 = 21;
                pg8::gemm_phase<pg8::EpiSwiGLU, pg8::OneUnit, P7_ALIGN, PG8_SP2>(lds, g, S1, E, opaque_tid(wave_s)); }
            { TIDS(); (void)tid; convert_w_down_dyn(INP(15), WSP(bf16, WS_WD), WSP(unsigned, WS_CTL) + CW_CV, bid, wave, lane); }
        } else {
            const int rem = NU7 % G, first_idle = (rem == 0) ? 0 : rem, nidle = G - first_idle;
            if (bid >= first_idle) { TIDS(); (void)tid; convert_w_down(INP(15), WSP(bf16, WS_WD), bid - first_idle, nidle, wave, lane); } } } }
    SEAM(7);
    { KARGP(); if (IN(8)) REPS(8) { const int G = KINT(160);
        pg8::Gemm g{WSP(bf16, WS_ACT), WSP(bf16, WS_WD), M, DM, DFF}; pg8::StaticOrder S; S.init(M, DM, G, bid); S.wgm = P8_WGM;
        pg8::EpiPlain E{WSP(bf16, WS_H), DM};
        pg8::gemm_phase<pg8::EpiPlain, pg8::StaticOrder, PG8_ALIGN, PG8_SP2>(lds, g, S, E, opaque_tid(wave_s)); } }
    SEAML(8, 2);
    { KARGP(); if (IN(9)) { TIDS(); const int G = KINT(160); p9_final(lds, INP(0), WSP(bf16, WS_HM), WSP(bf16, WS_H), WSP(float, WS_MOD), INP(11), INP(16), OUTP(), G, bid, tid, wave, lane); } }
#if STAMP_PROBE == 8
    { KARGP(); const int tid = opaque_tid(wave_s); if (tid == 0) __hip_atomic_fetch_add(WSP(unsigned, WS_CTL) + CW_QHEAD + 40, *(volatile LAS unsigned*)(lds + LDSCTL_OFF + 16), __ATOMIC_RELAXED, __HIP_MEMORY_SCOPE_AGENT); }
#endif
#if STAMP_PROBE
    { KARGP(); const int tid = opaque_tid(wave_s); STAMP(9); XcdBarrier bar; bar.bar = WSP(unsigned, WS_CTL) + CW_BAR; bar.x = xb_xcc_id(); bar.st = (volatile LAS unsigned*)(lds + MISC_OFF) + 8; xcd_barrier(bar, tid);
      if (bid == 0) { LAS int* sh = (LAS int*)lds; const unsigned long long* st = WSP(unsigned long long, 65536);
          if (tid < 66) sh[tid] = (tid == 65) ? -2000000000 : 0;
          __syncthreads();
          for (int k = (STAMP_PROBE == 1 ? 4 : 0); k <= (STAMP_PROBE == 3 ? -1 : 9); ++k) { if (!(((STAMP_MASK) >> k) & 1)) continue;
              if (tid < 64) sh[128 + tid] = -2000000000; if (tid == 64) { sh[192] = 0; sh[193] = -2000000000; }
              __syncthreads();
              if (tid < 256) { const int v = (int)(long long)(st[k * 256 + tid] - st[k * 256]); const int g = 8 * (tid & 7) + ((tid >> 3) & 7);
                  __hip_atomic_fetch_max(sh + 128 + g, v, __ATOMIC_RELAXED, __HIP_MEMORY_SCOPE_WORKGROUP); __hip_atomic_fetch_add(sh + 192, v, __ATOMIC_RELAXED, __HIP_MEMORY_SCOPE_WORKGROUP); }
              __syncthreads();
              if (tid < 64) { const int Lg = sh[128 + tid] * 256 - sh[192]; sh[tid] += Lg; __hip_atomic_fetch_max(sh + 193, Lg, __ATOMIC_RELAXED, __HIP_MEMORY_SCOPE_WORKGROUP); }
              __syncthreads();
              if (tid == 0) sh[64] += sh[193];
              __syncthreads(); }
#if STAMP_PROBE == 3
          if (tid == 0) sh[64] = 0;
          __syncthreads();
          for (int k = 0; k <= 9; ++k) { if (!(((STAMP_MASK) >> k) & 1)) continue;
              if (tid < 16) sh[200 + tid] = (tid == 2 || tid == 3) ? -2000000000 : (tid == 4) ? 2000000000 : 0;
              __syncthreads();
              const int v = (tid < 256) ? (int)(long long)(st[k * 256 + tid] - st[k * 256]) : 0;
              if (tid < 256) { const int h = tid >> 7; __hip_atomic_fetch_add(sh + 200 + h, v, __ATOMIC_RELAXED, __HIP_MEMORY_SCOPE_WORKGROUP); __hip_atomic_fetch_max(sh + 202 + h, v, __ATOMIC_RELAXED, __HIP_MEMORY_SCOPE_WORKGROUP);
                  __hip_atomic_fetch_min(sh + 204, v, __ATOMIC_RELAXED, __HIP_MEMORY_SCOPE_WORKGROUP); __hip_atomic_fetch_add(sh + 208 + (tid & 7), v, __ATOMIC_RELAXED, __HIP_MEMORY_SCOPE_WORKGROUP); }
              __syncthreads();
              if (tid < 256 && STAMP_STAT == 6 && v * 256 > sh[200] + sh[201] + 256 * (STAMP_THR)) __hip_atomic_fetch_add(sh + 205, 1, __ATOMIC_RELAXED, __HIP_MEMORY_SCOPE_WORKGROUP);
              if (STAMP_STAT == 7 && k > 0) { if (tid == 0) sh[207] = -2000000000; __syncthreads();
                  if (tid < 256) __hip_atomic_fetch_max(sh + 207, (int)(long long)(st[(k - 1) * 256 + tid] - st[k * 256]), __ATOMIC_RELAXED, __HIP_MEMORY_SCOPE_WORKGROUP);
                  __syncthreads(); if (tid == 0) { const int mx = sh[202] > sh[203] ? sh[202] : sh[203]; sh[206] = 256 * (mx - sh[207]); } }
              __syncthreads();
              if (tid == 0) { const int sl = sh[200], shh = sh[201], sa = sl + shh; int r = 0;
                  if (STAMP_STAT == 1) r = sh[202] * 256 - 2 * sl; else if (STAMP_STAT == 2) r = sh[203] * 256 - 2 * shh; else if (STAMP_STAT == 3) r = 2 * sl - 2 * shh; else if (STAMP_STAT == 4) r = sa - 256 * sh[204];
                  else if (STAMP_STAT == 5) { int mx = -2000000000; for (int x = 0; x < 8; ++x) mx = sh[208 + x] > mx ? sh[208 + x] : mx; r = 8 * mx - sa; }
                  else if (STAMP_STAT == 6) r = sh[205] * 256 * 100;
                  else if (STAMP_STAT == 7) r = sh[206];
                  sh[64] += r; }
              __syncthreads(); }
#endif
          if (tid < 64) __hip_atomic_fetch_max(sh + 65, sh[tid], __ATOMIC_RELAXED, __HIP_MEMORY_SCOPE_WORKGROUP);
          __syncthreads();
#if STAMP_PROBE == 5
          if (tid == 0) { sh[64] = 0; sh[66] = -2000000000; sh[67] = 2000000000; }
          __syncthreads();
          if (tid < 256) { const int e = (int)(long long)(st[11 * 256 + tid] - st[11 * 256]), g = (int)(long long)(st[10 * 256 + tid] - st[11 * 256]), a = (int)(long long)(st[tid] - st[11 * 256]);
              __hip_atomic_fetch_add(sh + 64, STAMP_STAT == 0 ? g - e : STAMP_STAT == 1 ? a - g : 0, __ATOMIC_RELAXED, __HIP_MEMORY_SCOPE_WORKGROUP);
              __hip_atomic_fetch_max(sh + 66, e, __ATOMIC_RELAXED, __HIP_MEMORY_SCOPE_WORKGROUP); __hip_atomic_fetch_min(sh + 67, e, __ATOMIC_RELAXED, __HIP_MEMORY_SCOPE_WORKGROUP); }
          __syncthreads();
          if (tid == 0 && STAMP_STAT == 2) sh[64] = 256 * (sh[66] - sh[67]);
          __syncthreads();
#endif
#if STAMP_PROBE == 6
          if (tid == 0) sh[64] = 0;
          __syncthreads();
          for (int k = 0; k <= 8; ++k) { if (!(((STAMP_MASK) >> k) & 1)) continue;
              if (tid == 0) { sh[66] = -2000000000; sh[67] = -2000000000; sh[68] = 2000000000; }
              __syncthreads();
              if (tid < 256) { __hip_atomic_fetch_max(sh + 66, (int)(long long)(st[k * 256 + tid] - st[k * 256]), __ATOMIC_RELAXED, __HIP_MEMORY_SCOPE_WORKGROUP);
                  const int o = (int)(long long)(st[(k + 12) * 256 + tid] - st[k * 256]);
                  __hip_atomic_fetch_max(sh + 67, o, __ATOMIC_RELAXED, __HIP_MEMORY_SCOPE_WORKGROUP); __hip_atomic_fetch_min(sh + 68, o, __ATOMIC_RELAXED, __HIP_MEMORY_SCOPE_WORKGROUP); }
              __syncthreads();
              if (tid == 0) sh[64] += 256 * ((STAMP_STAT == 0 ? sh[67] : sh[68]) - sh[66]);
              __syncthreads(); }
#endif
#if STAMP_PROBE == 7
          if (tid == 0) sh[64] = 32 * (int)__hip_atomic_load(WSP(unsigned, WS_CTL) + CW_BAR + XB_TMO + 64, __ATOMIC_RELAXED, __HIP_MEMORY_SCOPE_AGENT);
          __syncthreads();
#endif
#if STAMP_PROBE == 8
          if (tid == 0) sh[64] = (int)__hip_atomic_load(WSP(unsigned, WS_CTL) + CW_QHEAD + 40, __ATOMIC_RELAXED, __HIP_MEMORY_SCOPE_AGENT);
          __syncthreads();
#endif
#if STAMP_PROBE == 4
          if (tid == 0) sh[64] = (int)__hip_atomic_load(WSP(unsigned, WS_CTL) + CW_QHEAD + 32, __ATOMIC_RELAXED, __HIP_MEMORY_SCOPE_AGENT);
          __syncthreads();
#endif
          if (tid == 0) { const long long t256 = (STAMP_PROBE == 1) ? (long long)(sh[64] - sh[65]) : (long long)sh[64]; const long long ticks = t256 * (STAMP_PROBE == 1 ? 16 : STAMP_MULT) / 256;
              const unsigned long long t0 = __builtin_amdgcn_s_memrealtime(); while ((long long)(__builtin_amdgcn_s_memrealtime() - t0) < ticks) __builtin_amdgcn_s_sleep(8); }
          __syncthreads(); }
      xcd_barrier(bar, tid); }
#endif
#if FA_SELFCHECK
    SEAM(8);
    { KARGP(); const int tid = opaque_tid(wave_s); if (bid == 0 && tid == 0 && __hip_atomic_load(WSP(unsigned, WS_CTL) + CW_QHEAD + 128, __ATOMIC_RELAXED, __HIP_MEMORY_SCOPE_AGENT) != 0u) OUTP()[0] = __builtin_nanf(""); }
#endif
}
#undef IN
#undef SEAM
#undef SEAML
#undef STAMP
#undef INP
#undef WSP
#undef OUTP
#undef KARGP
#undef KINT
#undef TIDS

typedef void (*kern_t)(Args);
template <int PHM> static bool set_attr() { return hipFuncSetAttribute((const void*)hymba_fwd<PHM>, hipFuncAttributeMaxDynamicSharedMemorySize, LDS_BYTES) == hipSuccess; }
extern "C" void kernel_launch(void* const* d_in, const int* in_sizes, int n_in, void* d_out, int out_size, void* d_ws, size_t ws_size, hipStream_t stream) {
    static int grid = 0;
#if MK_N_LAUNCHES == 1
    static const kern_t kerns[1] = {hymba_fwd<(PH_MASK)>};
#else
    static const kern_t kerns[N_PHASES] = {hymba_fwd<1>, hymba_fwd<2>, hymba_fwd<4>, hymba_fwd<8>, hymba_fwd<16>, hymba_fwd<32>, hymba_fwd<64>, hymba_fwd<128>, hymba_fwd<256>, hymba_fwd<512>};
#endif
    if (grid == 0) {
        if (n_in != 17 || in_sizes[0] != M * DM || out_size != M * DM || ws_size < WS_END) {
            fprintf(stderr, "kernel_launch: built for 17 inputs, x/out of %d floats, >= %zu bytes of workspace; got n_in %d, in0 %d, out %d, ws %zu; nothing launched\n", M * DM, (size_t)WS_END, n_in, n_in > 0 ? in_sizes[0] : -1, out_size, ws_size);
            grid = -1; return; }
        int dev = 0, cus = 0, per_cu = 0;
        if (hipGetDevice(&dev) != hipSuccess || hipDeviceGetAttribute(&cus, hipDeviceAttributeMultiprocessorCount, dev) != hipSuccess) { fprintf(stderr, "kernel_launch: device query failed\n"); grid = -1; return; }
#if MK_N_LAUNCHES == 1
        bool ok = set_attr<(PH_MASK)>();
#else
        bool ok = set_attr<1>() && set_attr<2>() && set_attr<4>() && set_attr<8>() && set_attr<16>() && set_attr<32>() && set_attr<64>() && set_attr<128>() && set_attr<256>() && set_attr<512>();
#endif
        if (!ok) { fprintf(stderr, "kernel_launch: hipFuncSetAttribute failed\n"); grid = -1; return; }
        if (hipOccupancyMaxActiveBlocksPerMultiprocessor(&per_cu, (const void*)kerns[0], NWAVES * 64, LDS_BYTES) != hipSuccess || per_cu < 1)
            fprintf(stderr, "kernel_launch: note: occupancy query reports %d workgroups per CU\n", per_cu);
        (void)hipGetLastError();
        grid = cus;
    }
    if (grid < 0) return;
    if (hipMemsetAsync((char*)d_ws + WS_CTL, 0, CTL_ZERO_BYTES, stream) != hipSuccess) { fprintf(stderr, "kernel_launch: memset failed\n"); return; }
    Args a{};
    for (int i = 0; i < 17; ++i) a.in[i] = (const float*)d_in[i];
    a.out = (float*)d_out; a.ws = (unsigned char*)d_ws; a.grid = grid; a.pad = 0; a.ph_lo = 0; a.ph_hi = N_PHASES;
    for (int li = 0; li < MK_N_LAUNCHES; ++li) {
        hipLaunchKernelGGL(kerns[li], dim3(grid), dim3(NWAVES * 64), LDS_BYTES, stream, a);
        const hipError_t le = hipPeekAtLastError();
        if (le != hipSuccess) { fprintf(stderr, "kernel_launch: launch %d failed: %s\n", li, hipGetErrorName(le)); break; }
    }
}
```

```cpp
#include <hip/hip_runtime.h>
#include <cstdio>
#include <cstdint>
#include <cmath>
#ifndef STAMP_PROBE
#define STAMP_PROBE 0
#endif
#ifndef STAMP_MASK
#define STAMP_MASK 0x3ff
#define STAMP_MULT 4
#define STAMP_STAT 1
#define STAMP_THR 2000
#endif
#ifndef P7_ENDGAME
#define P7_ENDGAME 1
#endif
#ifndef P2_WGM
#define P2_WGM 8
#endif
#ifndef P5_WGM
#define P5_WGM 8
#endif
#ifndef P7_WGM
#define P7_WGM 8
#endif
#ifndef PG8_PRIO
#define PG8_PRIO 1
#endif
#ifndef P7_ALIGN
#define P7_ALIGN true
#endif
#ifndef XCD_LOCAL_SEAMS
#define XCD_LOCAL_SEAMS 1
#endif
#ifndef P0_GEMV_WIDE
#define P0_GEMV_WIDE 1
#endif
#ifndef P8_WGM
#define P8_WGM 2
#endif
#ifndef P0_BLOCK_ITEMS
#define P0_BLOCK_ITEMS 1
#endif
#ifndef DUP_MASK
#define DUP_MASK 0
#endif
__device__ __forceinline__ int opaque_tid(int wave_s) { int l; asm volatile("v_mbcnt_lo_u32_b32 %0, -1, 0\n\tv_mbcnt_hi_u32_b32 %0, -1, %0" : "=v"(l)); return (wave_s << 6) | l; }
namespace pg8 {
#define PG8_LAS __attribute__((address_space(3)))
typedef unsigned short bf16_t;
typedef short bf16x8 __attribute__((ext_vector_type(8)));
typedef float f32x4 __attribute__((ext_vector_type(4)));
typedef unsigned u32x4 __attribute__((ext_vector_type(4)));
constexpr int BM = 256, BK = 64, HALF = 128, HTB = HALF * BK * 2  , STAGE_BYTES = 8 * HTB, NXCD = 8, WGM = 8;

__host__ __device__ __forceinline__ int lds_byte(int r, int c) { const int st = (r >> 4) * 2 + (c >> 5), rr = r & 15, cc = c & 31, ob = rr * 64 + cc * 2; return st * 1024 + (ob ^ (((ob >> 9) & 1) << 5)); }
__host__ __device__ __forceinline__ void stage_rc(int b, int& R, int& C) { const int st = b / 1024, sb = b % 1024, swz = sb ^ (((sb >> 9) & 1) << 5); R = (st >> 1) * 16 + swz / 64; C = (st & 1) * 32 + (swz % 64) / 2; }
__host__ __device__ __forceinline__ int perm32(int rho) { const int n = rho >> 4, i = rho & 15; return 8 * (i >> 2) + 4 * n + (i & 3); }

struct Unit { int pm, pn; };
struct Gemm { const bf16_t* A; const bf16_t* Bt; int M, N, K; };

struct StaticOrder {
    int nM, nN, nwg, G, c, imax, wgm;
    __host__ __device__ void init(int M, int N, int G_, int c_) { nM = M / BM; nN = N / BM; nwg = nM * nN; G = G_; c = c_; imax = 1 << 30; wgm = WGM; }
    __host__ __device__ bool next(int i, Unit& u) const {
        const long L = (long)i * G + c; if (L >= nwg || i >= imax) return false;
        int wgid = (int)L; { const int q = nwg / NXCD, r = nwg % NXCD, xcd = wgid % NXCD, off = wgid / NXCD; wgid = (xcd < r ? xcd * (q + 1) : r * (q + 1) + (xcd - r) * q) + off; }
        const int nig = wgm * nN, gid = wgid / nig, fm = gid * wgm, gsz = (nM - fm) < wgm ? (nM - fm) : wgm;
        u.pm = fm + ((wgid % nig) % gsz); u.pn = (wgid % nig) / gsz; return true;
    }
    __device__ __forceinline__ void a_ready(const Unit&) const {}
    __device__ __forceinline__ void done(const Unit&) const {}
};
struct OneUnit {
    StaticOrder S; int i0;
    __host__ __device__ bool next(int i, Unit& u) const { return i == 0 && S.next(i0, u); }
    __device__ __forceinline__ void a_ready(const Unit&) const {}
    __device__ __forceinline__ void done(const Unit&) const {}
};
__device__ __forceinline__ unsigned cvt_pk_bf16(float lo, float hi) { unsigned r; asm volatile("v_cvt_pk_bf16_f32 %0, %1, %2" : "=v"(r) : "v"(lo), "v"(hi)); return r; }
typedef float f32x2 __attribute__((ext_vector_type(2)));
struct EpiPlain {
    static constexpr bool PERM = true, AFTER_DRAIN = false;
    bf16_t* O; int ldc;
    __device__ __forceinline__ void operator()(const f32x4 (&acc)[2][2][4][2], const Unit& u, int wr, int wc, int fr, int fq) const {
        const int row0 = u.pm * BM + wr * 64 + fr, col0 = u.pn * BM + wc * 32 + 8 * fq;
#pragma unroll
        for (int ai = 0; ai < 2; ++ai)
#pragma unroll
            for (int m = 0; m < 4; ++m) { bf16_t* rowp = O + (size_t)(row0 + ai * HALF + m * 16) * ldc + col0;
#pragma unroll
                for (int bj = 0; bj < 2; ++bj) { const f32x4 v0 = acc[ai][bj][m][0], v1 = acc[ai][bj][m][1];
                    u32x4 w; w.x = cvt_pk_bf16(v0[0], v0[1]); w.y = cvt_pk_bf16(v0[2], v0[3]); w.z = cvt_pk_bf16(v1[0], v1[1]); w.w = cvt_pk_bf16(v1[2], v1[3]);
                    *(u32x4*)(rowp + bj * HALF) = w; } }
    }
};
struct EpiInProj {
    static constexpr bool PERM = true, AFTER_DRAIN = false;
    bf16_t *Q, *K, *V, *GB, *CU; float qscale; unsigned* qkmax;
    __device__ __forceinline__ void operator()(const f32x4 (&acc)[2][2][4][2], const Unit& u, int wr, int wc, int fr, int fq) const {
        const int row0 = u.pm * BM + wr * 64 + fr;
        if (u.pn < 32) {
            const int t = u.pn >> 3; bf16_t* base = (t == 0) ? Q : (t == 1) ? K : (t == 2) ? V : GB; const float s = (t == 0) ? qscale : 1.f;
            const int col0 = (u.pn & 7) * BM + wc * 32 + 8 * fq;
#pragma unroll
            for (int ai = 0; ai < 2; ++ai)
#pragma unroll
                for (int m = 0; m < 4; ++m) { bf16_t* rowp = base + (size_t)(row0 + ai * HALF + m * 16) * 2048 + col0;
#pragma unroll
                    for (int bj = 0; bj < 2; ++bj) { const f32x4 v0 = acc[ai][bj][m][0] * s, v1 = acc[ai][bj][m][1] * s;
                        u32x4 w; w.x = cvt_pk_bf16(v0[0], v0[1]); w.y = cvt_pk_bf16(v0[2], v0[3]); w.z = cvt_pk_bf16(v1[0], v1[1]); w.w = cvt_pk_bf16(v1[2], v1[3]);
                        *(u32x4*)(rowp + bj * HALF) = w; } }
            if (t <= 1) {
                float mx[2] = {0.f, 0.f};
#pragma unroll
                for (int ai = 0; ai < 2; ++ai)
#pragma unroll
                    for (int m = 0; m < 4; ++m)
#pragma unroll
                        for (int bj = 0; bj < 2; ++bj) { const f32x4 v0 = acc[ai][bj][m][0] * s, v1 = acc[ai][bj][m][1] * s;
                            float ss = (v0[0] * v0[0] + v0[1] * v0[1]) + (v0[2] * v0[2] + v0[3] * v0[3]) + (v1[0] * v1[0] + v1[1] * v1[1]) + (v1[2] * v1[2] + v1[3] * v1[3]);
                            ss += __shfl_xor(ss, 16); ss += __shfl_xor(ss, 32); mx[bj] = fmaxf(mx[bj], ss); }
#pragma unroll
                for (int bj = 0; bj < 2; ++bj) { float mm = mx[bj];
#pragma unroll
                    for (int o = 1; o < 16; o <<= 1) mm = fmaxf(mm, __shfl_xor(mm, o));
                    if (fr == 0 && fq == 0) __hip_atomic_fetch_max(qkmax + (((u.pm >> 5) * 16 + (u.pn & 7) * 2 + bj) * 2 + t) * 4 + wc, __float_as_uint(mm), __ATOMIC_RELAXED, __HIP_MEMORY_SCOPE_AGENT); }
            }
        } else {
            const int col0 = (u.pn - 32) * HALF + wc * 32 + 8 * fq;
#pragma unroll
            for (int ai = 0; ai < 2; ++ai)
#pragma unroll
                for (int m = 0; m < 4; ++m) { bf16_t* rowp = CU + (size_t)(row0 + ai * HALF + m * 16) * 2048 + col0;
                    const f32x4 v0 = acc[ai][0][m][0] * acc[ai][1][m][0], v1 = acc[ai][0][m][1] * acc[ai][1][m][1];
                    u32x4 w; w.x = cvt_pk_bf16(v0[0], v0[1]); w.y = cvt_pk_bf16(v0[2], v0[3]); w.z = cvt_pk_bf16(v1[0], v1[1]); w.w = cvt_pk_bf16(v1[2], v1[3]);
                    *(u32x4*)rowp = w; }
        }
    }
};
struct EpiSwiGLU {
    static constexpr bool PERM = true, AFTER_DRAIN = false;
    bf16_t* O; int ldc;
    __device__ __forceinline__ void operator()(const f32x4 (&acc)[2][2][4][2], const Unit& u, int wr, int wc, int fr, int fq) const {
        const int row0 = u.pm * BM + wr * 64 + fr, col0 = u.pn * HALF + wc * 32 + 8 * fq;
#pragma unroll
        for (int ai = 0; ai < 2; ++ai)
#pragma unroll
            for (int m = 0; m < 4; ++m) { bf16_t* rowp = O + (size_t)(row0 + ai * HALF + m * 16) * ldc + col0;
                f32x4 r[2];
#pragma unroll
                for (int n = 0; n < 2; ++n) { const f32x4 g = acc[ai][0][m][n], up = acc[ai][1][m][n];
#pragma unroll
                    for (int j = 0; j < 4; ++j) { const float e = __builtin_amdgcn_exp2f(g[j] * -1.4426950408889634f); r[n][j] = g[j] * up[j] * __builtin_amdgcn_rcpf(1.0f + e); } }
                u32x4 w; w.x = cvt_pk_bf16(r[0][0], r[0][1]); w.y = cvt_pk_bf16(r[0][2], r[0][3]); w.z = cvt_pk_bf16(r[1][0], r[1][1]); w.w = cvt_pk_bf16(r[1][2], r[1][3]);
                *(u32x4*)rowp = w; }
    }
};

template <class Epi, class Sched, bool ALIGN_EPI = false, bool SP2 = false>
__device__ __forceinline__ void gemm_phase(PG8_LAS unsigned char* lds, const Gemm g, const Sched& S, const Epi& E, const int tid) {
    const int wid = __builtin_amdgcn_readfirstlane(tid >> 6), lane = tid & 63, wr = wid >> 2, wc = wid & 3, fr = lane & 15, fq = lane >> 4;
    const int K = g.K, nt = K / BK;
    unsigned voffA[2], voffB[2];
#pragma unroll
    for (int i = 0; i < 2; ++i) { int R, C; stage_rc(tid * 16 + i * 8192, R, C); const int Rb = Epi::PERM ? ((R & ~31) + perm32(R & 31)) : R;
        voffA[i] = (unsigned)(R * K + C) * 2u; voffB[i] = (unsigned)(Rb * K + C) * 2u; }
    const size_t kstep = (size_t)(BK * 2);
    const size_t hstep = (size_t)HALF * K * 2;
    const size_t tstep = 2 * hstep;
    const unsigned ldsw = (unsigned)wid * 1024u;
    const int aoff = lds_byte(wr * 64 + fr, fq * 8), boff = lds_byte(wc * 32 + fr, fq * 8);
#define PG8_SA(b, h) (((b) * 2 + (h)) * HTB)
#define PG8_SB(b, h) ((4 + (b) * 2 + (h)) * HTB)
#define PG8_STAGE(bufoff, gbase, voff) do { _Pragma("unroll") for (int _i = 0; _i < 2; ++_i) \
        __builtin_amdgcn_global_load_lds((const unsigned*)((const char*)(gbase) + (voff)[_i]), (PG8_LAS unsigned*)(lds + (bufoff) + ldsw + _i * 8192), 16, 0, 0); } while (0)
#define PG8_LDA(dst, b, h) do { _Pragma("unroll") for (int m = 0; m < 4; ++m) _Pragma("unroll") for (int k = 0; k < 2; ++k) dst[m][k] = *(const PG8_LAS bf16x8*)(lds + PG8_SA(b, h) + aoff + m * 2048 + k * 1024); } while (0)
#define PG8_LDB(dst, b, h) do { _Pragma("unroll") for (int n = 0; n < 2; ++n) _Pragma("unroll") for (int k = 0; k < 2; ++k) dst[n][k] = *(const PG8_LAS bf16x8*)(lds + PG8_SB(b, h) + boff + n * 2048 + k * 1024); } while (0)
#define PG8_MMA(ai, bj, At, Bt) do { if (PG8_PRIO) __builtin_amdgcn_s_setprio(1); _Pragma("unroll") for (int m = 0; m < 4; ++m) _Pragma("unroll") for (int n = 0; n < 2; ++n) _Pragma("unroll") for (int k = 0; k < 2; ++k) \
        acc[ai][bj][m][n] = __builtin_amdgcn_mfma_f32_16x16x32_bf16(Bt[n][k], At[m][k], acc[ai][bj][m][n], 0, 0, 0); if (PG8_PRIO) __builtin_amdgcn_s_setprio(0); } while (0)
#define PG8_WAIT_V(n) asm volatile("s_waitcnt vmcnt(" #n ")" ::: "memory")
#define PG8_WAIT_L(n) asm volatile("s_waitcnt lgkmcnt(" #n ")" ::: "memory")
#define PG8_BAR __builtin_amdgcn_s_barrier()
#define PG8_SCHED __builtin_amdgcn_sched_barrier(0)
    Unit cur, nxt; int ui = 0;
    if (!S.next(0, cur)) return;
    f32x4 acc[2][2][4][2];
#pragma unroll
    for (int a = 0; a < 2; ++a)
#pragma unroll
        for (int b = 0; b < 2; ++b)
#pragma unroll
            for (int m = 0; m < 4; ++m)
#pragma unroll
                for (int n = 0; n < 2; ++n) acc[a][b][m][n] = (f32x4){0.f, 0.f, 0.f, 0.f};
    bf16x8 At[4][2], B0[2][2], B1[2][2];
    const char* cA = (const char*)g.A + (size_t)cur.pm * tstep; const char* cB = (const char*)g.Bt + (size_t)cur.pn * tstep;
    S.a_ready(cur);
    if constexpr (SP2) {
        PG8_STAGE(PG8_SB(0, 0), cB, voffB); PG8_STAGE(PG8_SB(0, 1), cB + hstep, voffB); PG8_STAGE(PG8_SA(0, 0), cA, voffA); PG8_STAGE(PG8_SA(0, 1), cA + hstep, voffA);
        if (wr == 1) PG8_BAR;
        PG8_WAIT_V(2); PG8_BAR;
        PG8_STAGE(PG8_SB(1, 0), cB + kstep, voffB); PG8_STAGE(PG8_SA(1, 0), cA + kstep, voffA); PG8_STAGE(PG8_SB(1, 1), cB + hstep + kstep, voffB);
        PG8_WAIT_V(6); PG8_BAR;
    } else {
        PG8_STAGE(PG8_SB(0, 0), cB, voffB); PG8_STAGE(PG8_SA(0, 0), cA, voffA); PG8_STAGE(PG8_SB(0, 1), cB + hstep, voffB); PG8_STAGE(PG8_SA(0, 1), cA + hstep, voffA);
        if (wr == 1) PG8_BAR;
        PG8_WAIT_V(4); PG8_BAR;
        PG8_STAGE(PG8_SB(1, 0), cB + kstep, voffB); PG8_STAGE(PG8_SA(1, 0), cA + kstep, voffA); PG8_STAGE(PG8_SB(1, 1), cB + hstep + kstep, voffB);
        PG8_WAIT_V(6); PG8_BAR;
    }
    for (;;) {
        const bool has_next = S.next(ui + 1, nxt);
        const char* nA = has_next ? (const char*)g.A + (size_t)nxt.pm * tstep : cA; const char* nB = has_next ? (const char*)g.Bt + (size_t)nxt.pn * tstep : cB;
        for (int t = 0; t < nt; t += 2) {
            const bool last = (t == nt - 2);
            const char* a1 = cA + (size_t)(t + 1) * kstep;
            const char* a2 = last ? nA : cA + (size_t)(t + 2) * kstep; const char* b2 = last ? nB : cB + (size_t)(t + 2) * kstep;
            const char* a3 = a2 + kstep; const char* b3 = b2 + kstep;
            if (last && has_next) S.a_ready(nxt);
            if constexpr (SP2) {
            PG8_LDB(B0, 0, 0); PG8_LDB(B1, 0, 1); PG8_SCHED; PG8_LDA(At, 0, 0); PG8_STAGE(PG8_SA(1, 1), a1 + hstep, voffA);
            PG8_WAIT_V(8); PG8_WAIT_L(0); PG8_BAR; PG8_MMA(0, 0, At, B0); PG8_MMA(0, 1, At, B1); PG8_BAR; PG8_SCHED;
            PG8_LDA(At, 0, 1); PG8_STAGE(PG8_SB(0, 0), b2, voffB); PG8_STAGE(PG8_SB(0, 1), b2 + hstep, voffB); PG8_STAGE(PG8_SA(0, 0), a2, voffA);
            PG8_WAIT_V(8); PG8_WAIT_L(0); PG8_BAR; PG8_MMA(1, 0, At, B0); PG8_MMA(1, 1, At, B1); PG8_BAR; PG8_SCHED;
            PG8_LDB(B0, 1, 0); PG8_LDB(B1, 1, 1); PG8_SCHED; PG8_LDA(At, 1, 0); PG8_STAGE(PG8_SA(0, 1), a2 + hstep, voffA);
            PG8_WAIT_V(8); PG8_WAIT_L(0); PG8_BAR; PG8_MMA(0, 0, At, B0); PG8_MMA(0, 1, At, B1); PG8_BAR; PG8_SCHED;
            PG8_LDA(At, 1, 1); PG8_STAGE(PG8_SB(1, 0), b3, voffB); PG8_STAGE(PG8_SB(1, 1), b3 + hstep, voffB); PG8_STAGE(PG8_SA(1, 0), a3, voffA);
            PG8_WAIT_V(8); PG8_WAIT_L(0); PG8_BAR; PG8_MMA(1, 0, At, B0); PG8_MMA(1, 1, At, B1); PG8_BAR; PG8_SCHED;
            } else {
            PG8_LDB(B0, 0, 0); PG8_SCHED; PG8_LDA(At, 0, 0); PG8_STAGE(PG8_SA(1, 1), a1 + hstep, voffA);
            PG8_WAIT_L(8); PG8_BAR; PG8_WAIT_L(0); PG8_MMA(0, 0, At, B0); PG8_BAR; PG8_SCHED;
            PG8_LDB(B1, 0, 1); PG8_STAGE(PG8_SB(0, 0), b2, voffB);
            PG8_BAR; PG8_WAIT_L(0); PG8_MMA(0, 1, At, B1); PG8_BAR;
            PG8_LDA(At, 0, 1); PG8_STAGE(PG8_SA(0, 0), a2, voffA);
            PG8_BAR; PG8_WAIT_L(0); PG8_MMA(1, 0, At, B0); PG8_BAR; PG8_SCHED;
            PG8_STAGE(PG8_SB(0, 1), b2 + hstep, voffB);
            PG8_WAIT_V(6); PG8_BAR; PG8_MMA(1, 1, At, B1); PG8_BAR;
            PG8_LDB(B0, 1, 0); PG8_SCHED; PG8_LDA(At, 1, 0); PG8_STAGE(PG8_SA(0, 1), a2 + hstep, voffA);
            PG8_WAIT_L(8); PG8_BAR; PG8_WAIT_L(0); PG8_MMA(0, 0, At, B0); PG8_BAR; PG8_SCHED;
            PG8_LDB(B1, 1, 1); PG8_STAGE(PG8_SB(1, 0), b3, voffB);
            PG8_BAR; PG8_WAIT_L(0); PG8_MMA(0, 1, At, B1); PG8_BAR;
            PG8_LDA(At, 1, 1); PG8_STAGE(PG8_SA(1, 0), a3, voffA);
            PG8_BAR; PG8_WAIT_L(0); PG8_MMA(1, 0, At, B0); PG8_BAR; PG8_SCHED;
            PG8_STAGE(PG8_SB(1, 1), b3 + hstep, voffB);
            PG8_WAIT_V(6); PG8_BAR; PG8_MMA(1, 1, At, B1); PG8_BAR;
            }
        }
#if STAMP_PROBE == 8 && STAMP_STAT == 0
        const unsigned long long te0_ = __builtin_amdgcn_s_memrealtime();
#endif
        if constexpr (ALIGN_EPI) { if (wr == 0) PG8_BAR; }
#if STAMP_PROBE == 8 && STAMP_STAT != 0
        const unsigned long long te0_ = __builtin_amdgcn_s_memrealtime();
#endif
        if constexpr (!Epi::AFTER_DRAIN) { E(acc, cur, wr, wc, fr, fq); S.done(cur); }
#if STAMP_PROBE == 8
        if (tid == 0) *(PG8_LAS unsigned*)(lds + 131072 + 16) += (unsigned)(__builtin_amdgcn_s_memrealtime() - te0_);
#endif
        if (!has_next) break;
#pragma unroll
        for (int a = 0; a < 2; ++a)
#pragma unroll
            for (int b = 0; b < 2; ++b)
#pragma unroll
                for (int m = 0; m < 4; ++m)
#pragma unroll
                    for (int n = 0; n < 2; ++n) acc[a][b][m][n] = (f32x4){0.f, 0.f, 0.f, 0.f};
        cur = nxt; cA = nA; cB = nB; ++ui;
        if constexpr (ALIGN_EPI) { if (wr == 1) PG8_BAR; }
    }
    PG8_WAIT_V(0);
    if constexpr (!ALIGN_EPI) { if (wr == 0) PG8_BAR; }
    PG8_BAR;
    if constexpr (Epi::AFTER_DRAIN) { E.fused(acc, cur, wr, wc, fr, fq, lds, wid, lane); S.done(cur); }
#undef PG8_SA
#undef PG8_SB
#undef PG8_STAGE
#undef PG8_LDA
#undef PG8_LDB
#undef PG8_MMA
#undef PG8_WAIT_V
#undef PG8_WAIT_L
#undef PG8_BAR
#undef PG8_SCHED
}
}
namespace fa {
typedef unsigned short bf16;
typedef short bf16x8 __attribute__((ext_vector_type(8)));
typedef short s16x4 __attribute__((ext_vector_type(4)));
typedef float f32x16 __attribute__((ext_vector_type(16)));
typedef float f32x4 __attribute__((ext_vector_type(4)));
typedef unsigned u32x4 __attribute__((ext_vector_type(4)));
constexpr int D = 128, PITCH = 2048, SEQ = 8192, NHEAD = 16;
constexpr int NW = 8, QBLK = 32, KVBLK = 64, QB = NW * QBLK, NQB = SEQ / QB;
constexpr int SHM_V = KVBLK * D * 2, SHM_K = KVBLK * D * 2;
constexpr int F_OFF = 2 * SHM_V + 2 * SHM_K + NW * 64 * 4 + 2048;
constexpr int ATT_LDS_BYTES = F_OFF + SEQ * 4 + 256;
constexpr float THR2 = 60.0f;
#define FA_KSWZ(row, colB) ((row) * 256 + ((colB) ^ (((row) & 7) << 4)))
#define FA_SBAR() __builtin_amdgcn_sched_barrier(0)
__device__ __forceinline__ int v_st(int k, int c) { const int kk = (k & ~0xC) | ((k & 4) << 1) | ((k & 8) >> 1); return ((kk >> 3) * 4 + (c >> 5)) * 512 + ((kk & 7) * 32 + (c & 31)) * 2; }
__device__ __forceinline__ int v_rd_base(int lane) { return ((lane & 3) << 3) | (((lane >> 2) & 3) << 6) | (((lane >> 4) & 1) << 5) | (((lane >> 5) & 1) << 8); }
constexpr int v_rd_off(int d0, int ks, int half) { return d0 * 512 + ks * 4096 + half * 2048; }
__device__ __forceinline__ int crow(int r, int hi) { return (r & 3) + 8 * (r >> 2) + 4 * hi; }
__device__ __forceinline__ unsigned cvtpk(float lo, float hi) { unsigned r; asm volatile("v_cvt_pk_bf16_f32 %0, %1, %2" : "=v"(r) : "v"(lo), "v"(hi)); return r; }
__device__ __forceinline__ bf16x8 load8(const bf16* p) { return *reinterpret_cast<const bf16x8*>(p); }
__device__ __forceinline__ void mask_tile(f32x16& p0, f32x16& p1, int dq) {
#pragma unroll
    for (int r = 0; r < 16; ++r) { const int c = (r & 3) + 8 * (r >> 2);
        const float t0 = __uint_as_float(0x7f800000u | ((unsigned)(dq - c) & 0x80000000u)), t1 = __uint_as_float(0x7f800000u | ((unsigned)(dq - c - 32) & 0x80000000u));
        p0[r] = fminf(p0[r], t0); p1[r] = fminf(p1[r], t1); }
}
__device__ __forceinline__ void partialSM(f32x16& p0, f32x16& p1, float& m_reg, float& mn, float& alpha) {
    float pmax = p0[0];
#pragma unroll
    for (int r = 1; r < 16; ++r) pmax = fmaxf(pmax, p0[r]);
#pragma unroll
    for (int r = 0; r < 16; ++r) pmax = fmaxf(pmax, p1[r]);
    { auto rr = __builtin_amdgcn_permlane32_swap(__float_as_uint(pmax), __float_as_uint(pmax), false, false);
      pmax = fmaxf(__uint_as_float(rr[0]), __uint_as_float(rr[1])); }
    if (__builtin_expect(__all((pmax - m_reg) <= THR2), 1)) { mn = m_reg; alpha = 1.f; }
    else { mn = fmaxf(m_reg, pmax); alpha = __builtin_amdgcn_exp2f(m_reg - mn); m_reg = mn; }
#pragma unroll
    for (int r = 0; r < 16; ++r) p0[r] = p0[r] - mn;
#pragma unroll
    for (int r = 0; r < 16; ++r) p1[r] = p1[r] - mn;
#pragma unroll
    for (int r = 0; r < 16; ++r) p0[r] = __builtin_amdgcn_exp2f(p0[r]);
}
__device__ __forceinline__ void finishSM(f32x16& p0, f32x16& p1, float alpha, float& l_reg, bf16x8& pa0, bf16x8& pa1, bf16x8& pa2, bf16x8& pa3) {
#pragma unroll
    for (int r = 0; r < 16; ++r) p1[r] = __builtin_amdgcn_exp2f(p1[r]);
    float ps = 0;
#pragma unroll
    for (int r = 0; r < 16; ++r) ps += p0[r];
#pragma unroll
    for (int r = 0; r < 16; ++r) ps += p1[r];
    { auto rr = __builtin_amdgcn_permlane32_swap(__float_as_uint(ps), __float_as_uint(ps), false, false);
      ps = __uint_as_float(rr[0]) + __uint_as_float(rr[1]); }
    l_reg = l_reg * alpha + ps;
#define FA_PK4(P, B_, OUT) do { unsigned a0 = cvtpk(P[B_+0], P[B_+1]), a1 = cvtpk(P[B_+2], P[B_+3]);                          \
        unsigned b0 = cvtpk(P[B_+4], P[B_+5]), b1 = cvtpk(P[B_+6], P[B_+7]);                                             \
        auto r0 = __builtin_amdgcn_permlane32_swap(a0, b0, false, false); auto r1 = __builtin_amdgcn_permlane32_swap(a1, b1, false, false); \
        u32x4 w = {r0[0], r1[0], r0[1], r1[1]}; OUT = *reinterpret_cast<bf16x8*>(&w); } while (0)
    FA_PK4(p0, 0, pa0); FA_PK4(p0, 8, pa1); FA_PK4(p1, 0, pa2); FA_PK4(p1, 8, pa3);
#undef FA_PK4
}
template <int KB>
__device__ __forceinline__ void qkt(f32x16& p0, f32x16& p1, const char* K_lds, int r32, int hi, const bf16x8* qr, const __attribute__((address_space(3))) float* fl) {
#pragma unroll
    for (int g = 0; g < 4; ++g) { const f32x4 a = *(const __attribute__((address_space(3))) f32x4*)(fl + 8 * g), b = *(const __attribute__((address_space(3))) f32x4*)(fl + 32 + 8 * g);
#pragma unroll
        for (int i = 0; i < 4; ++i) { p0[4 * g + i] = a[i]; p1[4 * g + i] = b[i]; } }
    const char* kb[4];
#pragma unroll
    for (int dd = 0; dd < 4; ++dd) kb[dd] = K_lds + KB * SHM_K + FA_KSWZ(r32, (dd * 16 + hi * 8) * 2);
#pragma unroll
    for (int d0 = 0; d0 < 8; ++d0) { const char* a = kb[d0 & 3] + (d0 >> 2) * 128;
        bf16x8 b0 = *reinterpret_cast<const bf16x8*>(a);
        bf16x8 b1 = *reinterpret_cast<const bf16x8*>(a + 32 * 256);
        p0 = __builtin_amdgcn_mfma_f32_32x32x16_bf16(b0, qr[d0], p0, 0, 0, 0);
        p1 = __builtin_amdgcn_mfma_f32_32x32x16_bf16(b1, qr[d0], p1, 0, 0, 0); }
}
template <int VB>
__device__ __forceinline__ void pv_tile(f32x16* o, int vb0, bf16x8 pa0, bf16x8 pa1, bf16x8 pa2, bf16x8 pa3) {
#define FA_TRRD(dst, off) asm volatile("ds_read_b64_tr_b16 %0, %1 offset:%2" : "=&v"(dst) : "v"(vb0), "i"(off) : "memory")
#define FA_PV_D0(d0) do { s16x4 l0, l1, l2, l3, h0, h1, h2, h3; constexpr int b_ = VB * SHM_V + v_rd_off(d0, 0, 0); \
        FA_TRRD(l0, b_); FA_TRRD(h0, b_ + 2048); FA_TRRD(l1, b_ + 4096); FA_TRRD(h1, b_ + 6144); FA_TRRD(l2, b_ + 8192); FA_TRRD(h2, b_ + 10240); FA_TRRD(l3, b_ + 12288); FA_TRRD(h3, b_ + 14336); \
        asm volatile("s_waitcnt lgkmcnt(0)" ::: "memory"); FA_SBAR();   \
        o[d0] = __builtin_amdgcn_mfma_f32_32x32x16_bf16(pa0, (bf16x8){l0[0], l0[1], l0[2], l0[3], h0[0], h0[1], h0[2], h0[3]}, o[d0], 0, 0, 0);   \
        o[d0] = __builtin_amdgcn_mfma_f32_32x32x16_bf16(pa1, (bf16x8){l1[0], l1[1], l1[2], l1[3], h1[0], h1[1], h1[2], h1[3]}, o[d0], 0, 0, 0);   \
        o[d0] = __builtin_amdgcn_mfma_f32_32x32x16_bf16(pa2, (bf16x8){l2[0], l2[1], l2[2], l2[3], h2[0], h2[1], h2[2], h2[3]}, o[d0], 0, 0, 0);   \
        o[d0] = __builtin_amdgcn_mfma_f32_32x32x16_bf16(pa3, (bf16x8){l3[0], l3[1], l3[2], l3[3], h3[0], h3[1], h3[2], h3[3]}, o[d0], 0, 0, 0); } while (0)
    FA_PV_D0(0); FA_PV_D0(1); FA_PV_D0(2); FA_PV_D0(3);
#undef FA_PV_D0
#undef FA_TRRD
}
constexpr size_t BUF = (size_t)16384 * 2048;
struct BlockRef { const bf16* Q; const bf16* K; int P0; int jlo; };
#ifndef FA_SELFCHECK
#define FA_SELFCHECK 0
#endif
#if FA_SELFCHECK
#endif
struct Seam { bf16x8 qr[8]; bf16x8 st_v0, st_v1, st_k0, st_k1; };
#define FA_TILE(p, k0, half) ((const char*)(p) + ((size_t)((k0) + 32 * (half)) * PITCH * 2))
#define FA_VMW() asm volatile("s_waitcnt vmcnt(0)" ::: "memory")
#define FA_VMWN(n) asm volatile("s_waitcnt vmcnt(%0)" :: "i"(n) : "memory")
#define FA_SLOAD(Kp, Vp, k0) do { S.st_v0 = load8((const bf16*)(FA_TILE(Vp, k0, 0) + svoff)); S.st_v1 = load8((const bf16*)(FA_TILE(Vp, k0, 1) + svoff));              \
                         S.st_k0 = load8((const bf16*)(FA_TILE(Kp, k0, 0) + svoff)); S.st_k1 = load8((const bf16*)(FA_TILE(Kp, k0, 1) + svoff)); } while (0)
#define FA_SWRITE_K(bf) do { *(bf16x8*)(K_lds + (bf) * SHM_K + kws) = S.st_k0; *(bf16x8*)(K_lds + (bf) * SHM_K + kws + 32 * 256) = S.st_k1; } while (0)
#define FA_SWRITE_V(bf) do { *(bf16x8*)(V_lds + (bf) * SHM_V + vst0) = S.st_v0; *(bf16x8*)(V_lds + (bf) * SHM_V + vst1) = S.st_v1; } while (0)
#define FA_SWRITE(bf) do { FA_SWRITE_V(bf); FA_SWRITE_K(bf); } while (0)
__device__ __forceinline__ void attn_prime(const BlockRef& cur, char* lds, Seam& S, const int tid) {
    const int wid = __builtin_amdgcn_readfirstlane(tid >> 6), lane = tid & 63, r32 = lane & 31, hi = lane >> 5;
    const int sr = tid >> 4, sc = (tid & 15) * 8, kws = FA_KSWZ(sr, sc * 2); const unsigned svoff = (unsigned)(sr * PITCH + sc) * 2u; char* K_lds = lds + 2 * SHM_V;
#pragma unroll
    for (int d0 = 0; d0 < 8; ++d0) S.qr[d0] = load8(cur.Q + (size_t)(wid * QBLK + r32) * PITCH + d0 * 16 + hi * 8);
    FA_SLOAD(cur.K, cur.K + BUF, cur.jlo * KVBLK); FA_VMW(); FA_SWRITE_K(0);
    __syncthreads();
}
__device__ __forceinline__ void attn_block(const BlockRef& cur, const BlockRef& nxt, char* lds, Seam& S, const int tid, const int obuf = 5) {
    const int wid = __builtin_amdgcn_readfirstlane(tid >> 6), lane = tid & 63, r32 = lane & 31, hi = lane >> 5;
    const int j_lo = cur.jlo, NT = cur.P0 / KVBLK + QB / KVBLK - j_lo;
    const int qlo = cur.P0 + wid * QBLK, qm = qlo + r32 - 4 * hi;
    char* V_lds = lds; char* K_lds = lds + 2 * SHM_V;
    float* ws = (float*)(lds + 2 * SHM_V + 2 * SHM_K) + wid * 64; float* li_l = ws, * al_l = ws + 32;
    const __attribute__((address_space(3))) float* Fl = (const __attribute__((address_space(3))) float*)((__attribute__((address_space(3))) char*)lds + F_OFF) + 4 * hi;
    float m_reg = -1e30f, l_reg = 0; f32x16 o[4] = {};
    const int sr = tid >> 4, sc = (tid & 15) * 8, vst0 = v_st(sr, sc), vst1 = vst0 + 8192  , kws = FA_KSWZ(sr, sc * 2); const unsigned svoff = (unsigned)(sr * PITCH + sc) * 2u;
    const int vb0 = (int)(uintptr_t)V_lds + v_rd_base(lane);
    const bf16* Kh = cur.K; const bf16* Vh = cur.K + BUF;
#define FA_RESC(a) do { if (__any((a) < 1.f)) { if (hi == 0) al_l[r32] = (a); asm volatile("s_waitcnt lgkmcnt(0)" ::: "memory");              \
                     for (int d_ = 0; d_ < 4; ++d_) for (int r = 0; r < 16; ++r) o[d_][r] *= al_l[crow(r, hi)]; } } while (0)
#define FA_KBASE(t) ((j_lo + (t)) * KVBLK)
#define FA_BIASMASK(P0_, P1_, t) do { const int kb_ = FA_KBASE(t); if (kb_ + KVBLK - 1 > qlo) mask_tile(P0_, P1_, qm - kb_); } while (0)
    constexpr int NQL = 8;
#define FA_SEAM_K0() do { FA_VMWN(NQL); FA_SWRITE_K(0); FA_SBAR(); } while (0)
    f32x16 pA0, pA1, pB0, pB1; float mnA, mnB, alA, alB; bf16x8 pa0, pa1, pa2, pa3;
    FA_SWRITE_V(0); FA_SBAR();
    if (NT > 1) { FA_SLOAD(Kh, Vh, FA_KBASE(1)); }
    FA_SBAR(); qkt<0>(pA0, pA1, K_lds, r32, hi, S.qr, Fl + FA_KBASE(0));
    FA_BIASMASK(pA0, pA1, 0); partialSM(pA0, pA1, m_reg, mnA, alA);
    if (NT > 1) { FA_VMW(); FA_SWRITE(1); }
    __syncthreads();
#define FA_HALF_STEP(PX0, PX1, mnX, alX, PY0, PY1, alY, t, KB, VB, SB) do {                                                      \
        FA_SBAR(); qkt<KB>(PX0, PX1, K_lds, r32, hi, S.qr, Fl + FA_KBASE(t));                                             \
        finishSM(PY0, PY1, alY, l_reg, pa0, pa1, pa2, pa3); FA_SBAR();                                                           \
        if ((t) + 1 < NT) { FA_SLOAD(Kh, Vh, FA_KBASE((t) + 1)); FA_SBAR(); }                                               \
        pv_tile<VB>(o, vb0, pa0, pa1, pa2, pa3); FA_BIASMASK(PX0, PX1, (t)); partialSM(PX0, PX1, m_reg, mnX, alX);                                        \
        __syncthreads();                                                                                                      \
        if ((t) + 1 < NT) { FA_VMW(); FA_SWRITE(SB); }                                                                          \
        FA_RESC(alX); __syncthreads(); } while (0)
    for (int t = 1; t + 1 < NT; t += 2) {
        FA_HALF_STEP(pB0, pB1, mnB, alB, pA0, pA1, alA, t, 1, 0, 0);
        FA_HALF_STEP(pA0, pA1, mnA, alA, pB0, pB1, alB, t + 1, 0, 1, 1);
    }
    const bool even = (NT & 1) == 0;
    if (even) { FA_SBAR(); qkt<1>(pB0, pB1, K_lds, r32, hi, S.qr, Fl + FA_KBASE(NT - 1)); FA_SBAR(); }
    FA_SLOAD(nxt.K, nxt.K + BUF, nxt.jlo * KVBLK); FA_SBAR();
#pragma unroll
    for (int d0 = 0; d0 < 8; ++d0) S.qr[d0] = load8(nxt.Q + (size_t)(wid * QBLK + r32) * PITCH + d0 * 16 + hi * 8);
    FA_SBAR();
    finishSM(pA0, pA1, alA, l_reg, pa0, pa1, pa2, pa3); FA_SBAR();
    pv_tile<0>(o, vb0, pa0, pa1, pa2, pa3);
    if (even) { FA_BIASMASK(pB0, pB1, NT - 1); partialSM(pB0, pB1, m_reg, mnB, alB); __syncthreads(); FA_RESC(alB);
        finishSM(pB0, pB1, alB, l_reg, pa0, pa1, pa2, pa3); FA_SBAR(); pv_tile<1>(o, vb0, pa0, pa1, pa2, pa3); }
    FA_SBAR(); FA_SEAM_K0();
    if (hi == 0) li_l[r32] = l_reg; asm volatile("s_waitcnt lgkmcnt(0)" ::: "memory");
    float rli[16];
#pragma unroll
    for (int r = 0; r < 16; ++r) rli[r] = __builtin_amdgcn_rcpf(li_l[crow(r, hi)]);
    bf16* Ow = const_cast<bf16*>(cur.Q) + (size_t)obuf * BUF + (size_t)(wid * QBLK) * PITCH;
    __attribute__((address_space(3))) char* stg = (__attribute__((address_space(3))) char*)lds + F_OFF + wid * 4096;
#pragma unroll
    for (int p = 0; p < 2; ++p) {
#pragma unroll
        for (int rr = 0; rr < 8; ++rr) { const int r = 8 * p + rr, rl = crow(r, hi) - 16 * p;
#pragma unroll
            for (int d0 = 0; d0 < 4; ++d0) { const float v = o[d0][r] * rli[r];
                *(__attribute__((address_space(3))) unsigned short*)(stg + rl * 256 + (d0 * 32 + r32) * 2) = (unsigned short)cvtpk(v, v); } }
        asm volatile("s_waitcnt lgkmcnt(0)" ::: "memory");
#pragma unroll
        for (int k = 0; k < 4; ++k) { const int q = lane + 64 * k; const u32x4 w = *(const __attribute__((address_space(3))) u32x4*)(stg + q * 16);
            *(u32x4*)(Ow + (size_t)(16 * p + (q >> 4)) * PITCH + (q & 15) * 8) = w; }
    }
    __syncthreads();
#undef FA_RESC
#undef FA_KBASE
#undef FA_BIASMASK
#undef FA_SEAM_K0
#undef FA_HALF_STEP
}
#undef FA_TILE
#undef FA_VMW
#undef FA_VMWN
#undef FA_SLOAD
#undef FA_SWRITE_K
#undef FA_SWRITE_V
#undef FA_SWRITE
__device__ __forceinline__ BlockRef block_ref(int bh, int qb, int jlo, const bf16* Q) {
    const int b = bh >> 4, h = bh & 15; BlockRef r;
    r.Q = Q + ((size_t)b * SEQ + (size_t)qb * QB) * PITCH + (size_t)h * D; r.K = Q + BUF + (size_t)b * SEQ * PITCH + (size_t)h * D; r.P0 = qb * QB; r.jlo = jlo; return r;
}
__device__ __forceinline__ void load_bias(char* lds, const float* FB, int bh, int k_lo, int k_hi, const int tid) {
    const f32x4* src = (const f32x4*)(FB + (size_t)bh * SEQ); __attribute__((address_space(3))) f32x4* dst = (__attribute__((address_space(3))) f32x4*)((__attribute__((address_space(3))) char*)lds + F_OFF);
    int t0 = tid; asm volatile("" : "+v"(t0));
    for (int i = k_lo / 4 + t0; i < k_hi / 4; i += NW * 64) dst[i] = src[i];
    __syncthreads();
}
#ifndef FA_PRUNE
#define FA_PRUNE 1
#endif
constexpr float PRUNE_T2 = 44.0f;
constexpr int NTICKETS = (1 + (((DUP_MASK) >> 3) & 1)) * 2 * NHEAD * NQB;
constexpr int XQ_OFF = F_OFF + SEQ * 4;
struct Ticket { int idx, bh, qb, jlo; };
constexpr int ORD_OFF = 104448;
static_assert(ORD_OFF >= ATT_LDS_BYTES, "order table behind the attention image");
__device__ __forceinline__ void build_order(char* lds, const float* FB, const unsigned* qkmax, const int tid) {
    __attribute__((address_space(3))) unsigned short* ord = (__attribute__((address_space(3))) unsigned short*)((__attribute__((address_space(3))) char*)lds + ORD_OFF);
    __attribute__((address_space(3))) int* Wc = (__attribute__((address_space(3))) int*)((__attribute__((address_space(3))) char*)lds + ORD_OFF + 2048);
    int t0 = tid; asm volatile("" : "+v"(t0));
    if (t0 < 2 * NHEAD) { float smax = 0.f;
#pragma unroll
        for (int w = 0; w < 4; ++w) smax += sqrtf(__uint_as_float(qkmax[(t0 * 2 + 0) * 4 + w]) * __uint_as_float(qkmax[(t0 * 2 + 1) * 4 + w]));
        const float fe = FB[(size_t)t0 * SEQ + SEQ - 1];
        const float win = (PRUNE_T2 + smax * 1.02f + 8.5f) * (float)SEQ / fmaxf(fe, 1.0f);
        Wc[t0] = (int)fminf(win * (1.0f / KVBLK) + 1.0f, 124.0f) + 4; }
    __syncthreads();
#pragma unroll 1
    for (int id = t0; id < 2 * NHEAD * NQB; id += NW * 64) {
        const int qb = NQB - 1 - (id >> 5), bh = id & 31, c0 = 4 * qb + 4, c1 = Wc[bh], c = c0 < c1 ? c0 : c1;
        const int fl = c >> 2, qa = (c - 1) >> 2, qe = (c - 4) >> 2; const bool m4 = (c & 3) == 0;
        const int ngt = 32 - (fl < 32 ? fl : 32), neq = (32 - (qa > qb + 1 ? qa : qb + 1)) > 0 ? 32 - (qa > qb + 1 ? qa : qb + 1) : 0;
        int pos = 0;
#pragma unroll 1
        for (int j = 0; j < 2 * NHEAD; ++j) { const int wj = Wc[j];
            if (wj > c) pos += ngt + ((m4 && (qe > qb || (qe == qb && j < bh))) ? 1 : 0);
            else if (wj == c) pos += neq + ((qb >= qa && j < bh) ? 1 : 0); }
        ord[pos] = (unsigned short)id; }
    __syncthreads();
}
__device__ __forceinline__ Ticket next_block(char* lds, const bf16* Q, const float* FB, const unsigned* qkmax, unsigned* qhead, const int tid, const bool prune = true) {
    __attribute__((address_space(3))) int* xi = (__attribute__((address_space(3))) int*)((__attribute__((address_space(3))) char*)lds + XQ_OFF);
    __attribute__((address_space(3))) float* xf = (__attribute__((address_space(3))) float*)(xi + 16);
    int t0 = tid; asm volatile("" : "+v"(t0));
    const int wid = __builtin_amdgcn_readfirstlane(t0 >> 6), lane = t0 & 63;
    if (t0 == 0) xi[0] = (int)__hip_atomic_fetch_add(qhead, 1u, __ATOMIC_RELAXED, __HIP_MEMORY_SCOPE_AGENT);
    __syncthreads();
    Ticket T; T.idx = xi[0]; { const int id = ((const __attribute__((address_space(3))) unsigned short*)((__attribute__((address_space(3))) char*)lds + ORD_OFF))[T.idx % (2 * NHEAD * NQB)]; T.qb = NQB - 1 - (id >> 5); T.bh = id & 31; } T.jlo = 0;
    if (T.idx >= NTICKETS) { __syncthreads(); return T; }
    const int b = T.bh >> 4, h = T.bh & 15, P0 = T.qb * QB;
#if FA_PRUNE
    const int row = t0 >> 1, half = t0 & 1;
    const int nb0 = P0 / KVBLK;
    const float fbend = (t0 < nb0) ? FB[(size_t)T.bh * SEQ + t0 * KVBLK + KVBLK - 1] : 0.f;
    const bf16* qp = Q + ((size_t)b * SEQ + P0 + row) * PITCH + (size_t)h * D + 64 * half; const bf16* kp = qp + BUF;
    float d = 0.f, nq[2] = {0.f, 0.f};
#pragma unroll
    for (int c = 0; c < 8; ++c) { const u32x4 qa = *(const u32x4*)(qp + 8 * c), ka = *(const u32x4*)(kp + 8 * c);
#pragma unroll
        for (int e = 0; e < 4; ++e) { const float q0 = __uint_as_float(qa[e] << 16), q1 = __uint_as_float(qa[e] & 0xffff0000u);
            d += q0 * __uint_as_float(ka[e] << 16); d += q1 * __uint_as_float(ka[e] & 0xffff0000u); nq[c >> 2] += q0 * q0 + q1 * q1; } }
    float bt = sqrtf(nq[0] * __uint_as_float(qkmax[(T.bh * 2 + 1) * 4 + 2 * half])) + sqrtf(nq[1] * __uint_as_float(qkmax[(T.bh * 2 + 1) * 4 + 2 * half + 1]));
    d += __shfl_xor(d, 1); bt += __shfl_xor(bt, 1);
    d += FB[(size_t)T.bh * SEQ + P0 + row];
    d -= bt * 1.02f + 0.5f;
#pragma unroll
    for (int o = 2; o < 64; o <<= 1) d = fminf(d, __shfl_xor(d, o));
    if (lane == 0) xf[wid] = d;
    __syncthreads();
    float mmin = xf[0];
#pragma unroll
    for (int w = 1; w < 8; ++w) mmin = fminf(mmin, xf[w]);
    const float thresh = prune ? mmin - PRUNE_T2 : -__builtin_inff();
    const bool skip = (t0 < nb0) && (fbend < thresh);
    const unsigned long long bal = __ballot(skip);
    if (lane == 0) xi[8 + wid] = __popcll(bal);
    __syncthreads();
    T.jlo = xi[8] + xi[9];
    __syncthreads();
#else
    __syncthreads();
#endif
    return T;
}
__device__ __forceinline__ void attn_phase(char* lds, const bf16* Q, const float* FB, const unsigned* qkmax, unsigned* qhead, const int tid, const bool prune = true, const int obuf = 5) {
    build_order(lds, FB, qkmax, tid);
    Ticket tc = next_block(lds, Q, FB, qkmax, qhead, tid, prune);
    if (tc.idx >= NTICKETS) return;
    BlockRef cur = block_ref(tc.bh, tc.qb, tc.jlo, Q);
    Seam S;
    load_bias(lds, FB, tc.bh, tc.jlo * KVBLK, (tc.qb + 1) * QB, tid);
    attn_prime(cur, lds, S, tid);
    for (;;) {
        const Ticket tn = next_block(lds, Q, FB, qkmax, qhead, tid, prune);
        const bool last = tn.idx >= NTICKETS;
        const BlockRef nxt = last ? cur : block_ref(tn.bh, tn.qb, tn.jlo, Q);
        attn_block(cur, nxt, lds, S, tid, obuf);
        if (last) break;
        load_bias(lds, FB, tn.bh, tn.jlo * KVBLK, (tn.qb + 1) * QB, tid);
        cur = nxt;
    }
}
}

constexpr int NWAVES = 8;
constexpr int BATCH = 2, SEQ = 8192, DM = 4096, NH = 16, HD = 128, AW = 2048, CW = 2048, DFF = 11008, NIN = 12304;
constexpr int M = BATCH * SEQ;
constexpr int NPROJ = 12288;
constexpr int NGU = 2 * DFF;
constexpr float EPS = 1e-6f;
constexpr float QSCALE = 0.08838834764831845f * 1.4426950408889634f;
#ifndef MK_N_LAUNCHES
#define MK_N_LAUNCHES 1
#endif
constexpr int N_PHASES = 10;

#ifndef PG8_ALIGN
#define PG8_ALIGN true
#endif
#ifndef PG8_SP2
#define PG8_SP2 true
#endif
constexpr size_t MiB = 1u << 20;
constexpr size_t WS_CTL = 0, CTL_ZERO_BYTES = 1 * MiB;
constexpr size_t WS_MOD = 512 * 1024;
constexpr size_t WS_WF = 1 * MiB;
constexpr size_t WS_FT = 2 * MiB;
constexpr size_t WS_FB = 3 * MiB;
constexpr size_t WS_WIN = 4 * MiB;
constexpr size_t WS_WOUT = WS_WIN + (size_t)NPROJ * DM * 2;
constexpr size_t WS_WGU = WS_WOUT + (size_t)DM * DM * 2;
constexpr size_t WS_WD = WS_WGU + (size_t)NGU * DM * 2;
constexpr size_t WS_H = WS_WD + (size_t)DM * DFF * 2;
constexpr size_t WS_Q = WS_H + (size_t)M * DM * 2;
constexpr size_t WS_K = WS_Q + (size_t)M * 2048 * 2, WS_V = WS_K + (size_t)M * 2048 * 2, WS_GB = WS_V + (size_t)M * 2048 * 2, WS_CU = WS_GB + (size_t)M * 2048 * 2, WS_YA = WS_CU + (size_t)M * 2048 * 2;
constexpr size_t WS_ACT = WS_Q;
constexpr size_t WS_HM = WS_YA + (size_t)M * 2048 * 2;
constexpr size_t WS_END = WS_HM + (size_t)M * DM * 2;
static_assert(WS_ACT + (size_t)M * DFF * 2 <= WS_HM, "ACT overlay fits inside Q..YA");
static_assert(WS_WIN % 256 == 0 && WS_WOUT % 256 == 0 && WS_WGU % 256 == 0 && WS_WD % 256 == 0 && WS_H % 256 == 0 && WS_Q % 256 == 0 && WS_HM % 256 == 0, "alignment");
constexpr int CW_BAR = 4096;
constexpr int CW_VX = 7680, CW_BAD = 7744, CW_LB = 8192;
constexpr int CW_CV = 1536, CW_OWN = 2048;
constexpr int CW_QHEAD = 512, CW_QKMAX = 1024;
constexpr int RING_BYTES = 131072, LDSCTL_OFF = RING_BYTES, MISC_OFF = LDSCTL_OFF + 320, LDS_BYTES = 147456;
static_assert(fa::ATT_LDS_BYTES <= RING_BYTES, "attention LDS");
static_assert(WS_K - WS_Q == fa::BUF * 2 && WS_V - WS_K == fa::BUF * 2 && WS_YA - WS_Q == 5 * fa::BUF * 2, "attention tensor spacing");

#define GAS __attribute__((address_space(1)))
#define LAS __attribute__((address_space(3)))
typedef unsigned short bf16;
typedef unsigned v4u __attribute__((ext_vector_type(4)));
typedef unsigned v2u __attribute__((ext_vector_type(2)));
typedef float f32x4 __attribute__((ext_vector_type(4)));
typedef short bf16x8 __attribute__((ext_vector_type(8)));
typedef GAS unsigned gu32;
#define RLX_AGENT __ATOMIC_RELAXED, __HIP_MEMORY_SCOPE_AGENT
#define LDS_WAIT() asm volatile("s_waitcnt lgkmcnt(0)" ::: "memory")
#define VM_WAIT() asm volatile("s_waitcnt vmcnt(0)" ::: "memory")
__device__ __forceinline__ unsigned f2bf(float f) { unsigned u = __builtin_bit_cast(unsigned, f); return (u + 0x7fffu + ((u >> 16) & 1u)) >> 16; }
__device__ __forceinline__ unsigned pk2(float lo, float hi) { return f2bf(lo) | (f2bf(hi) << 16); }
__device__ __forceinline__ float bflo(unsigned w) { return __builtin_bit_cast(float, w << 16); }
__device__ __forceinline__ float bfhi(unsigned w) { return __builtin_bit_cast(float, w & 0xffff0000u); }
__device__ __forceinline__ float wave_sum(float v) {
#pragma unroll
    for (int o = 1; o < 64; o <<= 1) v += __shfl_xor(v, o);
    return v;
}
__device__ __forceinline__ int xcd_row_block(int bid, int G) { return (G == 256) ? 32 * (bid & 7) + (bid >> 3) : bid; }
#define XB_TMO      128
#define XB_XCNT(j)  (256  + 64 * (j))
#define XB_XSUB(j)  (1280 + 64 * (j))
#define XB_XGEN(j)  (2304 + 64 * (j))
#define XB_TOP      3328
#define XB_TOPGEN   3392
#define XCD_BAR_WORDS 3456
#define XB_SPIN_CAP (1u << 18)
#ifndef XB_DIRECT_RELEASE
#define XB_DIRECT_RELEASE 0
#endif
#ifndef XB_EARLY_WB
#define XB_EARLY_WB 0u
#endif

__device__ __forceinline__ unsigned xb_ld(unsigned* p)              { return __hip_atomic_load(p, __ATOMIC_RELAXED, __HIP_MEMORY_SCOPE_AGENT); }
__device__ __forceinline__ unsigned xb_add(unsigned* p, unsigned v) { return __hip_atomic_fetch_add(p, v, __ATOMIC_RELAXED, __HIP_MEMORY_SCOPE_AGENT); }
__device__ __forceinline__ unsigned xb_xcc_id() { return (unsigned)__builtin_amdgcn_s_getreg((3 << 11) | 20) & 0xFu; }
#define XB_SPIN(cond, bar) do { unsigned _sp = 0; while (cond) { __builtin_amdgcn_s_sleep(1); \
    if ((++_sp & 255u) == 0u) { if (xb_ld(&(bar)[XB_TMO])) break; if (_sp > XB_SPIN_CAP) { atomicAdd(&(bar)[XB_TMO], 1u); break; } } } } while (0)

struct XcdBarrier {
    unsigned* bar; unsigned x;
    volatile LAS unsigned* st;
};

__device__ __forceinline__ XcdBarrier xcd_barrier_post(unsigned* bar, volatile LAS unsigned* st, const int tid) {
    XcdBarrier b; b.bar = bar; b.x = xb_xcc_id(); b.st = st;
    if (tid == 0) (void)xb_add(&bar[XB_XCNT(b.x)], 1u);
    return b;
}
__device__ __forceinline__ void xcd_barrier_complete(unsigned* bar, unsigned x, unsigned& nloc, unsigned& nx) {
    const unsigned G = gridDim.x * gridDim.y * gridDim.z;
    unsigned sum, cnt, mine, sp = 0u;
    for (;;) {
        sum = 0u; cnt = 0u; mine = 0u;
#pragma unroll
        for (unsigned j = 0; j < 16; ++j) { const unsigned c = xb_ld(&bar[XB_XCNT(j)]); sum += c; cnt += (c > 0u) ? 1u : 0u; mine = (j == x) ? c : mine; }
        if (sum == G) break;
        __builtin_amdgcn_s_sleep(1);
        if ((++sp & 255u) == 0u) { if (xb_ld(&bar[XB_TMO])) break; if (sp > XB_SPIN_CAP) { atomicAdd(&bar[XB_TMO], 1u); break; } }
    }
    nloc = mine > 0u ? mine : 1u; nx = cnt > 0u ? cnt : 1u;
}

__device__ __forceinline__ void xcd_barrier(const XcdBarrier& b, const int tid) {
    asm volatile("s_waitcnt vmcnt(0)" ::: "memory");
    __syncthreads();
    if (tid == 0) {
        unsigned* bar = b.bar;
        __builtin_amdgcn_s_waitcnt(0);
        unsigned nloc = b.st[0], nx = b.st[1];
        if (nloc == 0u) { xcd_barrier_complete(bar, b.x, nloc, nx); b.st[0] = nloc; b.st[1] = nx; }
        const unsigned old = xb_add(&bar[XB_XSUB(b.x)], 1u);
        const unsigned gen = old / nloc;
        if (old + 1u == (gen + 1u) * nloc) {
#if XB_DIRECT_RELEASE
            const unsigned cntl = b.st[2]; b.st[2] = cntl + 1u;
#endif
#if STAMP_PROBE == 7
            const unsigned long long tw0_ = __builtin_amdgcn_s_memrealtime();
#endif
            __builtin_amdgcn_fence(__ATOMIC_RELEASE, "agent");
            asm volatile("s_waitcnt vmcnt(0)" ::: "memory");
#if STAMP_PROBE == 7
            xb_add(&bar[XB_TMO + 64], (unsigned)(__builtin_amdgcn_s_memrealtime() - tw0_));
#endif
            const unsigned og = xb_add(&bar[XB_TOP], 1u);
            const unsigned tg = og / nx;
#if XB_DIRECT_RELEASE == 2
            (void)tg; if (og + 1u != (cntl + 1u) * nx) XB_SPIN(xb_ld(&bar[XB_TOP]) < (cntl + 1u) * nx, bar);
#else
            if (og + 1u == (tg + 1u) * nx) xb_add(&bar[XB_TOPGEN], 1u);
            else XB_SPIN(xb_ld(&bar[XB_TOPGEN]) == tg, bar);
#endif
            __builtin_amdgcn_fence(__ATOMIC_ACQUIRE, "agent");
            xb_add(&bar[XB_XGEN(b.x)], 1u);
            asm volatile("s_waitcnt vmcnt(0)" ::: "memory");
        } else {
#if XB_DIRECT_RELEASE
            const unsigned cnt = b.st[2]; b.st[2] = cnt + 1u;
#if XB_DIRECT_RELEASE == 2
            XB_SPIN(xb_ld(&bar[XB_TOP]) < (cnt + 1u) * nx, bar);
#else
            XB_SPIN(xb_ld(&bar[XB_TOPGEN]) == cnt, bar);
#endif
            __builtin_amdgcn_fence(__ATOMIC_ACQUIRE, "agent");
            asm volatile("s_waitcnt vmcnt(0)" ::: "memory");
        } if (false) {
#endif
#if XB_EARLY_WB
            if (((old - gen * nloc) & (XB_EARLY_WB - 1u)) == 0u) { __builtin_amdgcn_fence(__ATOMIC_RELEASE, "agent"); asm volatile("s_waitcnt vmcnt(0)" ::: "memory"); }
#endif
            XB_SPIN(xb_ld(&bar[XB_XGEN(b.x)]) == gen, bar);
            __builtin_amdgcn_fence(__ATOMIC_ACQUIRE, "agent");
            asm volatile("s_waitcnt vmcnt(0)" ::: "memory");
        }
    }
    __syncthreads();
}
__device__ __forceinline__ void xcd_local_check(unsigned* ctl, int bid, int G, const int tid) {
    if (tid == 0) { const unsigned me = xb_xcc_id() + 1u; unsigned e = 0u;
        __hip_atomic_compare_exchange_strong(ctl + CW_VX + (bid & 7), &e, me, __ATOMIC_RELAXED, __ATOMIC_RELAXED, __HIP_MEMORY_SCOPE_AGENT);
        if ((e != 0u && e != me) || G != 256) __hip_atomic_store(ctl + CW_BAD, 1u, __ATOMIC_RELAXED, __HIP_MEMORY_SCOPE_AGENT); }
}
__device__ __forceinline__ void xcd_local_seam(unsigned* ctl, int slot, int bid, int G, const int tid) {
    asm volatile("s_waitcnt vmcnt(0)" ::: "memory");
    __syncthreads();
    if (tid == 0) {
        unsigned* bar = ctl + CW_BAR; unsigned* w = ctl + CW_LB + 64 * (8 * slot + (bid & 7));
        const unsigned n = (unsigned)((G + 7 - (bid & 7)) / 8);
        __builtin_amdgcn_s_waitcnt(0);
        (void)xb_add(w, 1u);
        XB_SPIN(xb_ld(w) < n, bar);
        __builtin_amdgcn_fence(__ATOMIC_ACQUIRE, "agent");
        asm volatile("s_waitcnt vmcnt(0)" ::: "memory");
    }
    __syncthreads();
}
struct DestWin { bf16* W; __device__ __forceinline__ bf16* operator()(int n) const {
    if (n < 6144) return W + (size_t)n * DM;
    if (n < 6160) return nullptr;
    if (n < 8208) return W + (size_t)(6144 + (n - 6160)) * DM;
    if (n < 10256) { const int j = n - 8208; return W + (size_t)(8192 + (j >> 7) * 256 + (j & 127)) * DM; }
    const int j = n - 10256; return W + (size_t)(8192 + (j >> 7) * 256 + 128 + (j & 127)) * DM; } };
struct DestPlain { bf16* W; int K; __device__ __forceinline__ bf16* operator()(int n) const { return W + (size_t)n * K; } };
struct DestGU { bf16* W; int half; __device__ __forceinline__ bf16* operator()(int n) const { return W + (size_t)((n >> 7) * 256 + half * 128 + (n & 127)) * DM; } };
template <class Dest>
__device__ __forceinline__ void p0_transpose_item(const float* W, int K, int N, int item, int lane, const Dest dest) {
    const int nblk = (N + 63) / 64, kb = item / nblk, nb = item - kb * nblk, k0 = 64 * kb, n0 = 64 * nb;
    const int c4 = lane & 15, rs = lane >> 4, n = n0 + 4 * c4; const bool nok = n < N;
    const float* wp = W + (size_t)(k0 + 8 * rs) * N + n;
    f32x4 v[2][8];
#pragma unroll
    for (int jj = 0; jj < 2; ++jj)
#pragma unroll
        for (int kk = 0; kk < 8; ++kk) v[jj][kk] = nok ? __builtin_nontemporal_load((const GAS f32x4*)(wp + (size_t)(32 * jj + kk) * N)) : (f32x4){0.f, 0.f, 0.f, 0.f};
#pragma unroll
    for (int q = 0; q < 4; ++q) { bf16* drow = nok ? dest(n + q) : nullptr;
        if (drow) {
#pragma unroll
            for (int jj = 0; jj < 2; ++jj) { v4u o; o.x = pg8::cvt_pk_bf16(v[jj][0][q], v[jj][1][q]); o.y = pg8::cvt_pk_bf16(v[jj][2][q], v[jj][3][q]); o.z = pg8::cvt_pk_bf16(v[jj][4][q], v[jj][5][q]); o.w = pg8::cvt_pk_bf16(v[jj][6][q], v[jj][7][q]);
                *(GAS v4u*)(drow + k0 + 8 * (rs + 4 * jj)) = o; } } }
}
__device__ __forceinline__ unsigned w0_bcast(unsigned v) { return (unsigned)__builtin_amdgcn_readfirstlane((int)v); }
__device__ __forceinline__ int cv_pick(const unsigned* heads, int per, int start, int lane) {
    const unsigned h = (lane < 8) ? __hip_atomic_load(heads + 64 * lane, __ATOMIC_RELAXED, __HIP_MEMORY_SCOPE_AGENT) : 0xffffffffu;
    const unsigned mm = (unsigned)__ballot(h < (unsigned)per) & 0xffu;
    if (mm == 0u) return -1;
    const unsigned rot = ((mm >> start) | (mm << (8 - start))) & 0xffu;
    return (start + __builtin_ctz(rot)) & 7;
}
template <class F>
__device__ __forceinline__ void dyn_walk(unsigned* heads, const int per, int bid, int wave, int lane, F&& item) {
    int shard = cv_pick(heads, per, (bid + wave) & 7, lane);
    if (shard < 0) return;
    unsigned tv = 0u; if (lane == 0) tv = __hip_atomic_fetch_add(heads + 64 * shard, 1u, __ATOMIC_RELAXED, __HIP_MEMORY_SCOPE_AGENT);
    unsigned t = w0_bcast(tv);
#pragma unroll 1
    for (;;) {
        if (t >= (unsigned)per) { shard = cv_pick(heads, per, shard, lane); if (shard < 0) break;
            tv = 0u; if (lane == 0) tv = __hip_atomic_fetch_add(heads + 64 * shard, 1u, __ATOMIC_RELAXED, __HIP_MEMORY_SCOPE_AGENT); t = w0_bcast(tv); continue; }
        tv = 0u; if (lane == 0) tv = __hip_atomic_fetch_add(heads + 64 * shard, 1u, __ATOMIC_RELAXED, __HIP_MEMORY_SCOPE_AGENT);
        item(shard * per + (int)t);
        t = w0_bcast(tv);
    }
}
constexpr int P0_REPS = 1 + ((DUP_MASK) & 1);
struct P0Args { const float *c, *w_ada, *b_ada, *w_in, *w_out, *w_gate, *w_up, *w_down; float* mod; bf16 *WF, *WIN, *WOUT, *WGU, *WD; };
constexpr int P0_I_IN = (DM / 64) * ((NIN + 63) / 64), P0_I_OUT = (DM / 64) * (DM / 64), P0_I_G = (DM / 64) * (DFF / 64), P0_NITEMS = P0_I_IN + P0_I_OUT + 2 * P0_I_G;
struct P0Item { const float* W; bf16* Dst; int N, kind, k0, n0; };
__device__ __forceinline__ P0Item p0_decode(const P0Args& A, int it) {
    P0Item I; int r = it;
    if (r < P0_I_IN) { I.W = A.w_in; I.Dst = A.WIN; I.N = NIN; I.kind = 0; }
    else if ((r -= P0_I_IN) < P0_I_OUT) { I.W = A.w_out; I.Dst = A.WOUT; I.N = DM; I.kind = 1; }
    else if ((r -= P0_I_OUT) < P0_I_G) { I.W = A.w_gate; I.Dst = A.WGU; I.N = DFF; I.kind = 2; }
    else { r -= P0_I_G; I.W = A.w_up; I.Dst = A.WGU; I.N = DFF; I.kind = 3; }
    const int nblk = (I.N + 63) / 64, kb = r / nblk, nb = r - kb * nblk; I.k0 = 64 * kb; I.n0 = 64 * nb; return I;
}
__device__ __forceinline__ bf16* p0_dest(const P0Item& I, int n) {
    if (I.kind == 0) return DestWin{I.Dst}(n);
    if (I.kind == 1) return I.Dst + (size_t)n * DM;
    return DestGU{I.Dst, I.kind - 2}(n);
}
__device__ __forceinline__ void p0_load(const P0Item& I, int lane, f32x4 (&v)[2][8]) {
    const int c4 = lane & 15, rs = lane >> 4, n = I.n0 + 4 * c4; const bool nok = n < I.N;
    const float* wp = I.W + (size_t)(I.k0 + 8 * rs) * I.N + n;
#pragma unroll
    for (int jj = 0; jj < 2; ++jj)
#pragma unroll
        for (int kk = 0; kk < 8; ++kk) v[jj][kk] = nok ? __builtin_nontemporal_load((const GAS f32x4*)(wp + (size_t)(32 * jj + kk) * I.N)) : (f32x4){0.f, 0.f, 0.f, 0.f};
}
__device__ __forceinline__ void p0_store(const P0Item& I, int lane, const f32x4 (&v)[2][8]) {
    const int c4 = lane & 15, rs = lane >> 4, n = I.n0 + 4 * c4; const bool nok = n < I.N;
#pragma unroll
    for (int q = 0; q < 4; ++q) { bf16* drow = nok ? p0_dest(I, n + q) : nullptr;
        if (drow) {
#pragma unroll
            for (int jj = 0; jj < 2; ++jj) { v4u o; o.x = pg8::cvt_pk_bf16(v[jj][0][q], v[jj][1][q]); o.y = pg8::cvt_pk_bf16(v[jj][2][q], v[jj][3][q]); o.z = pg8::cvt_pk_bf16(v[jj][4][q], v[jj][5][q]); o.w = pg8::cvt_pk_bf16(v[jj][6][q], v[jj][7][q]);
                *(GAS v4u*)(drow + I.k0 + 8 * (rs + 4 * jj)) = o; } } }
}
__device__ __forceinline__ void p0_prologue(LAS unsigned char* lds, const P0Args& A, int G, int bid, int tid, int wave, int lane) {
#if STAMP_PROBE == 5
    if (tid == 0) ((unsigned long long*)((char*)A.mod - 524288 + 65536))[11 * 256 + bid] = __builtin_amdgcn_s_memrealtime();
#endif
    LAS float* cact = (LAS float*)(lds + 73728);
    for (int i = tid; i < 2 * DM; i += NWAVES * 64) { const float v = A.c[i]; cact[i] = v / (1.f + expf(-v)); }
    __syncthreads();
    if (G == 256 && P0_GEMV_WIDE) {
        LAS float* part = (LAS float*)lds;
        for (int rep0 = 0; rep0 < P0_REPS; ++rep0) {
            const int cg = bid & 15, kq = bid >> 4;
            if (tid < 384) {
                const int n = cg * 1536 + tid * 4;
                const float* wp = A.w_ada + (size_t)(kq * 256) * (6 * DM) + n;
                f32x4 a0 = {0.f, 0.f, 0.f, 0.f}, a1 = {0.f, 0.f, 0.f, 0.f};
#pragma unroll 32
                for (int kk = 0; kk < 256; ++kk) { const f32x4 w = __builtin_nontemporal_load((const GAS f32x4*)(wp + (size_t)kk * (6 * DM))); const float c0 = cact[kq * 256 + kk], c1 = cact[DM + kq * 256 + kk]; a0 += w * c0; a1 += w * c1; }
                if (kq == 0) { const f32x4 b = *(const f32x4*)(A.b_ada + n); a0 += b; a1 += b; }
                *(LAS f32x4*)(part + tid * 4) = a0; *(LAS f32x4*)(part + 1536 + tid * 4) = a1; }
            __syncthreads();
            if (rep0 == 0)
                for (int e = tid; e < 3072; e += NWAVES * 64) { const int bsel = (e >= 1536) ? 1 : 0, c = e - 1536 * bsel;
                    __hip_atomic_fetch_add(A.mod + bsel * 6 * DM + cg * 1536 + c, part[e], __ATOMIC_RELAXED, __HIP_MEMORY_SCOPE_AGENT); }
            __syncthreads();
        }
    } else
    for (int rep0 = 0; rep0 < P0_REPS; ++rep0)
    for (int it = bid; it < 12 * 64; it += G) {
        const int cg = it % 12, kc = it / 12, n = cg * 2048 + tid * 4;
        const float* wp = A.w_ada + (size_t)(kc * 64) * (6 * DM) + n;
        f32x4 a0 = {0.f, 0.f, 0.f, 0.f}, a1 = {0.f, 0.f, 0.f, 0.f};
#pragma unroll 32
        for (int kk = 0; kk < 64; ++kk) { const f32x4 w = __builtin_nontemporal_load((const GAS f32x4*)(wp + (size_t)kk * (6 * DM))); const float c0 = cact[kc * 64 + kk], c1 = cact[DM + kc * 64 + kk]; a0 += w * c0; a1 += w * c1; }
        if (kc == 0) { const f32x4 b = *(const f32x4*)(A.b_ada + n); a0 += b; a1 += b; }
        float* m0 = A.mod + n; float* m1 = A.mod + 6 * DM + n;
        if (rep0 == 0 || a0[0] == 1.2345678e30f)
#pragma unroll
        for (int j = 0; j < 4; ++j) { __hip_atomic_fetch_add(m0 + j, a0[j], __ATOMIC_RELAXED, __HIP_MEMORY_SCOPE_AGENT); __hip_atomic_fetch_add(m1 + j, a1[j], __ATOMIC_RELAXED, __HIP_MEMORY_SCOPE_AGENT); }
    }
#if STAMP_PROBE == 5
    if (tid == 0) ((unsigned long long*)((char*)A.mod - 524288 + 65536))[10 * 256 + bid] = __builtin_amdgcn_s_memrealtime();
#endif
    { const int g = bid * NWAVES * 64 + tid; if (g < 16 * DM) { const int k = g >> 4, n = g & 15; A.WF[(size_t)n * DM + k] = (bf16)f2bf(A.w_in[(size_t)k * NIN + 6144 + n]); } }
    if (P0_BLOCK_ITEMS) {
        constexpr int KB8 = DM / 512, B_IN = KB8 * ((NIN + 63) / 64), B_OUT = KB8 * (DM / 64), B_G = KB8 * (DFF / 64), B_ALL = B_IN + B_OUT + 2 * B_G, NVB = P0_REPS * B_ALL;
        auto bdecode = [&](int bi) { P0Item I; int r = bi % B_ALL;
            if (r < B_IN) { I.W = A.w_in; I.Dst = A.WIN; I.N = NIN; I.kind = 0; }
            else if ((r -= B_IN) < B_OUT) { I.W = A.w_out; I.Dst = A.WOUT; I.N = DM; I.kind = 1; }
            else if ((r -= B_OUT) < B_G) { I.W = A.w_gate; I.Dst = A.WGU; I.N = DFF; I.kind = 2; }
            else { r -= B_G; I.W = A.w_up; I.Dst = A.WGU; I.N = DFF; I.kind = 3; }
            const int nblk = (I.N + 63) / 64, kb = r / nblk, nb = r - kb * nblk; I.k0 = 512 * kb + 64 * wave; I.n0 = 64 * nb; return I; };
        LAS unsigned char* tile = lds;
        const int c4 = lane & 15, rs = lane >> 4;
        f32x4 va[2][8];
        int bi = bid;
        if (bi < NVB) { const P0Item I = bdecode(bi); p0_load(I, lane, va); }
        while (bi < NVB) {
            const P0Item I = bdecode(bi);
#pragma unroll
            for (int q = 0; q < 4; ++q)
#pragma unroll
                for (int jj = 0; jj < 2; ++jj) { v4u o; o.x = pg8::cvt_pk_bf16(va[jj][0][q], va[jj][1][q]); o.y = pg8::cvt_pk_bf16(va[jj][2][q], va[jj][3][q]); o.z = pg8::cvt_pk_bf16(va[jj][4][q], va[jj][5][q]); o.w = pg8::cvt_pk_bf16(va[jj][6][q], va[jj][7][q]);
                    *(LAS v4u*)(tile + (4 * c4 + q) * 1024 + (((8 * wave + rs + 4 * jj) ^ c4) << 4)) = o; }
            const int bn = bi + G;
            if (bn < NVB) { const P0Item In = bdecode(bn); p0_load(In, lane, va); }
            LDS_WAIT(); __builtin_amdgcn_s_barrier();
            const int kb0 = I.k0 - 64 * wave;
#pragma unroll
            for (int rr = 0; rr < 8; ++rr) { const int nl = 8 * wave + rr, n = I.n0 + nl; bf16* drow = (n < I.N) ? p0_dest(I, n) : nullptr;
                const v4u w = *(const LAS v4u*)(tile + nl * 1024 + ((lane ^ (nl >> 2)) << 4));
                if (drow) *(GAS v4u*)(drow + kb0 + 8 * lane) = w; }
            LDS_WAIT(); __builtin_amdgcn_s_barrier();
            bi = bn;
        }
        return;
    }
    const int gw = bid * NWAVES + wave, NGW = G * NWAVES;
    constexpr int NVIRT = P0_REPS * P0_NITEMS;
    f32x4 va[2][8], vb[2][8];
    int it = gw;
    if (it < NVIRT) { const P0Item I = p0_decode(A, it % P0_NITEMS); p0_load(I, lane, va); }
    while (it < NVIRT) {
        const int i1 = it + NGW, i2 = it + 2 * NGW;
        if (i1 < NVIRT) { const P0Item I = p0_decode(A, i1 % P0_NITEMS); p0_load(I, lane, vb); }
        { const P0Item I = p0_decode(A, it % P0_NITEMS); p0_store(I, lane, va); }
        if (i1 >= NVIRT) break;
        if (i2 < NVIRT) { const P0Item I = p0_decode(A, i2 % P0_NITEMS); p0_load(I, lane, va); }
        { const P0Item I = p0_decode(A, i1 % P0_NITEMS); p0_store(I, lane, vb); }
        it = i2;
    }
}
__device__ __forceinline__ void convert_w_down(const float* w_down, bf16* WD, int b, int nb, int wave, int lane) {
    constexpr int I_D = (DFF / 64) * (DM / 64);
    for (int it = b * NWAVES + wave; it < I_D; it += nb * NWAVES) p0_transpose_item(w_down, DFF, DM, it, lane, DestPlain{WD, DFF});
}
__device__ __forceinline__ int p7_claim(unsigned* ctl, int bid, int lane) {
    unsigned* own = ctl + CW_OWN; const unsigned me = (unsigned)(bid & 7) + 1u;
    int grp = -1; unsigned idx = 0u;
#pragma unroll 1
    for (int s = 0; s < 8 && grp < 0; ++s) { const int w = ((bid & 7) + s) & 7;
        unsigned o = 0u;
        if (lane == 0) { o = __hip_atomic_load(own + 64 * w, __ATOMIC_RELAXED, __HIP_MEMORY_SCOPE_AGENT);
            if (o == 0u) { unsigned e = 0u; __hip_atomic_compare_exchange_strong(own + 64 * w, &e, me, __ATOMIC_RELAXED, __ATOMIC_RELAXED, __HIP_MEMORY_SCOPE_AGENT); o = (e == 0u) ? me : e; } }
        o = w0_bcast(o);
        if (o == me) { unsigned i = 16u; if (lane == 0) i = __hip_atomic_fetch_add(own + 64 * w + 1, 1u, __ATOMIC_RELAXED, __HIP_MEMORY_SCOPE_AGENT); i = w0_bcast(i); if (i < 16u) { grp = w; idx = i; } } }
    return grp < 0 ? -1 : grp + 8 * (int)idx;
}
__device__ __forceinline__ void convert_w_down_dyn(const float* w_down, bf16* WD, unsigned* heads, int bid, int wave, int lane) {
    constexpr int CV_ITEMS = (DFF / 64) * (DM / 64);
    static_assert(CV_ITEMS % 8 == 0, "conversion shards");
    dyn_walk(heads, CV_ITEMS / 8, bid, wave, lane, [&](int it) { p0_transpose_item(w_down, DFF, DM, it, lane, DestPlain{WD, DFF}); });
}
__device__ __forceinline__ void p1_norm1(LAS unsigned char* lds, const float* x, const float* pre_norm_mix, const float* mod, const bf16* WF, bf16* H1, float* FT, int G, int bid, int tid, int wave, int lane) {
    LAS float* G1 = (LAS float*)lds; LAS float* SH1 = G1 + DM; LAS unsigned char* TILE = lds + 32768; LAS f32x4* fpart = (LAS f32x4*)(lds + 98304);
    int cur_b = -1, par = 0; const int r = lane & 15, kq = lane >> 4;
    constexpr int NT1 = M / 8;
    bf16x8 wfr[16];
    { const bf16* wfp0 = WF + (size_t)r * DM + wave * 512 + kq * 8;
#pragma unroll
      for (int i = 0; i < 16; ++i) wfr[i] = *(const GAS bf16x8*)(wfp0 + 32 * i); }
    f32x4 xr[16];
    if (bid < NT1) { const float* xp = x + (size_t)(bid * 8 + wave) * DM + lane * 4;
#pragma unroll
        for (int j = 0; j < 16; ++j) xr[j] = __builtin_nontemporal_load((const GAS f32x4*)(xp + 256 * j)); }
#pragma unroll 1
    for (int tile = bid; tile < NT1; tile += G) {
        const int b = tile / (SEQ / 8), row = tile * 8 + wave;
        if (b != cur_b) { __syncthreads();
            for (int i = tid; i < DM; i += NWAVES * 64) { G1[i] = pre_norm_mix[i] * (1.f + mod[b * 6 * DM + DM + i]); SH1[i] = mod[b * 6 * DM + i]; }
            __syncthreads(); cur_b = b; }
        float ss = 0.f;
#pragma unroll
        for (int j = 0; j < 16; ++j) { const f32x4 v = xr[j]; ss += (v[0] * v[0] + v[1] * v[1]) + (v[2] * v[2] + v[3] * v[3]); }
        ss = wave_sum(ss);
        const float rstd = 1.0f / sqrtf(ss * (1.0f / DM) + EPS);
        const bool has_nx = tile + G < NT1; const float* xn = x + (size_t)(row + 8 * G) * DM + lane * 4;
        bf16* hp = H1 + (size_t)row * DM + lane * 4;
        LAS unsigned char* trow = TILE + wave * (DM * 2) + 8 * (lane & 1);
#pragma unroll
        for (int j = 0; j < 16; ++j) {
            const f32x4 g = *(const LAS f32x4*)(G1 + 256 * j + lane * 4), sh = *(const LAS f32x4*)(SH1 + 256 * j + lane * 4);
            const f32x4 v = xr[j] * rstd * g + sh;
            v2u w; w.x = pg8::cvt_pk_bf16(v[0], v[1]); w.y = pg8::cvt_pk_bf16(v[2], v[3]);
            *(GAS v2u*)(hp + 256 * j) = w;
            *(LAS v2u*)(trow + (((32 * j + (lane >> 1)) ^ wave) << 4)) = w;
            if (has_nx) xr[j] = __builtin_nontemporal_load((const GAS f32x4*)(xn + 256 * j));
        }
        LDS_WAIT(); __builtin_amdgcn_s_barrier();
        f32x4 acc = {0.f, 0.f, 0.f, 0.f};
        const LAS unsigned char* arow = TILE + (r & 7) * (DM * 2);
#pragma unroll
        for (int i = 0; i < 16; ++i) {
            bf16x8 af = *(const LAS bf16x8*)(arow + (((64 * wave + 4 * i + kq) ^ (r & 7)) << 4));
            if (r >= 8) af = (bf16x8){0, 0, 0, 0, 0, 0, 0, 0};
            acc = __builtin_amdgcn_mfma_f32_16x16x32_bf16(af, wfr[i], acc, 0, 0, 0);
        }
        fpart[(par * 8 + wave) * 64 + lane] = acc;
        LDS_WAIT(); __builtin_amdgcn_s_barrier();
        if (wave == 0) { f32x4 s = fpart[(par * 8) * 64 + lane];
#pragma unroll
            for (int w = 1; w < 8; ++w) s += fpart[(par * 8 + w) * 64 + lane];
            const int t0 = (tile * 8) % SEQ + 4 * kq;
            if (kq < 2) *(GAS f32x4*)(FT + (size_t)(b * NH + r) * SEQ + t0) = s; }
        par ^= 1;
    }
}
__device__ __forceinline__ void p2_scan(LAS unsigned char* lds, const float* FT, const float* b_f, float* FB, int bh, int tid, int wave, int lane) {
    const float bias = b_f[bh & 15];
    const GAS f32x4* src = (const GAS f32x4*)(FT + (size_t)bh * SEQ + tid * 16);
    double pre[16]; double run = 0.0;
#pragma unroll
    for (int q = 0; q < 4; ++q) { const f32x4 v = src[q];
#pragma unroll
        for (int j = 0; j < 4; ++j) { const float z = v[j] + bias; const float ls = fminf(z, 0.f) - __logf(1.0f + __expf(-fabsf(z))); run += (double)ls; pre[4 * q + j] = run; } }
    double incl = run;
#pragma unroll
    for (int o = 1; o < 64; o <<= 1) { const double t = __shfl_up(incl, o); if (lane >= o) incl += t; }
    LAS double* wt = (LAS double*)lds;
    if (lane == 63) wt[wave] = incl;
    __syncthreads();
    double off = incl - run;
    for (int w = 0; w < wave; ++w) off += wt[w];
    GAS f32x4* dst = (GAS f32x4*)(FB + (size_t)bh * SEQ + tid * 16);
#pragma unroll
    for (int q = 0; q < 4; ++q) { f32x4 o;
#pragma unroll
        for (int j = 0; j < 4; ++j) o[j] = (float)(-(off + pre[4 * q + j]) * 1.4426950408889634);
        dst[q] = o; }
    __syncthreads();
}
__device__ __forceinline__ void unpack8(const v4u w, float (&f)[8]) { f[0] = bflo(w.x); f[1] = bfhi(w.x); f[2] = bflo(w.y); f[3] = bfhi(w.y); f[4] = bflo(w.z); f[5] = bfhi(w.z); f[6] = bflo(w.w); f[7] = bfhi(w.w); }
__device__ __forceinline__ void p4_ynorm_conv(LAS unsigned char* lds, const bf16* YA, const bf16* GB, const bf16* CU, const float* conv_w, const float* attn_g, const float* conv_g, bf16* Y, int G, int bid, int tid, int wave, int lane) {
    LAS float* CWl = (LAS float*)lds; LAS float* AGl = CWl + 3 * CW; LAS float* CGl = AGl + AW;
    for (int i = tid; i < 3 * CW; i += NWAVES * 64) CWl[i] = conv_w[i];
    for (int i = tid; i < AW; i += NWAVES * 64) { AGl[i] = attn_g[i]; CGl[i] = conv_g[i]; }
    __syncthreads();
    const int gw = xcd_row_block(bid, G) * NWAVES + wave, NGW = G * NWAVES;
    for (int chunk = gw; chunk < M / 8; chunk += NGW) {
        const int m0 = chunk * 8, t0 = m0 % SEQ;
        v4u c1[4], c2[4];
#pragma unroll
        for (int j = 0; j < 4; ++j) { c1[j] = (v4u){0u, 0u, 0u, 0u}; c2[j] = (v4u){0u, 0u, 0u, 0u}; }
        if (t0 != 0) {
#pragma unroll
            for (int j = 0; j < 4; ++j) { c1[j] = *(const GAS v4u*)(CU + (size_t)(m0 - 1) * CW + j * 512 + lane * 8); c2[j] = *(const GAS v4u*)(CU + (size_t)(m0 - 2) * CW + j * 512 + lane * 8); } }
#pragma unroll 1
        for (int rr = 0; rr < 8; ++rr) { const int m = m0 + rr; __builtin_amdgcn_sched_barrier(0);
            v4u a[4], c0[4], gb[4];
#pragma unroll
            for (int j = 0; j < 4; ++j) { a[j] = __builtin_nontemporal_load((const GAS v4u*)(YA + (size_t)m * AW + j * 512 + lane * 8)); c0[j] = __builtin_nontemporal_load((const GAS v4u*)(CU + (size_t)m * CW + j * 512 + lane * 8)); gb[j] = __builtin_nontemporal_load((const GAS v4u*)(GB + (size_t)m * CW + j * 512 + lane * 8)); }
            float ssa = 0.f;
#pragma unroll
            for (int j = 0; j < 4; ++j) { float f[8]; unpack8(a[j], f);
#pragma unroll
                for (int i = 0; i < 8; ++i) ssa += f[i] * f[i]; }
            __builtin_amdgcn_sched_barrier(0);
            const float rsa = 1.0f / sqrtf(wave_sum(ssa) * (1.0f / AW) + EPS);
#pragma unroll
            for (int j = 0; j < 4; ++j) { float f[8]; unpack8(a[j], f); const int cb = j * 512 + lane * 8;
                const f32x4 g0 = *(const LAS f32x4*)(AGl + cb), g1 = *(const LAS f32x4*)(AGl + cb + 4);
                v4u w; w.x = pg8::cvt_pk_bf16(f[0] * rsa * g0[0], f[1] * rsa * g0[1]); w.y = pg8::cvt_pk_bf16(f[2] * rsa * g0[2], f[3] * rsa * g0[3]);
                w.z = pg8::cvt_pk_bf16(f[4] * rsa * g1[0], f[5] * rsa * g1[1]); w.w = pg8::cvt_pk_bf16(f[6] * rsa * g1[2], f[7] * rsa * g1[3]);
                *(GAS v4u*)(Y + (size_t)m * DM + cb) = w; __builtin_amdgcn_sched_barrier(0); }
            float yc[4][8]; float ssc = 0.f;
#pragma unroll
            for (int j = 0; j < 4; ++j) { float f0[8], f1[8], f2[8], fg[8]; unpack8(c0[j], f0); unpack8(c1[j], f1); unpack8(c2[j], f2); unpack8(gb[j], fg); const int cb = j * 512 + lane * 8;
#pragma unroll
                for (int h = 0; h < 2; ++h) { const f32x4 w0 = *(const LAS f32x4*)(CWl + cb + 4 * h), w1 = *(const LAS f32x4*)(CWl + CW + cb + 4 * h), w2 = *(const LAS f32x4*)(CWl + 2 * CW + cb + 4 * h);
#pragma unroll
                    for (int i = 0; i < 4; ++i) { const float v = fg[4 * h + i] * (w0[i] * f2[4 * h + i] + w1[i] * f1[4 * h + i] + w2[i] * f0[4 * h + i]); yc[j][4 * h + i] = v; ssc += v * v; } }
                __builtin_amdgcn_sched_barrier(0); }
            const float rsc = 1.0f / sqrtf(wave_sum(ssc) * (1.0f / CW) + EPS);
#pragma unroll
            for (int j = 0; j < 4; ++j) { const int cb = j * 512 + lane * 8;
                const f32x4 g0 = *(const LAS f32x4*)(CGl + cb), g1 = *(const LAS f32x4*)(CGl + cb + 4);
                v4u w; w.x = pg8::cvt_pk_bf16(yc[j][0] * rsc * g0[0], yc[j][1] * rsc * g0[1]); w.y = pg8::cvt_pk_bf16(yc[j][2] * rsc * g0[2], yc[j][3] * rsc * g0[3]);
                w.z = pg8::cvt_pk_bf16(yc[j][4] * rsc * g1[0], yc[j][5] * rsc * g1[1]); w.w = pg8::cvt_pk_bf16(yc[j][6] * rsc * g1[2], yc[j][7] * rsc * g1[3]);
                *(GAS v4u*)(Y + (size_t)m * DM + AW + cb) = w; __builtin_amdgcn_sched_barrier(0); }
#pragma unroll
            for (int j = 0; j < 4; ++j) { c2[j] = c1[j]; c1[j] = c0[j]; }
        }
    }
}
__device__ __forceinline__ void p6_resid1(LAS unsigned char* lds, const float* x, const bf16* HM, const float* mod, const float* post_norm_mix, const float* pre_norm_ffn, bf16* H2, int G, int bid, int tid, int wave, int lane) {
    LAS float* V1 = (LAS float*)lds; LAS float* G2 = V1 + DM; LAS float* S2 = G2 + DM;
    int cur_b = -1;
    for (int blk = xcd_row_block(bid, G); blk < M / 64; blk += G) {
        const int b = blk / (SEQ / 64);
        if (b != cur_b) { __syncthreads();
            for (int i = tid; i < DM; i += NWAVES * 64) { const float* mb = mod + b * 6 * DM; V1[i] = mb[2 * DM + i] * post_norm_mix[i]; G2[i] = pre_norm_ffn[i] * (1.f + mb[4 * DM + i]); S2[i] = mb[3 * DM + i]; }
            __syncthreads(); cur_b = b; }
#pragma unroll 1
        for (int rr = 0; rr < 8; ++rr) { const int m = blk * 64 + wave * 8 + rr; __builtin_amdgcn_sched_barrier(0);
            f32x4 xv[16]; v2u hv[16];
#pragma unroll
            for (int j = 0; j < 16; ++j) { xv[j] = __builtin_nontemporal_load((const GAS f32x4*)(x + (size_t)m * DM + j * 256 + lane * 4)); hv[j] = __builtin_nontemporal_load((const GAS v2u*)(HM + (size_t)m * DM + j * 256 + lane * 4)); }
            float ss = 0.f;
#pragma unroll
            for (int j = 0; j < 16; ++j) { const float h0 = bflo(hv[j].x), h1 = bfhi(hv[j].x), h2 = bflo(hv[j].y), h3 = bfhi(hv[j].y); ss += (h0 * h0 + h1 * h1) + (h2 * h2 + h3 * h3); }
            const float r1 = 1.0f / sqrtf(wave_sum(ss) * (1.0f / DM) + EPS);
            float ss2 = 0.f;
#pragma unroll
            for (int j = 0; j < 16; ++j) { const f32x4 v1 = *(const LAS f32x4*)(V1 + j * 256 + lane * 4);
                f32x4 h = {bflo(hv[j].x), bfhi(hv[j].x), bflo(hv[j].y), bfhi(hv[j].y)};
                const f32x4 x1 = xv[j] + v1 * h * r1; xv[j] = x1;
                ss2 += (x1[0] * x1[0] + x1[1] * x1[1]) + (x1[2] * x1[2] + x1[3] * x1[3]); }
            const float r2 = 1.0f / sqrtf(wave_sum(ss2) * (1.0f / DM) + EPS);
#pragma unroll
            for (int j = 0; j < 16; ++j) { const f32x4 g2 = *(const LAS f32x4*)(G2 + j * 256 + lane * 4), s2 = *(const LAS f32x4*)(S2 + j * 256 + lane * 4);
                const f32x4 h = xv[j] * r2 * g2 + s2; v2u w; w.x = pg8::cvt_pk_bf16(h[0], h[1]); w.y = pg8::cvt_pk_bf16(h[2], h[3]);
                *(GAS v2u*)(H2 + (size_t)m * DM + j * 256 + lane * 4) = w; }
        }
    }
}
__device__ __forceinline__ void p9_final(LAS unsigned char* lds, const float* x, const bf16* HMIX, const bf16* HFFN, const float* mod, const float* post_norm_mix, const float* post_norm_ffn, float* out, int G, int bid, int tid, int wave, int lane) {
    LAS float* V1 = (LAS float*)lds; LAS float* V2 = V1 + DM;
    int cur_b = -1;
    for (int blk = xcd_row_block(bid, G); blk < M / 64; blk += G) {
        const int b = blk / (SEQ / 64);
        if (b != cur_b) { __syncthreads();
            for (int i = tid; i < DM; i += NWAVES * 64) { const float* mb = mod + b * 6 * DM; V1[i] = mb[2 * DM + i] * post_norm_mix[i]; V2[i] = mb[5 * DM + i] * post_norm_ffn[i]; }
            __syncthreads(); cur_b = b; }
#pragma unroll 1
        for (int rr = 0; rr < 8; ++rr) { const int m = blk * 64 + wave * 8 + rr; __builtin_amdgcn_sched_barrier(0);
            f32x4 xv[16]; v2u hv[16], fv[16];
#pragma unroll
            for (int j = 0; j < 16; ++j) { xv[j] = __builtin_nontemporal_load((const GAS f32x4*)(x + (size_t)m * DM + j * 256 + lane * 4)); hv[j] = __builtin_nontemporal_load((const GAS v2u*)(HMIX + (size_t)m * DM + j * 256 + lane * 4));
                fv[j] = __builtin_nontemporal_load((const GAS v2u*)(HFFN + (size_t)m * DM + j * 256 + lane * 4)); }
            float ss = 0.f, sf = 0.f;
#pragma unroll
            for (int j = 0; j < 16; ++j) { const float h0 = bflo(hv[j].x), h1 = bfhi(hv[j].x), h2 = bflo(hv[j].y), h3 = bfhi(hv[j].y); ss += (h0 * h0 + h1 * h1) + (h2 * h2 + h3 * h3);
                const float f0 = bflo(fv[j].x), f1 = bfhi(fv[j].x), f2 = bflo(fv[j].y), f3 = bfhi(fv[j].y); sf += (f0 * f0 + f1 * f1) + (f2 * f2 + f3 * f3); }
            const float r1 = 1.0f / sqrtf(wave_sum(ss) * (1.0f / DM) + EPS), r2 = 1.0f / sqrtf(wave_sum(sf) * (1.0f / DM) + EPS);
#pragma unroll
            for (int j = 0; j < 16; ++j) { const f32x4 v1 = *(const LAS f32x4*)(V1 + j * 256 + lane * 4), v2 = *(const LAS f32x4*)(V2 + j * 256 + lane * 4);
                f32x4 h = {bflo(hv[j].x), bfhi(hv[j].x), bflo(hv[j].y), bfhi(hv[j].y)}, f = {bflo(fv[j].x), bfhi(fv[j].x), bflo(fv[j].y), bfhi(fv[j].y)};
                const f32x4 x1 = xv[j] + v1 * h * r1;
                __builtin_nontemporal_store(x1 + v2 * f * r2, (GAS f32x4*)(out + (size_t)m * DM + j * 256 + lane * 4)); }
        }
    }
}
struct Args { const float* in[17]; float* out; unsigned char* ws; int ph_lo, ph_hi, grid, pad; };
#define KARGP() const __attribute__((address_space(4))) char* kp = (const __attribute__((address_space(4))) char*)__builtin_amdgcn_kernarg_segment_ptr(); asm volatile("" : "+s"(kp))
#define INP(i) (*(const float* const __attribute__((address_space(4)))*)(kp + 8 * (i)))
#define OUTP() (*(float* const __attribute__((address_space(4)))*)(kp + 136))
#define WSP(T, off) ((T*)(*(unsigned char* const __attribute__((address_space(4)))*)(kp + 144) + (off)))
#define KINT(off) (*(const int __attribute__((address_space(4)))*)(kp + (off)))
#define TIDS() const int tid = opaque_tid(wave_s), lane = tid & 63, wave = wave_s
#ifndef PH_MASK
#define PH_MASK 0x3ff
#endif
#define REPS(k) for (int rep_ = 0; rep_ < 1 + (((DUP_MASK) >> (k)) & 1); ++rep_)
#define IN(k) ((((PHM) >> (k)) & 1) != 0)
#if STAMP_PROBE
#define STAMP(k) if (tid == 0) WSP(unsigned long long, 65536)[(k) * 256 + bid] = __builtin_amdgcn_s_memrealtime()
#else
#define STAMP(k) (void)0
#endif
#define SEAM(k) do { KARGP(); if (IN(k) && IN((k) + 1)) { const int tid = opaque_tid(wave_s); STAMP(k); XcdBarrier bar; bar.bar = WSP(unsigned, WS_CTL) + CW_BAR; bar.x = xb_xcc_id(); bar.st = (volatile LAS unsigned*)(lds + MISC_OFF) + 8; xcd_barrier(bar, tid); STAMP((k) + 12); } } while (0)
#define SEAML(k, slot) do { KARGP(); if (IN(k) && IN((k) + 1)) { const int tid = opaque_tid(wave_s); const bool loc = (XCD_LOCAL_SEAMS != 0) && __hip_atomic_load(WSP(unsigned, WS_CTL) + CW_BAD, __ATOMIC_RELAXED, __HIP_MEMORY_SCOPE_AGENT) == 0u; \
    if (loc) { STAMP(k); xcd_local_seam(WSP(unsigned, WS_CTL), slot, bid, KINT(160), tid); STAMP((k) + 12); } else { SEAM(k); } } } while (0)
template <int PHM> __global__ void __launch_bounds__(NWAVES * 64, 2) hymba_fwd(Args args) {
    constexpr bool HAS_SEAM = (PHM & (PHM >> 1)) != 0;
    extern __shared__ __attribute__((aligned(16))) unsigned char lds_raw[];
    LAS unsigned char* lds = (LAS unsigned char*)lds_raw;
    const int wave_s = __builtin_amdgcn_readfirstlane((int)(threadIdx.x >> 6));
    const int bid = blockIdx.x;
    { KARGP(); TIDS(); (void)lane; (void)wave;
      for (int u = tid; u < (LDS_BYTES - LDSCTL_OFF) / 4; u += NWAVES * 64) ((LAS unsigned*)(lds + LDSCTL_OFF))[u] = 0u;
      __syncthreads();
      if (HAS_SEAM) { (void)xcd_barrier_post(WSP(unsigned, WS_CTL) + CW_BAR, (volatile LAS unsigned*)(lds + MISC_OFF) + 8, tid); xcd_local_check(WSP(unsigned, WS_CTL), bid, KINT(160), tid); } }

    { KARGP(); if (IN(0)) { TIDS(); const int G = KINT(160); P0Args A{INP(1), INP(2), INP(3), INP(5), INP(10), INP(13), INP(14), INP(15), WSP(float, WS_MOD), WSP(bf16, WS_WF), WSP(bf16, WS_WIN), WSP(bf16, WS_WOUT), WSP(bf16, WS_WGU), WSP(bf16, WS_WD)};
        p0_prologue(lds, A, G, bid, tid, wave, lane); } }
    SEAM(0);
    { KARGP(); if (IN(1)) REPS(1) { TIDS(); const int G = KINT(160); p1_norm1(lds, INP(0), INP(4), WSP(float, WS_MOD), WSP(bf16, WS_WF), WSP(bf16, WS_H), WSP(float, WS_FT), G, bid, tid, wave, lane); } }
    SEAM(1);
    { KARGP(); if (IN(2)) REPS(2) { const int G = KINT(160);
        if (bid < BATCH * NH) { TIDS(); p2_scan(lds, WSP(float, WS_FT), INP(6), WSP(float, WS_FB), bid, tid, wave, lane); STAMP(21); }
        pg8::Gemm g{WSP(bf16, WS_H), WSP(bf16, WS_WIN), M, NPROJ, DM}; pg8::StaticOrder S; S.init(M, NPROJ, G, bid); S.wgm = P2_WGM;
        pg8::EpiInProj E{WSP(bf16, WS_Q), WSP(bf16, WS_K), WSP(bf16, WS_V), WSP(bf16, WS_GB), WSP(bf16, WS_CU), QSCALE, WSP(unsigned, WS_CTL) + CW_QKMAX};
        pg8::gemm_phase<pg8::EpiInProj, pg8::StaticOrder, PG8_ALIGN, PG8_SP2>(lds, g, S, E, opaque_tid(wave_s)); } }
    SEAM(2);
    { KARGP(); if (IN(3)) { fa::attn_phase((char*)lds_raw, WSP(bf16, WS_Q), WSP(float, WS_FB), WSP(unsigned, WS_CTL) + CW_QKMAX, WSP(unsigned, WS_CTL) + CW_QHEAD, opaque_tid(wave_s)); } }
    SEAM(3);
#if FA_SELFCHECK
    { KARGP(); fa::attn_phase((char*)lds_raw, WSP(bf16, WS_Q), WSP(float, WS_FB), WSP(unsigned, WS_CTL) + CW_QKMAX, WSP(unsigned, WS_CTL) + CW_QHEAD + 64, opaque_tid(wave_s), false, 6); }
    SEAM(3);
    { KARGP(); TIDS(); (void)lane; (void)wave; const unsigned short* a = (const unsigned short*)WSP(bf16, WS_YA); const unsigned short* b = (const unsigned short*)WSP(bf16, WS_HM); unsigned bad = 0;
      for (size_t i = (size_t)bid * 512 + tid; i < (size_t)M * 2048; i += (size_t)KINT(160) * 512) { const float x = __uint_as_float((unsigned)a[i] << 16), y = __uint_as_float((unsigned)b[i] << 16);
          const float tol = fmaxf(fabsf(y), 1e-30f) * (1.0f / 100.0f);
          if (!(fabsf(x - y) <= tol)) bad++; }
      if (bad) __hip_atomic_fetch_add(WSP(unsigned, WS_CTL) + CW_QHEAD + 128, bad, __ATOMIC_RELAXED, __HIP_MEMORY_SCOPE_AGENT); }
    SEAM(3);
#endif
    { KARGP(); if (IN(4)) REPS(4) { TIDS(); const int G = KINT(160); p4_ynorm_conv(lds, WSP(bf16, WS_YA), WSP(bf16, WS_GB), WSP(bf16, WS_CU), INP(7), INP(8), INP(9), WSP(bf16, WS_H), G, bid, tid, wave, lane); } }
    SEAML(4, 0);
    { KARGP(); if (IN(5)) REPS(5) { const int G = KINT(160);
        pg8::Gemm g{WSP(bf16, WS_H), WSP(bf16, WS_WOUT), M, DM, DM}; pg8::StaticOrder S; S.init(M, DM, G, bid); S.wgm = P5_WGM;
        pg8::EpiPlain E{WSP(bf16, WS_HM), DM};
        pg8::gemm_phase<pg8::EpiPlain, pg8::StaticOrder, PG8_ALIGN, PG8_SP2>(lds, g, S, E, opaque_tid(wave_s)); } }
    SEAML(5, 1);
    { KARGP(); if (IN(6)) REPS(6) { TIDS(); const int G = KINT(160); p6_resid1(lds, INP(0), WSP(bf16, WS_HM), WSP(float, WS_MOD), INP(11), INP(12), WSP(bf16, WS_H), G, bid, tid, wave, lane); } }
    SEAM(6);
    { KARGP(); if (IN(7)) REPS(7) { const int G = KINT(160);
        constexpr int NU7 = (M / 256) * (NGU / 256);
        const bool endgame = (P7_ENDGAME != 0) && (G == 256) && (NU7 == 21 * 256 + 128);
        pg8::Gemm g{WSP(bf16, WS_H), WSP(bf16, WS_WGU), M, NGU, DM}; pg8::StaticOrder S; S.init(M, NGU, G, bid); S.wgm = P7_WGM; if (endgame) S.imax = 21;
        pg8::EpiSwiGLU E{WSP(bf16, WS_ACT), DFF};
        pg8::gemm_phase<pg8::EpiSwiGLU, pg8::StaticOrder, P7_ALIGN, PG8_SP2>(lds, g, S, E, opaque_tid(wave_s));
        if (endgame) {
            { TIDS(); (void)tid; if (wave == 0) { const int c = p7_claim(WSP(unsigned, WS_CTL), bid, lane); if (lane == 0) *(volatile LAS int*)(lds + LDSCTL_OFF) = c; } }
            __syncthreads();
            const int c = __builtin_amdgcn_readfirstlane(*(volatile LAS int*)(lds + LDSCTL_OFF));
            if (c >= 0) { pg8::OneUnit S1; S1.S.init(M, NGU, 256, c); S1.S.wgm = P7_WGM; S1.i0 = 21;
                pg8::gemm_phase<pg8::EpiSwiGLU, pg8::OneUnit, P7_ALIGN, PG8_SP2>(lds, g, S1, E, opaque_tid(wave_s)); }
            { TIDS(); (void)tid; convert_w_down_dyn(INP(15), WSP(bf16, WS_WD), WSP(unsigned, WS_CTL) + CW_CV, bid, wave, lane); }
        } else {
            const int rem = NU7 % G, first_idle = (rem == 0) ? 0 : rem, nidle = G - first_idle;
            if (bid >= first_idle) { TIDS(); (void)tid; convert_w_down(INP(15), WSP(bf16, WS_WD), bid - first_idle, nidle, wave, lane); } } } }
    SEAM(7);
    { KARGP(); if (IN(8)) REPS(8) { const int G = KINT(160);
        pg8::Gemm g{WSP(bf16, WS_ACT), WSP(bf16, WS_WD), M, DM, DFF}; pg8::StaticOrder S; S.init(M, DM, G, bid); S.wgm = P8_WGM;
        pg8::EpiPlain E{WSP(bf16, WS_H), DM};
        pg8::gemm_phase<pg8::EpiPlain, pg8::StaticOrder, PG8_ALIGN, PG8_SP2>(lds, g, S, E, opaque_tid(wave_s)); } }
    SEAML(8, 2);
    { KARGP(); if (IN(9)) { TIDS(); const int G = KINT(160); p9_final(lds, INP(0), WSP(bf16, WS_HM), WSP(bf16, WS_H), WSP(float, WS_MOD), INP(11), INP(16), OUTP(), G, bid, tid, wave, lane); } }
#if STAMP_PROBE == 8
    { KARGP(); const int tid = opaque_tid(wave_s); if (tid == 0) __hip_atomic_fetch_add(WSP(unsigned, WS_CTL) + CW_QHEAD + 40, *(volatile LAS unsigned*)(lds + LDSCTL_OFF + 16), __ATOMIC_RELAXED, __HIP_MEMORY_SCOPE_AGENT); }
#endif
#if STAMP_PROBE
    { KARGP(); const int tid = opaque_tid(wave_s); STAMP(9); XcdBarrier bar; bar.bar = WSP(unsigned, WS_CTL) + CW_BAR; bar.x = xb_xcc_id(); bar.st = (volatile LAS unsigned*)(lds + MISC_OFF) + 8; xcd_barrier(bar, tid);
      if (bid == 0) { LAS int* sh = (LAS int*)lds; const unsigned long long* st = WSP(unsigned long long, 65536);
          if (tid < 66) sh[tid] = (tid == 65) ? -2000000000 : 0;
          __syncthreads();
          for (int k = (STAMP_PROBE == 1 ? 4 : 0); k <= (STAMP_PROBE == 3 ? -1 : 9); ++k) { if (!(((STAMP_MASK) >> k) & 1)) continue;
              if (tid < 64) sh[128 + tid] = -2000000000; if (tid == 64) { sh[192] = 0; sh[193] = -2000000000; }
              __syncthreads();
              if (tid < 256) { const int v = (int)(long long)(st[k * 256 + tid] - st[k * 256]); const int g = 8 * (tid & 7) + ((tid >> 3) & 7);
                  __hip_atomic_fetch_max(sh + 128 + g, v, __ATOMIC_RELAXED, __HIP_MEMORY_SCOPE_WORKGROUP); __hip_atomic_fetch_add(sh + 192, v, __ATOMIC_RELAXED, __HIP_MEMORY_SCOPE_WORKGROUP); }
              __syncthreads();
              if (tid < 64) { const int Lg = sh[128 + tid] * 256 - sh[192]; sh[tid] += Lg; __hip_atomic_fetch_max(sh + 193, Lg, __ATOMIC_RELAXED, __HIP_MEMORY_SCOPE_WORKGROUP); }
              __syncthreads();
              if (tid == 0) sh[64] += sh[193];
              __syncthreads(); }
#if STAMP_PROBE == 3
          if (tid == 0) sh[64] = 0;
          __syncthreads();
          for (int k = 0; k <= 9; ++k) { if (!(((STAMP_MASK) >> k) & 1)) continue;
              if (tid < 16) sh[200 + tid] = (tid == 2 || tid == 3) ? -2000000000 : (tid == 4) ? 2000000000 : 0;
              __syncthreads();
              const int v = (tid < 256) ? (int)(long long)(st[k * 256 + tid] - st[k * 256]) : 0;
              if (tid < 256) { const int h = tid >> 7; __hip_atomic_fetch_add(sh + 200 + h, v, __ATOMIC_RELAXED, __HIP_MEMORY_SCOPE_WORKGROUP); __hip_atomic_fetch_max(sh + 202 + h, v, __ATOMIC_RELAXED, __HIP_MEMORY_SCOPE_WORKGROUP);
                  __hip_atomic_fetch_min(sh + 204, v, __ATOMIC_RELAXED, __HIP_MEMORY_SCOPE_WORKGROUP); __hip_atomic_fetch_add(sh + 208 + (tid & 7), v, __ATOMIC_RELAXED, __HIP_MEMORY_SCOPE_WORKGROUP); }
              __syncthreads();
              if (tid < 256 && STAMP_STAT == 6 && v * 256 > sh[200] + sh[201] + 256 * (STAMP_THR)) __hip_atomic_fetch_add(sh + 205, 1, __ATOMIC_RELAXED, __HIP_MEMORY_SCOPE_WORKGROUP);
              if (STAMP_STAT == 7 && k > 0) { if (tid == 0) sh[207] = -2000000000; __syncthreads();
                  if (tid < 256) __hip_atomic_fetch_max(sh + 207, (int)(long long)(st[(k - 1) * 256 + tid] - st[k * 256]), __ATOMIC_RELAXED, __HIP_MEMORY_SCOPE_WORKGROUP);
                  __syncthreads(); if (tid == 0) { const int mx = sh[202] > sh[203] ? sh[202] : sh[203]; sh[206] = 256 * (mx - sh[207]); } }
              __syncthreads();
              if (tid == 0) { const int sl = sh[200], shh = sh[201], sa = sl + shh; int r = 0;
                  if (STAMP_STAT == 1) r = sh[202] * 256 - 2 * sl; else if (STAMP_STAT == 2) r = sh[203] * 256 - 2 * shh; else if (STAMP_STAT == 3) r = 2 * sl - 2 * shh; else if (STAMP_STAT == 4) r = sa - 256 * sh[204];
                  else if (STAMP_STAT == 5) { int mx = -2000000000; for (int x = 0; x < 8; ++x) mx = sh[208 + x] > mx ? sh[208 + x] : mx; r = 8 * mx - sa; }
                  else if (STAMP_STAT == 6) r = sh[205] * 256 * 100;
                  else if (STAMP_STAT == 7) r = sh[206];
                  sh[64] += r; }
              __syncthreads(); }
#endif
          if (tid < 64) __hip_atomic_fetch_max(sh + 65, sh[tid], __ATOMIC_RELAXED, __HIP_MEMORY_SCOPE_WORKGROUP);
          __syncthreads();
#if STAMP_PROBE == 5
          if (tid == 0) { sh[64] = 0; sh[66] = -2000000000; sh[67] = 2000000000; }
          __syncthreads();
          if (tid < 256) { const int e = (int)(long long)(st[11 * 256 + tid] - st[11 * 256]), g = (int)(long long)(st[10 * 256 + tid] - st[11 * 256]), a = (int)(long long)(st[tid] - st[11 * 256]);
              __hip_atomic_fetch_add(sh + 64, STAMP_STAT == 0 ? g - e : STAMP_STAT == 1 ? a - g : 0, __ATOMIC_RELAXED, __HIP_MEMORY_SCOPE_WORKGROUP);
              __hip_atomic_fetch_max(sh + 66, e, __ATOMIC_RELAXED, __HIP_MEMORY_SCOPE_WORKGROUP); __hip_atomic_fetch_min(sh + 67, e, __ATOMIC_RELAXED, __HIP_MEMORY_SCOPE_WORKGROUP); }
          __syncthreads();
          if (tid == 0 && STAMP_STAT == 2) sh[64] = 256 * (sh[66] - sh[67]);
          __syncthreads();
#endif
#if STAMP_PROBE == 6
          if (tid == 0) sh[64] = 0;
          __syncthreads();
          for (int k = 0; k <= 8; ++k) { if (!(((STAMP_MASK) >> k) & 1)) continue;
              if (tid == 0) { sh[66] = -2000000000; sh[67] = -2000000000; sh[68] = 2000000000; }
              __syncthreads();
              if (tid < 256) { __hip_atomic_fetch_max(sh + 66, (int)(long long)(st[k * 256 + tid] - st[k * 256]), __ATOMIC_RELAXED, __HIP_MEMORY_SCOPE_WORKGROUP);
                  const int o = (int)(long long)(st[(k + 12) * 256 + tid] - st[k * 256]);
                  __hip_atomic_fetch_max(sh + 67, o, __ATOMIC_RELAXED, __HIP_MEMORY_SCOPE_WORKGROUP); __hip_atomic_fetch_min(sh + 68, o, __ATOMIC_RELAXED, __HIP_MEMORY_SCOPE_WORKGROUP); }
              __syncthreads();
              if (tid == 0) sh[64] += 256 * ((STAMP_STAT == 0 ? sh[67] : sh[68]) - sh[66]);
              __syncthreads(); }
#endif
#if STAMP_PROBE == 7
          if (tid == 0) sh[64] = 32 * (int)__hip_atomic_load(WSP(unsigned, WS_CTL) + CW_BAR + XB_TMO + 64, __ATOMIC_RELAXED, __HIP_MEMORY_SCOPE_AGENT);
          __syncthreads();
#endif
#if STAMP_PROBE == 8
          if (tid == 0) sh[64] = (int)__hip_atomic_load(WSP(unsigned, WS_CTL) + CW_QHEAD + 40, __ATOMIC_RELAXED, __HIP_MEMORY_SCOPE_AGENT);
          __syncthreads();
#endif
#if STAMP_PROBE == 10
          if (tid == 0) sh[64] = 0;
          __syncthreads();
          if (tid < 32) __hip_atomic_fetch_add(sh + 64, 8 * (int)(long long)(st[21 * 256 + tid] - st[13 * 256 + tid]), __ATOMIC_RELAXED, __HIP_MEMORY_SCOPE_WORKGROUP);
          __syncthreads();
#endif
#if STAMP_PROBE == 9
          if (tid == 0) sh[64] = (__hip_atomic_load(WSP(unsigned, WS_CTL) + CW_BAD, __ATOMIC_RELAXED, __HIP_MEMORY_SCOPE_AGENT) != 0u) ? 256 * 20000 : 0;
          __syncthreads();
#endif
#if STAMP_PROBE == 4
          if (tid == 0) sh[64] = (int)__hip_atomic_load(WSP(unsigned, WS_CTL) + CW_QHEAD + 32, __ATOMIC_RELAXED, __HIP_MEMORY_SCOPE_AGENT);
          __syncthreads();
#endif
          if (tid == 0) { const long long t256 = (STAMP_PROBE == 1) ? (long long)(sh[64] - sh[65]) : (long long)sh[64]; const long long ticks = t256 * (STAMP_PROBE == 1 ? 16 : STAMP_MULT) / 256;
              const unsigned long long t0 = __builtin_amdgcn_s_memrealtime(); while ((long long)(__builtin_amdgcn_s_memrealtime() - t0) < ticks) __builtin_amdgcn_s_sleep(8); }
          __syncthreads(); }
      xcd_barrier(bar, tid); }
#endif
#if FA_SELFCHECK
    SEAM(8);
    { KARGP(); const int tid = opaque_tid(wave_s); if (bid == 0 && tid == 0 && __hip_atomic_load(WSP(unsigned, WS_CTL) + CW_QHEAD + 128, __ATOMIC_RELAXED, __HIP_MEMORY_SCOPE_AGENT) != 0u) OUTP()[0] = __builtin_nanf(""); }
#endif
}
#undef IN
#undef SEAM
#undef SEAML
#undef STAMP
#undef INP
#undef WSP
#undef OUTP
#undef KARGP
#undef KINT
#undef TIDS

typedef void (*kern_t)(Args);
template <int PHM> static bool set_attr() { return hipFuncSetAttribute((const void*)hymba_fwd<PHM>, hipFuncAttributeMaxDynamicSharedMemorySize, LDS_BYTES) == hipSuccess; }
extern "C" void kernel_launch(void* const* d_in, const int* in_sizes, int n_in, void* d_out, int out_size, void* d_ws, size_t ws_size, hipStream_t stream) {
    static int grid = 0;
#if MK_N_LAUNCHES == 1
    static const kern_t kerns[1] = {hymba_fwd<(PH_MASK)>};
#else
    static const kern_t kerns[N_PHASES] = {hymba_fwd<1>, hymba_fwd<2>, hymba_fwd<4>, hymba_fwd<8>, hymba_fwd<16>, hymba_fwd<32>, hymba_fwd<64>, hymba_fwd<128>, hymba_fwd<256>, hymba_fwd<512>};
#endif
    if (grid == 0) {
        if (n_in != 17 || in_sizes[0] != M * DM || out_size != M * DM || ws_size < WS_END) {
            fprintf(stderr, "kernel_launch: built for 17 inputs, x/out of %d floats, >= %zu bytes of workspace; got n_in %d, in0 %d, out %d, ws %zu; nothing launched\n", M * DM, (size_t)WS_END, n_in, n_in > 0 ? in_sizes[0] : -1, out_size, ws_size);
            grid = -1; return; }
        int dev = 0, cus = 0, per_cu = 0;
        if (hipGetDevice(&dev) != hipSuccess || hipDeviceGetAttribute(&cus, hipDeviceAttributeMultiprocessorCount, dev) != hipSuccess) { fprintf(stderr, "kernel_launch: device query failed\n"); grid = -1; return; }
#if MK_N_LAUNCHES == 1
        bool ok = set_attr<(PH_MASK)>();
#else
        bool ok = set_attr<1>() && set_attr<2>() && set_attr<4>() && set_attr<8>() && set_attr<16>() && set_attr<32>() && set_attr<64>() && set_attr<128>() && set_attr<256>() && set_attr<512>();
#endif
        if (!ok) { fprintf(stderr, "kernel_launch: hipFuncSetAttribute failed\n"); grid = -1; return; }
        if (hipOccupancyMaxActiveBlocksPerMultiprocessor(&per_cu, (const void*)kerns[0], NWAVES * 64, LDS_BYTES) != hipSuccess || per_cu < 1)
            fprintf(stderr, "kernel_launch: note: occupancy query reports %d workgroups per CU\n", per_cu);
        (void)hipGetLastError();
        grid = cus;
    }
    if (grid < 0) return;
    if (hipMemsetAsync((char*)d_ws + WS_CTL, 0, CTL_ZERO_BYTES, stream) != hipSuccess) { fprintf(stderr, "kernel_launch: memset failed\n"); return; }
    Args a{};
    for (int i = 0; i < 17; ++i) a.in[i] = (const float*)d_in[i];
    a.out = (float*)d_out; a.ws = (unsigned char*)d_ws; a.grid = grid; a.pad = 0; a.ph_lo = 0; a.ph_hi = N_PHASES;
    for (int li = 0; li < MK_N_LAUNCHES; ++li) {
        hipLaunchKernelGGL(kerns[li], dim3(grid), dim3(NWAVES * 64), LDS_BYTES, stream, a);
        const hipError_t le = hipPeekAtLastError();
        if (le != hipSuccess) { fprintf(stderr, "kernel_launch: launch %d failed: %s\n", li, hipGetErrorName(le)); break; }
    }
}
```
